# Optimizing an MI355X kernel written in HIP

```python
import math
import jax, jax.numpy as jnp
from jax import lax
import numpy as np

D_MODEL = 1024
BATCH = 8
SEQ = 2048
DEPTH = 4
DEC_BATCH = 128
DEC_SEQ = 4
PAST_LEN = 16384
PAGE_SIZE = 128

A_WIDTH = D_MODEL // 2
A_HEAD_DIM = 64
A_HEADS = A_WIDTH // A_HEAD_DIM
A_DECAY_LORA = 64
A_AAA_LORA = 64
A_MV_LORA = 32
A_GATE_LORA = 128
GN_EPS_A = 64e-5
B_WIDTH = D_MODEL - A_WIDTH
B_HEADS = 4
B_DV = B_WIDTH // B_HEADS
B_DK = B_DV // 2
B_KW = B_HEADS * B_DK
B_GATE_LORA = 16
GLA_LOGIT_NORM = 16.0
GLA_CHUNK = 64
RMS_EPS = 1e-5
D_FF = 2816
CONV_W = 3
ALPHA = (2 * DEPTH) ** 0.25
BETA = (8 * DEPTH) ** -0.25
LN_EPS = 1e-5
SHIFT_W = 3 * A_WIDTH + A_DECAY_LORA + A_AAA_LORA + A_GATE_LORA
GLA_IN_W = 2 * B_KW + 2 * B_WIDTH + B_GATE_LORA
IN_W = SHIFT_W + GLA_IN_W

kernel_name = 'hybrid_rwkv7_gla_convglu_step'


def split_cols(t, sizes):
    idx = np.cumsum(sizes)[:-1].tolist()
    return jnp.split(t, idx, axis=-1)


def layer_norm(x, g, b):
    xf = x.astype(jnp.float32)
    mu = jnp.mean(xf, -1, keepdims=True)
    var = jnp.mean(jnp.square(xf - mu), -1, keepdims=True)
    return ((xf - mu) * lax.rsqrt(var + LN_EPS) * g + b).astype(x.dtype)


def rwkv7_group(pa, pa_prev, S0, v_first, vmix, mu, w0, w_up, a0, a_up, g_up, k_k, k_a, r_k, lnx_g, lnx_b):
    f32 = jnp.float32
    pa = pa.astype(f32)
    B, T, _ = pa.shape
    prev = jnp.concatenate([pa_prev.astype(f32), pa[:, :-1]], axis=1)
    xs = pa + (prev - pa) * mu
    r, k, v, w_lo, a_lo, g_lo = split_cols(xs, [A_WIDTH, A_WIDTH, A_WIDTH, A_DECAY_LORA, A_AAA_LORA, A_GATE_LORA])
    w = -jax.nn.softplus(-(w0 + jnp.tanh(w_lo) @ w_up)) - 0.5
    decay = jnp.exp(-jnp.exp(w))
    a = jax.nn.sigmoid(a0 + a_lo @ a_up)
    g = jax.nn.sigmoid(g_lo) @ g_up
    if vmix is None:
        v_first = v
    else:
        v0, v1, v2 = vmix
        v = v + (v_first - v) * jax.nn.sigmoid(v0 + (v @ v1) @ v2)
    heads = lambda t: t.reshape(B, T, A_HEADS, A_HEAD_DIM)
    kk = heads(k * k_k)
    kk = kk * lax.rsqrt(jnp.maximum(jnp.sum(kk * kk, -1, keepdims=True), 1e-24))
    k = k * (1.0 + (a - 1.0) * k_a)
    rh, kh, vh, dh, ah = heads(r), heads(k), heads(v), heads(decay), heads(a)

    def step(S, inp):
        r_t, d_t, k_t, v_t, kk_t, a_t = inp
        sa = jnp.einsum('bhvk,bhk->bhv', S, -kk_t)
        S = (S * d_t[:, :, None, :] + sa[..., None] * (kk_t * a_t)[:, :, None, :]
             + v_t[..., None] * k_t[:, :, None, :])
        return S, jnp.einsum('bhvk,bhk->bhv', S, r_t)

    tm = lambda t: jnp.moveaxis(t, 1, 0)
    S, o = lax.scan(step, S0.astype(f32), (tm(rh), tm(dh), tm(kh), tm(vh), tm(kk), tm(ah)))
    o = jnp.moveaxis(o, 0, 1)
    m = jnp.mean(o, -1, keepdims=True)
    var = jnp.mean(jnp.square(o - m), -1, keepdims=True)
    o = ((o - m) * lax.rsqrt(var + GN_EPS_A)).reshape(B, T, A_WIDTH) * lnx_g + lnx_b
    bonus = (jnp.sum(rh * kh * r_k, -1, keepdims=True) * vh).reshape(B, T, A_WIDTH)
    return (o + bonus) * g, S, pa[:, -1:], v_first


def gla_chunked(q, k, v, gk, S0):
    B, T, H, K = q.shape
    V = v.shape[-1]
    C = math.gcd(T, GLA_CHUNK)
    NC = T // C
    chunks = lambda t: t.reshape(B, NC, C, H, t.shape[-1]).swapaxes(0, 1)
    mask = jnp.tril(jnp.ones((C, C), dtype=bool))

    def step(S, inp):
        qc, kc, vc, gc = inp
        b = jnp.cumsum(gc, axis=1)
        qt = qc * jnp.exp(b)
        kt = kc * jnp.exp(-b)
        A = jnp.where(mask, jnp.einsum('bthk,bshk->bhts', qt, kt), 0.0)
        o = jnp.einsum('bhts,bshv->bthv', A, vc) + jnp.einsum('bthk,bhkv->bthv', qt, S)
        b_last = b[:, -1]
        kd = kc * jnp.exp(b_last[:, None] - b)
        S = S * jnp.exp(b_last)[..., None] + jnp.einsum('bshk,bshv->bhkv', kd, vc)
        return S, o

    S, o = lax.scan(step, S0, (chunks(q), chunks(k), chunks(v), chunks(gk)))
    return o.swapaxes(0, 1).reshape(B, T, H, V), S


def gla_group(pg, S0, f_up, f_bias, norm_g):
    f32 = jnp.float32
    pg = pg.astype(f32)
    B, T, _ = pg.shape
    q, k, v, g, f_lo = split_cols(pg, [B_KW, B_KW, B_WIDTH, B_WIDTH, B_GATE_LORA])
    gk = jax.nn.log_sigmoid(f_lo @ f_up + f_bias) / GLA_LOGIT_NORM
    hk = lambda t: t.reshape(B, T, B_HEADS, B_DK)
    o, S = gla_chunked(hk(q) * B_DK ** -0.5, hk(k), v.reshape(B, T, B_HEADS, B_DV), hk(gk), S0.astype(f32))
    o = o * lax.rsqrt(jnp.mean(o * o, -1, keepdims=True) + RMS_EPS) * norm_g
    return o.reshape(B, T, B_WIDTH) * jax.nn.silu(g), S


def conv_glu_ffn(x, conv_past, w_up, conv_w, conv_b, w_down):
    T = x.shape[1]
    gate, val = split_cols(x @ w_up, [D_FF, D_FF])
    padded = jnp.concatenate([conv_past.astype(gate.dtype), gate], axis=1)
    acc = conv_b
    for j in range(CONV_W):
        acc = acc + padded[:, j:j + T] * conv_w[j]
    h = jax.nn.gelu(acc, approximate=False) * val
    return h @ w_down, padded[:, T:]


def trunk(x, st_rwkv, st_shift, st_gla, st_conv, P):
    new_rwkv, new_shift, new_gla, new_conv = [], [], [], []
    v_first = None
    for l in range(DEPTH):
        proj = x @ P['w_in'][l]
        vmix = None if l == 0 else (P['vres_bias'][l - 1], P['vres_down'][l - 1], P['vres_up'][l - 1])
        oa, s_a, sh, v_first = rwkv7_group(
            proj[..., :SHIFT_W], st_shift[l], st_rwkv[l], v_first, vmix, P['tok_mu'][l],
            P['w0'][l], P['w_lora_up'][l], P['a0'][l], P['a_lora_up'][l], P['g_lora_up'][l],
            P['k_k'][l], P['k_a'][l], P['r_k'][l], P['lnx_g'][l], P['lnx_b'][l])
        ob, s_b = gla_group(proj[..., SHIFT_W:], st_gla[l], P['gla_f_up'][l], P['gla_f_bias'][l], P['gla_norm_g'][l])
        mix = jnp.concatenate([oa, ob], axis=-1).astype(x.dtype) @ P['w_out'][l]
        x = layer_norm(ALPHA * x + mix, P['ln1_g'][l], P['ln1_b'][l])
        f, cv = conv_glu_ffn(x, st_conv[l], P['w_up'][l], P['conv_w'][l], P['conv_b'][l], P['w_down'][l])
        x = layer_norm(ALPHA * x + f, P['ln2_g'][l], P['ln2_b'][l])
        new_rwkv.append(s_a)
        new_shift.append(sh)
        new_gla.append(s_b)
        new_conv.append(cv)
    return (x, jnp.stack(new_rwkv).astype(st_rwkv.dtype), jnp.stack(new_shift).astype(st_shift.dtype),
            jnp.stack(new_gla).astype(st_gla.dtype), jnp.stack(new_conv).astype(st_conv.dtype))


def setup_inputs(seed: int = 0) -> dict:
    key = jax.random.key(seed)
    ks = iter(jax.random.split(key, 40))
    f32 = jnp.float32
    nrm = lambda shape, s: jax.random.normal(next(ks), shape, f32) * s
    L = DEPTH
    x_prompt = nrm((BATCH, SEQ, D_MODEL), 1.0)
    x_sample = nrm((DEC_BATCH, DEC_SEQ, D_MODEL), 1.0)
    state_rwkv = nrm((L, DEC_BATCH, A_HEADS, A_HEAD_DIM, A_HEAD_DIM), 0.3)
    state_shift = nrm((L, DEC_BATCH, 1, SHIFT_W), 1.0)
    state_gla = nrm((L, DEC_BATCH, B_HEADS, B_DK, B_DV), 0.3)
    state_conv = nrm((L, DEC_BATCH, CONV_W - 1, D_FF), BETA)
    col_scale = np.ones(IN_W, np.float32)
    col_scale[2 * A_WIDTH:3 * A_WIDTH] = BETA
    gv0 = SHIFT_W + 2 * B_KW
    col_scale[gv0:gv0 + B_WIDTH] = BETA
    w_in = nrm((L, D_MODEL, IN_W), D_MODEL ** -0.5) * jnp.asarray(col_scale)
    tok_mu = jax.random.uniform(next(ks), (L, SHIFT_W), f32)
    w0 = jax.random.uniform(next(ks), (L, A_WIDTH), f32, -6.5, -1.5)
    w_lora_up = nrm((L, A_DECAY_LORA, A_WIDTH), 0.1)
    a0 = nrm((L, A_WIDTH), 0.1)
    a_lora_up = nrm((L, A_AAA_LORA, A_WIDTH), 0.1)
    g_lora_up = nrm((L, A_GATE_LORA, A_WIDTH), A_GATE_LORA ** -0.5)
    k_k = 0.85 + nrm((L, A_WIDTH), 0.02)
    k_a = 1.0 + nrm((L, A_WIDTH), 0.02)
    r_k = nrm((L, A_HEADS, A_HEAD_DIM), 0.1)
    lnx_g = 1.0 + nrm((L, A_WIDTH), 0.02)
    lnx_b = nrm((L, A_WIDTH), 0.02)
    vres_bias = 1.0 + nrm((L - 1, A_WIDTH), 0.1)
    vres_down = nrm((L - 1, A_WIDTH, A_MV_LORA), A_WIDTH ** -0.5)
    vres_up = nrm((L - 1, A_MV_LORA, A_WIDTH), 0.1)
    gla_f_up = nrm((L, B_GATE_LORA, B_KW), B_GATE_LORA ** -0.5)
    gla_f_bias = nrm((L, B_KW), 0.5)
    gla_norm_g = 1.0 + nrm((L, B_DV), 0.02)
    w_out = nrm((L, D_MODEL, D_MODEL), D_MODEL ** -0.5 * BETA)
    ln1_g = 1.0 + nrm((L, D_MODEL), 0.02)
    ln1_b = nrm((L, D_MODEL), 0.02)
    w_up = nrm((L, D_MODEL, 2 * D_FF), D_MODEL ** -0.5 * BETA)
    conv_w = nrm((L, CONV_W, D_FF), CONV_W ** -0.5)
    conv_b = nrm((L, D_FF), 0.02)
    w_down = nrm((L, D_FF, D_MODEL), D_FF ** -0.5 * BETA)
    ln2_g = 1.0 + nrm((L, D_MODEL), 0.02)
    ln2_b = nrm((L, D_MODEL), 0.02)
    return {'x_prompt': x_prompt, 'x_sample': x_sample, 'state_rwkv': state_rwkv,
            'state_shift': state_shift, 'state_gla': state_gla, 'state_conv': state_conv,
            'w_in': w_in, 'tok_mu': tok_mu, 'w0': w0, 'w_lora_up': w_lora_up, 'a0': a0,
            'a_lora_up': a_lora_up, 'g_lora_up': g_lora_up, 'k_k': k_k, 'k_a': k_a, 'r_k': r_k,
            'lnx_g': lnx_g, 'lnx_b': lnx_b, 'vres_bias': vres_bias, 'vres_down': vres_down,
            'vres_up': vres_up, 'gla_f_up': gla_f_up, 'gla_f_bias': gla_f_bias,
            'gla_norm_g': gla_norm_g, 'w_out': w_out, 'ln1_g': ln1_g, 'ln1_b': ln1_b,
            'w_up': w_up, 'conv_w': conv_w, 'conv_b': conv_b, 'w_down': w_down,
            'ln2_g': ln2_g, 'ln2_b': ln2_b}


def reference(x_prompt, x_sample, state_rwkv, state_shift, state_gla, state_conv,
              w_in, tok_mu, w0, w_lora_up, a0, a_lora_up, g_lora_up, k_k, k_a, r_k,
              lnx_g, lnx_b, vres_bias, vres_down, vres_up, gla_f_up, gla_f_bias, gla_norm_g,
              w_out, ln1_g, ln1_b, w_up, conv_w, conv_b, w_down, ln2_g, ln2_b):
    P = dict(w_in=w_in, tok_mu=tok_mu, w0=w0, w_lora_up=w_lora_up, a0=a0, a_lora_up=a_lora_up,
             g_lora_up=g_lora_up, k_k=k_k, k_a=k_a, r_k=r_k, lnx_g=lnx_g, lnx_b=lnx_b,
             vres_bias=vres_bias, vres_down=vres_down, vres_up=vres_up, gla_f_up=gla_f_up,
             gla_f_bias=gla_f_bias, gla_norm_g=gla_norm_g, w_out=w_out, ln1_g=ln1_g, ln1_b=ln1_b,
             w_up=w_up, conv_w=conv_w, conv_b=conv_b, w_down=w_down, ln2_g=ln2_g, ln2_b=ln2_b)
    zeros = lambda s: jnp.zeros((DEPTH, BATCH) + s.shape[2:], s.dtype)
    y_prompt, rwkv_p, shift_p, gla_p, conv_p = trunk(
        x_prompt, zeros(state_rwkv), zeros(state_shift), zeros(state_gla), zeros(state_conv), P)
    y_sample, rwkv_s, shift_s, gla_s, conv_s = trunk(
        x_sample, state_rwkv, state_shift, state_gla, state_conv, P)
    return (y_prompt, y_sample, rwkv_p, rwkv_s, shift_p, shift_s, gla_p, gla_s, conv_p, conv_s)
```

```cpp
#include <hip/hip_runtime.h>
#include <hip/hip_cooperative_groups.h>
#include <cstdio>
namespace cg = cooperative_groups;

#define PG8_LAS __attribute__((address_space(3)))
typedef unsigned short u16;
typedef unsigned int u32;
typedef unsigned short bf16_t;
typedef short bf16x8 __attribute__((ext_vector_type(8)));
typedef float f32x4 __attribute__((ext_vector_type(4)));
typedef float f32x2 __attribute__((ext_vector_type(2)));
typedef unsigned u32x4 __attribute__((ext_vector_type(4)));
typedef unsigned u32x2 __attribute__((ext_vector_type(2)));

constexpr int MTOK = 16896, MP = 16384, DM = 1024, NL = 4;
constexpr int SHIFT_W = 1792, INP = 3584, DFF = 2816;
constexpr float ALPHA = 1.6817928305074290f;
constexpr float GN_EPS_A = 64e-5f, RMS_EPS = 1e-5f, LN_EPS = 1e-5f;
constexpr int LDS_BYTES = 139264;
constexpr int TC = 32;

enum { I_XP = 0, I_XS, I_SRWKV, I_SSHIFT, I_SGLA, I_SCONV, I_WIN, I_MU, I_W0, I_WLU, I_A0, I_ALU, I_GLU, I_KK, I_KA, I_RK, I_LNXG, I_LNXB,
       I_VB, I_VD, I_VU, I_FUP, I_FB, I_NG, I_WOUT, I_LN1G, I_LN1B, I_WUP, I_CW, I_CB, I_WDOWN, I_LN2G, I_LN2B };

constexpr size_t O_Y = 0;
constexpr size_t O_RWKV_P = (size_t)MTOK * DM;
constexpr size_t O_RWKV_S = O_RWKV_P + (size_t)4 * 8 * 8 * 4096;
constexpr size_t O_SHIFT_P = O_RWKV_S + (size_t)4 * 128 * 8 * 4096;
constexpr size_t O_SHIFT_S = O_SHIFT_P + (size_t)4 * 8 * 1792;
constexpr size_t O_GLA_P = O_SHIFT_S + (size_t)4 * 128 * 1792;
constexpr size_t O_GLA_S = O_GLA_P + (size_t)4 * 8 * 4 * 8192;
constexpr size_t O_CONV_P = O_GLA_S + (size_t)4 * 128 * 4 * 8192;
constexpr size_t O_CONV_S = O_CONV_P + (size_t)4 * 8 * 2 * 2816;
constexpr size_t O_END = O_CONV_S + (size_t)4 * 128 * 2 * 2816;

constexpr size_t W_WIN = 0;
constexpr size_t W_WOUT = W_WIN + (size_t)INP * 1024 * 2;
constexpr size_t W_WUP = W_WOUT + (size_t)1024 * 1024 * 2;
constexpr size_t W_WDOWN = W_WUP + (size_t)5632 * 1024 * 2;
constexpr size_t W_WLT = W_WDOWN + (size_t)1024 * 2816 * 2;
constexpr size_t W_ALT = W_WLT + 512 * 64 * 2;
constexpr size_t W_GLT = W_ALT + 512 * 64 * 2;
constexpr size_t W_V1T = W_GLT + 512 * 128 * 2;
constexpr size_t W_V2T = W_V1T + 32 * 512 * 2;
constexpr size_t W_FT = W_V2T + 512 * 32 * 2;
constexpr size_t W_XB = W_FT + 256 * 32 * 2;
constexpr size_t W_VFIRST = W_XB + (size_t)MTOK * 1024 * 2;
constexpr size_t W_BUFB = W_VFIRST + (size_t)MTOK * 512 * 2;
constexpr size_t W_R = W_BUFB + (size_t)MTOK * 1024 * 4;
constexpr size_t W_PROJA = W_R;
constexpr size_t W_PROJB = W_PROJA + (size_t)MTOK * 1792 * 2;
constexpr size_t W_D8 = W_PROJB + (size_t)MTOK * 1792 * 2;
constexpr size_t W_VBUF = W_D8 + (size_t)MTOK * 512 * 4;
constexpr size_t W_GBUF = W_VBUF + (size_t)MTOK * 512 * 2;
constexpr size_t W_DEC = W_GBUF + (size_t)MTOK * 512 * 2;
constexpr size_t W_RK = W_DEC + (size_t)MTOK * 256 * 4;
constexpr size_t W_END1 = W_RK + (size_t)MTOK * 8 * 4;
constexpr size_t W_GATE = W_R;
constexpr size_t W_VAL = W_GATE + (size_t)MTOK * 2816 * 2;
constexpr size_t W_END2 = W_VAL + (size_t)MTOK * 2816 * 2;
constexpr size_t W_END = W_END1 > W_END2 ? W_END1 : W_END2;
constexpr size_t W_OBUFA = W_PROJA;
constexpr size_t W_OBUFB = W_PROJA + (size_t)MTOK * 512 * 2;

struct Params { const float* in[33]; float* out; unsigned char* ws; };

__device__ __forceinline__ unsigned cvt_pk_bf16(float lo, float hi) { unsigned r; asm volatile("v_cvt_pk_bf16_f32 %0, %1, %2" : "=v"(r) : "v"(lo), "v"(hi)); return r; }
__device__ __forceinline__ float bflo(u32 w) { return __uint_as_float(w << 16); }
__device__ __forceinline__ float bfhi(u32 w) { return __uint_as_float(w & 0xffff0000u); }
__device__ __forceinline__ f32x4 ld_bf4(const u16* p) { const u32x2 w = *(const u32x2*)p; return (f32x4){bflo(w.x), bfhi(w.x), bflo(w.y), bfhi(w.y)}; }
__device__ __forceinline__ void st_bf4(u16* p, f32x4 v) { u32x2 w; w.x = cvt_pk_bf16(v[0], v[1]); w.y = cvt_pk_bf16(v[2], v[3]); *(u32x2*)p = w; }
__device__ __forceinline__ float sigmoidf_(float x) { return 1.0f / (1.0f + __expf(-x)); }
__device__ __forceinline__ float softplusf_(float x) { return fmaxf(x, 0.f) + log1pf(__expf(-fabsf(x))); }
template <int CTRL> __device__ __forceinline__ float dppf(float x) { return __builtin_bit_cast(float, __builtin_amdgcn_update_dpp(0, __builtin_bit_cast(int, x), CTRL, 0xF, 0xF, true)); }
__device__ __forceinline__ float red16(float x) { x += dppf<0xB1>(x); x += dppf<0x4E>(x); x += dppf<0x141>(x); x += dppf<0x140>(x); return x; }

__device__ __forceinline__ int opaque_tid() { int t = threadIdx.x; asm volatile("" : "+v"(t)); return t; }
__device__ __forceinline__ int opaque_bid() { int b = blockIdx.x; asm volatile("" : "+s"(b)); return b; }

namespace pg8 {
constexpr int BM = 256, BK = 64, HALF = 128, HTB = HALF * BK * 2, STAGE_BYTES = 8 * HTB, NXCD = 8, WGM = 8;
__host__ __device__ __forceinline__ int lds_byte(int r, int c) { const int st = (r >> 4) * 2 + (c >> 5), rr = r & 15, cc = c & 31, ob = rr * 64 + cc * 2; return st * 1024 + (ob ^ (((ob >> 9) & 1) << 5)); }
__host__ __device__ __forceinline__ void stage_rc(int b, int& R, int& C) { const int st = b / 1024, sb = b % 1024, swz = sb ^ (((sb >> 9) & 1) << 5); R = (st >> 1) * 16 + swz / 64; C = (st & 1) * 32 + (swz % 64) / 2; }
struct Unit { int pm, pn; };
struct Gemm { const bf16_t* A; const bf16_t* Bt; int M, N, K; };
struct StaticOrder {
    int nM, nN, nwg, G, c;
    __host__ __device__ void init(int M, int N, int G_, int c_) { nM = M / BM; nN = N / BM; nwg = nM * nN; G = G_; c = c_; }
    __host__ __device__ bool next(int i, Unit& u) const {
        const long L = (long)i * G + c; if (L >= nwg) return false;
        int wgid = (int)L; { const int q = nwg / NXCD, r = nwg % NXCD, xcd = wgid % NXCD, off = wgid / NXCD; wgid = (xcd < r ? xcd * (q + 1) : r * (q + 1) + (xcd - r) * q) + off; }
        const int nig = WGM * nN, gid = wgid / nig, fm = gid * WGM, gsz = (nM - fm) < WGM ? (nM - fm) : WGM;
        u.pm = fm + ((wgid % nig) % gsz); u.pn = (wgid % nig) / gsz; return true;
    }
};

template <class Epi>
__device__ __forceinline__ void gemm_phase(PG8_LAS unsigned char* lds, const Gemm g, const StaticOrder& S, const Epi& E) {
    const int tid = opaque_tid(), wid = __builtin_amdgcn_readfirstlane(tid >> 6), lane = tid & 63, wr = wid >> 2, wc = wid & 3, fr = lane & 15, fq = lane >> 4;
    const int K = g.K, nt = K / BK;
    unsigned voffA[2], voffB[2];
#pragma unroll
    for (int i = 0; i < 2; ++i) { int R, C; stage_rc(tid * 16 + i * 8192, R, C); voffA[i] = (unsigned)(R * K + C) * 2u; voffB[i] = voffA[i]; }
    const size_t kstep = (size_t)(BK * 2);
    const size_t hstep = (size_t)HALF * K * 2;
    const size_t tstep = 2 * hstep;
    const unsigned ldsw = (unsigned)wid * 1024u;
    const int aoff = lds_byte(wr * 64 + fr, fq * 8), boff = lds_byte(wc * 32 + fr, fq * 8);
#define PG8_SA(b, h) (((b) * 2 + (h)) * HTB)
#define PG8_SB(b, h) ((4 + (b) * 2 + (h)) * HTB)
#define PG8_STAGE(bufoff, gbase, voff) do { _Pragma("unroll") for (int _i = 0; _i < 2; ++_i) \
        __builtin_amdgcn_global_load_lds((const unsigned*)((const char*)(gbase) + (voff)[_i]), (PG8_LAS unsigned*)(lds + (bufoff) + ldsw + _i * 8192), 16, 0, 0); } while (0)
#define PG8_LDA(dst, b, h) do { _Pragma("unroll") for (int m = 0; m < 4; ++m) _Pragma("unroll") for (int k = 0; k < 2; ++k) dst[m][k] = *(const PG8_LAS bf16x8*)(lds + PG8_SA(b, h) + aoff + m * 2048 + k * 1024); } while (0)
#define PG8_LDB(dst, b, h) do { _Pragma("unroll") for (int n = 0; n < 2; ++n) _Pragma("unroll") for (int k = 0; k < 2; ++k) dst[n][k] = *(const PG8_LAS bf16x8*)(lds + PG8_SB(b, h) + boff + n * 2048 + k * 1024); } while (0)
#define PG8_MMA(ai, bj, At, Bt) do { __builtin_amdgcn_s_setprio(1); _Pragma("unroll") for (int m = 0; m < 4; ++m) _Pragma("unroll") for (int n = 0; n < 2; ++n) _Pragma("unroll") for (int k = 0; k < 2; ++k) \
        acc[ai][bj][m][n] = __builtin_amdgcn_mfma_f32_16x16x32_bf16(Bt[n][k], At[m][k], acc[ai][bj][m][n], 0, 0, 0); __builtin_amdgcn_s_setprio(0); } while (0)
#define PG8_WAIT_V(n) asm volatile("s_waitcnt vmcnt(" #n ")" ::: "memory")
#define PG8_WAIT_L(n) asm volatile("s_waitcnt lgkmcnt(" #n ")" ::: "memory")
#define PG8_BAR __builtin_amdgcn_s_barrier()
#define PG8_SCHED __builtin_amdgcn_sched_barrier(0)
    Unit cur, nxt; int ui = 0;
    if (!S.next(0, cur)) return;
    f32x4 acc[2][2][4][2];
#pragma unroll
    for (int a = 0; a < 2; ++a)
#pragma unroll
        for (int b = 0; b < 2; ++b)
#pragma unroll
            for (int m = 0; m < 4; ++m)
#pragma unroll
                for (int n = 0; n < 2; ++n) acc[a][b][m][n] = (f32x4){0.f, 0.f, 0.f, 0.f};
    bf16x8 At[4][2], B0[2][2], B1[2][2];
    const char* cA = (const char*)g.A + (size_t)cur.pm * tstep; const char* cB = (const char*)g.Bt + (size_t)cur.pn * tstep;
    PG8_STAGE(PG8_SB(0, 0), cB, voffB); PG8_STAGE(PG8_SA(0, 0), cA, voffA); PG8_STAGE(PG8_SB(0, 1), cB + hstep, voffB); PG8_STAGE(PG8_SA(0, 1), cA + hstep, voffA);
    if (wr == 1) PG8_BAR;
    PG8_WAIT_V(4); PG8_BAR;
    PG8_STAGE(PG8_SB(1, 0), cB + kstep, voffB); PG8_STAGE(PG8_SA(1, 0), cA + kstep, voffA); PG8_STAGE(PG8_SB(1, 1), cB + hstep + kstep, voffB);
    PG8_WAIT_V(6); PG8_BAR;
    for (;;) {
        const bool has_next = S.next(ui + 1, nxt);
        const char* nA = has_next ? (const char*)g.A + (size_t)nxt.pm * tstep : cA; const char* nB = has_next ? (const char*)g.Bt + (size_t)nxt.pn * tstep : cB;
        for (int t = 0; t < nt; t += 2) {
            const bool last = (t == nt - 2);
            const char* a1 = cA + (size_t)(t + 1) * kstep;
            const char* a2 = last ? nA : cA + (size_t)(t + 2) * kstep; const char* b2 = last ? nB : cB + (size_t)(t + 2) * kstep;
            const char* a3 = a2 + kstep; const char* b3 = b2 + kstep;
            PG8_LDB(B0, 0, 0); PG8_SCHED; PG8_LDA(At, 0, 0); PG8_STAGE(PG8_SA(1, 1), a1 + hstep, voffA);
            PG8_WAIT_L(8); PG8_BAR; PG8_WAIT_L(0); PG8_MMA(0, 0, At, B0); PG8_BAR; PG8_SCHED;
            PG8_LDB(B1, 0, 1); PG8_STAGE(PG8_SB(0, 0), b2, voffB);
            PG8_BAR; PG8_WAIT_L(0); PG8_MMA(0, 1, At, B1); PG8_BAR;
            PG8_LDA(At, 0, 1); PG8_STAGE(PG8_SA(0, 0), a2, voffA);
            PG8_BAR; PG8_WAIT_L(0); PG8_MMA(1, 0, At, B0); PG8_BAR; PG8_SCHED;
            PG8_STAGE(PG8_SB(0, 1), b2 + hstep, voffB);
            PG8_WAIT_V(6); PG8_BAR; PG8_MMA(1, 1, At, B1); PG8_BAR;
            PG8_LDB(B0, 1, 0); PG8_SCHED; PG8_LDA(At, 1, 0); PG8_STAGE(PG8_SA(0, 1), a2 + hstep, voffA);
            PG8_WAIT_L(8); PG8_BAR; PG8_WAIT_L(0); PG8_MMA(0, 0, At, B0); PG8_BAR; PG8_SCHED;
            PG8_LDB(B1, 1, 1); PG8_STAGE(PG8_SB(1, 0), b3, voffB);
            PG8_BAR; PG8_WAIT_L(0); PG8_MMA(0, 1, At, B1); PG8_BAR;
            PG8_LDA(At, 1, 1); PG8_STAGE(PG8_SA(1, 0), a3, voffA);
            PG8_BAR; PG8_WAIT_L(0); PG8_MMA(1, 0, At, B0); PG8_BAR; PG8_SCHED;
            PG8_STAGE(PG8_SB(1, 1), b3 + hstep, voffB);
            PG8_WAIT_V(6); PG8_BAR; PG8_MMA(1, 1, At, B1); PG8_BAR;
        }
        E(acc, cur, wr, wc, fr, fq);
        if (!has_next) break;
#pragma unroll
        for (int a = 0; a < 2; ++a)
#pragma unroll
            for (int b = 0; b < 2; ++b)
#pragma unroll
                for (int m = 0; m < 4; ++m)
#pragma unroll
                    for (int n = 0; n < 2; ++n) acc[a][b][m][n] = (f32x4){0.f, 0.f, 0.f, 0.f};
        cur = nxt; cA = nA; cB = nB; ++ui;
    }
    PG8_WAIT_V(0);
    if (wr == 0) PG8_BAR;
    PG8_BAR;
#undef PG8_SA
#undef PG8_SB
#undef PG8_STAGE
#undef PG8_LDA
#undef PG8_LDB
#undef PG8_MMA
#undef PG8_WAIT_V
#undef PG8_WAIT_L
#undef PG8_BAR
#undef PG8_SCHED
}
}
using pg8::Unit;

struct EpiProj {
    u16* projA; u16* projB; float* shift_p; float* shift_s;
    __device__ __forceinline__ void operator()(const f32x4 (&acc)[2][2][4][2], const Unit& u, int wr, int wc, int fr, int fq) const {
        const int row0 = u.pm * 256 + wr * 64 + fr;
        const bool isA = u.pn < 7;
        u16* base = isA ? projA : projB;
        const int colt = (isA ? u.pn : u.pn - 7) * 256 + wc * 32 + 4 * fq;
#pragma unroll
        for (int ai = 0; ai < 2; ++ai)
#pragma unroll
            for (int m = 0; m < 4; ++m) {
                const int row = row0 + ai * 128 + m * 16;
                u16* rowp = base + (size_t)row * 1792 + colt;
#pragma unroll
                for (int bj = 0; bj < 2; ++bj)
#pragma unroll
                    for (int n = 0; n < 2; ++n) st_bf4(rowp + bj * 128 + n * 16, acc[ai][bj][m][n]);
                if (isA) {
                    float* dst = nullptr;
                    if (row < MP) { if ((row & 2047) == 2047) dst = shift_p + (size_t)(row >> 11) * 1792; }
                    else { const int r = row - MP; if ((r & 3) == 3) dst = shift_s + (size_t)(r >> 2) * 1792; }
                    if (dst) {
#pragma unroll
                        for (int bj = 0; bj < 2; ++bj)
#pragma unroll
                            for (int n = 0; n < 2; ++n) *(f32x4*)(dst + colt + bj * 128 + n * 16) = acc[ai][bj][m][n];
                    }
                }
            }
    }
};
struct EpiResid {
    const float* base; float* out;
    __device__ __forceinline__ void operator()(const f32x4 (&acc)[2][2][4][2], const Unit& u, int wr, int wc, int fr, int fq) const {
        const int row0 = u.pm * 256 + wr * 64 + fr, col0 = u.pn * 256 + wc * 32 + 4 * fq;
#pragma unroll
        for (int ai = 0; ai < 2; ++ai)
#pragma unroll
            for (int m = 0; m < 4; ++m) {
                const size_t off = (size_t)(row0 + ai * 128 + m * 16) * 1024 + col0;
#pragma unroll
                for (int bj = 0; bj < 2; ++bj)
#pragma unroll
                    for (int n = 0; n < 2; ++n) { const f32x4 b = *(const f32x4*)(base + off + bj * 128 + n * 16); *(f32x4*)(out + off + bj * 128 + n * 16) = b * ALPHA + acc[ai][bj][m][n]; }
            }
    }
};
struct EpiUp {
    u16* gate; u16* val; float* conv_p; float* conv_s;
    __device__ __forceinline__ void operator()(const f32x4 (&acc)[2][2][4][2], const Unit& u, int wr, int wc, int fr, int fq) const {
        const int row0 = u.pm * 256 + wr * 64 + fr;
        const bool isG = u.pn < 11;
        u16* base = isG ? gate : val;
        const int colt = (isG ? u.pn : u.pn - 11) * 256 + wc * 32 + 4 * fq;
#pragma unroll
        for (int ai = 0; ai < 2; ++ai)
#pragma unroll
            for (int m = 0; m < 4; ++m) {
                const int row = row0 + ai * 128 + m * 16;
                u16* rowp = base + (size_t)row * DFF + colt;
#pragma unroll
                for (int bj = 0; bj < 2; ++bj)
#pragma unroll
                    for (int n = 0; n < 2; ++n) st_bf4(rowp + bj * 128 + n * 16, acc[ai][bj][m][n]);
                if (isG) {
                    float* dst = nullptr;
                    if (row < MP) { const int t = row & 2047; if (t >= 2046) dst = conv_p + (size_t)((row >> 11) * 2 + (t - 2046)) * DFF; }
                    else { const int r = row - MP, t = r & 3; if (t >= 2) dst = conv_s + (size_t)((r >> 2) * 2 + (t - 2)) * DFF; }
                    if (dst) {
#pragma unroll
                        for (int bj = 0; bj < 2; ++bj)
#pragma unroll
                            for (int n = 0; n < 2; ++n) *(f32x4*)(dst + colt + bj * 128 + n * 16) = acc[ai][bj][m][n];
                    }
                }
            }
    }
};

__device__ __forceinline__ void transpose_tile(const float* __restrict__ src, u16* __restrict__ dst, int K, int N, int nT, int item, float* tile) {
    const int t = opaque_tid();
    const int kt = item / nT, ntile = item - kt * nT, k0 = kt * 64, n0 = ntile * 64;
    { const int row = t >> 3, c8 = (t & 7) * 8;
      f32x4 a = (f32x4){0.f, 0.f, 0.f, 0.f}, b = a;
      if (n0 + c8 < N) { const float* sp = src + (size_t)(k0 + row) * N + n0 + c8; a = *(const f32x4*)sp; b = *(const f32x4*)(sp + 4); }
      float* tp = tile + row * 65 + c8;
      tp[0] = a[0]; tp[1] = a[1]; tp[2] = a[2]; tp[3] = a[3]; tp[4] = b[0]; tp[5] = b[1]; tp[6] = b[2]; tp[7] = b[3]; }
    __syncthreads();
    { const int n = t >> 3, k8 = (t & 7) * 8;
      float v[8];
#pragma unroll
      for (int j = 0; j < 8; ++j) v[j] = tile[(k8 + j) * 65 + n];
      u32x4 w; w.x = cvt_pk_bf16(v[0], v[1]); w.y = cvt_pk_bf16(v[2], v[3]); w.z = cvt_pk_bf16(v[4], v[5]); w.w = cvt_pk_bf16(v[6], v[7]);
      *(u32x4*)(dst + (size_t)(n0 + n) * K + k0 + k8) = w; }
    __syncthreads();
}
__device__ __forceinline__ void small_transpose(const float* __restrict__ src, u16* __restrict__ dst, int K, int N, int Kpad, size_t gt, size_t nth) {
    for (size_t i = gt; i < (size_t)N * Kpad; i += nth) { const int n = (int)(i / Kpad), k = (int)(i - (size_t)n * Kpad); const float v = k < K ? src[(size_t)k * N + n] : 0.f; dst[i] = (u16)(cvt_pk_bf16(v, 0.f) & 0xffffu); }
}
__device__ void convert_phase(const Params& p, int l, float* tile) {
    unsigned char* ws = p.ws;
    const int bid = opaque_bid();
    const size_t gt = (size_t)bid * 512 + opaque_tid(), nth = (size_t)gridDim.x * 512;
    constexpr int n1 = 16 * 56, n2 = 16 * 16, n3 = 16 * 88, n4 = 44 * 16;
    for (int it = bid; it < n1 + n2 + n3 + n4; it += gridDim.x) {
        if (it < n1) transpose_tile(p.in[I_WIN] + (size_t)l * 1024 * 3344, (u16*)(ws + W_WIN), 1024, 3344, 56, it, tile);
        else if (it < n1 + n2) transpose_tile(p.in[I_WOUT] + (size_t)l * 1024 * 1024, (u16*)(ws + W_WOUT), 1024, 1024, 16, it - n1, tile);
        else if (it < n1 + n2 + n3) transpose_tile(p.in[I_WUP] + (size_t)l * 1024 * 5632, (u16*)(ws + W_WUP), 1024, 5632, 88, it - n1 - n2, tile);
        else transpose_tile(p.in[I_WDOWN] + (size_t)l * 2816 * 1024, (u16*)(ws + W_WDOWN), 2816, 1024, 16, it - n1 - n2 - n3, tile);
    }
    small_transpose(p.in[I_WLU] + (size_t)l * 64 * 512, (u16*)(ws + W_WLT), 64, 512, 64, gt, nth);
    small_transpose(p.in[I_ALU] + (size_t)l * 64 * 512, (u16*)(ws + W_ALT), 64, 512, 64, gt, nth);
    small_transpose(p.in[I_GLU] + (size_t)l * 128 * 512, (u16*)(ws + W_GLT), 128, 512, 128, gt, nth);
    if (l > 0) {
        small_transpose(p.in[I_VD] + (size_t)(l - 1) * 512 * 32, (u16*)(ws + W_V1T), 512, 32, 512, gt, nth);
        small_transpose(p.in[I_VU] + (size_t)(l - 1) * 32 * 512, (u16*)(ws + W_V2T), 32, 512, 32, gt, nth);
    }
    small_transpose(p.in[I_FUP] + (size_t)l * 16 * 256, (u16*)(ws + W_FT), 16, 256, 32, gt, nth);
    if (l == 0) {
        float* xa = p.out + O_Y; u16* xb = (u16*)(ws + W_XB);
        for (size_t i = gt; i < (size_t)MTOK * 256; i += nth) {
            const size_t e = i * 4;
            const f32x4 v = e < (size_t)MP * 1024 ? *(const f32x4*)(p.in[I_XP] + e) : *(const f32x4*)(p.in[I_XS] + (e - (size_t)MP * 1024));
            *(f32x4*)(xa + e) = v; st_bf4(xb + e, v);
        }
    }
}

__device__ void ln_phase(float* Y, u16* xb, const float* __restrict__ g, const float* __restrict__ b) {
    const int tt_ = opaque_tid();
    const int lane = tt_ & 63, gw = opaque_bid() * 8 + (tt_ >> 6), nw = gridDim.x * 8;
    f32x4 gv[4], bv[4];
#pragma unroll
    for (int i = 0; i < 4; ++i) { gv[i] = *(const f32x4*)(g + i * 256 + lane * 4); bv[i] = *(const f32x4*)(b + i * 256 + lane * 4); }
    for (int row = gw; row < MTOK; row += nw) {
        float* yp = Y + (size_t)row * 1024 + lane * 4;
        f32x4 v[4]; float s = 0.f;
#pragma unroll
        for (int i = 0; i < 4; ++i) { v[i] = *(const f32x4*)(yp + i * 256); s += (v[i][0] + v[i][1]) + (v[i][2] + v[i][3]); }
#pragma unroll
        for (int o = 32; o >= 1; o >>= 1) s += __shfl_xor(s, o);
        const float mu = s * (1.0f / 1024.0f); float q = 0.f;
#pragma unroll
        for (int i = 0; i < 4; ++i) { const f32x4 d = v[i] - mu; q += (d[0] * d[0] + d[1] * d[1]) + (d[2] * d[2] + d[3] * d[3]); }
#pragma unroll
        for (int o = 32; o >= 1; o >>= 1) q += __shfl_xor(q, o);
        const float rstd = rsqrtf(q * (1.0f / 1024.0f) + LN_EPS);
#pragma unroll
        for (int i = 0; i < 4; ++i) { const f32x4 o = (v[i] - mu) * rstd * gv[i] + bv[i]; *(f32x4*)(yp + i * 256) = o; st_bf4(xb + (size_t)row * 1024 + i * 256 + lane * 4, o); }
    }
}

__device__ void convglu_phase(const u16* __restrict__ gate, u16* val, const float* __restrict__ past  , const float* __restrict__ cw, const float* __restrict__ cb) {
    const size_t gt = (size_t)opaque_bid() * 512 + opaque_tid(), nth = (size_t)gridDim.x * 512;
    for (size_t idx = gt; idx < (size_t)MTOK * 352; idx += nth) {
        const int row = (int)(idx / 352), c = (int)(idx - (size_t)row * 352) * 8;
        int t; const float* pst = nullptr;
        if (row < MP) t = row & 2047; else { const int r = row - MP; t = r & 3; pst = past + (size_t)(r >> 2) * 2 * DFF; }
        float g0[8], g1[8], g2[8], vv[8];
        { const u32x4 w = *(const u32x4*)(gate + (size_t)row * DFF + c); g0[0] = bflo(w.x); g0[1] = bfhi(w.x); g0[2] = bflo(w.y); g0[3] = bfhi(w.y); g0[4] = bflo(w.z); g0[5] = bfhi(w.z); g0[6] = bflo(w.w); g0[7] = bfhi(w.w); }
        { const u32x4 w = *(const u32x4*)(val + (size_t)row * DFF + c); vv[0] = bflo(w.x); vv[1] = bfhi(w.x); vv[2] = bflo(w.y); vv[3] = bfhi(w.y); vv[4] = bflo(w.z); vv[5] = bfhi(w.z); vv[6] = bflo(w.w); vv[7] = bfhi(w.w); }
        if (t >= 1) { const u32x4 w = *(const u32x4*)(gate + (size_t)(row - 1) * DFF + c); g1[0] = bflo(w.x); g1[1] = bfhi(w.x); g1[2] = bflo(w.y); g1[3] = bfhi(w.y); g1[4] = bflo(w.z); g1[5] = bfhi(w.z); g1[6] = bflo(w.w); g1[7] = bfhi(w.w); }
        else {
#pragma unroll
            for (int j = 0; j < 8; ++j) g1[j] = pst ? pst[DFF + c + j] : 0.f; }
        if (t >= 2) { const u32x4 w = *(const u32x4*)(gate + (size_t)(row - 2) * DFF + c); g2[0] = bflo(w.x); g2[1] = bfhi(w.x); g2[2] = bflo(w.y); g2[3] = bfhi(w.y); g2[4] = bflo(w.z); g2[5] = bfhi(w.z); g2[6] = bflo(w.w); g2[7] = bfhi(w.w); }
        else {
#pragma unroll
            for (int j = 0; j < 8; ++j) g2[j] = pst ? pst[t * DFF + c + j] : 0.f; }
        float h[8];
#pragma unroll
        for (int j = 0; j < 8; ++j) {
            const float a = cb[c + j] + g2[j] * cw[c + j] + g1[j] * cw[DFF + c + j] + g0[j] * cw[2 * DFF + c + j];
            h[j] = 0.5f * a * (1.0f + erff(a * 0.70710678118654752f)) * vv[j];
        }
        u32x4 w; w.x = cvt_pk_bf16(h[0], h[1]); w.y = cvt_pk_bf16(h[2], h[3]); w.z = cvt_pk_bf16(h[4], h[5]); w.w = cvt_pk_bf16(h[6], h[7]);
        *(u32x4*)(val + (size_t)row * DFF + c) = w;
    }
}

struct PrepCtx {
    const u16* projA; const u16* projB; const float* mu; const float* sshift  ;
};
__device__ __forceinline__ f32x4 xs4(const PrepCtx& c, int i, int col) {
    const f32x4 cur = ld_bf4(c.projA + (size_t)i * 1792 + col);
    f32x4 prev;
    bool first; int b = 0;
    if (i < MP) first = (i & 2047) == 0; else { const int r = i - MP; first = (r & 3) == 0; b = r >> 2; }
    if (!first) prev = ld_bf4(c.projA + (size_t)(i - 1) * 1792 + col);
    else if (i < MP) prev = (f32x4){0.f, 0.f, 0.f, 0.f};
    else prev = *(const f32x4*)(c.sshift + (size_t)b * 1792 + col);
    const f32x4 m = *(const f32x4*)(c.mu + col);
    return cur + (prev - cur) * m;
}
__device__ __forceinline__ bf16x8 ldg_frag(const u16* p) { return *(const bf16x8*)p; }

__device__ void prep_phase(const Params& p, int l, PG8_LAS unsigned char* lds) {
    unsigned char* ws = p.ws;
    PrepCtx c; c.projA = (const u16*)(ws + W_PROJA); c.projB = (const u16*)(ws + W_PROJB); c.mu = p.in[I_MU] + (size_t)l * 1792; c.sshift = p.in[I_SSHIFT] + (size_t)l * 128 * 1792;
    const u16* wlT = (const u16*)(ws + W_WLT); const u16* alT = (const u16*)(ws + W_ALT); const u16* glT = (const u16*)(ws + W_GLT);
    const u16* v1T = (const u16*)(ws + W_V1T); const u16* v2T = (const u16*)(ws + W_V2T); const u16* fT = (const u16*)(ws + W_FT);
    u32x4* A16 = (u32x4*)(ws + W_BUFB); float* D8 = (float*)(ws + W_D8); u16* vbuf = (u16*)(ws + W_VBUF); u16* gbuf = (u16*)(ws + W_GBUF);
    float* decb = (float*)(ws + W_DEC); float* rkb = (float*)(ws + W_RK); u16* vfirst = (u16*)(ws + W_VFIRST);
    const float* w0 = p.in[I_W0] + l * 512; const float* a0 = p.in[I_A0] + l * 512; const float* k_k = p.in[I_KK] + l * 512; const float* k_a = p.in[I_KA] + l * 512;
    const float* r_k = p.in[I_RK] + l * 512; const float* vb = l > 0 ? p.in[I_VB] + (l - 1) * 512 : nullptr; const float* fbias = p.in[I_FB] + l * 256;
    constexpr int S_TW = 144, S_AL = 144, S_SG = 272, S_XV = 1040, S_FL = 80, S_PP = 80;
    constexpr int O_TW = 0, O_AL = O_TW + 16 * S_TW, O_SG = O_AL + 16 * S_AL, O_XV = O_SG + 16 * S_SG, O_FL = O_XV + 16 * S_XV, O_PP = O_FL + 16 * S_FL;
    const int t = opaque_tid(), wid = t >> 6, lane = t & 63, fr = lane & 15, fq = lane >> 4, h = wid;
    for (int blk = opaque_bid(); blk < MTOK / 16; blk += gridDim.x) {
        const int i0 = blk * 16;
#pragma unroll
        for (int q = 0; q < 6; ++q) {
            const int op = t + 512 * q, r = op / 192, g4 = op - r * 192, col = 1024 + 4 * g4;
            f32x4 x = xs4(c, i0 + r, col);
            int off;
            if (col < 1536) off = O_XV + r * S_XV + (col - 1024) * 2;
            else if (col < 1600) { off = O_TW + r * S_TW + (col - 1536) * 2; x = (f32x4){tanhf(x[0]), tanhf(x[1]), tanhf(x[2]), tanhf(x[3])}; }
            else if (col < 1664) off = O_AL + r * S_AL + (col - 1600) * 2;
            else { off = O_SG + r * S_SG + (col - 1664) * 2; x = (f32x4){sigmoidf_(x[0]), sigmoidf_(x[1]), sigmoidf_(x[2]), sigmoidf_(x[3])}; }
            u32x2 w; w.x = cvt_pk_bf16(x[0], x[1]); w.y = cvt_pk_bf16(x[2], x[3]);
            *(PG8_LAS u32x2*)(lds + off) = w;
        }
        if (t < 128) { const int r = t >> 3, c4 = (t & 7) * 4; u32x2 w = (u32x2){0u, 0u}; if (c4 < 16) w = *(const u32x2*)(c.projB + (size_t)(i0 + r) * 1792 + 1536 + c4); *(PG8_LAS u32x2*)(lds + O_FL + r * S_FL + c4 * 2) = w; }
        __syncthreads();
        bf16x8 pfrag = (bf16x8){0, 0, 0, 0, 0, 0, 0, 0};
        if (l > 0) {
            f32x4 accP0 = (f32x4){0.f, 0.f, 0.f, 0.f}, accP1 = accP0;
#pragma unroll 4
            for (int ks = 0; ks < 16; ++ks) {
                const bf16x8 af = *(const PG8_LAS bf16x8*)(lds + O_XV + fr * S_XV + (ks * 32 + fq * 8) * 2);
                accP0 = __builtin_amdgcn_mfma_f32_16x16x32_bf16(ldg_frag(v1T + (size_t)fr * 512 + ks * 32 + fq * 8), af, accP0, 0, 0, 0);
                accP1 = __builtin_amdgcn_mfma_f32_16x16x32_bf16(ldg_frag(v1T + (size_t)(16 + fr) * 512 + ks * 32 + fq * 8), af, accP1, 0, 0, 0);
            }
            const u32 w0_ = cvt_pk_bf16(accP0[0], accP0[1]), w1_ = cvt_pk_bf16(accP0[2], accP0[3]), w2_ = cvt_pk_bf16(accP1[0], accP1[1]), w3_ = cvt_pk_bf16(accP1[2], accP1[3]);
            const u32x4 pw = (u32x4){w0_, w1_, w2_, w3_};
            pfrag = __builtin_bit_cast(bf16x8, pw);
        }
        const int i = i0 + fr;
        float ss = 0.f;
#pragma unroll
        for (int n = 0; n < 4; ++n) { const int cb_ = h * 64 + 16 * n + 4 * fq; const f32x4 xk = xs4(c, i, 512 + cb_) * *(const f32x4*)(k_k + cb_); ss += (xk[0] * xk[0] + xk[1] * xk[1]) + (xk[2] * xk[2] + xk[3] * xk[3]); }
        ss += __shfl_xor(ss, 16); ss += __shfl_xor(ss, 32);
        const float inorm = rsqrtf(fmaxf(ss, 1e-24f));
        float rks = 0.f;
#pragma unroll 1
        for (int n = 0; n < 4; ++n) {
            const int cn = h * 64 + 16 * n, cb_ = cn + 4 * fq;
            f32x4 aW = (f32x4){0.f, 0.f, 0.f, 0.f}, aA = aW, aG = aW, aV = aW;
#pragma unroll
            for (int ks = 0; ks < 2; ++ks) {
                aW = __builtin_amdgcn_mfma_f32_16x16x32_bf16(ldg_frag(wlT + (size_t)(cn + fr) * 64 + ks * 32 + fq * 8), *(const PG8_LAS bf16x8*)(lds + O_TW + fr * S_TW + (ks * 32 + fq * 8) * 2), aW, 0, 0, 0);
                aA = __builtin_amdgcn_mfma_f32_16x16x32_bf16(ldg_frag(alT + (size_t)(cn + fr) * 64 + ks * 32 + fq * 8), *(const PG8_LAS bf16x8*)(lds + O_AL + fr * S_AL + (ks * 32 + fq * 8) * 2), aA, 0, 0, 0);
            }
#pragma unroll
            for (int ks = 0; ks < 4; ++ks)
                aG = __builtin_amdgcn_mfma_f32_16x16x32_bf16(ldg_frag(glT + (size_t)(cn + fr) * 128 + ks * 32 + fq * 8), *(const PG8_LAS bf16x8*)(lds + O_SG + fr * S_SG + (ks * 32 + fq * 8) * 2), aG, 0, 0, 0);
            if (l > 0) {
                const u32x2 va = *(const u32x2*)(v2T + (size_t)(cn + fr) * 32 + 4 * fq), vc = *(const u32x2*)(v2T + (size_t)(cn + fr) * 32 + 16 + 4 * fq);
                const u32x4 vw = (u32x4){va.x, va.y, vc.x, vc.y};
                aV = __builtin_amdgcn_mfma_f32_16x16x32_bf16(__builtin_bit_cast(bf16x8, vw), pfrag, aV, 0, 0, 0);
            }
            const f32x4 xr = xs4(c, i, cb_), xk = xs4(c, i, 512 + cb_), xv = xs4(c, i, 1024 + cb_);
            const f32x4 w0v = *(const f32x4*)(w0 + cb_), a0v = *(const f32x4*)(a0 + cb_), kkv = *(const f32x4*)(k_k + cb_), kav = *(const f32x4*)(k_a + cb_), rkv = *(const f32x4*)(r_k + cb_);
            f32x4 vp = xv;
            if (l == 0) st_bf4(vfirst + (size_t)i * 512 + cb_, xv);
            else { const f32x4 vf = ld_bf4(vfirst + (size_t)i * 512 + cb_); const f32x4 vbv = *(const f32x4*)(vb + cb_);
#pragma unroll
                for (int j = 0; j < 4; ++j) vp[j] = xv[j] + (vf[j] - xv[j]) * sigmoidf_(vbv[j] + aV[j]);
            }
            f32x4 dd, kt, kn, bb;
#pragma unroll
            for (int j = 0; j < 4; ++j) {
                const float wv = -softplusf_(-(w0v[j] + aW[j])) - 0.5f;
                dd[j] = __expf(-__expf(wv));
                const float a = sigmoidf_(a0v[j] + aA[j]);
                kn[j] = xk[j] * kkv[j] * inorm;
                kt[j] = xk[j] * (1.0f + (a - 1.0f) * kav[j]);
                bb[j] = kn[j] * a;
                rks += xr[j] * kt[j] * rkv[j];
            }
            const int p0 = 8 * n + 2 * fq;
            u32x4 rec0, rec1;
            rec0.x = cvt_pk_bf16(xr[0], xr[1]); rec0.y = cvt_pk_bf16(kt[0], kt[1]); rec0.z = cvt_pk_bf16(kn[0], kn[1]); rec0.w = cvt_pk_bf16(bb[0], bb[1]);
            rec1.x = cvt_pk_bf16(xr[2], xr[3]); rec1.y = cvt_pk_bf16(kt[2], kt[3]); rec1.z = cvt_pk_bf16(kn[2], kn[3]); rec1.w = cvt_pk_bf16(bb[2], bb[3]);
            u32x4* ap = A16 + ((size_t)i * 8 + h) * 32 + p0;
            ap[0] = rec0; ap[1] = rec1;
            *(f32x4*)(D8 + (size_t)i * 512 + cb_) = dd;
            st_bf4(vbuf + (size_t)i * 512 + cb_, vp);
            st_bf4(gbuf + (size_t)i * 512 + cb_, aG);
        }
        rks += __shfl_xor(rks, 16); rks += __shfl_xor(rks, 32);
        if (fq == 0) rkb[(size_t)i * 8 + h] = rks;
#pragma unroll
        for (int n2 = 0; n2 < 2; ++n2) {
            const int cn = 32 * h + 16 * n2;
            f32x4 aF = (f32x4){0.f, 0.f, 0.f, 0.f};
            aF = __builtin_amdgcn_mfma_f32_16x16x32_bf16(ldg_frag(fT + (size_t)(cn + fr) * 32 + fq * 8), *(const PG8_LAS bf16x8*)(lds + O_FL + fr * S_FL + (fq * 8) * 2), aF, 0, 0, 0);
            const f32x4 fb = *(const f32x4*)(fbias + cn + 4 * fq);
            f32x4 dc;
#pragma unroll
            for (int j = 0; j < 4; ++j) { const float z = aF[j] + fb[j]; dc[j] = __expf(-softplusf_(-z) * (1.0f / 16.0f)); }
            *(f32x4*)(decb + (size_t)i * 256 + cn + 4 * fq) = dc;
        }
        __syncthreads();
    }
}

struct ScanItem {
    int tok0, T, L;
    int h, q;
    int hg, cgp;
    const float* s0_rwkv; float* so_rwkv;
    const float* s0_gla; float* so_gla;
};
template <int LSEG>
__device__ __forceinline__ void scan_item(const Params& p, const ScanItem& it, PG8_LAS unsigned char* lds) {
    unsigned char* ws = p.ws;
    const u32x4* A16 = (const u32x4*)(ws + W_BUFB); const float* D8 = (const float*)(ws + W_D8); const u16* vbuf = (const u16*)(ws + W_VBUF);
    const u16* projB = (const u16*)(ws + W_PROJB); const float* decb = (const float*)(ws + W_DEC);
    u16* obufA = (u16*)(ws + W_OBUFA); u16* obufB = (u16*)(ws + W_OBUFB);
    const int t = opaque_tid(), wid = t >> 6, lane = t & 63, kq = lane & 15, rsel = lane >> 4;
    constexpr int BUF = 69632, OR = 0, OKT = 8192, OKN = 16384, OB = 24576, OD = 32768, OVR = 40960, OQ = 43008, OK = 51200, ODC = 59392, OVG = 67584;
    const int nchunk = it.T / TC;
    u32x4 sa0, sa1; f32x4 sd, sdec; u32x2 svr = (u32x2){0u, 0u}, sq, sk;
#define SC_GLOAD(ch_) do { const int tk_ = it.tok0 + (ch_) * TC; \
        { const int i0 = t, i1 = t + 512; sa0 = A16[((size_t)(tk_ + (i0 >> 5)) * 8 + it.h) * 32 + (i0 & 31)]; sa1 = A16[((size_t)(tk_ + (i1 >> 5)) * 8 + it.h) * 32 + (i1 & 31)]; } \
        { const int st = t >> 4, c4 = (t & 15) * 4; sd = *(const f32x4*)(D8 + (size_t)(tk_ + st) * 512 + it.h * 64 + c4); \
          sq = *(const u32x2*)(projB + (size_t)(tk_ + st) * 1792 + it.hg * 64 + c4); sk = *(const u32x2*)(projB + (size_t)(tk_ + st) * 1792 + 256 + it.hg * 64 + c4); \
          sdec = *(const f32x4*)(decb + (size_t)(tk_ + st) * 256 + it.hg * 64 + c4); } \
        if (t < 128) { const int st = t >> 2, c4 = (t & 3) * 4; svr = *(const u32x2*)(vbuf + (size_t)(tk_ + st) * 512 + it.h * 64 + it.q * 16 + c4); } \
        else if (t < 256) { const int tt = t - 128, st = tt >> 2, c4 = (tt & 3) * 4; svr = *(const u32x2*)(projB + (size_t)(tk_ + st) * 1792 + 512 + it.hg * 128 + it.cgp * 16 + c4); } } while (0)
#define SC_LSTORE(buf_) do { PG8_LAS unsigned char* b_ = lds + (buf_) * BUF; \
        { const int i0 = t, i1 = t + 512; \
          { const int st = i0 >> 5, pp = i0 & 31; const int o = (st * 64 + 2 * pp) * 4; \
            *(PG8_LAS f32x2*)(b_ + OR + o) = (f32x2){bflo(sa0.x), bfhi(sa0.x)}; *(PG8_LAS f32x2*)(b_ + OKT + o) = (f32x2){bflo(sa0.y), bfhi(sa0.y)}; \
            *(PG8_LAS f32x2*)(b_ + OKN + o) = (f32x2){bflo(sa0.z), bfhi(sa0.z)}; *(PG8_LAS f32x2*)(b_ + OB + o) = (f32x2){bflo(sa0.w), bfhi(sa0.w)}; } \
          { const int st = i1 >> 5, pp = i1 & 31; const int o = (st * 64 + 2 * pp) * 4; \
            *(PG8_LAS f32x2*)(b_ + OR + o) = (f32x2){bflo(sa1.x), bfhi(sa1.x)}; *(PG8_LAS f32x2*)(b_ + OKT + o) = (f32x2){bflo(sa1.y), bfhi(sa1.y)}; \
            *(PG8_LAS f32x2*)(b_ + OKN + o) = (f32x2){bflo(sa1.z), bfhi(sa1.z)}; *(PG8_LAS f32x2*)(b_ + OB + o) = (f32x2){bflo(sa1.w), bfhi(sa1.w)}; } } \
        { const int st = t >> 4, c4 = (t & 15) * 4; const int o = (st * 64 + c4) * 4; \
          *(PG8_LAS f32x4*)(b_ + OD + o) = sd; *(PG8_LAS f32x4*)(b_ + ODC + o) = sdec; \
          *(PG8_LAS f32x4*)(b_ + OQ + o) = (f32x4){bflo(sq.x), bfhi(sq.x), bflo(sq.y), bfhi(sq.y)} * 0.125f; \
          *(PG8_LAS f32x4*)(b_ + OK + o) = (f32x4){bflo(sk.x), bfhi(sk.x), bflo(sk.y), bfhi(sk.y)}; } \
        if (t < 128) { const int st = t >> 2, c4 = (t & 3) * 4; *(PG8_LAS f32x4*)(b_ + OVR + (st * 16 + c4) * 4) = (f32x4){bflo(svr.x), bfhi(svr.x), bflo(svr.y), bfhi(svr.y)}; } \
        else if (t < 256) { const int tt = t - 128, st = tt >> 2, c4 = (tt & 3) * 4; *(PG8_LAS f32x4*)(b_ + OVG + (st * 16 + c4) * 4) = (f32x4){bflo(svr.x), bfhi(svr.x), bflo(svr.y), bfhi(svr.y)}; } } while (0)
    const bool isR = wid < 4;
    const int w4 = wid & 3;
    const int row = it.q * 16 + 4 * w4 + rsel;
    const int col = it.cgp * 16 + 4 * w4 + rsel;
    f32x4 S = (f32x4){0.f, 0.f, 0.f, 0.f}, Sn = S;
#define SC_LOAD_STATE(dst_, seg_) do { const int sg_ = (seg_); \
        if (isR) { if (!it.s0_rwkv) dst_ = (f32x4){0.f, 0.f, 0.f, 0.f}; else dst_ = *(const f32x4*)(it.s0_rwkv + (size_t)sg_ * 8 * 4096 + row * 64 + 4 * kq); } \
        else if (!it.s0_gla) dst_ = (f32x4){0.f, 0.f, 0.f, 0.f}; \
        else { const float* sp_ = it.s0_gla + (size_t)sg_ * 4 * 8192 + (size_t)(4 * kq) * 128 + col; dst_ = (f32x4){sp_[0], sp_[128], sp_[256], sp_[384]}; } } while (0)
#define SC_STORE_STATE(seg_, s_) do { const int sg_ = (seg_); \
        if (isR) { *(f32x4*)(it.so_rwkv + (size_t)sg_ * 8 * 4096 + row * 64 + 4 * kq) = s_; } \
        else { float* sp_ = it.so_gla + (size_t)sg_ * 4 * 8192 + (size_t)(4 * kq) * 128 + col; sp_[0] = s_[0]; sp_[128] = s_[1]; sp_[256] = s_[2]; sp_[384] = s_[3]; } } while (0)
    SC_GLOAD(0);
    SC_LOAD_STATE(Sn, 0);
    SC_LSTORE(0);
    __syncthreads();
    u16* oAp = obufA + (size_t)it.tok0 * 512 + it.h * 64 + row;
    u16* oBp = obufB + (size_t)it.tok0 * 512 + it.hg * 128 + col;
    const int vsl = (4 * w4 + rsel) * 4;
#define SC_STEP_R(s_) do { const int o = ((s_) * 64 + 4 * kq) * 4; \
        const f32x4 r4 = *(const PG8_LAS f32x4*)(b + OR + o), k4 = *(const PG8_LAS f32x4*)(b + OKT + o), n4 = *(const PG8_LAS f32x4*)(b + OKN + o), b4 = *(const PG8_LAS f32x4*)(b + OB + o), d4 = *(const PG8_LAS f32x4*)(b + OD + o); \
        const float v = *(const PG8_LAS float*)(b + OVR + (s_) * 64 + vsl); \
        float dot = (S[0] * n4[0] + S[1] * n4[1]) + (S[2] * n4[2] + S[3] * n4[3]); \
        dot = red16(dot); \
        S = S * d4 - b4 * dot + k4 * v; \
        float o_ = (S[0] * r4[0] + S[1] * r4[1]) + (S[2] * r4[2] + S[3] * r4[3]); \
        o_ = red16(o_); \
        if (kq == 0) oAp[(size_t)(s_) * 512] = (u16)(cvt_pk_bf16(o_, 0.f) & 0xffffu); } while (0)
#define SC_STEP_G(s_) do { const int o = ((s_) * 64 + 4 * kq) * 4; \
        const f32x4 q4 = *(const PG8_LAS f32x4*)(b + OQ + o), k4 = *(const PG8_LAS f32x4*)(b + OK + o), d4 = *(const PG8_LAS f32x4*)(b + ODC + o); \
        const float v = *(const PG8_LAS float*)(b + OVG + (s_) * 64 + vsl); \
        S = S * d4 + k4 * v; \
        float o_ = (S[0] * q4[0] + S[1] * q4[1]) + (S[2] * q4[2] + S[3] * q4[3]); \
        o_ = red16(o_); \
        if (kq == 0) oBp[(size_t)(s_) * 512] = (u16)(cvt_pk_bf16(o_, 0.f) & 0xffffu); } while (0)
    for (int ch = 0; ch < nchunk; ++ch) {
        const bool more = ch + 1 < nchunk;
        if (more) SC_GLOAD(ch + 1);
        PG8_LAS unsigned char* b = lds + (ch & 1) * BUF;
        if (LSEG >= TC) {
            if (ch == 0) S = Sn;
            if (isR) {
#pragma unroll 8
                for (int s = 0; s < TC; ++s) SC_STEP_R(s);
            } else {
#pragma unroll 8
                for (int s = 0; s < TC; ++s) SC_STEP_G(s);
            }
            if (!more) SC_STORE_STATE(0, S);
        } else {
#pragma unroll 1
            for (int sgi = 0; sgi < TC / LSEG; ++sgi) {
                const int seg = ch * (TC / LSEG) + sgi;
                S = Sn;
                if ((seg + 1) * LSEG < it.T) SC_LOAD_STATE(Sn, seg + 1);
                if (isR) {
#pragma unroll
                    for (int s2 = 0; s2 < LSEG; ++s2) SC_STEP_R(sgi * LSEG + s2);
                } else {
#pragma unroll
                    for (int s2 = 0; s2 < LSEG; ++s2) SC_STEP_G(sgi * LSEG + s2);
                }
                SC_STORE_STATE(seg, S);
            }
        }
        oAp += (size_t)TC * 512; oBp += (size_t)TC * 512;
        if (more) SC_LSTORE((ch + 1) & 1);
        __syncthreads();
    }
#undef SC_STEP_R
#undef SC_STEP_G
}
__device__ void scan_phase(const Params& p, int l, PG8_LAS unsigned char* lds, int which  ) {
    float* out = p.out;
    const int bid = opaque_bid();
    if (which & 1) for (int i = bid; i < 256; i += gridDim.x) {
        ScanItem it; const int s = i >> 5;
        it.tok0 = s * 2048; it.T = 2048; it.L = 2048; it.h = (i >> 2) & 7; it.q = i & 3; it.hg = (i >> 3) & 3; it.cgp = i & 7;
        it.s0_rwkv = nullptr; it.so_rwkv = out + O_RWKV_P + ((size_t)(l * 8 + s) * 8 + it.h) * 4096;
        it.s0_gla = nullptr; it.so_gla = out + O_GLA_P + ((size_t)(l * 8 + s) * 4 + it.hg) * 8192;
        scan_item<2048>(p, it, lds);
    }
    if (which & 2) for (int i = bid; i < 256; i += gridDim.x) {
        ScanItem it; const int bg = i >> 5, b0 = bg * 16;
        it.tok0 = MP + bg * 64; it.T = 64; it.L = 4; it.h = (i >> 2) & 7; it.q = i & 3; it.hg = (i >> 3) & 3; it.cgp = i & 7;
        it.s0_rwkv = p.in[I_SRWKV] + ((size_t)(l * 128 + b0) * 8 + it.h) * 4096; it.so_rwkv = out + O_RWKV_S + ((size_t)(l * 128 + b0) * 8 + it.h) * 4096;
        it.s0_gla = p.in[I_SGLA] + ((size_t)(l * 128 + b0) * 4 + it.hg) * 8192; it.so_gla = out + O_GLA_S + ((size_t)(l * 128 + b0) * 4 + it.hg) * 8192;
        scan_item<4>(p, it, lds);
    }
}

__device__ void post_phase(const Params& p, int l) {
    unsigned char* ws = p.ws;
    const u16* obufA = (const u16*)(ws + W_OBUFA); const u16* obufB = (const u16*)(ws + W_OBUFB); const u16* vbuf = (const u16*)(ws + W_VBUF); const u16* gbuf = (const u16*)(ws + W_GBUF);
    const float* rkb = (const float*)(ws + W_RK); const u16* projB = (const u16*)(ws + W_PROJB); u16* oab = (u16*)(ws + W_XB);
    const float* lg = p.in[I_LNXG] + l * 512; const float* lb = p.in[I_LNXB] + l * 512; const float* ng = p.in[I_NG] + l * 128;
    const int tt_ = opaque_tid();
    const int lane = tt_ & 63, gw = opaque_bid() * 8 + (tt_ >> 6), nw = gridDim.x * 8;
    const int c = lane * 8;
    float lgv[8], lbv[8], ngv[8];
#pragma unroll
    for (int j = 0; j < 8; ++j) { lgv[j] = lg[c + j]; lbv[j] = lb[c + j]; ngv[j] = ng[(c & 127) + j]; }
    for (int i = gw; i < MTOK; i += nw) {
        {
            const f32x4 o0 = ld_bf4(obufA + (size_t)i * 512 + c), o1 = ld_bf4(obufA + (size_t)i * 512 + c + 4);
            const f32x4 v0 = ld_bf4(vbuf + (size_t)i * 512 + c), v1 = ld_bf4(vbuf + (size_t)i * 512 + c + 4);
            const f32x4 g0 = ld_bf4(gbuf + (size_t)i * 512 + c), g1 = ld_bf4(gbuf + (size_t)i * 512 + c + 4);
            const float rk = rkb[(size_t)i * 8 + (lane >> 3)];
            float s = (o0[0] + o0[1]) + (o0[2] + o0[3]) + (o1[0] + o1[1]) + (o1[2] + o1[3]);
            s += __shfl_xor(s, 1); s += __shfl_xor(s, 2); s += __shfl_xor(s, 4);
            const float m = s * (1.0f / 64.0f);
            const f32x4 d0 = o0 - m, d1 = o1 - m;
            float q = (d0[0] * d0[0] + d0[1] * d0[1]) + (d0[2] * d0[2] + d0[3] * d0[3]) + (d1[0] * d1[0] + d1[1] * d1[1]) + (d1[2] * d1[2] + d1[3] * d1[3]);
            q += __shfl_xor(q, 1); q += __shfl_xor(q, 2); q += __shfl_xor(q, 4);
            const float rs = rsqrtf(q * (1.0f / 64.0f) + GN_EPS_A);
            f32x4 y0, y1;
#pragma unroll
            for (int j = 0; j < 4; ++j) { y0[j] = (d0[j] * rs * lgv[j] + lbv[j] + rk * v0[j]) * g0[j]; y1[j] = (d1[j] * rs * lgv[4 + j] + lbv[4 + j] + rk * v1[j]) * g1[j]; }
            u32x4 w; w.x = cvt_pk_bf16(y0[0], y0[1]); w.y = cvt_pk_bf16(y0[2], y0[3]); w.z = cvt_pk_bf16(y1[0], y1[1]); w.w = cvt_pk_bf16(y1[2], y1[3]);
            *(u32x4*)(oab + (size_t)i * 1024 + c) = w;
        }
        {
            const f32x4 o0 = ld_bf4(obufB + (size_t)i * 512 + c), o1 = ld_bf4(obufB + (size_t)i * 512 + c + 4);
            const f32x4 g0 = ld_bf4(projB + (size_t)i * 1792 + 1024 + c), g1 = ld_bf4(projB + (size_t)i * 1792 + 1024 + c + 4);
            float q = (o0[0] * o0[0] + o0[1] * o0[1]) + (o0[2] * o0[2] + o0[3] * o0[3]) + (o1[0] * o1[0] + o1[1] * o1[1]) + (o1[2] * o1[2] + o1[3] * o1[3]);
            q += __shfl_xor(q, 1); q += __shfl_xor(q, 2); q += __shfl_xor(q, 4); q += __shfl_xor(q, 8);
            const float rs = rsqrtf(q * (1.0f / 128.0f) + RMS_EPS);
            f32x4 y0, y1;
#pragma unroll
            for (int j = 0; j < 4; ++j) { y0[j] = o0[j] * rs * ngv[j] * (g0[j] * sigmoidf_(g0[j])); y1[j] = o1[j] * rs * ngv[4 + j] * (g1[j] * sigmoidf_(g1[j])); }
            u32x4 w; w.x = cvt_pk_bf16(y0[0], y0[1]); w.y = cvt_pk_bf16(y0[2], y0[3]); w.z = cvt_pk_bf16(y1[0], y1[1]); w.w = cvt_pk_bf16(y1[2], y1[3]);
            *(u32x4*)(oab + (size_t)i * 1024 + 512 + c) = w;
        }
    }
}

__device__ __forceinline__ void gsync(cg::grid_group& grid) {
    __builtin_amdgcn_fence(__ATOMIC_RELEASE, "agent");
    asm volatile("s_waitcnt vmcnt(0)" ::: "memory");
    grid.sync();
    __builtin_amdgcn_fence(__ATOMIC_ACQUIRE, "agent");
    asm volatile("s_waitcnt vmcnt(0)" ::: "memory");
    __syncthreads();
}

__global__ void __launch_bounds__(512, 2) mega(Params p) {
    extern __shared__ __attribute__((aligned(16))) unsigned char smem[];
    PG8_LAS unsigned char* lds = (PG8_LAS unsigned char*)smem;
    cg::grid_group grid = cg::this_grid();
    unsigned char* ws = p.ws;
    float* bufA = p.out + O_Y; float* bufB = (float*)(ws + W_BUFB); u16* xb = (u16*)(ws + W_XB);
    pg8::StaticOrder S;
#define PHASE_END() gsync(grid)
    gsync(grid);
    { const size_t gt0 = (size_t)blockIdx.x * 512 + threadIdx.x, nth0 = (size_t)gridDim.x * 512; u32x4* w = (u32x4*)p.ws; for (size_t i = gt0; i < W_END / 16; i += nth0) w[i] = (u32x4){0u, 0u, 0u, 0u}; }
    gsync(grid);
    convert_phase(p, 0, (float*)smem);
    PHASE_END();
    for (int l = 0; l < NL; ++l) {
        {
            pg8::Gemm g; g.A = xb; g.Bt = (const u16*)(ws + W_WIN); g.M = MTOK; g.N = INP; g.K = 1024;
            EpiProj E; E.projA = (u16*)(ws + W_PROJA); E.projB = (u16*)(ws + W_PROJB); E.shift_p = p.out + O_SHIFT_P + (size_t)l * 8 * 1792; E.shift_s = p.out + O_SHIFT_S + (size_t)l * 128 * 1792;
            S.init(MTOK, INP, gridDim.x, opaque_bid()); pg8::gemm_phase(lds, g, S, E);
        }
        PHASE_END();
        prep_phase(p, l, lds);
        PHASE_END();
        scan_phase(p, l, lds, 3);
        PHASE_END();
        scan_phase(p, l, lds, 2);
        PHASE_END();
        post_phase(p, l);
        PHASE_END();
        {
            pg8::Gemm g; g.A = xb; g.Bt = (const u16*)(ws + W_WOUT); g.M = MTOK; g.N = 1024; g.K = 1024;
            EpiResid E; E.base = bufA; E.out = bufB;
            S.init(MTOK, 1024, gridDim.x, opaque_bid()); pg8::gemm_phase(lds, g, S, E);
        }
        PHASE_END();
        ln_phase(bufB, xb, p.in[I_LN1G] + l * 1024, p.in[I_LN1B] + l * 1024);
        PHASE_END();
        {
            pg8::Gemm g; g.A = xb; g.Bt = (const u16*)(ws + W_WUP); g.M = MTOK; g.N = 5632; g.K = 1024;
            EpiUp E; E.gate = (u16*)(ws + W_GATE); E.val = (u16*)(ws + W_VAL); E.conv_p = p.out + O_CONV_P + (size_t)l * 8 * 2 * DFF; E.conv_s = p.out + O_CONV_S + (size_t)l * 128 * 2 * DFF;
            S.init(MTOK, 5632, gridDim.x, opaque_bid()); pg8::gemm_phase(lds, g, S, E);
        }
        PHASE_END();
        convglu_phase((const u16*)(ws + W_GATE), (u16*)(ws + W_VAL), p.in[I_SCONV] + (size_t)l * 128 * 2 * DFF, p.in[I_CW] + (size_t)l * 3 * DFF, p.in[I_CB] + (size_t)l * DFF);
        PHASE_END();
        {
            pg8::Gemm g; g.A = (const u16*)(ws + W_VAL); g.Bt = (const u16*)(ws + W_WDOWN); g.M = MTOK; g.N = 1024; g.K = DFF;
            EpiResid E; E.base = bufB; E.out = bufA;
            S.init(MTOK, 1024, gridDim.x, opaque_bid()); pg8::gemm_phase(lds, g, S, E);
        }
        PHASE_END();
        ln_phase(bufA, xb, p.in[I_LN2G] + l * 1024, p.in[I_LN2B] + l * 1024);
        if (l + 1 < NL) convert_phase(p, l + 1, (float*)smem);
        PHASE_END();
    }
}

extern "C" void kernel_launch(void* const* d_in, const int* in_sizes, int n_in, void* d_out, int out_size, void* d_ws, size_t ws_size, hipStream_t stream) {
    static int grid_blocks = 0;
    if (!grid_blocks) {
        int dev = 0, cus = 0, per_cu = 0;
        (void)hipGetDevice(&dev);
        (void)hipDeviceGetAttribute(&cus, hipDeviceAttributeMultiprocessorCount, dev);
        (void)hipFuncSetAttribute((const void*)mega, hipFuncAttributeMaxDynamicSharedMemorySize, LDS_BYTES);
        (void)hipOccupancyMaxActiveBlocksPerMultiprocessor(&per_cu, (const void*)mega, 512, LDS_BYTES);
        grid_blocks = cus;
        if (n_in != 33 || (size_t)out_size != O_END || ws_size < W_END) { fprintf(stderr, "kernel_launch: unexpected sizes n_in %d out %d ws %zu (need %zu)\n", n_in, out_size, ws_size, (size_t)W_END); grid_blocks = -1; }
    }
    if (grid_blocks < 0) return;
    Params p{};
    for (int i = 0; i < 33; ++i) p.in[i] = (const float*)d_in[i];
    p.out = (float*)d_out; p.ws = (unsigned char*)d_ws;
    void* args[] = {&p};
    hipError_t e = hipLaunchCooperativeKernel((const void*)mega, dim3(grid_blocks), dim3(512), args, LDS_BYTES, stream);
    if (e != hipSuccess) fprintf(stderr, "cooperative launch failed: %s (grid %d)\n", hipGetErrorString(e), grid_blocks);
}
```

```cpp
#include <hip/hip_runtime.h>
#include <hip/hip_cooperative_groups.h>
#include <cstdio>
namespace cg = cooperative_groups;

#define PG8_LAS __attribute__((address_space(3)))
typedef unsigned short u16;
typedef unsigned int u32;
typedef unsigned short bf16_t;
typedef short bf16x8 __attribute__((ext_vector_type(8)));
typedef float f32x4 __attribute__((ext_vector_type(4)));
typedef float f32x2 __attribute__((ext_vector_type(2)));
typedef unsigned u32x4 __attribute__((ext_vector_type(4)));
typedef unsigned u32x2 __attribute__((ext_vector_type(2)));

constexpr int MTOK = 16896, MP = 16384, DM = 1024, NL = 4;
constexpr int SHIFT_W = 1792, INP = 3584, DFF = 2816;
constexpr float ALPHA = 1.6817928305074290f;
constexpr float GN_EPS_A = 64e-5f, RMS_EPS = 1e-5f, LN_EPS = 1e-5f;
constexpr int LDS_BYTES = 139264;
constexpr int TC = 32;

enum { I_XP = 0, I_XS, I_SRWKV, I_SSHIFT, I_SGLA, I_SCONV, I_WIN, I_MU, I_W0, I_WLU, I_A0, I_ALU, I_GLU, I_KK, I_KA, I_RK, I_LNXG, I_LNXB,
       I_VB, I_VD, I_VU, I_FUP, I_FB, I_NG, I_WOUT, I_LN1G, I_LN1B, I_WUP, I_CW, I_CB, I_WDOWN, I_LN2G, I_LN2B };

constexpr size_t O_Y = 0;
constexpr size_t O_RWKV_P = (size_t)MTOK * DM;
constexpr size_t O_RWKV_S = O_RWKV_P + (size_t)4 * 8 * 8 * 4096;
constexpr size_t O_SHIFT_P = O_RWKV_S + (size_t)4 * 128 * 8 * 4096;
constexpr size_t O_SHIFT_S = O_SHIFT_P + (size_t)4 * 8 * 1792;
constexpr size_t O_GLA_P = O_SHIFT_S + (size_t)4 * 128 * 1792;
constexpr size_t O_GLA_S = O_GLA_P + (size_t)4 * 8 * 4 * 8192;
constexpr size_t O_CONV_P = O_GLA_S + (size_t)4 * 128 * 4 * 8192;
constexpr size_t O_CONV_S = O_CONV_P + (size_t)4 * 8 * 2 * 2816;
constexpr size_t O_END = O_CONV_S + (size_t)4 * 128 * 2 * 2816;

constexpr size_t W_WIN = 0;
constexpr size_t W_WOUT = W_WIN + (size_t)INP * 1024 * 2;
constexpr size_t W_WUP = W_WOUT + (size_t)1024 * 1024 * 2;
constexpr size_t W_WDOWN = W_WUP + (size_t)5632 * 1024 * 2;
constexpr size_t W_WLT = W_WDOWN + (size_t)1024 * 2816 * 2;
constexpr size_t W_ALT = W_WLT + 512 * 64 * 2;
constexpr size_t W_GLT = W_ALT + 512 * 64 * 2;
constexpr size_t W_V1T = W_GLT + 512 * 128 * 2;
constexpr size_t W_V2T = W_V1T + 32 * 512 * 2;
constexpr size_t W_FT = W_V2T + 512 * 32 * 2;
constexpr size_t W_XB = W_FT + 256 * 32 * 2;
constexpr size_t W_VFIRST = W_XB + (size_t)MTOK * 1024 * 2;
constexpr size_t W_BUFB = W_VFIRST + (size_t)MTOK * 512 * 2;
constexpr size_t W_R = W_BUFB + (size_t)MTOK * 1024 * 4;
constexpr size_t W_PROJA = W_R;
constexpr size_t W_PROJB = W_PROJA + (size_t)MTOK * 1792 * 2;
constexpr size_t W_D8 = W_PROJB + (size_t)MTOK * 1792 * 2;
constexpr size_t W_VBUF = W_D8 + (size_t)MTOK * 512 * 4;
constexpr size_t W_GBUF = W_VBUF + (size_t)MTOK * 512 * 2;
constexpr size_t W_DEC = W_GBUF + (size_t)MTOK * 512 * 2;
constexpr size_t W_RK = W_DEC + (size_t)MTOK * 256 * 4;
constexpr size_t W_END1 = W_RK + (size_t)MTOK * 8 * 4;
constexpr size_t W_GATE = W_R;
constexpr size_t W_VAL = W_GATE + (size_t)MTOK * 2816 * 2;
constexpr size_t W_END2 = W_VAL + (size_t)MTOK * 2816 * 2;
constexpr size_t W_END = W_END1 > W_END2 ? W_END1 : W_END2;
constexpr size_t W_OBUFA = W_PROJA;
constexpr size_t W_OBUFB = W_PROJA + (size_t)MTOK * 512 * 2;

struct Params { const float* in[33]; float* out; unsigned char* ws; };
typedef const Params __attribute__((address_space(4)))* KP;
__device__ __forceinline__ KP kparams() { unsigned long long k = (unsigned long long)__builtin_amdgcn_kernarg_segment_ptr(); asm volatile("" : "+s"(k)); return (KP)k; }

typedef __bf16 bf16v2 __attribute__((ext_vector_type(2)));
__device__ __forceinline__ unsigned cvt_pk_bf16(float lo, float hi) { const f32x2 v = (f32x2){lo, hi}; const bf16v2 b = __builtin_convertvector(v, bf16v2); return __builtin_bit_cast(unsigned, b); }
__device__ __forceinline__ float bflo(u32 w) { return __uint_as_float(w << 16); }
__device__ __forceinline__ float bfhi(u32 w) { return __uint_as_float(w & 0xffff0000u); }
__device__ __forceinline__ f32x4 ld_bf4(const u16* p) { const u32x2 w = *(const u32x2*)p; return (f32x4){bflo(w.x), bfhi(w.x), bflo(w.y), bfhi(w.y)}; }
__device__ __forceinline__ unsigned cvt_pk_bf16_asm(float lo, float hi) { unsigned r; asm volatile("v_cvt_pk_bf16_f32 %0, %1, %2" : "=v"(r) : "v"(lo), "v"(hi)); return r; }
__device__ __forceinline__ void st_bf4_asm(u16* p, f32x4 v) { u32x2 w; w.x = cvt_pk_bf16_asm(v[0], v[1]); w.y = cvt_pk_bf16_asm(v[2], v[3]); *(u32x2*)p = w; }
__device__ __forceinline__ void st_bf4(u16* p, f32x4 v) { u32x2 w; w.x = cvt_pk_bf16(v[0], v[1]); w.y = cvt_pk_bf16(v[2], v[3]); *(u32x2*)p = w; }
__device__ __forceinline__ float sigmoidf_(float x) { return 1.0f / (1.0f + __expf(-x)); }
__device__ __forceinline__ float softplusf_(float x) { return fmaxf(x, 0.f) + log1pf(__expf(-fabsf(x))); }
template <int CTRL> __device__ __forceinline__ float dppf(float x) { return __builtin_bit_cast(float, __builtin_amdgcn_update_dpp(0, __builtin_bit_cast(int, x), CTRL, 0xF, 0xF, true)); }
__device__ __forceinline__ float red16(float x) { x += dppf<0xB1>(x); x += dppf<0x4E>(x); x += dppf<0x141>(x); x += dppf<0x140>(x); return x; }

__device__ __forceinline__ int opaque_tid() { int t = threadIdx.x; asm volatile("" : "+v"(t)); return t; }
__device__ __forceinline__ int opaque_bid() { int b = blockIdx.x; asm volatile("" : "+s"(b)); return b; }

namespace pg8 {
constexpr int BM = 256, BK = 64, HALF = 128, HTB = HALF * BK * 2, STAGE_BYTES = 8 * HTB, NXCD = 8, WGM = 8;
__host__ __device__ __forceinline__ int lds_byte(int r, int c) { const int st = (r >> 4) * 2 + (c >> 5), rr = r & 15, cc = c & 31, ob = rr * 64 + cc * 2; return st * 1024 + (ob ^ (((ob >> 9) & 1) << 5)); }
__host__ __device__ __forceinline__ void stage_rc(int b, int& R, int& C) { const int st = b / 1024, sb = b % 1024, swz = sb ^ (((sb >> 9) & 1) << 5); R = (st >> 1) * 16 + swz / 64; C = (st & 1) * 32 + (swz % 64) / 2; }
struct Unit { int pm, pn; };
struct Gemm { const bf16_t* A; const bf16_t* Bt; int M, N, K; };
struct StaticOrder {
    int nM, nN, nwg, G, c;
    __host__ __device__ void init(int M, int N, int G_, int c_) { nM = M / BM; nN = N / BM; nwg = nM * nN; G = G_; c = c_; }
    __host__ __device__ bool next(int i, Unit& u) const {
        const long L = (long)i * G + c; if (L >= nwg) return false;
        int wgid = (int)L; { const int q = nwg / NXCD, r = nwg % NXCD, xcd = wgid % NXCD, off = wgid / NXCD; wgid = (xcd < r ? xcd * (q + 1) : r * (q + 1) + (xcd - r) * q) + off; }
        const int nig = WGM * nN, gid = wgid / nig, fm = gid * WGM, gsz = (nM - fm) < WGM ? (nM - fm) : WGM;
        u.pm = fm + ((wgid % nig) % gsz); u.pn = (wgid % nig) / gsz; return true;
    }
};

template <class Epi>
__device__ __forceinline__ void gemm_phase(PG8_LAS unsigned char* lds, const Gemm g, const StaticOrder& S, const Epi& E) {
    const int tid = opaque_tid(), wid = __builtin_amdgcn_readfirstlane(tid >> 6), lane = tid & 63, wr = wid >> 2, wc = wid & 3, fr = lane & 15, fq = lane >> 4;
    const int K = g.K, nt = K / BK;
    unsigned voffA[2], voffB[2];
#pragma unroll
    for (int i = 0; i < 2; ++i) { int R, C; stage_rc(tid * 16 + i * 8192, R, C); voffA[i] = (unsigned)(R * K + C) * 2u; voffB[i] = voffA[i]; }
    const size_t kstep = (size_t)(BK * 2);
    const size_t hstep = (size_t)HALF * K * 2;
    const size_t tstep = 2 * hstep;
    const unsigned ldsw = (unsigned)wid * 1024u;
    const int aoff = lds_byte(wr * 64 + fr, fq * 8), boff = lds_byte(wc * 32 + fr, fq * 8);
#define PG8_SA(b, h) (((b) * 2 + (h)) * HTB)
#define PG8_SB(b, h) ((4 + (b) * 2 + (h)) * HTB)
#define PG8_STAGE(bufoff, gbase, voff) do { _Pragma("unroll") for (int _i = 0; _i < 2; ++_i) \
        __builtin_amdgcn_global_load_lds((const unsigned*)((const char*)(gbase) + (voff)[_i]), (PG8_LAS unsigned*)(lds + (bufoff) + ldsw + _i * 8192), 16, 0, 0); } while (0)
#define PG8_LDA(dst, b, h) do { _Pragma("unroll") for (int m = 0; m < 4; ++m) _Pragma("unroll") for (int k = 0; k < 2; ++k) dst[m][k] = *(const PG8_LAS bf16x8*)(lds + PG8_SA(b, h) + aoff + m * 2048 + k * 1024); } while (0)
#define PG8_LDB(dst, b, h) do { _Pragma("unroll") for (int n = 0; n < 2; ++n) _Pragma("unroll") for (int k = 0; k < 2; ++k) dst[n][k] = *(const PG8_LAS bf16x8*)(lds + PG8_SB(b, h) + boff + n * 2048 + k * 1024); } while (0)
#define PG8_MMA(ai, bj, At, Bt) do { __builtin_amdgcn_s_setprio(1); _Pragma("unroll") for (int m = 0; m < 4; ++m) _Pragma("unroll") for (int n = 0; n < 2; ++n) _Pragma("unroll") for (int k = 0; k < 2; ++k) \
        acc[ai][bj][m][n] = __builtin_amdgcn_mfma_f32_16x16x32_bf16(Bt[n][k], At[m][k], acc[ai][bj][m][n], 0, 0, 0); __builtin_amdgcn_s_setprio(0); } while (0)
#define PG8_WAIT_V(n) asm volatile("s_waitcnt vmcnt(" #n ")" ::: "memory")
#define PG8_WAIT_L(n) asm volatile("s_waitcnt lgkmcnt(" #n ")" ::: "memory")
#define PG8_BAR __builtin_amdgcn_s_barrier()
#define PG8_SCHED __builtin_amdgcn_sched_barrier(0)
    Unit cur, nxt; int ui = 0;
    if (!S.next(0, cur)) return;
    f32x4 acc[2][2][4][2];
#pragma unroll
    for (int a = 0; a < 2; ++a)
#pragma unroll
        for (int b = 0; b < 2; ++b)
#pragma unroll
            for (int m = 0; m < 4; ++m)
#pragma unroll
                for (int n = 0; n < 2; ++n) acc[a][b][m][n] = (f32x4){0.f, 0.f, 0.f, 0.f};
    bf16x8 At[4][2], B0[2][2], B1[2][2];
    const char* cA = (const char*)g.A + (size_t)cur.pm * tstep; const char* cB = (const char*)g.Bt + (size_t)cur.pn * tstep;
    PG8_STAGE(PG8_SB(0, 0), cB, voffB); PG8_STAGE(PG8_SA(0, 0), cA, voffA); PG8_STAGE(PG8_SB(0, 1), cB + hstep, voffB); PG8_STAGE(PG8_SA(0, 1), cA + hstep, voffA);
    if (wr == 1) PG8_BAR;
    PG8_WAIT_V(4); PG8_BAR;
    PG8_STAGE(PG8_SB(1, 0), cB + kstep, voffB); PG8_STAGE(PG8_SA(1, 0), cA + kstep, voffA); PG8_STAGE(PG8_SB(1, 1), cB + hstep + kstep, voffB);
    PG8_WAIT_V(6); PG8_BAR;
    for (;;) {
        const bool has_next = S.next(ui + 1, nxt);
        const char* nA = has_next ? (const char*)g.A + (size_t)nxt.pm * tstep : cA; const char* nB = has_next ? (const char*)g.Bt + (size_t)nxt.pn * tstep : cB;
        for (int t = 0; t < nt; t += 2) {
            const bool last = (t == nt - 2);
            const char* a1 = cA + (size_t)(t + 1) * kstep;
            const char* a2 = last ? nA : cA + (size_t)(t + 2) * kstep; const char* b2 = last ? nB : cB + (size_t)(t + 2) * kstep;
            const char* a3 = a2 + kstep; const char* b3 = b2 + kstep;
            PG8_LDB(B0, 0, 0); PG8_SCHED; PG8_LDA(At, 0, 0); PG8_STAGE(PG8_SA(1, 1), a1 + hstep, voffA);
            PG8_WAIT_L(8); PG8_BAR; PG8_WAIT_L(0); PG8_MMA(0, 0, At, B0); PG8_BAR; PG8_SCHED;
            PG8_LDB(B1, 0, 1); PG8_STAGE(PG8_SB(0, 0), b2, voffB);
            PG8_BAR; PG8_WAIT_L(0); PG8_MMA(0, 1, At, B1); PG8_BAR;
            PG8_LDA(At, 0, 1); PG8_STAGE(PG8_SA(0, 0), a2, voffA);
            PG8_BAR; PG8_WAIT_L(0); PG8_MMA(1, 0, At, B0); PG8_BAR; PG8_SCHED;
            PG8_STAGE(PG8_SB(0, 1), b2 + hstep, voffB);
            PG8_WAIT_V(6); PG8_BAR; PG8_MMA(1, 1, At, B1); PG8_BAR;
            PG8_LDB(B0, 1, 0); PG8_SCHED; PG8_LDA(At, 1, 0); PG8_STAGE(PG8_SA(0, 1), a2 + hstep, voffA);
            PG8_WAIT_L(8); PG8_BAR; PG8_WAIT_L(0); PG8_MMA(0, 0, At, B0); PG8_BAR; PG8_SCHED;
            PG8_LDB(B1, 1, 1); PG8_STAGE(PG8_SB(1, 0), b3, voffB);
            PG8_BAR; PG8_WAIT_L(0); PG8_MMA(0, 1, At, B1); PG8_BAR;
            PG8_LDA(At, 1, 1); PG8_STAGE(PG8_SA(1, 0), a3, voffA);
            PG8_BAR; PG8_WAIT_L(0); PG8_MMA(1, 0, At, B0); PG8_BAR; PG8_SCHED;
            PG8_STAGE(PG8_SB(1, 1), b3 + hstep, voffB);
            PG8_WAIT_V(6); PG8_BAR; PG8_MMA(1, 1, At, B1); PG8_BAR;
        }
        asm volatile("s_nop 7\n\ts_nop 7\n\ts_nop 7" ::: "memory");
        E(acc, cur, wr, wc, fr, fq);
        if (!has_next) break;
#pragma unroll
        for (int a = 0; a < 2; ++a)
#pragma unroll
            for (int b = 0; b < 2; ++b)
#pragma unroll
                for (int m = 0; m < 4; ++m)
#pragma unroll
                    for (int n = 0; n < 2; ++n) acc[a][b][m][n] = (f32x4){0.f, 0.f, 0.f, 0.f};
        cur = nxt; cA = nA; cB = nB; ++ui;
    }
    PG8_WAIT_V(0);
    if (wr == 0) PG8_BAR;
    PG8_BAR;
#undef PG8_SA
#undef PG8_SB
#undef PG8_STAGE
#undef PG8_LDA
#undef PG8_LDB
#undef PG8_MMA
#undef PG8_WAIT_V
#undef PG8_WAIT_L
#undef PG8_BAR
#undef PG8_SCHED
}
}
using pg8::Unit;

struct EpiProj {
    u16* projA; u16* projB; float* shift_p; float* shift_s;
    __device__ __forceinline__ void operator()(const f32x4 (&acc)[2][2][4][2], const Unit& u, int wr, int wc, int fr, int fq) const {
        const int row0 = u.pm * 256 + wr * 64 + fr;
        const bool isA = u.pn < 7;
        u16* base = isA ? projA : projB;
        const int colt = (isA ? u.pn : u.pn - 7) * 256 + wc * 32 + 4 * fq;
#pragma unroll
        for (int ai = 0; ai < 2; ++ai)
#pragma unroll
            for (int m = 0; m < 4; ++m) {
                const int row = row0 + ai * 128 + m * 16;
                u16* rowp = base + (size_t)row * 1792 + colt;
#pragma unroll
                for (int bj = 0; bj < 2; ++bj)
#pragma unroll
                    for (int n = 0; n < 2; ++n) st_bf4_asm(rowp + bj * 128 + n * 16, acc[ai][bj][m][n]);
                if (isA) {
                    float* dst = nullptr;
                    if (row < MP) { if ((row & 2047) == 2047) dst = shift_p + (size_t)(row >> 11) * 1792; }
                    else { const int r = row - MP; if ((r & 3) == 3) dst = shift_s + (size_t)(r >> 2) * 1792; }
                    if (dst) {
#pragma unroll
                        for (int bj = 0; bj < 2; ++bj)
#pragma unroll
                            for (int n = 0; n < 2; ++n) *(f32x4*)(dst + colt + bj * 128 + n * 16) = acc[ai][bj][m][n];
                    }
                }
            }
    }
};
struct EpiResid {
    const float* base; float* out;
    __device__ __forceinline__ void operator()(const f32x4 (&acc)[2][2][4][2], const Unit& u, int wr, int wc, int fr, int fq) const {
        const int row0 = u.pm * 256 + wr * 64 + fr, col0 = u.pn * 256 + wc * 32 + 4 * fq;
#pragma unroll
        for (int ai = 0; ai < 2; ++ai)
#pragma unroll
            for (int m = 0; m < 4; ++m) {
                const size_t off = (size_t)(row0 + ai * 128 + m * 16) * 1024 + col0;
#pragma unroll
                for (int bj = 0; bj < 2; ++bj)
#pragma unroll
                    for (int n = 0; n < 2; ++n) { const f32x4 b = *(const f32x4*)(base + off + bj * 128 + n * 16); *(f32x4*)(out + off + bj * 128 + n * 16) = b * ALPHA + acc[ai][bj][m][n]; }
            }
    }
};
struct EpiUp {
    u16* gate; u16* val; float* conv_p; float* conv_s;
    __device__ __forceinline__ void operator()(const f32x4 (&acc)[2][2][4][2], const Unit& u, int wr, int wc, int fr, int fq) const {
        const int row0 = u.pm * 256 + wr * 64 + fr;
        const bool isG = u.pn < 11;
        u16* base = isG ? gate : val;
        const int colt = (isG ? u.pn : u.pn - 11) * 256 + wc * 32 + 4 * fq;
#pragma unroll
        for (int ai = 0; ai < 2; ++ai)
#pragma unroll
            for (int m = 0; m < 4; ++m) {
                const int row = row0 + ai * 128 + m * 16;
                u16* rowp = base + (size_t)row * DFF + colt;
#pragma unroll
                for (int bj = 0; bj < 2; ++bj)
#pragma unroll
                    for (int n = 0; n < 2; ++n) st_bf4_asm(rowp + bj * 128 + n * 16, acc[ai][bj][m][n]);
                if (isG) {
                    float* dst = nullptr;
                    if (row < MP) { const int t = row & 2047; if (t >= 2046) dst = conv_p + (size_t)((row >> 11) * 2 + (t - 2046)) * DFF; }
                    else { const int r = row - MP, t = r & 3; if (t >= 2) dst = conv_s + (size_t)((r >> 2) * 2 + (t - 2)) * DFF; }
                    if (dst) {
#pragma unroll
                        for (int bj = 0; bj < 2; ++bj)
#pragma unroll
                            for (int n = 0; n < 2; ++n) *(f32x4*)(dst + colt + bj * 128 + n * 16) = acc[ai][bj][m][n];
                    }
                }
            }
    }
};

__device__ __forceinline__ void transpose_tile(const float* __restrict__ src, u16* __restrict__ dst, int K, int N, int nT, int item, float* tile) {
    const int t = opaque_tid();
    const int kt = item / nT, ntile = item - kt * nT, k0 = kt * 64, n0 = ntile * 64;
    { const int row = t >> 3, c8 = (t & 7) * 8;
      f32x4 a = (f32x4){0.f, 0.f, 0.f, 0.f}, b = a;
      if (n0 + c8 < N) { const float* sp = src + (size_t)(k0 + row) * N + n0 + c8; a = *(const f32x4*)sp; b = *(const f32x4*)(sp + 4); }
      float* tp = tile + row * 65 + c8;
      tp[0] = a[0]; tp[1] = a[1]; tp[2] = a[2]; tp[3] = a[3]; tp[4] = b[0]; tp[5] = b[1]; tp[6] = b[2]; tp[7] = b[3]; }
    __syncthreads();
    { const int n = t >> 3, k8 = (t & 7) * 8;
      float v[8];
#pragma unroll
      for (int j = 0; j < 8; ++j) v[j] = tile[(k8 + j) * 65 + n];
      u32x4 w; w.x = cvt_pk_bf16(v[0], v[1]); w.y = cvt_pk_bf16(v[2], v[3]); w.z = cvt_pk_bf16(v[4], v[5]); w.w = cvt_pk_bf16(v[6], v[7]);
      *(u32x4*)(dst + (size_t)(n0 + n) * K + k0 + k8) = w; }
    __syncthreads();
}
__device__ __forceinline__ void small_transpose(const float* __restrict__ src, u16* __restrict__ dst, int K, int N, int Kpad, size_t gt, size_t nth) {
    for (size_t i = gt; i < (size_t)N * Kpad; i += nth) { const int n = (int)(i / Kpad), k = (int)(i - (size_t)n * Kpad); const float v = k < K ? src[(size_t)k * N + n] : 0.f; dst[i] = (u16)(cvt_pk_bf16(v, 0.f) & 0xffffu); }
}
__device__ void convert_phase(KP p, int l, float* tile) {
    unsigned char* ws = p->ws;
    const int bid = opaque_bid();
    const size_t gt = (size_t)bid * 512 + opaque_tid(), nth = (size_t)gridDim.x * 512;
    constexpr int n1 = 16 * 56, n2 = 16 * 16, n3 = 16 * 88, n4 = 44 * 16;
    for (int it = bid; it < n1 + n2 + n3 + n4; it += gridDim.x) {
        if (it < n1) transpose_tile(p->in[I_WIN] + (size_t)l * 1024 * 3344, (u16*)(ws + W_WIN), 1024, 3344, 56, it, tile);
        else if (it < n1 + n2) transpose_tile(p->in[I_WOUT] + (size_t)l * 1024 * 1024, (u16*)(ws + W_WOUT), 1024, 1024, 16, it - n1, tile);
        else if (it < n1 + n2 + n3) transpose_tile(p->in[I_WUP] + (size_t)l * 1024 * 5632, (u16*)(ws + W_WUP), 1024, 5632, 88, it - n1 - n2, tile);
        else transpose_tile(p->in[I_WDOWN] + (size_t)l * 2816 * 1024, (u16*)(ws + W_WDOWN), 2816, 1024, 16, it - n1 - n2 - n3, tile);
    }
    small_transpose(p->in[I_WLU] + (size_t)l * 64 * 512, (u16*)(ws + W_WLT), 64, 512, 64, gt, nth);
    small_transpose(p->in[I_ALU] + (size_t)l * 64 * 512, (u16*)(ws + W_ALT), 64, 512, 64, gt, nth);
    small_transpose(p->in[I_GLU] + (size_t)l * 128 * 512, (u16*)(ws + W_GLT), 128, 512, 128, gt, nth);
    if (l > 0) {
        small_transpose(p->in[I_VD] + (size_t)(l - 1) * 512 * 32, (u16*)(ws + W_V1T), 512, 32, 512, gt, nth);
        small_transpose(p->in[I_VU] + (size_t)(l - 1) * 32 * 512, (u16*)(ws + W_V2T), 32, 512, 32, gt, nth);
    }
    small_transpose(p->in[I_FUP] + (size_t)l * 16 * 256, (u16*)(ws + W_FT), 16, 256, 32, gt, nth);
    if (l == 0) {
        float* xa = p->out + O_Y; u16* xb = (u16*)(ws + W_XB);
        for (size_t i = gt; i < (size_t)MTOK * 256; i += nth) {
            const size_t e = i * 4;
            const f32x4 v = e < (size_t)MP * 1024 ? *(const f32x4*)(p->in[I_XP] + e) : *(const f32x4*)(p->in[I_XS] + (e - (size_t)MP * 1024));
            *(f32x4*)(xa + e) = v; st_bf4(xb + e, v);
        }
    }
}

__device__ void ln_phase(float* Y, u16* xb, const float* __restrict__ g, const float* __restrict__ b) {
    const int tt_ = opaque_tid();
    const int lane = tt_ & 63, gw = opaque_bid() * 8 + (tt_ >> 6), nw = gridDim.x * 8;
    f32x4 gv[4], bv[4];
#pragma unroll
    for (int i = 0; i < 4; ++i) { gv[i] = *(const f32x4*)(g + i * 256 + lane * 4); bv[i] = *(const f32x4*)(b + i * 256 + lane * 4); }
    for (int row = gw; row < MTOK; row += nw) {
        float* yp = Y + (size_t)row * 1024 + lane * 4;
        f32x4 v[4]; float s = 0.f;
#pragma unroll
        for (int i = 0; i < 4; ++i) { v[i] = *(const f32x4*)(yp + i * 256); s += (v[i][0] + v[i][1]) + (v[i][2] + v[i][3]); }
#pragma unroll
        for (int o = 32; o >= 1; o >>= 1) s += __shfl_xor(s, o);
        const float mu = s * (1.0f / 1024.0f); float q = 0.f;
#pragma unroll
        for (int i = 0; i < 4; ++i) { const f32x4 d = v[i] - mu; q += (d[0] * d[0] + d[1] * d[1]) + (d[2] * d[2] + d[3] * d[3]); }
#pragma unroll
        for (int o = 32; o >= 1; o >>= 1) q += __shfl_xor(q, o);
        const float rstd = rsqrtf(q * (1.0f / 1024.0f) + LN_EPS);
#pragma unroll
        for (int i = 0; i < 4; ++i) { const f32x4 o = (v[i] - mu) * rstd * gv[i] + bv[i]; *(f32x4*)(yp + i * 256) = o; st_bf4(xb + (size_t)row * 1024 + i * 256 + lane * 4, o); }
    }
}

__device__ void convglu_phase(const u16* __restrict__ gate, u16* val, const float* __restrict__ past  , const float* __restrict__ cw, const float* __restrict__ cb) {
    const size_t gt = (size_t)opaque_bid() * 512 + opaque_tid(), nth = (size_t)gridDim.x * 512;
    for (size_t idx = gt; idx < (size_t)MTOK * 352; idx += nth) {
        const int row = (int)(idx / 352), c = (int)(idx - (size_t)row * 352) * 8;
        int t; const float* pst = nullptr;
        if (row < MP) t = row & 2047; else { const int r = row - MP; t = r & 3; pst = past + (size_t)(r >> 2) * 2 * DFF; }
        float g0[8], g1[8], g2[8], vv[8];
        { const u32x4 w = *(const u32x4*)(gate + (size_t)row * DFF + c); g0[0] = bflo(w.x); g0[1] = bfhi(w.x); g0[2] = bflo(w.y); g0[3] = bfhi(w.y); g0[4] = bflo(w.z); g0[5] = bfhi(w.z); g0[6] = bflo(w.w); g0[7] = bfhi(w.w); }
        { const u32x4 w = *(const u32x4*)(val + (size_t)row * DFF + c); vv[0] = bflo(w.x); vv[1] = bfhi(w.x); vv[2] = bflo(w.y); vv[3] = bfhi(w.y); vv[4] = bflo(w.z); vv[5] = bfhi(w.z); vv[6] = bflo(w.w); vv[7] = bfhi(w.w); }
        if (t >= 1) { const u32x4 w = *(const u32x4*)(gate + (size_t)(row - 1) * DFF + c); g1[0] = bflo(w.x); g1[1] = bfhi(w.x); g1[2] = bflo(w.y); g1[3] = bfhi(w.y); g1[4] = bflo(w.z); g1[5] = bfhi(w.z); g1[6] = bflo(w.w); g1[7] = bfhi(w.w); }
        else {
#pragma unroll
            for (int j = 0; j < 8; ++j) g1[j] = pst ? pst[DFF + c + j] : 0.f; }
        if (t >= 2) { const u32x4 w = *(const u32x4*)(gate + (size_t)(row - 2) * DFF + c); g2[0] = bflo(w.x); g2[1] = bfhi(w.x); g2[2] = bflo(w.y); g2[3] = bfhi(w.y); g2[4] = bflo(w.z); g2[5] = bfhi(w.z); g2[6] = bflo(w.w); g2[7] = bfhi(w.w); }
        else {
#pragma unroll
            for (int j = 0; j < 8; ++j) g2[j] = pst ? pst[t * DFF + c + j] : 0.f; }
        float h[8];
#pragma unroll
        for (int j = 0; j < 8; ++j) {
            const float a = cb[c + j] + g2[j] * cw[c + j] + g1[j] * cw[DFF + c + j] + g0[j] * cw[2 * DFF + c + j];
            h[j] = 0.5f * a * (1.0f + erff(a * 0.70710678118654752f)) * vv[j];
        }
        u32x4 w; w.x = cvt_pk_bf16(h[0], h[1]); w.y = cvt_pk_bf16(h[2], h[3]); w.z = cvt_pk_bf16(h[4], h[5]); w.w = cvt_pk_bf16(h[6], h[7]);
        *(u32x4*)(val + (size_t)row * DFF + c) = w;
    }
}

struct PrepCtx {
    const u16* projA; const u16* projB; const float* mu; const float* sshift  ;
};
__device__ __forceinline__ f32x4 xs4(const PrepCtx& c, int i, int col) {
    const f32x4 cur = ld_bf4(c.projA + (size_t)i * 1792 + col);
    f32x4 prev;
    bool first; int b = 0;
    if (i < MP) first = (i & 2047) == 0; else { const int r = i - MP; first = (r & 3) == 0; b = r >> 2; }
    if (!first) prev = ld_bf4(c.projA + (size_t)(i - 1) * 1792 + col);
    else if (i < MP) prev = (f32x4){0.f, 0.f, 0.f, 0.f};
    else prev = *(const f32x4*)(c.sshift + (size_t)b * 1792 + col);
    const f32x4 m = *(const f32x4*)(c.mu + col);
    return cur + (prev - cur) * m;
}
__device__ __forceinline__ bf16x8 ldg_frag(const u16* p) { return *(const bf16x8*)p; }

__device__ void prep_phase(KP p, int l, PG8_LAS unsigned char* lds) {
    unsigned char* ws = p->ws;
    PrepCtx c; c.projA = (const u16*)(ws + W_PROJA); c.projB = (const u16*)(ws + W_PROJB); c.mu = p->in[I_MU] + (size_t)l * 1792; c.sshift = p->in[I_SSHIFT] + (size_t)l * 128 * 1792;
    const u16* wlT = (const u16*)(ws + W_WLT); const u16* alT = (const u16*)(ws + W_ALT); const u16* glT = (const u16*)(ws + W_GLT);
    const u16* v1T = (const u16*)(ws + W_V1T); const u16* v2T = (const u16*)(ws + W_V2T); const u16* fT = (const u16*)(ws + W_FT);
    u32x4* A16 = (u32x4*)(ws + W_BUFB); float* D8 = (float*)(ws + W_D8); u16* vbuf = (u16*)(ws + W_VBUF); u16* gbuf = (u16*)(ws + W_GBUF);
    float* decb = (float*)(ws + W_DEC); float* rkb = (float*)(ws + W_RK); u16* vfirst = (u16*)(ws + W_VFIRST);
    const float* w0 = p->in[I_W0] + l * 512; const float* a0 = p->in[I_A0] + l * 512; const float* k_k = p->in[I_KK] + l * 512; const float* k_a = p->in[I_KA] + l * 512;
    const float* r_k = p->in[I_RK] + l * 512; const float* vb = l > 0 ? p->in[I_VB] + (l - 1) * 512 : nullptr; const float* fbias = p->in[I_FB] + l * 256;
    constexpr int S_TW = 144, S_AL = 144, S_SG = 272, S_XV = 1040, S_FL = 80, S_PP = 80;
    constexpr int O_TW = 0, O_AL = O_TW + 16 * S_TW, O_SG = O_AL + 16 * S_AL, O_XV = O_SG + 16 * S_SG, O_FL = O_XV + 16 * S_XV, O_PP = O_FL + 16 * S_FL;
    const int t = opaque_tid(), wid = t >> 6, lane = t & 63, fr = lane & 15, fq = lane >> 4, h = wid;
    for (int blk = opaque_bid(); blk < MTOK / 16; blk += gridDim.x) {
        const int i0 = blk * 16;
#pragma unroll 1
        for (int q = 0; q < 6; ++q) {
            const int op = t + 512 * q, r = op / 192, g4 = op - r * 192, col = 1024 + 4 * g4;
            f32x4 x = xs4(c, i0 + r, col);
            int off;
            if (col < 1536) off = O_XV + r * S_XV + (col - 1024) * 2;
            else if (col < 1600) { off = O_TW + r * S_TW + (col - 1536) * 2; x = (f32x4){tanhf(x[0]), tanhf(x[1]), tanhf(x[2]), tanhf(x[3])}; }
            else if (col < 1664) off = O_AL + r * S_AL + (col - 1600) * 2;
            else { off = O_SG + r * S_SG + (col - 1664) * 2; x = (f32x4){sigmoidf_(x[0]), sigmoidf_(x[1]), sigmoidf_(x[2]), sigmoidf_(x[3])}; }
            u32x2 w; w.x = cvt_pk_bf16(x[0], x[1]); w.y = cvt_pk_bf16(x[2], x[3]);
            *(PG8_LAS u32x2*)(lds + off) = w;
        }
        if (t < 128) { const int r = t >> 3, c4 = (t & 7) * 4; u32x2 w = (u32x2){0u, 0u}; if (c4 < 16) w = *(const u32x2*)(c.projB + (size_t)(i0 + r) * 1792 + 1536 + c4); *(PG8_LAS u32x2*)(lds + O_FL + r * S_FL + c4 * 2) = w; }
        __syncthreads();
        bf16x8 pfrag = (bf16x8){0, 0, 0, 0, 0, 0, 0, 0};
        if (l > 0) {
            f32x4 accP0 = (f32x4){0.f, 0.f, 0.f, 0.f}, accP1 = accP0;
#pragma unroll 4
            for (int ks = 0; ks < 16; ++ks) {
                const bf16x8 af = *(const PG8_LAS bf16x8*)(lds + O_XV + fr * S_XV + (ks * 32 + fq * 8) * 2);
                accP0 = __builtin_amdgcn_mfma_f32_16x16x32_bf16(ldg_frag(v1T + (size_t)fr * 512 + ks * 32 + fq * 8), af, accP0, 0, 0, 0);
                accP1 = __builtin_amdgcn_mfma_f32_16x16x32_bf16(ldg_frag(v1T + (size_t)(16 + fr) * 512 + ks * 32 + fq * 8), af, accP1, 0, 0, 0);
            }
            const u32 w0_ = cvt_pk_bf16(accP0[0], accP0[1]), w1_ = cvt_pk_bf16(accP0[2], accP0[3]), w2_ = cvt_pk_bf16(accP1[0], accP1[1]), w3_ = cvt_pk_bf16(accP1[2], accP1[3]);
            const u32x4 pw = (u32x4){w0_, w1_, w2_, w3_};
            pfrag = __builtin_bit_cast(bf16x8, pw);
        }
        const int i = i0 + fr;
        float ss = 0.f;
#pragma unroll
        for (int n = 0; n < 4; ++n) { const int cb_ = h * 64 + 16 * n + 4 * fq; const f32x4 xk = xs4(c, i, 512 + cb_) * *(const f32x4*)(k_k + cb_); ss += (xk[0] * xk[0] + xk[1] * xk[1]) + (xk[2] * xk[2] + xk[3] * xk[3]); }
        ss += __shfl_xor(ss, 16); ss += __shfl_xor(ss, 32);
        const float inorm = rsqrtf(fmaxf(ss, 1e-24f));
        float rks = 0.f;
#pragma unroll 1
        for (int n = 0; n < 4; ++n) {
            const int cn = h * 64 + 16 * n, cb_ = cn + 4 * fq;
            f32x4 aW = (f32x4){0.f, 0.f, 0.f, 0.f}, aA = aW, aG = aW, aV = aW;
#pragma unroll
            for (int ks = 0; ks < 2; ++ks) {
                aW = __builtin_amdgcn_mfma_f32_16x16x32_bf16(ldg_frag(wlT + (size_t)(cn + fr) * 64 + ks * 32 + fq * 8), *(const PG8_LAS bf16x8*)(lds + O_TW + fr * S_TW + (ks * 32 + fq * 8) * 2), aW, 0, 0, 0);
                aA = __builtin_amdgcn_mfma_f32_16x16x32_bf16(ldg_frag(alT + (size_t)(cn + fr) * 64 + ks * 32 + fq * 8), *(const PG8_LAS bf16x8*)(lds + O_AL + fr * S_AL + (ks * 32 + fq * 8) * 2), aA, 0, 0, 0);
            }
#pragma unroll
            for (int ks = 0; ks < 4; ++ks)
                aG = __builtin_amdgcn_mfma_f32_16x16x32_bf16(ldg_frag(glT + (size_t)(cn + fr) * 128 + ks * 32 + fq * 8), *(const PG8_LAS bf16x8*)(lds + O_SG + fr * S_SG + (ks * 32 + fq * 8) * 2), aG, 0, 0, 0);
            if (l > 0) {
                const u32x2 va = *(const u32x2*)(v2T + (size_t)(cn + fr) * 32 + 4 * fq), vc = *(const u32x2*)(v2T + (size_t)(cn + fr) * 32 + 16 + 4 * fq);
                const u32x4 vw = (u32x4){va.x, va.y, vc.x, vc.y};
                aV = __builtin_amdgcn_mfma_f32_16x16x32_bf16(__builtin_bit_cast(bf16x8, vw), pfrag, aV, 0, 0, 0);
            }
            const f32x4 xr = xs4(c, i, cb_), xk = xs4(c, i, 512 + cb_), xv = xs4(c, i, 1024 + cb_);
            const f32x4 w0v = *(const f32x4*)(w0 + cb_), a0v = *(const f32x4*)(a0 + cb_), kkv = *(const f32x4*)(k_k + cb_), kav = *(const f32x4*)(k_a + cb_), rkv = *(const f32x4*)(r_k + cb_);
            f32x4 vp = xv;
            if (l == 0) st_bf4(vfirst + (size_t)i * 512 + cb_, xv);
            else { const f32x4 vf = ld_bf4(vfirst + (size_t)i * 512 + cb_); const f32x4 vbv = *(const f32x4*)(vb + cb_);
#pragma unroll
                for (int j = 0; j < 4; ++j) vp[j] = xv[j] + (vf[j] - xv[j]) * sigmoidf_(vbv[j] + aV[j]);
            }
            f32x4 dd, kt, kn, bb;
#pragma unroll
            for (int j = 0; j < 4; ++j) {
                const float wv = -softplusf_(-(w0v[j] + aW[j])) - 0.5f;
                dd[j] = __expf(-__expf(wv));
                const float a = sigmoidf_(a0v[j] + aA[j]);
                kn[j] = xk[j] * kkv[j] * inorm;
                kt[j] = xk[j] * (1.0f + (a - 1.0f) * kav[j]);
                bb[j] = kn[j] * a;
                rks += xr[j] * kt[j] * rkv[j];
            }
            const int p0 = 8 * n + 2 * fq;
            u32x4 rec0, rec1;
            rec0.x = cvt_pk_bf16(xr[0], xr[1]); rec0.y = cvt_pk_bf16(kt[0], kt[1]); rec0.z = cvt_pk_bf16(kn[0], kn[1]); rec0.w = cvt_pk_bf16(bb[0], bb[1]);
            rec1.x = cvt_pk_bf16(xr[2], xr[3]); rec1.y = cvt_pk_bf16(kt[2], kt[3]); rec1.z = cvt_pk_bf16(kn[2], kn[3]); rec1.w = cvt_pk_bf16(bb[2], bb[3]);
            u32x4* ap = A16 + ((size_t)i * 8 + h) * 32 + p0;
            ap[0] = rec0; ap[1] = rec1;
            *(f32x4*)(D8 + (size_t)i * 512 + cb_) = dd;
            st_bf4(vbuf + (size_t)i * 512 + cb_, vp);
            st_bf4(gbuf + (size_t)i * 512 + cb_, aG);
        }
        rks += __shfl_xor(rks, 16); rks += __shfl_xor(rks, 32);
        if (fq == 0) rkb[(size_t)i * 8 + h] = rks;
#pragma unroll
        for (int n2 = 0; n2 < 2; ++n2) {
            const int cn = 32 * h + 16 * n2;
            f32x4 aF = (f32x4){0.f, 0.f, 0.f, 0.f};
            aF = __builtin_amdgcn_mfma_f32_16x16x32_bf16(ldg_frag(fT + (size_t)(cn + fr) * 32 + fq * 8), *(const PG8_LAS bf16x8*)(lds + O_FL + fr * S_FL + (fq * 8) * 2), aF, 0, 0, 0);
            const f32x4 fb = *(const f32x4*)(fbias + cn + 4 * fq);
            f32x4 dc;
#pragma unroll
            for (int j = 0; j < 4; ++j) { const float z = aF[j] + fb[j]; dc[j] = __expf(-softplusf_(-z) * (1.0f / 16.0f)); }
            *(f32x4*)(decb + (size_t)i * 256 + cn + 4 * fq) = dc;
        }
        __syncthreads();
    }
}

struct ScanItem {
    int tok0, T, L;
    int h, q;
    int hg, cgp;
    const float* s0_rwkv; float* so_rwkv;
    const float* s0_gla; float* so_gla;
};
template <int LSEG>
__device__ __forceinline__ void scan_item(KP p, const ScanItem& it, PG8_LAS unsigned char* lds) {
    unsigned char* ws = p->ws;
    const u32x4* A16 = (const u32x4*)(ws + W_BUFB); const float* D8 = (const float*)(ws + W_D8); const u16* vbuf = (const u16*)(ws + W_VBUF);
    const u16* projB = (const u16*)(ws + W_PROJB); const float* decb = (const float*)(ws + W_DEC);
    u16* obufA = (u16*)(ws + W_OBUFA); u16* obufB = (u16*)(ws + W_OBUFB);
    const int t = opaque_tid(), wid = t >> 6, lane = t & 63, kq = lane & 15, rsel = lane >> 4;
    constexpr int BUF = 69632, OR = 0, OKT = 8192, OKN = 16384, OB = 24576, OD = 32768, OVR = 40960, OQ = 43008, OK = 51200, ODC = 59392, OVG = 67584;
    const int nchunk = it.T / TC;
    u32x4 sa0, sa1; f32x4 sd, sdec; u32x2 svr = (u32x2){0u, 0u}, sq, sk;
#define SC_GLOAD(ch_) do { const int tk_ = it.tok0 + (ch_) * TC; \
        { const int i0 = t, i1 = t + 512; sa0 = A16[((size_t)(tk_ + (i0 >> 5)) * 8 + it.h) * 32 + (i0 & 31)]; sa1 = A16[((size_t)(tk_ + (i1 >> 5)) * 8 + it.h) * 32 + (i1 & 31)]; } \
        { const int st = t >> 4, c4 = (t & 15) * 4; sd = *(const f32x4*)(D8 + (size_t)(tk_ + st) * 512 + it.h * 64 + c4); \
          sq = *(const u32x2*)(projB + (size_t)(tk_ + st) * 1792 + it.hg * 64 + c4); sk = *(const u32x2*)(projB + (size_t)(tk_ + st) * 1792 + 256 + it.hg * 64 + c4); \
          sdec = *(const f32x4*)(decb + (size_t)(tk_ + st) * 256 + it.hg * 64 + c4); } \
        if (t < 128) { const int st = t >> 2, c4 = (t & 3) * 4; svr = *(const u32x2*)(vbuf + (size_t)(tk_ + st) * 512 + it.h * 64 + it.q * 16 + c4); } \
        else if (t < 256) { const int tt = t - 128, st = tt >> 2, c4 = (tt & 3) * 4; svr = *(const u32x2*)(projB + (size_t)(tk_ + st) * 1792 + 512 + it.hg * 128 + it.cgp * 16 + c4); } } while (0)
#define SC_LSTORE(buf_) do { PG8_LAS unsigned char* b_ = lds + (buf_) * BUF; \
        { const int i0 = t, i1 = t + 512; \
          { const int st = i0 >> 5, pp = i0 & 31; const int o = (st * 64 + 2 * pp) * 4; \
            *(PG8_LAS f32x2*)(b_ + OR + o) = (f32x2){bflo(sa0.x), bfhi(sa0.x)}; *(PG8_LAS f32x2*)(b_ + OKT + o) = (f32x2){bflo(sa0.y), bfhi(sa0.y)}; \
            *(PG8_LAS f32x2*)(b_ + OKN + o) = (f32x2){bflo(sa0.z), bfhi(sa0.z)}; *(PG8_LAS f32x2*)(b_ + OB + o) = (f32x2){bflo(sa0.w), bfhi(sa0.w)}; } \
          { const int st = i1 >> 5, pp = i1 & 31; const int o = (st * 64 + 2 * pp) * 4; \
            *(PG8_LAS f32x2*)(b_ + OR + o) = (f32x2){bflo(sa1.x), bfhi(sa1.x)}; *(PG8_LAS f32x2*)(b_ + OKT + o) = (f32x2){bflo(sa1.y), bfhi(sa1.y)}; \
            *(PG8_LAS f32x2*)(b_ + OKN + o) = (f32x2){bflo(sa1.z), bfhi(sa1.z)}; *(PG8_LAS f32x2*)(b_ + OB + o) = (f32x2){bflo(sa1.w), bfhi(sa1.w)}; } } \
        { const int st = t >> 4, c4 = (t & 15) * 4; const int o = (st * 64 + c4) * 4; \
          *(PG8_LAS f32x4*)(b_ + OD + o) = sd; *(PG8_LAS f32x4*)(b_ + ODC + o) = sdec; \
          *(PG8_LAS f32x4*)(b_ + OQ + o) = (f32x4){bflo(sq.x), bfhi(sq.x), bflo(sq.y), bfhi(sq.y)} * 0.125f; \
          *(PG8_LAS f32x4*)(b_ + OK + o) = (f32x4){bflo(sk.x), bfhi(sk.x), bflo(sk.y), bfhi(sk.y)}; } \
        if (t < 128) { const int st = t >> 2, c4 = (t & 3) * 4; *(PG8_LAS f32x4*)(b_ + OVR + (st * 16 + c4) * 4) = (f32x4){bflo(svr.x), bfhi(svr.x), bflo(svr.y), bfhi(svr.y)}; } \
        else if (t < 256) { const int tt = t - 128, st = tt >> 2, c4 = (tt & 3) * 4; *(PG8_LAS f32x4*)(b_ + OVG + (st * 16 + c4) * 4) = (f32x4){bflo(svr.x), bfhi(svr.x), bflo(svr.y), bfhi(svr.y)}; } } while (0)
    const bool isR = wid < 4;
    const int w4 = wid & 3;
    const int row = it.q * 16 + 4 * w4 + rsel;
    const int col = it.cgp * 16 + 4 * w4 + rsel;
    f32x4 S = (f32x4){0.f, 0.f, 0.f, 0.f}, Sn = S;
#define SC_LOAD_STATE(dst_, seg_) do { const int sg_ = (seg_); \
        if (isR) { if (!it.s0_rwkv) dst_ = (f32x4){0.f, 0.f, 0.f, 0.f}; else dst_ = *(const f32x4*)(it.s0_rwkv + (size_t)sg_ * 8 * 4096 + row * 64 + 4 * kq); } \
        else if (!it.s0_gla) dst_ = (f32x4){0.f, 0.f, 0.f, 0.f}; \
        else { const float* sp_ = it.s0_gla + (size_t)sg_ * 4 * 8192 + (size_t)(4 * kq) * 128 + col; dst_ = (f32x4){sp_[0], sp_[128], sp_[256], sp_[384]}; } } while (0)
#define SC_STORE_STATE(seg_, s_) do { const int sg_ = (seg_); \
        if (isR) { *(f32x4*)(it.so_rwkv + (size_t)sg_ * 8 * 4096 + row * 64 + 4 * kq) = s_; } \
        else { float* sp_ = it.so_gla + (size_t)sg_ * 4 * 8192 + (size_t)(4 * kq) * 128 + col; sp_[0] = s_[0]; sp_[128] = s_[1]; sp_[256] = s_[2]; sp_[384] = s_[3]; } } while (0)
    SC_GLOAD(0);
    SC_LOAD_STATE(Sn, 0);
    SC_LSTORE(0);
    __syncthreads();
    u16* oAp = obufA + (size_t)it.tok0 * 512 + it.h * 64 + row;
    u16* oBp = obufB + (size_t)it.tok0 * 512 + it.hg * 128 + col;
    const int vsl = (4 * w4 + rsel) * 4;
#define SC_STEP_R(s_) do { const int o = ((s_) * 64 + 4 * kq) * 4; \
        const f32x4 r4 = *(const PG8_LAS f32x4*)(b + OR + o), k4 = *(const PG8_LAS f32x4*)(b + OKT + o), n4 = *(const PG8_LAS f32x4*)(b + OKN + o), b4 = *(const PG8_LAS f32x4*)(b + OB + o), d4 = *(const PG8_LAS f32x4*)(b + OD + o); \
        const float v = *(const PG8_LAS float*)(b + OVR + (s_) * 64 + vsl); \
        float dot = (S[0] * n4[0] + S[1] * n4[1]) + (S[2] * n4[2] + S[3] * n4[3]); \
        dot = red16(dot); \
        S = S * d4 - b4 * dot + k4 * v; \
        float o_ = (S[0] * r4[0] + S[1] * r4[1]) + (S[2] * r4[2] + S[3] * r4[3]); \
        o_ = red16(o_); \
        if (kq == 0) oAp[(size_t)(s_) * 512] = (u16)(cvt_pk_bf16(o_, 0.f) & 0xffffu); } while (0)
#define SC_STEP_G(s_) do { const int o = ((s_) * 64 + 4 * kq) * 4; \
        const f32x4 q4 = *(const PG8_LAS f32x4*)(b + OQ + o), k4 = *(const PG8_LAS f32x4*)(b + OK + o), d4 = *(const PG8_LAS f32x4*)(b + ODC + o); \
        const float v = *(const PG8_LAS float*)(b + OVG + (s_) * 64 + vsl); \
        S = S * d4 + k4 * v; \
        float o_ = (S[0] * q4[0] + S[1] * q4[1]) + (S[2] * q4[2] + S[3] * q4[3]); \
        o_ = red16(o_); \
        if (kq == 0) oBp[(size_t)(s_) * 512] = (u16)(cvt_pk_bf16(o_, 0.f) & 0xffffu); } while (0)
    for (int ch = 0; ch < nchunk; ++ch) {
        const bool more = ch + 1 < nchunk;
        if (more) SC_GLOAD(ch + 1);
        PG8_LAS unsigned char* b = lds + (ch & 1) * BUF;
        if (LSEG >= TC) {
            if (ch == 0) S = Sn;
            if (isR) {
#pragma unroll 8
                for (int s = 0; s < TC; ++s) SC_STEP_R(s);
            } else {
#pragma unroll 8
                for (int s = 0; s < TC; ++s) SC_STEP_G(s);
            }
            if (!more) SC_STORE_STATE(0, S);
        } else {
#pragma unroll 1
            for (int sgi = 0; sgi < TC / LSEG; ++sgi) {
                const int seg = ch * (TC / LSEG) + sgi;
                S = Sn;
                if ((seg + 1) * LSEG < it.T) SC_LOAD_STATE(Sn, seg + 1);
                if (isR) {
#pragma unroll
                    for (int s2 = 0; s2 < LSEG; ++s2) SC_STEP_R(sgi * LSEG + s2);
                } else {
#pragma unroll
                    for (int s2 = 0; s2 < LSEG; ++s2) SC_STEP_G(sgi * LSEG + s2);
                }
                SC_STORE_STATE(seg, S);
            }
        }
        oAp += (size_t)TC * 512; oBp += (size_t)TC * 512;
        if (more) SC_LSTORE((ch + 1) & 1);
        __syncthreads();
    }
#undef SC_STEP_R
#undef SC_STEP_G
}
__device__ void scan_phase(KP p, int l, PG8_LAS unsigned char* lds) {
    float* out = p->out;
    const int bid = opaque_bid();
    for (int i = bid; i < 256; i += gridDim.x) {
        ScanItem it; const int s = i >> 5;
        it.tok0 = s * 2048; it.T = 2048; it.L = 2048; it.h = (i >> 2) & 7; it.q = i & 3; it.hg = (i >> 3) & 3; it.cgp = i & 7;
        it.s0_rwkv = nullptr; it.so_rwkv = out + O_RWKV_P + ((size_t)(l * 8 + s) * 8 + it.h) * 4096;
        it.s0_gla = nullptr; it.so_gla = out + O_GLA_P + ((size_t)(l * 8 + s) * 4 + it.hg) * 8192;
        scan_item<2048>(p, it, lds);
    }
    for (int i = bid; i < 256; i += gridDim.x) {
        ScanItem it; const int bg = i >> 5, b0 = bg * 16;
        it.tok0 = MP + bg * 64; it.T = 64; it.L = 4; it.h = (i >> 2) & 7; it.q = i & 3; it.hg = (i >> 3) & 3; it.cgp = i & 7;
        it.s0_rwkv = p->in[I_SRWKV] + ((size_t)(l * 128 + b0) * 8 + it.h) * 4096; it.so_rwkv = out + O_RWKV_S + ((size_t)(l * 128 + b0) * 8 + it.h) * 4096;
        it.s0_gla = p->in[I_SGLA] + ((size_t)(l * 128 + b0) * 4 + it.hg) * 8192; it.so_gla = out + O_GLA_S + ((size_t)(l * 128 + b0) * 4 + it.hg) * 8192;
        scan_item<4>(p, it, lds);
    }
}

__device__ void post_phase(KP p, int l) {
    unsigned char* ws = p->ws;
    const u16* obufA = (const u16*)(ws + W_OBUFA); const u16* obufB = (const u16*)(ws + W_OBUFB); const u16* vbuf = (const u16*)(ws + W_VBUF); const u16* gbuf = (const u16*)(ws + W_GBUF);
    const float* rkb = (const float*)(ws + W_RK); const u16* projB = (const u16*)(ws + W_PROJB); u16* oab = (u16*)(ws + W_XB);
    const float* lg = p->in[I_LNXG] + l * 512; const float* lb = p->in[I_LNXB] + l * 512; const float* ng = p->in[I_NG] + l * 128;
    const int tt_ = opaque_tid();
    const int lane = tt_ & 63, gw = opaque_bid() * 8 + (tt_ >> 6), nw = gridDim.x * 8;
    const int c = lane * 8;
    float lgv[8], lbv[8], ngv[8];
#pragma unroll
    for (int j = 0; j < 8; ++j) { lgv[j] = lg[c + j]; lbv[j] = lb[c + j]; ngv[j] = ng[(c & 127) + j]; }
    for (int i = gw; i < MTOK; i += nw) {
        {
            const f32x4 o0 = ld_bf4(obufA + (size_t)i * 512 + c), o1 = ld_bf4(obufA + (size_t)i * 512 + c + 4);
            const f32x4 v0 = ld_bf4(vbuf + (size_t)i * 512 + c), v1 = ld_bf4(vbuf + (size_t)i * 512 + c + 4);
            const f32x4 g0 = ld_bf4(gbuf + (size_t)i * 512 + c), g1 = ld_bf4(gbuf + (size_t)i * 512 + c + 4);
            const float rk = rkb[(size_t)i * 8 + (lane >> 3)];
            float s = (o0[0] + o0[1]) + (o0[2] + o0[3]) + (o1[0] + o1[1]) + (o1[2] + o1[3]);
            s += __shfl_xor(s, 1); s += __shfl_xor(s, 2); s += __shfl_xor(s, 4);
            const float m = s * (1.0f / 64.0f);
            const f32x4 d0 = o0 - m, d1 = o1 - m;
            float q = (d0[0] * d0[0] + d0[1] * d0[1]) + (d0[2] * d0[2] + d0[3] * d0[3]) + (d1[0] * d1[0] + d1[1] * d1[1]) + (d1[2] * d1[2] + d1[3] * d1[3]);
            q += __shfl_xor(q, 1); q += __shfl_xor(q, 2); q += __shfl_xor(q, 4);
            const float rs = rsqrtf(q * (1.0f / 64.0f) + GN_EPS_A);
            f32x4 y0, y1;
#pragma unroll
            for (int j = 0; j < 4; ++j) { y0[j] = (d0[j] * rs * lgv[j] + lbv[j] + rk * v0[j]) * g0[j]; y1[j] = (d1[j] * rs * lgv[4 + j] + lbv[4 + j] + rk * v1[j]) * g1[j]; }
            u32x4 w; w.x = cvt_pk_bf16(y0[0], y0[1]); w.y = cvt_pk_bf16(y0[2], y0[3]); w.z = cvt_pk_bf16(y1[0], y1[1]); w.w = cvt_pk_bf16(y1[2], y1[3]);
            *(u32x4*)(oab + (size_t)i * 1024 + c) = w;
        }
        {
            const f32x4 o0 = ld_bf4(obufB + (size_t)i * 512 + c), o1 = ld_bf4(obufB + (size_t)i * 512 + c + 4);
            const f32x4 g0 = ld_bf4(projB + (size_t)i * 1792 + 1024 + c), g1 = ld_bf4(projB + (size_t)i * 1792 + 1024 + c + 4);
            float q = (o0[0] * o0[0] + o0[1] * o0[1]) + (o0[2] * o0[2] + o0[3] * o0[3]) + (o1[0] * o1[0] + o1[1] * o1[1]) + (o1[2] * o1[2] + o1[3] * o1[3]);
            q += __shfl_xor(q, 1); q += __shfl_xor(q, 2); q += __shfl_xor(q, 4); q += __shfl_xor(q, 8);
            const float rs = rsqrtf(q * (1.0f / 128.0f) + RMS_EPS);
            f32x4 y0, y1;
#pragma unroll
            for (int j = 0; j < 4; ++j) { y0[j] = o0[j] * rs * ngv[j] * (g0[j] * sigmoidf_(g0[j])); y1[j] = o1[j] * rs * ngv[4 + j] * (g1[j] * sigmoidf_(g1[j])); }
            u32x4 w; w.x = cvt_pk_bf16(y0[0], y0[1]); w.y = cvt_pk_bf16(y0[2], y0[3]); w.z = cvt_pk_bf16(y1[0], y1[1]); w.w = cvt_pk_bf16(y1[2], y1[3]);
            *(u32x4*)(oab + (size_t)i * 1024 + 512 + c) = w;
        }
    }
}

__device__ __forceinline__ void gsync(cg::grid_group& grid) {
    asm volatile("s_waitcnt vmcnt(0)" ::: "memory");
    grid.sync();
    if (threadIdx.x < 64) { __builtin_amdgcn_fence(__ATOMIC_ACQUIRE, "agent"); asm volatile("s_waitcnt vmcnt(0)" ::: "memory"); }
    __syncthreads();
}

__global__ void __launch_bounds__(512, 2) mega(Params p_unused) {
    KP p = kparams();
    extern __shared__ __attribute__((aligned(16))) unsigned char smem[];
    PG8_LAS unsigned char* lds = (PG8_LAS unsigned char*)smem;
    cg::grid_group grid = cg::this_grid();
    unsigned char* ws = p->ws;
    float* bufA = p->out + O_Y; float* bufB = (float*)(ws + W_BUFB); u16* xb = (u16*)(ws + W_XB);
    pg8::StaticOrder S;
#define PHASE_END() gsync(grid)
    gsync(grid);
    convert_phase(kparams(), 0, (float*)smem);
    PHASE_END();
    for (int l = 0; l < NL; ++l) {
        {
            pg8::Gemm g; g.A = xb; g.Bt = (const u16*)(ws + W_WIN); g.M = MTOK; g.N = INP; g.K = 1024;
            EpiProj E; E.projA = (u16*)(ws + W_PROJA); E.projB = (u16*)(ws + W_PROJB); E.shift_p = p->out + O_SHIFT_P + (size_t)l * 8 * 1792; E.shift_s = p->out + O_SHIFT_S + (size_t)l * 128 * 1792;
            S.init(MTOK, INP, gridDim.x, opaque_bid()); pg8::gemm_phase(lds, g, S, E);
        }
        PHASE_END();
        prep_phase(kparams(), l, lds);
        PHASE_END();
        scan_phase(kparams(), l, lds);
        PHASE_END();
        post_phase(kparams(), l);
        PHASE_END();
        {
            pg8::Gemm g; g.A = xb; g.Bt = (const u16*)(ws + W_WOUT); g.M = MTOK; g.N = 1024; g.K = 1024;
            EpiResid E; E.base = bufA; E.out = bufB;
            S.init(MTOK, 1024, gridDim.x, opaque_bid()); pg8::gemm_phase(lds, g, S, E);
        }
        PHASE_END();
        ln_phase(bufB, xb, p->in[I_LN1G] + l * 1024, p->in[I_LN1B] + l * 1024);
        PHASE_END();
        {
            pg8::Gemm g; g.A = xb; g.Bt = (const u16*)(ws + W_WUP); g.M = MTOK; g.N = 5632; g.K = 1024;
            EpiUp E; E.gate = (u16*)(ws + W_GATE); E.val = (u16*)(ws + W_VAL); E.conv_p = p->out + O_CONV_P + (size_t)l * 8 * 2 * DFF; E.conv_s = p->out + O_CONV_S + (size_t)l * 128 * 2 * DFF;
            S.init(MTOK, 5632, gridDim.x, opaque_bid()); pg8::gemm_phase(lds, g, S, E);
        }
        PHASE_END();
        convglu_phase((const u16*)(ws + W_GATE), (u16*)(ws + W_VAL), p->in[I_SCONV] + (size_t)l * 128 * 2 * DFF, p->in[I_CW] + (size_t)l * 3 * DFF, p->in[I_CB] + (size_t)l * DFF);
        PHASE_END();
        {
            pg8::Gemm g; g.A = (const u16*)(ws + W_VAL); g.Bt = (const u16*)(ws + W_WDOWN); g.M = MTOK; g.N = 1024; g.K = DFF;
            EpiResid E; E.base = bufB; E.out = bufA;
            S.init(MTOK, 1024, gridDim.x, opaque_bid()); pg8::gemm_phase(lds, g, S, E);
        }
        PHASE_END();
        ln_phase(bufA, xb, p->in[I_LN2G] + l * 1024, p->in[I_LN2B] + l * 1024);
        if (l + 1 < NL) convert_phase(kparams(), l + 1, (float*)smem);
        PHASE_END();
    }
}

extern "C" void kernel_launch(void* const* d_in, const int* in_sizes, int n_in, void* d_out, int out_size, void* d_ws, size_t ws_size, hipStream_t stream) {
    static int grid_blocks = 0;
    if (!grid_blocks) {
        int dev = 0, cus = 0, per_cu = 0;
        (void)hipGetDevice(&dev);
        (void)hipDeviceGetAttribute(&cus, hipDeviceAttributeMultiprocessorCount, dev);
        (void)hipFuncSetAttribute((const void*)mega, hipFuncAttributeMaxDynamicSharedMemorySize, LDS_BYTES);
        (void)hipOccupancyMaxActiveBlocksPerMultiprocessor(&per_cu, (const void*)mega, 512, LDS_BYTES);
        grid_blocks = cus;
        if (n_in != 33 || (size_t)out_size != O_END || ws_size < W_END) { fprintf(stderr, "kernel_launch: unexpected sizes n_in %d out %d ws %zu (need %zu)\n", n_in, out_size, ws_size, (size_t)W_END); grid_blocks = -1; }
    }
    if (grid_blocks < 0) return;
    Params p{};
    for (int i = 0; i < 33; ++i) p.in[i] = (const float*)d_in[i];
    p.out = (float*)d_out; p.ws = (unsigned char*)d_ws;
    void* args[] = {&p};
    hipError_t e = hipLaunchCooperativeKernel((const void*)mega, dim3(grid_blocks), dim3(512), args, LDS_BYTES, stream);
    if (e != hipSuccess) fprintf(stderr, "cooperative launch failed: %s (grid %d)\n", hipGetErrorString(e), grid_blocks);
}
```

```cpp
#include <hip/hip_runtime.h>
#include <hip/hip_cooperative_groups.h>
#include <cstdio>
namespace cg = cooperative_groups;

#define PG8_LAS __attribute__((address_space(3)))
typedef unsigned short u16;
typedef unsigned int u32;
typedef unsigned short bf16_t;
typedef short bf16x8 __attribute__((ext_vector_type(8)));
typedef float f32x4 __attribute__((ext_vector_type(4)));
typedef float f32x2 __attribute__((ext_vector_type(2)));
typedef unsigned u32x4 __attribute__((ext_vector_type(4)));
typedef unsigned u32x2 __attribute__((ext_vector_type(2)));

constexpr int MTOK = 16896, MP = 16384, DM = 1024, NL = 4;
constexpr int SHIFT_W = 1792, INP = 3584, DFF = 2816;
constexpr float ALPHA = 1.6817928305074290f;
constexpr float GN_EPS_A = 64e-5f, RMS_EPS = 1e-5f, LN_EPS = 1e-5f;
constexpr int LDS_BYTES = 139264;
constexpr int TC = 32;

enum { I_XP = 0, I_XS, I_SRWKV, I_SSHIFT, I_SGLA, I_SCONV, I_WIN, I_MU, I_W0, I_WLU, I_A0, I_ALU, I_GLU, I_KK, I_KA, I_RK, I_LNXG, I_LNXB,
       I_VB, I_VD, I_VU, I_FUP, I_FB, I_NG, I_WOUT, I_LN1G, I_LN1B, I_WUP, I_CW, I_CB, I_WDOWN, I_LN2G, I_LN2B };

constexpr size_t O_Y = 0;
constexpr size_t O_RWKV_P = (size_t)MTOK * DM;
constexpr size_t O_RWKV_S = O_RWKV_P + (size_t)4 * 8 * 8 * 4096;
constexpr size_t O_SHIFT_P = O_RWKV_S + (size_t)4 * 128 * 8 * 4096;
constexpr size_t O_SHIFT_S = O_SHIFT_P + (size_t)4 * 8 * 1792;
constexpr size_t O_GLA_P = O_SHIFT_S + (size_t)4 * 128 * 1792;
constexpr size_t O_GLA_S = O_GLA_P + (size_t)4 * 8 * 4 * 8192;
constexpr size_t O_CONV_P = O_GLA_S + (size_t)4 * 128 * 4 * 8192;
constexpr size_t O_CONV_S = O_CONV_P + (size_t)4 * 8 * 2 * 2816;
constexpr size_t O_END = O_CONV_S + (size_t)4 * 128 * 2 * 2816;

constexpr size_t W_WIN = 0;
constexpr size_t W_WOUT = W_WIN + (size_t)INP * 1024 * 2;
constexpr size_t W_WUP = W_WOUT + (size_t)1024 * 1024 * 2;
constexpr size_t W_WDOWN = W_WUP + (size_t)5632 * 1024 * 2;
constexpr size_t W_WLT = W_WDOWN + (size_t)1024 * 2816 * 2;
constexpr size_t W_ALT = W_WLT + 512 * 64 * 2;
constexpr size_t W_GLT = W_ALT + 512 * 64 * 2;
constexpr size_t W_V1T = W_GLT + 512 * 128 * 2;
constexpr size_t W_V2T = W_V1T + 32 * 512 * 2;
constexpr size_t W_FT = W_V2T + 512 * 32 * 2;
constexpr size_t W_XB = W_FT + 256 * 32 * 2;
constexpr size_t W_VFIRST = W_XB + (size_t)MTOK * 1024 * 2;
constexpr size_t W_BUFB = W_VFIRST + (size_t)MTOK * 512 * 2;
constexpr size_t W_R = W_BUFB + (size_t)MTOK * 1024 * 4;
constexpr size_t W_PROJA = W_R;
constexpr size_t W_PROJB = W_PROJA + (size_t)MTOK * 1792 * 2;
constexpr size_t W_D8 = W_PROJB + (size_t)MTOK * 1792 * 2;
constexpr size_t W_VBUF = W_D8 + (size_t)MTOK * 512 * 4;
constexpr size_t W_GBUF = W_VBUF + (size_t)MTOK * 512 * 2;
constexpr size_t W_DEC = W_GBUF + (size_t)MTOK * 512 * 2;
constexpr size_t W_RK = W_DEC + (size_t)MTOK * 256 * 4;
constexpr size_t W_END1 = W_RK + (size_t)MTOK * 8 * 4;
constexpr size_t W_GATE = W_R;
constexpr size_t W_VAL = W_GATE + (size_t)MTOK * 2816 * 2;
constexpr size_t W_END2 = W_VAL + (size_t)MTOK * 2816 * 2;
constexpr size_t W_END = W_END1 > W_END2 ? W_END1 : W_END2;
constexpr size_t W_OBUFA = W_PROJA;
constexpr size_t W_OBUFB = W_PROJA + (size_t)MTOK * 512 * 2;

struct Params { const float* in[33]; float* out; unsigned char* ws; };
typedef const Params __attribute__((address_space(4)))* KP;
__device__ __forceinline__ KP kparams() { unsigned long long k = (unsigned long long)__builtin_amdgcn_kernarg_segment_ptr(); asm volatile("" : "+s"(k)); return (KP)k; }

typedef __bf16 bf16v2 __attribute__((ext_vector_type(2)));
__device__ __forceinline__ unsigned cvt_pk_bf16(float lo, float hi) { const f32x2 v = (f32x2){lo, hi}; const bf16v2 b = __builtin_convertvector(v, bf16v2); return __builtin_bit_cast(unsigned, b); }
__device__ __forceinline__ float bflo(u32 w) { return __uint_as_float(w << 16); }
__device__ __forceinline__ float bfhi(u32 w) { return __uint_as_float(w & 0xffff0000u); }
__device__ __forceinline__ f32x4 ld_bf4(const u16* p) { const u32x2 w = *(const u32x2*)p; return (f32x4){bflo(w.x), bfhi(w.x), bflo(w.y), bfhi(w.y)}; }
__device__ __forceinline__ unsigned cvt_pk_bf16_asm(float lo, float hi) { unsigned r; asm volatile("v_cvt_pk_bf16_f32 %0, %1, %2" : "=v"(r) : "v"(lo), "v"(hi)); return r; }
__device__ __forceinline__ void st_bf4_asm(u16* p, f32x4 v) { u32x2 w; w.x = cvt_pk_bf16_asm(v[0], v[1]); w.y = cvt_pk_bf16_asm(v[2], v[3]); *(u32x2*)p = w; }
__device__ __forceinline__ void st_bf4(u16* p, f32x4 v) { u32x2 w; w.x = cvt_pk_bf16(v[0], v[1]); w.y = cvt_pk_bf16(v[2], v[3]); *(u32x2*)p = w; }
__device__ __forceinline__ float sigmoidf_(float x) { return 1.0f / (1.0f + __expf(-x)); }
__device__ __forceinline__ float softplusf_(float x) { return fmaxf(x, 0.f) + log1pf(__expf(-fabsf(x))); }
template <int CTRL> __device__ __forceinline__ float dppf(float x) { return __builtin_bit_cast(float, __builtin_amdgcn_update_dpp(0, __builtin_bit_cast(int, x), CTRL, 0xF, 0xF, true)); }
__device__ __forceinline__ float red16(float x) { x += dppf<0xB1>(x); x += dppf<0x4E>(x); x += dppf<0x141>(x); x += dppf<0x140>(x); return x; }

__device__ __forceinline__ int opaque_tid() { int t = threadIdx.x; asm volatile("" : "+v"(t)); return t; }
__device__ __forceinline__ int opaque_bid() { int b = blockIdx.x; asm volatile("" : "+s"(b)); return b; }

namespace pg8 {
constexpr int BM = 256, BK = 64, HALF = 128, HTB = HALF * BK * 2, STAGE_BYTES = 8 * HTB, NXCD = 8, WGM = 8;
__host__ __device__ __forceinline__ int lds_byte(int r, int c) { const int st = (r >> 4) * 2 + (c >> 5), rr = r & 15, cc = c & 31, ob = rr * 64 + cc * 2; return st * 1024 + (ob ^ (((ob >> 9) & 1) << 5)); }
__host__ __device__ __forceinline__ void stage_rc(int b, int& R, int& C) { const int st = b / 1024, sb = b % 1024, swz = sb ^ (((sb >> 9) & 1) << 5); R = (st >> 1) * 16 + swz / 64; C = (st & 1) * 32 + (swz % 64) / 2; }
struct Unit { int pm, pn; };
struct Gemm { const bf16_t* A; const bf16_t* Bt; int M, N, K; };
struct StaticOrder {
    int nM, nN, nwg, G, c;
    __host__ __device__ void init(int M, int N, int G_, int c_) { nM = M / BM; nN = N / BM; nwg = nM * nN; G = G_; c = c_; }
    __host__ __device__ bool next(int i, Unit& u) const {
        const long L = (long)i * G + c; if (L >= nwg) return false;
        int wgid = (int)L; { const int q = nwg / NXCD, r = nwg % NXCD, xcd = wgid % NXCD, off = wgid / NXCD; wgid = (xcd < r ? xcd * (q + 1) : r * (q + 1) + (xcd - r) * q) + off; }
        const int nig = WGM * nN, gid = wgid / nig, fm = gid * WGM, gsz = (nM - fm) < WGM ? (nM - fm) : WGM;
        u.pm = fm + ((wgid % nig) % gsz); u.pn = (wgid % nig) / gsz; return true;
    }
};

template <class Epi>
__device__ __forceinline__ void gemm_phase(PG8_LAS unsigned char* lds, const Gemm g, const StaticOrder& S, const Epi& E) {
    const int tid = opaque_tid(), wid = __builtin_amdgcn_readfirstlane(tid >> 6), lane = tid & 63, wr = wid >> 2, wc = wid & 3, fr = lane & 15, fq = lane >> 4;
    const int K = g.K, nt = K / BK;
    unsigned voffA[2], voffB[2];
#pragma unroll
    for (int i = 0; i < 2; ++i) { int R, C; stage_rc(tid * 16 + i * 8192, R, C); voffA[i] = (unsigned)(R * K + C) * 2u; voffB[i] = voffA[i]; }
    const size_t kstep = (size_t)(BK * 2);
    const size_t hstep = (size_t)HALF * K * 2;
    const size_t tstep = 2 * hstep;
    const unsigned ldsw = (unsigned)wid * 1024u;
    const int aoff = lds_byte(wr * 64 + fr, fq * 8), boff = lds_byte(wc * 32 + fr, fq * 8);
#define PG8_SA(b, h) (((b) * 2 + (h)) * HTB)
#define PG8_SB(b, h) ((4 + (b) * 2 + (h)) * HTB)
#define PG8_STAGE(bufoff, gbase, voff) do { _Pragma("unroll") for (int _i = 0; _i < 2; ++_i) \
        __builtin_amdgcn_global_load_lds((const unsigned*)((const char*)(gbase) + (voff)[_i]), (PG8_LAS unsigned*)(lds + (bufoff) + ldsw + _i * 8192), 16, 0, 0); } while (0)
#define PG8_LDA(dst, b, h) do { _Pragma("unroll") for (int m = 0; m < 4; ++m) _Pragma("unroll") for (int k = 0; k < 2; ++k) dst[m][k] = *(const PG8_LAS bf16x8*)(lds + PG8_SA(b, h) + aoff + m * 2048 + k * 1024); } while (0)
#define PG8_LDB(dst, b, h) do { _Pragma("unroll") for (int n = 0; n < 2; ++n) _Pragma("unroll") for (int k = 0; k < 2; ++k) dst[n][k] = *(const PG8_LAS bf16x8*)(lds + PG8_SB(b, h) + boff + n * 2048 + k * 1024); } while (0)
#define PG8_MMA(ai, bj, At, Bt) do { __builtin_amdgcn_s_setprio(1); _Pragma("unroll") for (int m = 0; m < 4; ++m) _Pragma("unroll") for (int n = 0; n < 2; ++n) _Pragma("unroll") for (int k = 0; k < 2; ++k) \
        acc[ai][bj][m][n] = __builtin_amdgcn_mfma_f32_16x16x32_bf16(Bt[n][k], At[m][k], acc[ai][bj][m][n], 0, 0, 0); __builtin_amdgcn_s_setprio(0); } while (0)
#define PG8_WAIT_V(n) asm volatile("s_waitcnt vmcnt(" #n ")" ::: "memory")
#define PG8_WAIT_L(n) asm volatile("s_waitcnt lgkmcnt(" #n ")" ::: "memory")
#define PG8_BAR __builtin_amdgcn_s_barrier()
#define PG8_SCHED __builtin_amdgcn_sched_barrier(0)
    Unit cur, nxt; int ui = 0;
    if (!S.next(0, cur)) return;
    f32x4 acc[2][2][4][2];
#pragma unroll
    for (int a = 0; a < 2; ++a)
#pragma unroll
        for (int b = 0; b < 2; ++b)
#pragma unroll
            for (int m = 0; m < 4; ++m)
#pragma unroll
                for (int n = 0; n < 2; ++n) acc[a][b][m][n] = (f32x4){0.f, 0.f, 0.f, 0.f};
    bf16x8 At[4][2], B0[2][2], B1[2][2];
    const char* cA = (const char*)g.A + (size_t)cur.pm * tstep; const char* cB = (const char*)g.Bt + (size_t)cur.pn * tstep;
    PG8_STAGE(PG8_SB(0, 0), cB, voffB); PG8_STAGE(PG8_SA(0, 0), cA, voffA); PG8_STAGE(PG8_SB(0, 1), cB + hstep, voffB); PG8_STAGE(PG8_SA(0, 1), cA + hstep, voffA);
    if (wr == 1) PG8_BAR;
    PG8_WAIT_V(4); PG8_BAR;
    PG8_STAGE(PG8_SB(1, 0), cB + kstep, voffB); PG8_STAGE(PG8_SA(1, 0), cA + kstep, voffA); PG8_STAGE(PG8_SB(1, 1), cB + hstep + kstep, voffB);
    PG8_WAIT_V(6); PG8_BAR;
    for (;;) {
        const bool has_next = S.next(ui + 1, nxt);
        const char* nA = has_next ? (const char*)g.A + (size_t)nxt.pm * tstep : cA; const char* nB = has_next ? (const char*)g.Bt + (size_t)nxt.pn * tstep : cB;
        for (int t = 0; t < nt; t += 2) {
            const bool last = (t == nt - 2);
            const char* a1 = cA + (size_t)(t + 1) * kstep;
            const char* a2 = last ? nA : cA + (size_t)(t + 2) * kstep; const char* b2 = last ? nB : cB + (size_t)(t + 2) * kstep;
            const char* a3 = a2 + kstep; const char* b3 = b2 + kstep;
            PG8_LDB(B0, 0, 0); PG8_SCHED; PG8_LDA(At, 0, 0); PG8_STAGE(PG8_SA(1, 1), a1 + hstep, voffA);
            PG8_WAIT_L(8); PG8_BAR; PG8_WAIT_L(0); PG8_MMA(0, 0, At, B0); PG8_BAR; PG8_SCHED;
            PG8_LDB(B1, 0, 1); PG8_STAGE(PG8_SB(0, 0), b2, voffB);
            PG8_BAR; PG8_WAIT_L(0); PG8_MMA(0, 1, At, B1); PG8_BAR;
            PG8_LDA(At, 0, 1); PG8_STAGE(PG8_SA(0, 0), a2, voffA);
            PG8_BAR; PG8_WAIT_L(0); PG8_MMA(1, 0, At, B0); PG8_BAR; PG8_SCHED;
            PG8_STAGE(PG8_SB(0, 1), b2 + hstep, voffB);
            PG8_WAIT_V(6); PG8_BAR; PG8_MMA(1, 1, At, B1); PG8_BAR;
            PG8_LDB(B0, 1, 0); PG8_SCHED; PG8_LDA(At, 1, 0); PG8_STAGE(PG8_SA(0, 1), a2 + hstep, voffA);
            PG8_WAIT_L(8); PG8_BAR; PG8_WAIT_L(0); PG8_MMA(0, 0, At, B0); PG8_BAR; PG8_SCHED;
            PG8_LDB(B1, 1, 1); PG8_STAGE(PG8_SB(1, 0), b3, voffB);
            PG8_BAR; PG8_WAIT_L(0); PG8_MMA(0, 1, At, B1); PG8_BAR;
            PG8_LDA(At, 1, 1); PG8_STAGE(PG8_SA(1, 0), a3, voffA);
            PG8_BAR; PG8_WAIT_L(0); PG8_MMA(1, 0, At, B0); PG8_BAR; PG8_SCHED;
            PG8_STAGE(PG8_SB(1, 1), b3 + hstep, voffB);
            PG8_WAIT_V(6); PG8_BAR; PG8_MMA(1, 1, At, B1); PG8_BAR;
        }
        asm volatile("s_nop 7\n\ts_nop 7\n\ts_nop 7" ::: "memory");
        E(acc, cur, wr, wc, fr, fq);
        if (!has_next) break;
#pragma unroll
        for (int a = 0; a < 2; ++a)
#pragma unroll
            for (int b = 0; b < 2; ++b)
#pragma unroll
                for (int m = 0; m < 4; ++m)
#pragma unroll
                    for (int n = 0; n < 2; ++n) acc[a][b][m][n] = (f32x4){0.f, 0.f, 0.f, 0.f};
        cur = nxt; cA = nA; cB = nB; ++ui;
    }
    PG8_WAIT_V(0);
    if (wr == 0) PG8_BAR;
    PG8_BAR;
#undef PG8_SA
#undef PG8_SB
#undef PG8_STAGE
#undef PG8_LDA
#undef PG8_LDB
#undef PG8_MMA
#undef PG8_WAIT_V
#undef PG8_WAIT_L
#undef PG8_BAR
#undef PG8_SCHED
}
}
using pg8::Unit;

struct EpiProj {
    u16* projA; u16* projB; float* shift_p; float* shift_s;
    __device__ __forceinline__ void operator()(const f32x4 (&acc)[2][2][4][2], const Unit& u, int wr, int wc, int fr, int fq) const {
        const int row0 = u.pm * 256 + wr * 64 + fr;
        const bool isA = u.pn < 7;
        u16* base = isA ? projA : projB;
        const int colt = (isA ? u.pn : u.pn - 7) * 256 + wc * 32 + 4 * fq;
#pragma unroll
        for (int ai = 0; ai < 2; ++ai)
#pragma unroll
            for (int m = 0; m < 4; ++m) {
                const int row = row0 + ai * 128 + m * 16;
                u16* rowp = base + (size_t)row * 1792 + colt;
#pragma unroll
                for (int bj = 0; bj < 2; ++bj)
#pragma unroll
                    for (int n = 0; n < 2; ++n) st_bf4_asm(rowp + bj * 128 + n * 16, acc[ai][bj][m][n]);
                if (isA) {
                    float* dst = nullptr;
                    if (row < MP) { if ((row & 2047) == 2047) dst = shift_p + (size_t)(row >> 11) * 1792; }
                    else { const int r = row - MP; if ((r & 3) == 3) dst = shift_s + (size_t)(r >> 2) * 1792; }
                    if (dst) {
#pragma unroll
                        for (int bj = 0; bj < 2; ++bj)
#pragma unroll
                            for (int n = 0; n < 2; ++n) *(f32x4*)(dst + colt + bj * 128 + n * 16) = acc[ai][bj][m][n];
                    }
                }
            }
    }
};
struct EpiResid {
    const float* base; float* out;
    __device__ __forceinline__ void operator()(const f32x4 (&acc)[2][2][4][2], const Unit& u, int wr, int wc, int fr, int fq) const {
        const int row0 = u.pm * 256 + wr * 64 + fr, col0 = u.pn * 256 + wc * 32 + 4 * fq;
#pragma unroll
        for (int ai = 0; ai < 2; ++ai)
#pragma unroll
            for (int m = 0; m < 4; ++m) {
                const size_t off = (size_t)(row0 + ai * 128 + m * 16) * 1024 + col0;
#pragma unroll
                for (int bj = 0; bj < 2; ++bj)
#pragma unroll
                    for (int n = 0; n < 2; ++n) { const f32x4 b = *(const f32x4*)(base + off + bj * 128 + n * 16); *(f32x4*)(out + off + bj * 128 + n * 16) = b * ALPHA + acc[ai][bj][m][n]; }
            }
    }
};
struct EpiUp {
    u16* gate; u16* val; float* conv_p; float* conv_s;
    __device__ __forceinline__ void operator()(const f32x4 (&acc)[2][2][4][2], const Unit& u, int wr, int wc, int fr, int fq) const {
        const int row0 = u.pm * 256 + wr * 64 + fr;
        const bool isG = u.pn < 11;
        u16* base = isG ? gate : val;
        const int colt = (isG ? u.pn : u.pn - 11) * 256 + wc * 32 + 4 * fq;
#pragma unroll
        for (int ai = 0; ai < 2; ++ai)
#pragma unroll
            for (int m = 0; m < 4; ++m) {
                const int row = row0 + ai * 128 + m * 16;
                u16* rowp = base + (size_t)row * DFF + colt;
#pragma unroll
                for (int bj = 0; bj < 2; ++bj)
#pragma unroll
                    for (int n = 0; n < 2; ++n) st_bf4_asm(rowp + bj * 128 + n * 16, acc[ai][bj][m][n]);
                if (isG) {
                    float* dst = nullptr;
                    if (row < MP) { const int t = row & 2047; if (t >= 2046) dst = conv_p + (size_t)((row >> 11) * 2 + (t - 2046)) * DFF; }
                    else { const int r = row - MP, t = r & 3; if (t >= 2) dst = conv_s + (size_t)((r >> 2) * 2 + (t - 2)) * DFF; }
                    if (dst) {
#pragma unroll
                        for (int bj = 0; bj < 2; ++bj)
#pragma unroll
                            for (int n = 0; n < 2; ++n) *(f32x4*)(dst + colt + bj * 128 + n * 16) = acc[ai][bj][m][n];
                    }
                }
            }
    }
};

__device__ __forceinline__ void transpose_tile(const float* __restrict__ src, u16* __restrict__ dst, int K, int N, int nT, int item, float* tile) {
    const int t = opaque_tid();
    const int kt = item / nT, ntile = item - kt * nT, k0 = kt * 64, n0 = ntile * 64;
    { const int row = t >> 3, c8 = (t & 7) * 8;
      f32x4 a = (f32x4){0.f, 0.f, 0.f, 0.f}, b = a;
      if (n0 + c8 < N) { const float* sp = src + (size_t)(k0 + row) * N + n0 + c8; a = *(const f32x4*)sp; b = *(const f32x4*)(sp + 4); }
      float* tp = tile + row * 65 + c8;
      tp[0] = a[0]; tp[1] = a[1]; tp[2] = a[2]; tp[3] = a[3]; tp[4] = b[0]; tp[5] = b[1]; tp[6] = b[2]; tp[7] = b[3]; }
    __syncthreads();
    { const int n = t >> 3, k8 = (t & 7) * 8;
      float v[8];
#pragma unroll
      for (int j = 0; j < 8; ++j) v[j] = tile[(k8 + j) * 65 + n];
      u32x4 w; w.x = cvt_pk_bf16(v[0], v[1]); w.y = cvt_pk_bf16(v[2], v[3]); w.z = cvt_pk_bf16(v[4], v[5]); w.w = cvt_pk_bf16(v[6], v[7]);
      *(u32x4*)(dst + (size_t)(n0 + n) * K + k0 + k8) = w; }
    __syncthreads();
}
__device__ __forceinline__ void small_transpose(const float* __restrict__ src, u16* __restrict__ dst, int K, int N, int Kpad, size_t gt, size_t nth) {
    for (size_t i = gt; i < (size_t)N * Kpad; i += nth) { const int n = (int)(i / Kpad), k = (int)(i - (size_t)n * Kpad); const float v = k < K ? src[(size_t)k * N + n] : 0.f; dst[i] = (u16)(cvt_pk_bf16(v, 0.f) & 0xffffu); }
}
__device__ void convert_phase(KP p, int l, float* tile) {
    unsigned char* ws = p->ws;
    const int bid = opaque_bid();
    const size_t gt = (size_t)bid * 512 + opaque_tid(), nth = (size_t)gridDim.x * 512;
    constexpr int n1 = 16 * 56, n2 = 16 * 16, n3 = 16 * 88, n4 = 44 * 16;
    for (int it = bid; it < n1 + n2 + n3 + n4; it += gridDim.x) {
        if (it < n1) transpose_tile(p->in[I_WIN] + (size_t)l * 1024 * 3344, (u16*)(ws + W_WIN), 1024, 3344, 56, it, tile);
        else if (it < n1 + n2) transpose_tile(p->in[I_WOUT] + (size_t)l * 1024 * 1024, (u16*)(ws + W_WOUT), 1024, 1024, 16, it - n1, tile);
        else if (it < n1 + n2 + n3) transpose_tile(p->in[I_WUP] + (size_t)l * 1024 * 5632, (u16*)(ws + W_WUP), 1024, 5632, 88, it - n1 - n2, tile);
        else transpose_tile(p->in[I_WDOWN] + (size_t)l * 2816 * 1024, (u16*)(ws + W_WDOWN), 2816, 1024, 16, it - n1 - n2 - n3, tile);
    }
    small_transpose(p->in[I_WLU] + (size_t)l * 64 * 512, (u16*)(ws + W_WLT), 64, 512, 64, gt, nth);
    small_transpose(p->in[I_ALU] + (size_t)l * 64 * 512, (u16*)(ws + W_ALT), 64, 512, 64, gt, nth);
    small_transpose(p->in[I_GLU] + (size_t)l * 128 * 512, (u16*)(ws + W_GLT), 128, 512, 128, gt, nth);
    if (l > 0) {
        small_transpose(p->in[I_VD] + (size_t)(l - 1) * 512 * 32, (u16*)(ws + W_V1T), 512, 32, 512, gt, nth);
        small_transpose(p->in[I_VU] + (size_t)(l - 1) * 32 * 512, (u16*)(ws + W_V2T), 32, 512, 32, gt, nth);
    }
    small_transpose(p->in[I_FUP] + (size_t)l * 16 * 256, (u16*)(ws + W_FT), 16, 256, 32, gt, nth);
    if (l == 0) {
        float* xa = p->out + O_Y; u16* xb = (u16*)(ws + W_XB);
        for (size_t i = gt; i < (size_t)MTOK * 256; i += nth) {
            const size_t e = i * 4;
            const f32x4 v = e < (size_t)MP * 1024 ? *(const f32x4*)(p->in[I_XP] + e) : *(const f32x4*)(p->in[I_XS] + (e - (size_t)MP * 1024));
            *(f32x4*)(xa + e) = v; st_bf4(xb + e, v);
        }
    }
}

__device__ void ln_phase(float* Y, u16* xb, const float* __restrict__ g, const float* __restrict__ b) {
    const int tt_ = opaque_tid();
    const int lane = tt_ & 63, gw = opaque_bid() * 8 + (tt_ >> 6), nw = gridDim.x * 8;
    f32x4 gv[4], bv[4];
#pragma unroll
    for (int i = 0; i < 4; ++i) { gv[i] = *(const f32x4*)(g + i * 256 + lane * 4); bv[i] = *(const f32x4*)(b + i * 256 + lane * 4); }
    for (int row = gw; row < MTOK; row += nw) {
        float* yp = Y + (size_t)row * 1024 + lane * 4;
        f32x4 v[4]; float s = 0.f;
#pragma unroll
        for (int i = 0; i < 4; ++i) { v[i] = *(const f32x4*)(yp + i * 256); s += (v[i][0] + v[i][1]) + (v[i][2] + v[i][3]); }
#pragma unroll
        for (int o = 32; o >= 1; o >>= 1) s += __shfl_xor(s, o);
        const float mu = s * (1.0f / 1024.0f); float q = 0.f;
#pragma unroll
        for (int i = 0; i < 4; ++i) { const f32x4 d = v[i] - mu; q += (d[0] * d[0] + d[1] * d[1]) + (d[2] * d[2] + d[3] * d[3]); }
#pragma unroll
        for (int o = 32; o >= 1; o >>= 1) q += __shfl_xor(q, o);
        const float rstd = rsqrtf(q * (1.0f / 1024.0f) + LN_EPS);
#pragma unroll
        for (int i = 0; i < 4; ++i) { const f32x4 o = (v[i] - mu) * rstd * gv[i] + bv[i]; *(f32x4*)(yp + i * 256) = o; st_bf4(xb + (size_t)row * 1024 + i * 256 + lane * 4, o); }
    }
}

__device__ __forceinline__ void unpack8(const u32x4 w, float* f) { f[0] = bflo(w.x); f[1] = bfhi(w.x); f[2] = bflo(w.y); f[3] = bfhi(w.y); f[4] = bflo(w.z); f[5] = bfhi(w.z); f[6] = bflo(w.w); f[7] = bfhi(w.w); }
__device__ __forceinline__ float gelu_as(float v) {
    const float av = fabsf(v), t = __builtin_amdgcn_rcpf(av * 0.2316418882f + 1.0f);
    float q = t * 0.5307027145f + (-0.7265760135f); q = q * t + 0.7107068705f; q = q * t + (-0.142248368f); q = q * t + 0.127414796f; q = q * t;
    const float e = __builtin_amdgcn_exp2f((v * v) * (-0.72134752044f));
    const float m = v * (q * e);
    return v < 0.f ? m : v - m;
}
__device__ void convglu_phase(const u16* __restrict__ gate, u16* val, const float* __restrict__ past  , const float* __restrict__ cw, const float* __restrict__ cb) {
    const size_t gt = (size_t)opaque_bid() * 512 + opaque_tid(), nth = (size_t)gridDim.x * 512;
    for (size_t idx = gt; idx < (size_t)(MTOK / 4) * 352; idx += nth) {
        const int rg = (int)(idx / 352), c = (int)(idx - (size_t)rg * 352) * 8, row0 = rg * 4;
        bool first; const float* pst = nullptr;
        if (row0 < MP) first = (row0 & 2047) == 0; else { first = true; pst = past + (size_t)((row0 - MP) >> 2) * 2 * DFF; }
        float w0[8], w1[8], w2[8], bb[8], gm2[8], gm1[8];
#pragma unroll
        for (int j = 0; j < 8; ++j) { w0[j] = cw[c + j]; w1[j] = cw[DFF + c + j]; w2[j] = cw[2 * DFF + c + j]; bb[j] = cb[c + j]; }
        if (!first) { unpack8(*(const u32x4*)(gate + (size_t)(row0 - 2) * DFF + c), gm2); unpack8(*(const u32x4*)(gate + (size_t)(row0 - 1) * DFF + c), gm1); }
        else {
#pragma unroll
            for (int j = 0; j < 8; ++j) { gm2[j] = pst ? pst[c + j] : 0.f; gm1[j] = pst ? pst[DFF + c + j] : 0.f; } }
#pragma unroll
        for (int r = 0; r < 4; ++r) {
            float g0[8], vv[8], h[8];
            unpack8(*(const u32x4*)(gate + (size_t)(row0 + r) * DFF + c), g0);
            unpack8(*(const u32x4*)(val + (size_t)(row0 + r) * DFF + c), vv);
#pragma unroll
            for (int j = 0; j < 8; ++j) { const float a = bb[j] + gm2[j] * w0[j] + gm1[j] * w1[j] + g0[j] * w2[j]; h[j] = gelu_as(a) * vv[j]; gm2[j] = gm1[j]; gm1[j] = g0[j]; }
            u32x4 w; w.x = cvt_pk_bf16(h[0], h[1]); w.y = cvt_pk_bf16(h[2], h[3]); w.z = cvt_pk_bf16(h[4], h[5]); w.w = cvt_pk_bf16(h[6], h[7]);
            *(u32x4*)(val + (size_t)(row0 + r) * DFF + c) = w;
        }
    }
}

struct PrepCtx {
    const u16* projA; const u16* projB; const float* mu; const float* sshift  ;
};
__device__ __forceinline__ f32x4 xs4(const PrepCtx& c, int i, int col) {
    const f32x4 cur = ld_bf4(c.projA + (size_t)i * 1792 + col);
    f32x4 prev;
    bool first; int b = 0;
    if (i < MP) first = (i & 2047) == 0; else { const int r = i - MP; first = (r & 3) == 0; b = r >> 2; }
    if (!first) prev = ld_bf4(c.projA + (size_t)(i - 1) * 1792 + col);
    else if (i < MP) prev = (f32x4){0.f, 0.f, 0.f, 0.f};
    else prev = *(const f32x4*)(c.sshift + (size_t)b * 1792 + col);
    const f32x4 m = *(const f32x4*)(c.mu + col);
    return cur + (prev - cur) * m;
}
__device__ __forceinline__ bf16x8 ldg_frag(const u16* p) { return *(const bf16x8*)p; }

__device__ void prep_phase(KP p, int l, PG8_LAS unsigned char* lds) {
    unsigned char* ws = p->ws;
    PrepCtx c; c.projA = (const u16*)(ws + W_PROJA); c.projB = (const u16*)(ws + W_PROJB); c.mu = p->in[I_MU] + (size_t)l * 1792; c.sshift = p->in[I_SSHIFT] + (size_t)l * 128 * 1792;
    const u16* wlT = (const u16*)(ws + W_WLT); const u16* alT = (const u16*)(ws + W_ALT); const u16* glT = (const u16*)(ws + W_GLT);
    const u16* v1T = (const u16*)(ws + W_V1T); const u16* v2T = (const u16*)(ws + W_V2T); const u16* fT = (const u16*)(ws + W_FT);
    u32x4* A16 = (u32x4*)(ws + W_BUFB); float* D8 = (float*)(ws + W_D8); u16* vbuf = (u16*)(ws + W_VBUF); u16* gbuf = (u16*)(ws + W_GBUF);
    float* decb = (float*)(ws + W_DEC); float* rkb = (float*)(ws + W_RK); u16* vfirst = (u16*)(ws + W_VFIRST);
    const float* w0 = p->in[I_W0] + l * 512; const float* a0 = p->in[I_A0] + l * 512; const float* k_k = p->in[I_KK] + l * 512; const float* k_a = p->in[I_KA] + l * 512;
    const float* r_k = p->in[I_RK] + l * 512; const float* vb = l > 0 ? p->in[I_VB] + (l - 1) * 512 : nullptr; const float* fbias = p->in[I_FB] + l * 256;
    constexpr int S_TW = 144, S_AL = 144, S_SG = 272, S_XV = 1040, S_FL = 80, S_PP = 80;
    constexpr int O_TW = 0, O_AL = O_TW + 16 * S_TW, O_SG = O_AL + 16 * S_AL, O_XV = O_SG + 16 * S_SG, O_FL = O_XV + 16 * S_XV, O_PP = O_FL + 16 * S_FL;
    const int t = opaque_tid(), wid = t >> 6, lane = t & 63, fr = lane & 15, fq = lane >> 4, h = wid;
    for (int blk = opaque_bid(); blk < MTOK / 16; blk += gridDim.x) {
        const int i0 = blk * 16;
#pragma unroll 1
        for (int q = 0; q < 6; ++q) {
            const int op = t + 512 * q, r = op / 192, g4 = op - r * 192, col = 1024 + 4 * g4;
            f32x4 x = xs4(c, i0 + r, col);
            int off;
            if (col < 1536) off = O_XV + r * S_XV + (col - 1024) * 2;
            else if (col < 1600) { off = O_TW + r * S_TW + (col - 1536) * 2; x = (f32x4){tanhf(x[0]), tanhf(x[1]), tanhf(x[2]), tanhf(x[3])}; }
            else if (col < 1664) off = O_AL + r * S_AL + (col - 1600) * 2;
            else { off = O_SG + r * S_SG + (col - 1664) * 2; x = (f32x4){sigmoidf_(x[0]), sigmoidf_(x[1]), sigmoidf_(x[2]), sigmoidf_(x[3])}; }
            u32x2 w; w.x = cvt_pk_bf16(x[0], x[1]); w.y = cvt_pk_bf16(x[2], x[3]);
            *(PG8_LAS u32x2*)(lds + off) = w;
        }
        if (t < 128) { const int r = t >> 3, c4 = (t & 7) * 4; u32x2 w = (u32x2){0u, 0u}; if (c4 < 16) w = *(const u32x2*)(c.projB + (size_t)(i0 + r) * 1792 + 1536 + c4); *(PG8_LAS u32x2*)(lds + O_FL + r * S_FL + c4 * 2) = w; }
        __syncthreads();
        bf16x8 pfrag = (bf16x8){0, 0, 0, 0, 0, 0, 0, 0};
        if (l > 0) {
            f32x4 accP0 = (f32x4){0.f, 0.f, 0.f, 0.f}, accP1 = accP0;
#pragma unroll 4
            for (int ks = 0; ks < 16; ++ks) {
                const bf16x8 af = *(const PG8_LAS bf16x8*)(lds + O_XV + fr * S_XV + (ks * 32 + fq * 8) * 2);
                accP0 = __builtin_amdgcn_mfma_f32_16x16x32_bf16(ldg_frag(v1T + (size_t)fr * 512 + ks * 32 + fq * 8), af, accP0, 0, 0, 0);
                accP1 = __builtin_amdgcn_mfma_f32_16x16x32_bf16(ldg_frag(v1T + (size_t)(16 + fr) * 512 + ks * 32 + fq * 8), af, accP1, 0, 0, 0);
            }
            const u32 w0_ = cvt_pk_bf16(accP0[0], accP0[1]), w1_ = cvt_pk_bf16(accP0[2], accP0[3]), w2_ = cvt_pk_bf16(accP1[0], accP1[1]), w3_ = cvt_pk_bf16(accP1[2], accP1[3]);
            const u32x4 pw = (u32x4){w0_, w1_, w2_, w3_};
            pfrag = __builtin_bit_cast(bf16x8, pw);
        }
        const int i = i0 + fr;
        float ss = 0.f;
#pragma unroll
        for (int n = 0; n < 4; ++n) { const int cb_ = h * 64 + 16 * n + 4 * fq; const f32x4 xk = xs4(c, i, 512 + cb_) * *(const f32x4*)(k_k + cb_); ss += (xk[0] * xk[0] + xk[1] * xk[1]) + (xk[2] * xk[2] + xk[3] * xk[3]); }
        ss += __shfl_xor(ss, 16); ss += __shfl_xor(ss, 32);
        const float inorm = rsqrtf(fmaxf(ss, 1e-24f));
        float rks = 0.f;
#pragma unroll 1
        for (int n = 0; n < 4; ++n) {
            const int cn = h * 64 + 16 * n, cb_ = cn + 4 * fq;
            f32x4 aW = (f32x4){0.f, 0.f, 0.f, 0.f}, aA = aW, aG = aW, aV = aW;
#pragma unroll
            for (int ks = 0; ks < 2; ++ks) {
                aW = __builtin_amdgcn_mfma_f32_16x16x32_bf16(ldg_frag(wlT + (size_t)(cn + fr) * 64 + ks * 32 + fq * 8), *(const PG8_LAS bf16x8*)(lds + O_TW + fr * S_TW + (ks * 32 + fq * 8) * 2), aW, 0, 0, 0);
                aA = __builtin_amdgcn_mfma_f32_16x16x32_bf16(ldg_frag(alT + (size_t)(cn + fr) * 64 + ks * 32 + fq * 8), *(const PG8_LAS bf16x8*)(lds + O_AL + fr * S_AL + (ks * 32 + fq * 8) * 2), aA, 0, 0, 0);
            }
#pragma unroll
            for (int ks = 0; ks < 4; ++ks)
                aG = __builtin_amdgcn_mfma_f32_16x16x32_bf16(ldg_frag(glT + (size_t)(cn + fr) * 128 + ks * 32 + fq * 8), *(const PG8_LAS bf16x8*)(lds + O_SG + fr * S_SG + (ks * 32 + fq * 8) * 2), aG, 0, 0, 0);
            if (l > 0) {
                const u32x2 va = *(const u32x2*)(v2T + (size_t)(cn + fr) * 32 + 4 * fq), vc = *(const u32x2*)(v2T + (size_t)(cn + fr) * 32 + 16 + 4 * fq);
                const u32x4 vw = (u32x4){va.x, va.y, vc.x, vc.y};
                aV = __builtin_amdgcn_mfma_f32_16x16x32_bf16(__builtin_bit_cast(bf16x8, vw), pfrag, aV, 0, 0, 0);
            }
            const f32x4 xr = xs4(c, i, cb_), xk = xs4(c, i, 512 + cb_), xv = xs4(c, i, 1024 + cb_);
            const f32x4 w0v = *(const f32x4*)(w0 + cb_), a0v = *(const f32x4*)(a0 + cb_), kkv = *(const f32x4*)(k_k + cb_), kav = *(const f32x4*)(k_a + cb_), rkv = *(const f32x4*)(r_k + cb_);
            f32x4 vp = xv;
            if (l == 0) st_bf4(vfirst + (size_t)i * 512 + cb_, xv);
            else { const f32x4 vf = ld_bf4(vfirst + (size_t)i * 512 + cb_); const f32x4 vbv = *(const f32x4*)(vb + cb_);
#pragma unroll
                for (int j = 0; j < 4; ++j) vp[j] = xv[j] + (vf[j] - xv[j]) * sigmoidf_(vbv[j] + aV[j]);
            }
            f32x4 dd, kt, kn, bb;
#pragma unroll
            for (int j = 0; j < 4; ++j) {
                const float wv = -softplusf_(-(w0v[j] + aW[j])) - 0.5f;
                dd[j] = __expf(-__expf(wv));
                const float a = sigmoidf_(a0v[j] + aA[j]);
                kn[j] = xk[j] * kkv[j] * inorm;
                kt[j] = xk[j] * (1.0f + (a - 1.0f) * kav[j]);
                bb[j] = kn[j] * a;
                rks += xr[j] * kt[j] * rkv[j];
            }
            const int p0 = 8 * n + 2 * fq;
            u32x4 rec0, rec1;
            rec0.x = cvt_pk_bf16(xr[0], xr[1]); rec0.y = cvt_pk_bf16(kt[0], kt[1]); rec0.z = cvt_pk_bf16(kn[0], kn[1]); rec0.w = cvt_pk_bf16(bb[0], bb[1]);
            rec1.x = cvt_pk_bf16(xr[2], xr[3]); rec1.y = cvt_pk_bf16(kt[2], kt[3]); rec1.z = cvt_pk_bf16(kn[2], kn[3]); rec1.w = cvt_pk_bf16(bb[2], bb[3]);
            u32x4* ap = A16 + ((size_t)i * 8 + h) * 32 + p0;
            ap[0] = rec0; ap[1] = rec1;
            *(f32x4*)(D8 + (size_t)i * 512 + cb_) = dd;
            st_bf4(vbuf + (size_t)i * 512 + cb_, vp);
            st_bf4(gbuf + (size_t)i * 512 + cb_, aG);
        }
        rks += __shfl_xor(rks, 16); rks += __shfl_xor(rks, 32);
        if (fq == 0) rkb[(size_t)i * 8 + h] = rks;
#pragma unroll
        for (int n2 = 0; n2 < 2; ++n2) {
            const int cn = 32 * h + 16 * n2;
            f32x4 aF = (f32x4){0.f, 0.f, 0.f, 0.f};
            aF = __builtin_amdgcn_mfma_f32_16x16x32_bf16(ldg_frag(fT + (size_t)(cn + fr) * 32 + fq * 8), *(const PG8_LAS bf16x8*)(lds + O_FL + fr * S_FL + (fq * 8) * 2), aF, 0, 0, 0);
            const f32x4 fb = *(const f32x4*)(fbias + cn + 4 * fq);
            f32x4 dc;
#pragma unroll
            for (int j = 0; j < 4; ++j) { const float z = aF[j] + fb[j]; dc[j] = __expf(-softplusf_(-z) * (1.0f / 16.0f)); }
            *(f32x4*)(decb + (size_t)i * 256 + cn + 4 * fq) = dc;
        }
        __syncthreads();
    }
}

struct ScanItem {
    int tok0, T, L;
    int h, q;
    int hg, cgp;
    const float* s0_rwkv; float* so_rwkv;
    const float* s0_gla; float* so_gla;
};
template <int LSEG>
__device__ __forceinline__ void scan_item(KP p, const ScanItem& it, PG8_LAS unsigned char* lds) {
    unsigned char* ws = p->ws;
    const u32x4* A16 = (const u32x4*)(ws + W_BUFB); const float* D8 = (const float*)(ws + W_D8); const u16* vbuf = (const u16*)(ws + W_VBUF);
    const u16* projB = (const u16*)(ws + W_PROJB); const float* decb = (const float*)(ws + W_DEC);
    u16* obufA = (u16*)(ws + W_OBUFA); u16* obufB = (u16*)(ws + W_OBUFB);
    const int t = opaque_tid(), wid = t >> 6, lane = t & 63, kq = lane & 15, rsel = lane >> 4;
    constexpr int BUF = 69632, OR = 0, OKT = 8192, OKN = 16384, OB = 24576, OD = 32768, OVR = 40960, OQ = 43008, OK = 51200, ODC = 59392, OVG = 67584;
    const int nchunk = it.T / TC;
    u32x4 sa0, sa1; f32x4 sd, sdec; u32x2 svr = (u32x2){0u, 0u}, sq, sk;
#define SC_GLOAD(ch_) do { const int tk_ = it.tok0 + (ch_) * TC; \
        { const int i0 = t, i1 = t + 512; sa0 = A16[((size_t)(tk_ + (i0 >> 5)) * 8 + it.h) * 32 + (i0 & 31)]; sa1 = A16[((size_t)(tk_ + (i1 >> 5)) * 8 + it.h) * 32 + (i1 & 31)]; } \
        { const int st = t >> 4, c4 = (t & 15) * 4; sd = *(const f32x4*)(D8 + (size_t)(tk_ + st) * 512 + it.h * 64 + c4); \
          sq = *(const u32x2*)(projB + (size_t)(tk_ + st) * 1792 + it.hg * 64 + c4); sk = *(const u32x2*)(projB + (size_t)(tk_ + st) * 1792 + 256 + it.hg * 64 + c4); \
          sdec = *(const f32x4*)(decb + (size_t)(tk_ + st) * 256 + it.hg * 64 + c4); } \
        if (t < 128) { const int st = t >> 2, c4 = (t & 3) * 4; svr = *(const u32x2*)(vbuf + (size_t)(tk_ + st) * 512 + it.h * 64 + it.q * 16 + c4); } \
        else if (t < 256) { const int tt = t - 128, st = tt >> 2, c4 = (tt & 3) * 4; svr = *(const u32x2*)(projB + (size_t)(tk_ + st) * 1792 + 512 + it.hg * 128 + it.cgp * 16 + c4); } } while (0)
#define SC_LSTORE(buf_) do { PG8_LAS unsigned char* b_ = lds + (buf_) * BUF; \
        { const int i0 = t, i1 = t + 512; \
          { const int st = i0 >> 5, pp = i0 & 31; const int o = (st * 64 + 2 * pp) * 4; \
            *(PG8_LAS f32x2*)(b_ + OR + o) = (f32x2){bflo(sa0.x), bfhi(sa0.x)}; *(PG8_LAS f32x2*)(b_ + OKT + o) = (f32x2){bflo(sa0.y), bfhi(sa0.y)}; \
            *(PG8_LAS f32x2*)(b_ + OKN + o) = (f32x2){bflo(sa0.z), bfhi(sa0.z)}; *(PG8_LAS f32x2*)(b_ + OB + o) = (f32x2){bflo(sa0.w), bfhi(sa0.w)}; } \
          { const int st = i1 >> 5, pp = i1 & 31; const int o = (st * 64 + 2 * pp) * 4; \
            *(PG8_LAS f32x2*)(b_ + OR + o) = (f32x2){bflo(sa1.x), bfhi(sa1.x)}; *(PG8_LAS f32x2*)(b_ + OKT + o) = (f32x2){bflo(sa1.y), bfhi(sa1.y)}; \
            *(PG8_LAS f32x2*)(b_ + OKN + o) = (f32x2){bflo(sa1.z), bfhi(sa1.z)}; *(PG8_LAS f32x2*)(b_ + OB + o) = (f32x2){bflo(sa1.w), bfhi(sa1.w)}; } } \
        { const int st = t >> 4, c4 = (t & 15) * 4; const int o = (st * 64 + c4) * 4; \
          *(PG8_LAS f32x4*)(b_ + OD + o) = sd; *(PG8_LAS f32x4*)(b_ + ODC + o) = sdec; \
          *(PG8_LAS f32x4*)(b_ + OQ + o) = (f32x4){bflo(sq.x), bfhi(sq.x), bflo(sq.y), bfhi(sq.y)} * 0.125f; \
          *(PG8_LAS f32x4*)(b_ + OK + o) = (f32x4){bflo(sk.x), bfhi(sk.x), bflo(sk.y), bfhi(sk.y)}; } \
        if (t < 128) { const int st = t >> 2, c4 = (t & 3) * 4; *(PG8_LAS f32x4*)(b_ + OVR + (st * 16 + c4) * 4) = (f32x4){bflo(svr.x), bfhi(svr.x), bflo(svr.y), bfhi(svr.y)}; } \
        else if (t < 256) { const int tt = t - 128, st = tt >> 2, c4 = (tt & 3) * 4; *(PG8_LAS f32x4*)(b_ + OVG + (st * 16 + c4) * 4) = (f32x4){bflo(svr.x), bfhi(svr.x), bflo(svr.y), bfhi(svr.y)}; } } while (0)
    const bool isR = wid < 4;
    const int w4 = wid & 3;
    const int row = it.q * 16 + 4 * w4 + rsel;
    const int col = it.cgp * 16 + 4 * w4 + rsel;
    f32x4 S = (f32x4){0.f, 0.f, 0.f, 0.f}, Sn = S;
#define SC_LOAD_STATE(dst_, seg_) do { const int sg_ = (seg_); \
        if (isR) { if (!it.s0_rwkv) dst_ = (f32x4){0.f, 0.f, 0.f, 0.f}; else dst_ = *(const f32x4*)(it.s0_rwkv + (size_t)sg_ * 8 * 4096 + row * 64 + 4 * kq); } \
        else if (!it.s0_gla) dst_ = (f32x4){0.f, 0.f, 0.f, 0.f}; \
        else { const float* sp_ = it.s0_gla + (size_t)sg_ * 4 * 8192 + (size_t)(4 * kq) * 128 + col; dst_ = (f32x4){sp_[0], sp_[128], sp_[256], sp_[384]}; } } while (0)
#define SC_STORE_STATE(seg_, s_) do { const int sg_ = (seg_); \
        if (isR) { *(f32x4*)(it.so_rwkv + (size_t)sg_ * 8 * 4096 + row * 64 + 4 * kq) = s_; } \
        else { float* sp_ = it.so_gla + (size_t)sg_ * 4 * 8192 + (size_t)(4 * kq) * 128 + col; sp_[0] = s_[0]; sp_[128] = s_[1]; sp_[256] = s_[2]; sp_[384] = s_[3]; } } while (0)
    SC_GLOAD(0);
    SC_LOAD_STATE(Sn, 0);
    SC_LSTORE(0);
    __syncthreads();
    u16* oAp = obufA + (size_t)it.tok0 * 512 + it.h * 64 + row;
    u16* oBp = obufB + (size_t)it.tok0 * 512 + it.hg * 128 + col;
    const int vsl = (4 * w4 + rsel) * 4;
#define SC_STEP_R(s_) do { const int o = ((s_) * 64 + 4 * kq) * 4; \
        const f32x4 r4 = *(const PG8_LAS f32x4*)(b + OR + o), k4 = *(const PG8_LAS f32x4*)(b + OKT + o), n4 = *(const PG8_LAS f32x4*)(b + OKN + o), b4 = *(const PG8_LAS f32x4*)(b + OB + o), d4 = *(const PG8_LAS f32x4*)(b + OD + o); \
        const float v = *(const PG8_LAS float*)(b + OVR + (s_) * 64 + vsl); \
        float dot = (S[0] * n4[0] + S[1] * n4[1]) + (S[2] * n4[2] + S[3] * n4[3]); \
        dot = red16(dot); \
        S = S * d4 - b4 * dot + k4 * v; \
        float o_ = (S[0] * r4[0] + S[1] * r4[1]) + (S[2] * r4[2] + S[3] * r4[3]); \
        o_ = red16(o_); \
        if (kq == 0) oAp[(size_t)(s_) * 512] = (u16)(cvt_pk_bf16(o_, 0.f) & 0xffffu); } while (0)
#define SC_STEP_G(s_) do { const int o = ((s_) * 64 + 4 * kq) * 4; \
        const f32x4 q4 = *(const PG8_LAS f32x4*)(b + OQ + o), k4 = *(const PG8_LAS f32x4*)(b + OK + o), d4 = *(const PG8_LAS f32x4*)(b + ODC + o); \
        const float v = *(const PG8_LAS float*)(b + OVG + (s_) * 64 + vsl); \
        S = S * d4 + k4 * v; \
        float o_ = (S[0] * q4[0] + S[1] * q4[1]) + (S[2] * q4[2] + S[3] * q4[3]); \
        o_ = red16(o_); \
        if (kq == 0) oBp[(size_t)(s_) * 512] = (u16)(cvt_pk_bf16(o_, 0.f) & 0xffffu); } while (0)
    for (int ch = 0; ch < nchunk; ++ch) {
        const bool more = ch + 1 < nchunk;
        if (more) SC_GLOAD(ch + 1);
        PG8_LAS unsigned char* b = lds + (ch & 1) * BUF;
        if (LSEG >= TC) {
            if (ch == 0) S = Sn;
            if (isR) {
#pragma unroll 8
                for (int s = 0; s < TC; ++s) SC_STEP_R(s);
            } else {
#pragma unroll 8
                for (int s = 0; s < TC; ++s) SC_STEP_G(s);
            }
            if (!more) SC_STORE_STATE(0, S);
        } else {
#pragma unroll 1
            for (int sgi = 0; sgi < TC / LSEG; ++sgi) {
                const int seg = ch * (TC / LSEG) + sgi;
                S = Sn;
                if ((seg + 1) * LSEG < it.T) SC_LOAD_STATE(Sn, seg + 1);
                if (isR) {
#pragma unroll
                    for (int s2 = 0; s2 < LSEG; ++s2) SC_STEP_R(sgi * LSEG + s2);
                } else {
#pragma unroll
                    for (int s2 = 0; s2 < LSEG; ++s2) SC_STEP_G(sgi * LSEG + s2);
                }
                SC_STORE_STATE(seg, S);
            }
        }
        oAp += (size_t)TC * 512; oBp += (size_t)TC * 512;
        if (more) SC_LSTORE((ch + 1) & 1);
        __syncthreads();
    }
#undef SC_STEP_R
#undef SC_STEP_G
}
__device__ void scan_phase(KP p, int l, PG8_LAS unsigned char* lds) {
    float* out = p->out;
    const int bid = opaque_bid();
    for (int i = bid; i < 256; i += gridDim.x) {
        ScanItem it; const int s = i >> 5;
        it.tok0 = s * 2048; it.T = 2048; it.L = 2048; it.h = (i >> 2) & 7; it.q = i & 3; it.hg = (i >> 3) & 3; it.cgp = i & 7;
        it.s0_rwkv = nullptr; it.so_rwkv = out + O_RWKV_P + ((size_t)(l * 8 + s) * 8 + it.h) * 4096;
        it.s0_gla = nullptr; it.so_gla = out + O_GLA_P + ((size_t)(l * 8 + s) * 4 + it.hg) * 8192;
        scan_item<2048>(p, it, lds);
    }
    for (int i = bid; i < 256; i += gridDim.x) {
        ScanItem it; const int bg = i >> 5, b0 = bg * 16;
        it.tok0 = MP + bg * 64; it.T = 64; it.L = 4; it.h = (i >> 2) & 7; it.q = i & 3; it.hg = (i >> 3) & 3; it.cgp = i & 7;
        it.s0_rwkv = p->in[I_SRWKV] + ((size_t)(l * 128 + b0) * 8 + it.h) * 4096; it.so_rwkv = out + O_RWKV_S + ((size_t)(l * 128 + b0) * 8 + it.h) * 4096;
        it.s0_gla = p->in[I_SGLA] + ((size_t)(l * 128 + b0) * 4 + it.hg) * 8192; it.so_gla = out + O_GLA_S + ((size_t)(l * 128 + b0) * 4 + it.hg) * 8192;
        scan_item<4>(p, it, lds);
    }
}

__device__ void post_phase(KP p, int l) {
    unsigned char* ws = p->ws;
    const u16* obufA = (const u16*)(ws + W_OBUFA); const u16* obufB = (const u16*)(ws + W_OBUFB); const u16* vbuf = (const u16*)(ws + W_VBUF); const u16* gbuf = (const u16*)(ws + W_GBUF);
    const float* rkb = (const float*)(ws + W_RK); const u16* projB = (const u16*)(ws + W_PROJB); u16* oab = (u16*)(ws + W_XB);
    const float* lg = p->in[I_LNXG] + l * 512; const float* lb = p->in[I_LNXB] + l * 512; const float* ng = p->in[I_NG] + l * 128;
    const int tt_ = opaque_tid();
    const int lane = tt_ & 63, gw = opaque_bid() * 8 + (tt_ >> 6), nw = gridDim.x * 8;
    const int c = lane * 8;
    float lgv[8], lbv[8], ngv[8];
#pragma unroll
    for (int j = 0; j < 8; ++j) { lgv[j] = lg[c + j]; lbv[j] = lb[c + j]; ngv[j] = ng[(c & 127) + j]; }
    for (int i = gw; i < MTOK; i += nw) {
        {
            const f32x4 o0 = ld_bf4(obufA + (size_t)i * 512 + c), o1 = ld_bf4(obufA + (size_t)i * 512 + c + 4);
            const f32x4 v0 = ld_bf4(vbuf + (size_t)i * 512 + c), v1 = ld_bf4(vbuf + (size_t)i * 512 + c + 4);
            const f32x4 g0 = ld_bf4(gbuf + (size_t)i * 512 + c), g1 = ld_bf4(gbuf + (size_t)i * 512 + c + 4);
            const float rk = rkb[(size_t)i * 8 + (lane >> 3)];
            float s = (o0[0] + o0[1]) + (o0[2] + o0[3]) + (o1[0] + o1[1]) + (o1[2] + o1[3]);
            s += __shfl_xor(s, 1); s += __shfl_xor(s, 2); s += __shfl_xor(s, 4);
            const float m = s * (1.0f / 64.0f);
            const f32x4 d0 = o0 - m, d1 = o1 - m;
            float q = (d0[0] * d0[0] + d0[1] * d0[1]) + (d0[2] * d0[2] + d0[3] * d0[3]) + (d1[0] * d1[0] + d1[1] * d1[1]) + (d1[2] * d1[2] + d1[3] * d1[3]);
            q += __shfl_xor(q, 1); q += __shfl_xor(q, 2); q += __shfl_xor(q, 4);
            const float rs = rsqrtf(q * (1.0f / 64.0f) + GN_EPS_A);
            f32x4 y0, y1;
#pragma unroll
            for (int j = 0; j < 4; ++j) { y0[j] = (d0[j] * rs * lgv[j] + lbv[j] + rk * v0[j]) * g0[j]; y1[j] = (d1[j] * rs * lgv[4 + j] + lbv[4 + j] + rk * v1[j]) * g1[j]; }
            u32x4 w; w.x = cvt_pk_bf16(y0[0], y0[1]); w.y = cvt_pk_bf16(y0[2], y0[3]); w.z = cvt_pk_bf16(y1[0], y1[1]); w.w = cvt_pk_bf16(y1[2], y1[3]);
            *(u32x4*)(oab + (size_t)i * 1024 + c) = w;
        }
        {
            const f32x4 o0 = ld_bf4(obufB + (size_t)i * 512 + c), o1 = ld_bf4(obufB + (size_t)i * 512 + c + 4);
            const f32x4 g0 = ld_bf4(projB + (size_t)i * 1792 + 1024 + c), g1 = ld_bf4(projB + (size_t)i * 1792 + 1024 + c + 4);
            float q = (o0[0] * o0[0] + o0[1] * o0[1]) + (o0[2] * o0[2] + o0[3] * o0[3]) + (o1[0] * o1[0] + o1[1] * o1[1]) + (o1[2] * o1[2] + o1[3] * o1[3]);
            q += __shfl_xor(q, 1); q += __shfl_xor(q, 2); q += __shfl_xor(q, 4); q += __shfl_xor(q, 8);
            const float rs = rsqrtf(q * (1.0f / 128.0f) + RMS_EPS);
            f32x4 y0, y1;
#pragma unroll
            for (int j = 0; j < 4; ++j) { y0[j] = o0[j] * rs * ngv[j] * (g0[j] * sigmoidf_(g0[j])); y1[j] = o1[j] * rs * ngv[4 + j] * (g1[j] * sigmoidf_(g1[j])); }
            u32x4 w; w.x = cvt_pk_bf16(y0[0], y0[1]); w.y = cvt_pk_bf16(y0[2], y0[3]); w.z = cvt_pk_bf16(y1[0], y1[1]); w.w = cvt_pk_bf16(y1[2], y1[3]);
            *(u32x4*)(oab + (size_t)i * 1024 + 512 + c) = w;
        }
    }
}

__device__ __forceinline__ void gsync(cg::grid_group& grid) {
    asm volatile("s_waitcnt vmcnt(0)" ::: "memory");
    grid.sync();
    if (threadIdx.x < 64) { __builtin_amdgcn_fence(__ATOMIC_ACQUIRE, "agent"); asm volatile("s_waitcnt vmcnt(0)" ::: "memory"); }
    __syncthreads();
}

__global__ void __launch_bounds__(512, 2) mega(Params p_unused) {
    KP p = kparams();
    extern __shared__ __attribute__((aligned(16))) unsigned char smem[];
    PG8_LAS unsigned char* lds = (PG8_LAS unsigned char*)smem;
    cg::grid_group grid = cg::this_grid();
    unsigned char* ws = p->ws;
    float* bufA = p->out + O_Y; float* bufB = (float*)(ws + W_BUFB); u16* xb = (u16*)(ws + W_XB);
    pg8::StaticOrder S;
#define PHASE_END() gsync(grid)
    gsync(grid);
    convert_phase(kparams(), 0, (float*)smem);
    PHASE_END();
    for (int l = 0; l < NL; ++l) {
        {
            pg8::Gemm g; g.A = xb; g.Bt = (const u16*)(ws + W_WIN); g.M = MTOK; g.N = INP; g.K = 1024;
            EpiProj E; E.projA = (u16*)(ws + W_PROJA); E.projB = (u16*)(ws + W_PROJB); E.shift_p = p->out + O_SHIFT_P + (size_t)l * 8 * 1792; E.shift_s = p->out + O_SHIFT_S + (size_t)l * 128 * 1792;
            S.init(MTOK, INP, gridDim.x, opaque_bid()); pg8::gemm_phase(lds, g, S, E);
        }
        PHASE_END();
        prep_phase(kparams(), l, lds);
        PHASE_END();
        scan_phase(kparams(), l, lds);
        PHASE_END();
        post_phase(kparams(), l);
        PHASE_END();
        {
            pg8::Gemm g; g.A = xb; g.Bt = (const u16*)(ws + W_WOUT); g.M = MTOK; g.N = 1024; g.K = 1024;
            EpiResid E; E.base = bufA; E.out = bufB;
            S.init(MTOK, 1024, gridDim.x, opaque_bid()); pg8::gemm_phase(lds, g, S, E);
        }
        PHASE_END();
        ln_phase(bufB, xb, p->in[I_LN1G] + l * 1024, p->in[I_LN1B] + l * 1024);
        PHASE_END();
        {
            pg8::Gemm g; g.A = xb; g.Bt = (const u16*)(ws + W_WUP); g.M = MTOK; g.N = 5632; g.K = 1024;
            EpiUp E; E.gate = (u16*)(ws + W_GATE); E.val = (u16*)(ws + W_VAL); E.conv_p = p->out + O_CONV_P + (size_t)l * 8 * 2 * DFF; E.conv_s = p->out + O_CONV_S + (size_t)l * 128 * 2 * DFF;
            S.init(MTOK, 5632, gridDim.x, opaque_bid()); pg8::gemm_phase(lds, g, S, E);
        }
        PHASE_END();
        convglu_phase((const u16*)(ws + W_GATE), (u16*)(ws + W_VAL), p->in[I_SCONV] + (size_t)l * 128 * 2 * DFF, p->in[I_CW] + (size_t)l * 3 * DFF, p->in[I_CB] + (size_t)l * DFF);
        PHASE_END();
        {
            pg8::Gemm g; g.A = (const u16*)(ws + W_VAL); g.Bt = (const u16*)(ws + W_WDOWN); g.M = MTOK; g.N = 1024; g.K = DFF;
            EpiResid E; E.base = bufB; E.out = bufA;
            S.init(MTOK, 1024, gridDim.x, opaque_bid()); pg8::gemm_phase(lds, g, S, E);
        }
        PHASE_END();
        ln_phase(bufA, xb, p->in[I_LN2G] + l * 1024, p->in[I_LN2B] + l * 1024);
        if (l + 1 < NL) convert_phase(kparams(), l + 1, (float*)smem);
        PHASE_END();
    }
}

extern "C" void kernel_launch(void* const* d_in, const int* in_sizes, int n_in, void* d_out, int out_size, void* d_ws, size_t ws_size, hipStream_t stream) {
    static int grid_blocks = 0;
    if (!grid_blocks) {
        int dev = 0, cus = 0, per_cu = 0;
        (void)hipGetDevice(&dev);
        (void)hipDeviceGetAttribute(&cus, hipDeviceAttributeMultiprocessorCount, dev);
        (void)hipFuncSetAttribute((const void*)mega, hipFuncAttributeMaxDynamicSharedMemorySize, LDS_BYTES);
        (void)hipOccupancyMaxActiveBlocksPerMultiprocessor(&per_cu, (const void*)mega, 512, LDS_BYTES);
        grid_blocks = cus;
        if (n_in != 33 || (size_t)out_size != O_END || ws_size < W_END) { fprintf(stderr, "kernel_launch: unexpected sizes n_in %d out %d ws %zu (need %zu)\n", n_in, out_size, ws_size, (size_t)W_END); grid_blocks = -1; }
    }
    if (grid_blocks < 0) return;
    Params p{};
    for (int i = 0; i < 33; ++i) p.in[i] = (const float*)d_in[i];
    p.out = (float*)d_out; p.ws = (unsigned char*)d_ws;
    void* args[] = {&p};
    hipError_t e = hipLaunchCooperativeKernel((const void*)mega, dim3(grid_blocks), dim3(512), args, LDS_BYTES, stream);
    if (e != hipSuccess) fprintf(stderr, "cooperative launch failed: %s (grid %d)\n", hipGetErrorString(e), grid_blocks);
}
```

```cpp
#include <hip/hip_runtime.h>
#include <hip/hip_cooperative_groups.h>
#include <cstdio>
namespace cg = cooperative_groups;

#define PG8_LAS __attribute__((address_space(3)))
typedef unsigned short u16;
typedef unsigned int u32;
typedef unsigned short bf16_t;
typedef short bf16x8 __attribute__((ext_vector_type(8)));
typedef float f32x4 __attribute__((ext_vector_type(4)));
typedef float f32x2 __attribute__((ext_vector_type(2)));
typedef unsigned u32x4 __attribute__((ext_vector_type(4)));
typedef unsigned u32x2 __attribute__((ext_vector_type(2)));

constexpr int MTOK = 16896, MP = 16384, DM = 1024, NL = 4;
constexpr int SHIFT_W = 1792, INP = 3584, DFF = 2816;
constexpr float ALPHA = 1.6817928305074290f;
constexpr float GN_EPS_A = 64e-5f, RMS_EPS = 1e-5f, LN_EPS = 1e-5f;
constexpr int LDS_BYTES = 139264 + 16;
constexpr int TC = 32;

enum { I_XP = 0, I_XS, I_SRWKV, I_SSHIFT, I_SGLA, I_SCONV, I_WIN, I_MU, I_W0, I_WLU, I_A0, I_ALU, I_GLU, I_KK, I_KA, I_RK, I_LNXG, I_LNXB,
       I_VB, I_VD, I_VU, I_FUP, I_FB, I_NG, I_WOUT, I_LN1G, I_LN1B, I_WUP, I_CW, I_CB, I_WDOWN, I_LN2G, I_LN2B };

constexpr size_t O_Y = 0;
constexpr size_t O_RWKV_P = (size_t)MTOK * DM;
constexpr size_t O_RWKV_S = O_RWKV_P + (size_t)4 * 8 * 8 * 4096;
constexpr size_t O_SHIFT_P = O_RWKV_S + (size_t)4 * 128 * 8 * 4096;
constexpr size_t O_SHIFT_S = O_SHIFT_P + (size_t)4 * 8 * 1792;
constexpr size_t O_GLA_P = O_SHIFT_S + (size_t)4 * 128 * 1792;
constexpr size_t O_GLA_S = O_GLA_P + (size_t)4 * 8 * 4 * 8192;
constexpr size_t O_CONV_P = O_GLA_S + (size_t)4 * 128 * 4 * 8192;
constexpr size_t O_CONV_S = O_CONV_P + (size_t)4 * 8 * 2 * 2816;
constexpr size_t O_END = O_CONV_S + (size_t)4 * 128 * 2 * 2816;

constexpr size_t W_WIN = 0;
constexpr size_t W_WOUT = W_WIN + (size_t)INP * 1024 * 2;
constexpr size_t W_WUP = W_WOUT + (size_t)1024 * 1024 * 2;
constexpr size_t W_WDOWN = W_WUP + (size_t)5632 * 1024 * 2;
constexpr size_t W_WLT = W_WDOWN + (size_t)1024 * 2816 * 2;
constexpr size_t W_ALT = W_WLT + 512 * 64 * 2;
constexpr size_t W_GLT = W_ALT + 512 * 64 * 2;
constexpr size_t W_V1T = W_GLT + 512 * 128 * 2;
constexpr size_t W_V2T = W_V1T + 32 * 512 * 2;
constexpr size_t W_FT = W_V2T + 512 * 32 * 2;
constexpr size_t W_XB = W_FT + 256 * 32 * 2;
constexpr size_t W_VFIRST = W_XB + (size_t)MTOK * 1024 * 2;
constexpr size_t W_BUFB = W_VFIRST + (size_t)MTOK * 512 * 2;
constexpr size_t W_R = W_BUFB + (size_t)MTOK * 1024 * 4;
constexpr size_t W_PROJA = W_R;
constexpr size_t W_PROJB = W_PROJA + (size_t)MTOK * 1792 * 2;
constexpr size_t W_D8 = W_PROJB + (size_t)MTOK * 1792 * 2;
constexpr size_t W_VBUF = W_D8 + (size_t)MTOK * 512 * 4;
constexpr size_t W_GBUF = W_VBUF + (size_t)MTOK * 512 * 2;
constexpr size_t W_DEC = W_GBUF + (size_t)MTOK * 512 * 2;
constexpr size_t W_RK = W_DEC + (size_t)MTOK * 256 * 4;
constexpr size_t W_END1 = W_RK + (size_t)MTOK * 8 * 4;
constexpr size_t W_GATE = W_R;
constexpr size_t W_VAL = W_GATE + (size_t)MTOK * 2816 * 2;
constexpr size_t W_END2 = W_VAL + (size_t)MTOK * 2816 * 2;
constexpr size_t W_END = W_END1 > W_END2 ? W_END1 : W_END2;
constexpr size_t W_BAR = (W_END + 255) / 256 * 256;
constexpr size_t W_TOTAL = W_BAR + 16384;
constexpr size_t W_OBUFA = W_PROJA;
constexpr size_t W_OBUFB = W_PROJA + (size_t)MTOK * 512 * 2;

struct Params { const float* in[33]; float* out; unsigned char* ws; };
typedef const Params __attribute__((address_space(4)))* KP;
__device__ __forceinline__ KP kparams() { unsigned long long k = (unsigned long long)__builtin_amdgcn_kernarg_segment_ptr(); asm volatile("" : "+s"(k)); return (KP)k; }

typedef __bf16 bf16v2 __attribute__((ext_vector_type(2)));
__device__ __forceinline__ unsigned cvt_pk_bf16(float lo, float hi) { const f32x2 v = (f32x2){lo, hi}; const bf16v2 b = __builtin_convertvector(v, bf16v2); return __builtin_bit_cast(unsigned, b); }
__device__ __forceinline__ float bflo(u32 w) { return __uint_as_float(w << 16); }
__device__ __forceinline__ float bfhi(u32 w) { return __uint_as_float(w & 0xffff0000u); }
__device__ __forceinline__ f32x4 ld_bf4(const u16* p) { const u32x2 w = *(const u32x2*)p; return (f32x4){bflo(w.x), bfhi(w.x), bflo(w.y), bfhi(w.y)}; }
__device__ __forceinline__ unsigned cvt_pk_bf16_asm(float lo, float hi) { unsigned r; asm volatile("v_cvt_pk_bf16_f32 %0, %1, %2" : "=v"(r) : "v"(lo), "v"(hi)); return r; }
__device__ __forceinline__ void st_bf4_asm(u16* p, f32x4 v) { u32x2 w; w.x = cvt_pk_bf16_asm(v[0], v[1]); w.y = cvt_pk_bf16_asm(v[2], v[3]); *(u32x2*)p = w; }
__device__ __forceinline__ void st_bf4(u16* p, f32x4 v) { u32x2 w; w.x = cvt_pk_bf16(v[0], v[1]); w.y = cvt_pk_bf16(v[2], v[3]); *(u32x2*)p = w; }
__device__ __forceinline__ float sigmoidf_(float x) { return 1.0f / (1.0f + __expf(-x)); }
__device__ __forceinline__ float softplusf_(float x) { return fmaxf(x, 0.f) + log1pf(__expf(-fabsf(x))); }
template <int CTRL> __device__ __forceinline__ float dppf(float x) { return __builtin_bit_cast(float, __builtin_amdgcn_update_dpp(0, __builtin_bit_cast(int, x), CTRL, 0xF, 0xF, true)); }
__device__ __forceinline__ float red16(float x) { x += dppf<0xB1>(x); x += dppf<0x4E>(x); x += dppf<0x141>(x); x += dppf<0x140>(x); return x; }

__device__ __forceinline__ int opaque_tid() { int t = threadIdx.x; asm volatile("" : "+v"(t)); return t; }
__device__ __forceinline__ int opaque_bid() { int b = blockIdx.x; asm volatile("" : "+s"(b)); return b; }

namespace pg8 {
constexpr int BM = 256, BK = 64, HALF = 128, HTB = HALF * BK * 2, STAGE_BYTES = 8 * HTB, NXCD = 8, WGM = 8;
__host__ __device__ __forceinline__ int lds_byte(int r, int c) { const int st = (r >> 4) * 2 + (c >> 5), rr = r & 15, cc = c & 31, ob = rr * 64 + cc * 2; return st * 1024 + (ob ^ (((ob >> 9) & 1) << 5)); }
__host__ __device__ __forceinline__ void stage_rc(int b, int& R, int& C) { const int st = b / 1024, sb = b % 1024, swz = sb ^ (((sb >> 9) & 1) << 5); R = (st >> 1) * 16 + swz / 64; C = (st & 1) * 32 + (swz % 64) / 2; }
struct Unit { int pm, pn; };
struct Gemm { const bf16_t* A; const bf16_t* Bt; int M, N, K; };
struct StaticOrder {
    int nM, nN, nwg, G, c;
    __host__ __device__ void init(int M, int N, int G_, int c_) { nM = M / BM; nN = N / BM; nwg = nM * nN; G = G_; c = c_; }
    __host__ __device__ bool next(int i, Unit& u) const {
        const long L = (long)i * G + c; if (L >= nwg) return false;
        int wgid = (int)L; { const int q = nwg / NXCD, r = nwg % NXCD, xcd = wgid % NXCD, off = wgid / NXCD; wgid = (xcd < r ? xcd * (q + 1) : r * (q + 1) + (xcd - r) * q) + off; }
        const int nig = WGM * nN, gid = wgid / nig, fm = gid * WGM, gsz = (nM - fm) < WGM ? (nM - fm) : WGM;
        u.pm = fm + ((wgid % nig) % gsz); u.pn = (wgid % nig) / gsz; return true;
    }
};

template <class Epi>
__device__ __forceinline__ void gemm_phase(PG8_LAS unsigned char* lds, const Gemm g, const StaticOrder& S, const Epi& E) {
    const int tid = opaque_tid(), wid = __builtin_amdgcn_readfirstlane(tid >> 6), lane = tid & 63, wr = wid >> 2, wc = wid & 3, fr = lane & 15, fq = lane >> 4;
    const int K = g.K, nt = K / BK;
    unsigned voffA[2], voffB[2];
#pragma unroll
    for (int i = 0; i < 2; ++i) { int R, C; stage_rc(tid * 16 + i * 8192, R, C); voffA[i] = (unsigned)(R * K + C) * 2u; voffB[i] = voffA[i]; }
    const size_t kstep = (size_t)(BK * 2);
    const size_t hstep = (size_t)HALF * K * 2;
    const size_t tstep = 2 * hstep;
    const unsigned ldsw = (unsigned)wid * 1024u;
    const int aoff = lds_byte(wr * 64 + fr, fq * 8), boff = lds_byte(wc * 32 + fr, fq * 8);
#define PG8_SA(b, h) (((b) * 2 + (h)) * HTB)
#define PG8_SB(b, h) ((4 + (b) * 2 + (h)) * HTB)
#define PG8_STAGE(bufoff, gbase, voff) do { _Pragma("unroll") for (int _i = 0; _i < 2; ++_i) \
        __builtin_amdgcn_global_load_lds((const unsigned*)((const char*)(gbase) + (voff)[_i]), (PG8_LAS unsigned*)(lds + (bufoff) + ldsw + _i * 8192), 16, 0, 0); } while (0)
#define PG8_LDA(dst, b, h) do { _Pragma("unroll") for (int m = 0; m < 4; ++m) _Pragma("unroll") for (int k = 0; k < 2; ++k) dst[m][k] = *(const PG8_LAS bf16x8*)(lds + PG8_SA(b, h) + aoff + m * 2048 + k * 1024); } while (0)
#define PG8_LDB(dst, b, h) do { _Pragma("unroll") for (int n = 0; n < 2; ++n) _Pragma("unroll") for (int k = 0; k < 2; ++k) dst[n][k] = *(const PG8_LAS bf16x8*)(lds + PG8_SB(b, h) + boff + n * 2048 + k * 1024); } while (0)
#define PG8_MMA(ai, bj, At, Bt) do { __builtin_amdgcn_s_setprio(1); _Pragma("unroll") for (int m = 0; m < 4; ++m) _Pragma("unroll") for (int n = 0; n < 2; ++n) _Pragma("unroll") for (int k = 0; k < 2; ++k) \
        acc[ai][bj][m][n] = __builtin_amdgcn_mfma_f32_16x16x32_bf16(Bt[n][k], At[m][k], acc[ai][bj][m][n], 0, 0, 0); __builtin_amdgcn_s_setprio(0); } while (0)
#define PG8_WAIT_V(n) asm volatile("s_waitcnt vmcnt(" #n ")" ::: "memory")
#define PG8_WAIT_L(n) asm volatile("s_waitcnt lgkmcnt(" #n ")" ::: "memory")
#define PG8_BAR __builtin_amdgcn_s_barrier()
#define PG8_SCHED __builtin_amdgcn_sched_barrier(0)
    Unit cur, nxt; int ui = 0;
    if (!S.next(0, cur)) return;
    f32x4 acc[2][2][4][2];
#pragma unroll
    for (int a = 0; a < 2; ++a)
#pragma unroll
        for (int b = 0; b < 2; ++b)
#pragma unroll
            for (int m = 0; m < 4; ++m)
#pragma unroll
                for (int n = 0; n < 2; ++n) acc[a][b][m][n] = (f32x4){0.f, 0.f, 0.f, 0.f};
    bf16x8 At[4][2], B0[2][2], B1[2][2];
    const char* cA = (const char*)g.A + (size_t)cur.pm * tstep; const char* cB = (const char*)g.Bt + (size_t)cur.pn * tstep;
    PG8_STAGE(PG8_SB(0, 0), cB, voffB); PG8_STAGE(PG8_SA(0, 0), cA, voffA); PG8_STAGE(PG8_SB(0, 1), cB + hstep, voffB); PG8_STAGE(PG8_SA(0, 1), cA + hstep, voffA);
    if (wr == 1) PG8_BAR;
    PG8_WAIT_V(4); PG8_BAR;
    PG8_STAGE(PG8_SB(1, 0), cB + kstep, voffB); PG8_STAGE(PG8_SA(1, 0), cA + kstep, voffA); PG8_STAGE(PG8_SB(1, 1), cB + hstep + kstep, voffB);
    PG8_WAIT_V(6); PG8_BAR;
    for (;;) {
        const bool has_next = S.next(ui + 1, nxt);
        const char* nA = has_next ? (const char*)g.A + (size_t)nxt.pm * tstep : cA; const char* nB = has_next ? (const char*)g.Bt + (size_t)nxt.pn * tstep : cB;
        for (int t = 0; t < nt; t += 2) {
            const bool last = (t == nt - 2);
            const char* a1 = cA + (size_t)(t + 1) * kstep;
            const char* a2 = last ? nA : cA + (size_t)(t + 2) * kstep; const char* b2 = last ? nB : cB + (size_t)(t + 2) * kstep;
            const char* a3 = a2 + kstep; const char* b3 = b2 + kstep;
            PG8_LDB(B0, 0, 0); PG8_SCHED; PG8_LDA(At, 0, 0); PG8_STAGE(PG8_SA(1, 1), a1 + hstep, voffA);
            PG8_WAIT_L(8); PG8_BAR; PG8_WAIT_L(0); PG8_MMA(0, 0, At, B0); PG8_BAR; PG8_SCHED;
            PG8_LDB(B1, 0, 1); PG8_STAGE(PG8_SB(0, 0), b2, voffB);
            PG8_BAR; PG8_WAIT_L(0); PG8_MMA(0, 1, At, B1); PG8_BAR;
            PG8_LDA(At, 0, 1); PG8_STAGE(PG8_SA(0, 0), a2, voffA);
            PG8_BAR; PG8_WAIT_L(0); PG8_MMA(1, 0, At, B0); PG8_BAR; PG8_SCHED;
            PG8_STAGE(PG8_SB(0, 1), b2 + hstep, voffB);
            PG8_WAIT_V(6); PG8_BAR; PG8_MMA(1, 1, At, B1); PG8_BAR;
            PG8_LDB(B0, 1, 0); PG8_SCHED; PG8_LDA(At, 1, 0); PG8_STAGE(PG8_SA(0, 1), a2 + hstep, voffA);
            PG8_WAIT_L(8); PG8_BAR; PG8_WAIT_L(0); PG8_MMA(0, 0, At, B0); PG8_BAR; PG8_SCHED;
            PG8_LDB(B1, 1, 1); PG8_STAGE(PG8_SB(1, 0), b3, voffB);
            PG8_BAR; PG8_WAIT_L(0); PG8_MMA(0, 1, At, B1); PG8_BAR;
            PG8_LDA(At, 1, 1); PG8_STAGE(PG8_SA(1, 0), a3, voffA);
            PG8_BAR; PG8_WAIT_L(0); PG8_MMA(1, 0, At, B0); PG8_BAR; PG8_SCHED;
            PG8_STAGE(PG8_SB(1, 1), b3 + hstep, voffB);
            PG8_WAIT_V(6); PG8_BAR; PG8_MMA(1, 1, At, B1); PG8_BAR;
        }
        asm volatile("s_nop 7\n\ts_nop 7\n\ts_nop 7" ::: "memory");
        E(acc, cur, wr, wc, fr, fq);
        if (!has_next) break;
#pragma unroll
        for (int a = 0; a < 2; ++a)
#pragma unroll
            for (int b = 0; b < 2; ++b)
#pragma unroll
                for (int m = 0; m < 4; ++m)
#pragma unroll
                    for (int n = 0; n < 2; ++n) acc[a][b][m][n] = (f32x4){0.f, 0.f, 0.f, 0.f};
        cur = nxt; cA = nA; cB = nB; ++ui;
    }
    PG8_WAIT_V(0);
    if (wr == 0) PG8_BAR;
    PG8_BAR;
#undef PG8_SA
#undef PG8_SB
#undef PG8_STAGE
#undef PG8_LDA
#undef PG8_LDB
#undef PG8_MMA
#undef PG8_WAIT_V
#undef PG8_WAIT_L
#undef PG8_BAR
#undef PG8_SCHED
}
}
using pg8::Unit;

struct EpiProj {
    u16* projA; u16* projB; float* shift_p; float* shift_s;
    __device__ __forceinline__ void operator()(const f32x4 (&acc)[2][2][4][2], const Unit& u, int wr, int wc, int fr, int fq) const {
        const int row0 = u.pm * 256 + wr * 64 + fr;
        const bool isA = u.pn < 7;
        u16* base = isA ? projA : projB;
        const int colt = (isA ? u.pn : u.pn - 7) * 256 + wc * 32 + 4 * fq;
#pragma unroll
        for (int ai = 0; ai < 2; ++ai)
#pragma unroll
            for (int m = 0; m < 4; ++m) {
                const int row = row0 + ai * 128 + m * 16;
                u16* rowp = base + (size_t)row * 1792 + colt;
#pragma unroll
                for (int bj = 0; bj < 2; ++bj)
#pragma unroll
                    for (int n = 0; n < 2; ++n) st_bf4_asm(rowp + bj * 128 + n * 16, acc[ai][bj][m][n]);
                if (isA) {
                    float* dst = nullptr;
                    if (row < MP) { if ((row & 2047) == 2047) dst = shift_p + (size_t)(row >> 11) * 1792; }
                    else { const int r = row - MP; if ((r & 3) == 3) dst = shift_s + (size_t)(r >> 2) * 1792; }
                    if (dst) {
#pragma unroll
                        for (int bj = 0; bj < 2; ++bj)
#pragma unroll
                            for (int n = 0; n < 2; ++n) *(f32x4*)(dst + colt + bj * 128 + n * 16) = acc[ai][bj][m][n];
                    }
                }
            }
    }
};
struct EpiResid {
    const float* base; float* out;
    __device__ __forceinline__ void operator()(const f32x4 (&acc)[2][2][4][2], const Unit& u, int wr, int wc, int fr, int fq) const {
        const int row0 = u.pm * 256 + wr * 64 + fr, col0 = u.pn * 256 + wc * 32 + 4 * fq;
#pragma unroll
        for (int ai = 0; ai < 2; ++ai)
#pragma unroll
            for (int m = 0; m < 4; ++m) {
                const size_t off = (size_t)(row0 + ai * 128 + m * 16) * 1024 + col0;
#pragma unroll
                for (int bj = 0; bj < 2; ++bj)
#pragma unroll
                    for (int n = 0; n < 2; ++n) { const f32x4 b = *(const f32x4*)(base + off + bj * 128 + n * 16); *(f32x4*)(out + off + bj * 128 + n * 16) = b * ALPHA + acc[ai][bj][m][n]; }
            }
    }
};
struct EpiUp {
    u16* gate; u16* val; float* conv_p; float* conv_s;
    __device__ __forceinline__ void operator()(const f32x4 (&acc)[2][2][4][2], const Unit& u, int wr, int wc, int fr, int fq) const {
        const int row0 = u.pm * 256 + wr * 64 + fr;
        const bool isG = u.pn < 11;
        u16* base = isG ? gate : val;
        const int colt = (isG ? u.pn : u.pn - 11) * 256 + wc * 32 + 4 * fq;
#pragma unroll
        for (int ai = 0; ai < 2; ++ai)
#pragma unroll
            for (int m = 0; m < 4; ++m) {
                const int row = row0 + ai * 128 + m * 16;
                u16* rowp = base + (size_t)row * DFF + colt;
#pragma unroll
                for (int bj = 0; bj < 2; ++bj)
#pragma unroll
                    for (int n = 0; n < 2; ++n) st_bf4_asm(rowp + bj * 128 + n * 16, acc[ai][bj][m][n]);
                if (isG) {
                    float* dst = nullptr;
                    if (row < MP) { const int t = row & 2047; if (t >= 2046) dst = conv_p + (size_t)((row >> 11) * 2 + (t - 2046)) * DFF; }
                    else { const int r = row - MP, t = r & 3; if (t >= 2) dst = conv_s + (size_t)((r >> 2) * 2 + (t - 2)) * DFF; }
                    if (dst) {
#pragma unroll
                        for (int bj = 0; bj < 2; ++bj)
#pragma unroll
                            for (int n = 0; n < 2; ++n) *(f32x4*)(dst + colt + bj * 128 + n * 16) = acc[ai][bj][m][n];
                    }
                }
            }
    }
};

__device__ __forceinline__ void transpose_tile(const float* __restrict__ src, u16* __restrict__ dst, int K, int N, int nT, int item, float* tile) {
    const int t = opaque_tid();
    const int kt = item / nT, ntile = item - kt * nT, k0 = kt * 64, n0 = ntile * 64;
    { const int row = t >> 3, c8 = (t & 7) * 8;
      f32x4 a = (f32x4){0.f, 0.f, 0.f, 0.f}, b = a;
      if (n0 + c8 < N) { const float* sp = src + (size_t)(k0 + row) * N + n0 + c8; a = *(const f32x4*)sp; b = *(const f32x4*)(sp + 4); }
      float* tp = tile + row * 65 + c8;
      tp[0] = a[0]; tp[1] = a[1]; tp[2] = a[2]; tp[3] = a[3]; tp[4] = b[0]; tp[5] = b[1]; tp[6] = b[2]; tp[7] = b[3]; }
    __syncthreads();
    { const int n = t >> 3, k8 = (t & 7) * 8;
      float v[8];
#pragma unroll
      for (int j = 0; j < 8; ++j) v[j] = tile[(k8 + j) * 65 + n];
      u32x4 w; w.x = cvt_pk_bf16(v[0], v[1]); w.y = cvt_pk_bf16(v[2], v[3]); w.z = cvt_pk_bf16(v[4], v[5]); w.w = cvt_pk_bf16(v[6], v[7]);
      *(u32x4*)(dst + (size_t)(n0 + n) * K + k0 + k8) = w; }
    __syncthreads();
}
__device__ __forceinline__ void small_transpose(const float* __restrict__ src, u16* __restrict__ dst, int K, int N, int Kpad, size_t gt, size_t nth) {
    for (size_t i = gt; i < (size_t)N * Kpad; i += nth) { const int n = (int)(i / Kpad), k = (int)(i - (size_t)n * Kpad); const float v = k < K ? src[(size_t)k * N + n] : 0.f; dst[i] = (u16)(cvt_pk_bf16(v, 0.f) & 0xffffu); }
}
__device__ void convert_phase(KP p, int l, float* tile) {
    unsigned char* ws = p->ws;
    const int bid = opaque_bid();
    const size_t gt = (size_t)bid * 512 + opaque_tid(), nth = (size_t)gridDim.x * 512;
    constexpr int n1 = 16 * 56, n2 = 16 * 16, n3 = 16 * 88, n4 = 44 * 16;
    for (int it = bid; it < n1 + n2 + n3 + n4; it += gridDim.x) {
        if (it < n1) transpose_tile(p->in[I_WIN] + (size_t)l * 1024 * 3344, (u16*)(ws + W_WIN), 1024, 3344, 56, it, tile);
        else if (it < n1 + n2) transpose_tile(p->in[I_WOUT] + (size_t)l * 1024 * 1024, (u16*)(ws + W_WOUT), 1024, 1024, 16, it - n1, tile);
        else if (it < n1 + n2 + n3) transpose_tile(p->in[I_WUP] + (size_t)l * 1024 * 5632, (u16*)(ws + W_WUP), 1024, 5632, 88, it - n1 - n2, tile);
        else transpose_tile(p->in[I_WDOWN] + (size_t)l * 2816 * 1024, (u16*)(ws + W_WDOWN), 2816, 1024, 16, it - n1 - n2 - n3, tile);
    }
    small_transpose(p->in[I_WLU] + (size_t)l * 64 * 512, (u16*)(ws + W_WLT), 64, 512, 64, gt, nth);
    small_transpose(p->in[I_ALU] + (size_t)l * 64 * 512, (u16*)(ws + W_ALT), 64, 512, 64, gt, nth);
    small_transpose(p->in[I_GLU] + (size_t)l * 128 * 512, (u16*)(ws + W_GLT), 128, 512, 128, gt, nth);
    if (l > 0) {
        small_transpose(p->in[I_VD] + (size_t)(l - 1) * 512 * 32, (u16*)(ws + W_V1T), 512, 32, 512, gt, nth);
        small_transpose(p->in[I_VU] + (size_t)(l - 1) * 32 * 512, (u16*)(ws + W_V2T), 32, 512, 32, gt, nth);
    }
    small_transpose(p->in[I_FUP] + (size_t)l * 16 * 256, (u16*)(ws + W_FT), 16, 256, 32, gt, nth);
    if (l == 0) {
        float* xa = p->out + O_Y; u16* xb = (u16*)(ws + W_XB);
        for (size_t i = gt; i < (size_t)MTOK * 256; i += nth) {
            const size_t e = i * 4;
            const f32x4 v = e < (size_t)MP * 1024 ? *(const f32x4*)(p->in[I_XP] + e) : *(const f32x4*)(p->in[I_XS] + (e - (size_t)MP * 1024));
            *(f32x4*)(xa + e) = v; st_bf4(xb + e, v);
        }
    }
}

__device__ void ln_phase(float* Y, u16* xb, const float* __restrict__ g, const float* __restrict__ b) {
    const int tt_ = opaque_tid();
    const int lane = tt_ & 63, gw = opaque_bid() * 8 + (tt_ >> 6), nw = gridDim.x * 8;
    f32x4 gv[4], bv[4];
#pragma unroll
    for (int i = 0; i < 4; ++i) { gv[i] = *(const f32x4*)(g + i * 256 + lane * 4); bv[i] = *(const f32x4*)(b + i * 256 + lane * 4); }
    for (int row = gw; row < MTOK; row += nw) {
        float* yp = Y + (size_t)row * 1024 + lane * 4;
        f32x4 v[4]; float s = 0.f;
#pragma unroll
        for (int i = 0; i < 4; ++i) { v[i] = *(const f32x4*)(yp + i * 256); s += (v[i][0] + v[i][1]) + (v[i][2] + v[i][3]); }
#pragma unroll
        for (int o = 32; o >= 1; o >>= 1) s += __shfl_xor(s, o);
        const float mu = s * (1.0f / 1024.0f); float q = 0.f;
#pragma unroll
        for (int i = 0; i < 4; ++i) { const f32x4 d = v[i] - mu; q += (d[0] * d[0] + d[1] * d[1]) + (d[2] * d[2] + d[3] * d[3]); }
#pragma unroll
        for (int o = 32; o >= 1; o >>= 1) q += __shfl_xor(q, o);
        const float rstd = rsqrtf(q * (1.0f / 1024.0f) + LN_EPS);
#pragma unroll
        for (int i = 0; i < 4; ++i) { const f32x4 o = (v[i] - mu) * rstd * gv[i] + bv[i]; *(f32x4*)(yp + i * 256) = o; st_bf4(xb + (size_t)row * 1024 + i * 256 + lane * 4, o); }
    }
}

__device__ __forceinline__ void unpack8(const u32x4 w, float* f) { f[0] = bflo(w.x); f[1] = bfhi(w.x); f[2] = bflo(w.y); f[3] = bfhi(w.y); f[4] = bflo(w.z); f[5] = bfhi(w.z); f[6] = bflo(w.w); f[7] = bfhi(w.w); }
__device__ __forceinline__ float gelu_as(float v) {
    const float av = fabsf(v), t = __builtin_amdgcn_rcpf(av * 0.2316418882f + 1.0f);
    float q = t * 0.5307027145f + (-0.7265760135f); q = q * t + 0.7107068705f; q = q * t + (-0.142248368f); q = q * t + 0.127414796f; q = q * t;
    const float e = __builtin_amdgcn_exp2f((v * v) * (-0.72134752044f));
    const float m = v * (q * e);
    return v < 0.f ? m : v - m;
}
__device__ void convglu_phase(const u16* __restrict__ gate, u16* val, const float* __restrict__ past  , const float* __restrict__ cw, const float* __restrict__ cb) {
    const size_t gt = (size_t)opaque_bid() * 512 + opaque_tid(), nth = (size_t)gridDim.x * 512;
    for (size_t idx = gt; idx < (size_t)(MTOK / 4) * 352; idx += nth) {
        const int rg = (int)(idx / 352), c = (int)(idx - (size_t)rg * 352) * 8, row0 = rg * 4;
        bool first; const float* pst = nullptr;
        if (row0 < MP) first = (row0 & 2047) == 0; else { first = true; pst = past + (size_t)((row0 - MP) >> 2) * 2 * DFF; }
        float w0[8], w1[8], w2[8], bb[8], gm2[8], gm1[8];
#pragma unroll
        for (int j = 0; j < 8; ++j) { w0[j] = cw[c + j]; w1[j] = cw[DFF + c + j]; w2[j] = cw[2 * DFF + c + j]; bb[j] = cb[c + j]; }
        if (!first) { unpack8(*(const u32x4*)(gate + (size_t)(row0 - 2) * DFF + c), gm2); unpack8(*(const u32x4*)(gate + (size_t)(row0 - 1) * DFF + c), gm1); }
        else {
#pragma unroll
            for (int j = 0; j < 8; ++j) { gm2[j] = pst ? pst[c + j] : 0.f; gm1[j] = pst ? pst[DFF + c + j] : 0.f; } }
#pragma unroll
        for (int r = 0; r < 4; ++r) {
            float g0[8], vv[8], h[8];
            unpack8(*(const u32x4*)(gate + (size_t)(row0 + r) * DFF + c), g0);
            unpack8(*(const u32x4*)(val + (size_t)(row0 + r) * DFF + c), vv);
#pragma unroll
            for (int j = 0; j < 8; ++j) { const float a = bb[j] + gm2[j] * w0[j] + gm1[j] * w1[j] + g0[j] * w2[j]; h[j] = gelu_as(a) * vv[j]; gm2[j] = gm1[j]; gm1[j] = g0[j]; }
            u32x4 w; w.x = cvt_pk_bf16(h[0], h[1]); w.y = cvt_pk_bf16(h[2], h[3]); w.z = cvt_pk_bf16(h[4], h[5]); w.w = cvt_pk_bf16(h[6], h[7]);
            *(u32x4*)(val + (size_t)(row0 + r) * DFF + c) = w;
        }
    }
}

struct PrepCtx {
    const u16* projA; const u16* projB; const float* mu; const float* sshift  ;
};
__device__ __forceinline__ f32x4 xs4(const PrepCtx& c, int i, int col) {
    const f32x4 cur = ld_bf4(c.projA + (size_t)i * 1792 + col);
    f32x4 prev;
    bool first; int b = 0;
    if (i < MP) first = (i & 2047) == 0; else { const int r = i - MP; first = (r & 3) == 0; b = r >> 2; }
    if (!first) prev = ld_bf4(c.projA + (size_t)(i - 1) * 1792 + col);
    else if (i < MP) prev = (f32x4){0.f, 0.f, 0.f, 0.f};
    else prev = *(const f32x4*)(c.sshift + (size_t)b * 1792 + col);
    const f32x4 m = *(const f32x4*)(c.mu + col);
    return cur + (prev - cur) * m;
}
__device__ __forceinline__ bf16x8 ldg_frag(const u16* p) { return *(const bf16x8*)p; }

__device__ void prep_phase(KP p, int l, PG8_LAS unsigned char* lds) {
    unsigned char* ws = p->ws;
    PrepCtx c; c.projA = (const u16*)(ws + W_PROJA); c.projB = (const u16*)(ws + W_PROJB); c.mu = p->in[I_MU] + (size_t)l * 1792; c.sshift = p->in[I_SSHIFT] + (size_t)l * 128 * 1792;
    const u16* wlT = (const u16*)(ws + W_WLT); const u16* alT = (const u16*)(ws + W_ALT); const u16* glT = (const u16*)(ws + W_GLT);
    const u16* v1T = (const u16*)(ws + W_V1T); const u16* v2T = (const u16*)(ws + W_V2T); const u16* fT = (const u16*)(ws + W_FT);
    u32x4* A16 = (u32x4*)(ws + W_BUFB); float* D8 = (float*)(ws + W_D8); u16* vbuf = (u16*)(ws + W_VBUF); u16* gbuf = (u16*)(ws + W_GBUF);
    float* decb = (float*)(ws + W_DEC); float* rkb = (float*)(ws + W_RK); u16* vfirst = (u16*)(ws + W_VFIRST);
    const float* w0 = p->in[I_W0] + l * 512; const float* a0 = p->in[I_A0] + l * 512; const float* k_k = p->in[I_KK] + l * 512; const float* k_a = p->in[I_KA] + l * 512;
    const float* r_k = p->in[I_RK] + l * 512; const float* vb = l > 0 ? p->in[I_VB] + (l - 1) * 512 : nullptr; const float* fbias = p->in[I_FB] + l * 256;
    constexpr int S_TW = 144, S_AL = 144, S_SG = 272, S_XV = 1040, S_FL = 80, S_PP = 80;
    constexpr int O_TW = 0, O_AL = O_TW + 16 * S_TW, O_SG = O_AL + 16 * S_AL, O_XV = O_SG + 16 * S_SG, O_FL = O_XV + 16 * S_XV, O_PP = O_FL + 16 * S_FL;
    const int t = opaque_tid(), wid = t >> 6, lane = t & 63, fr = lane & 15, fq = lane >> 4, h = wid;
    for (int blk = opaque_bid(); blk < MTOK / 16; blk += gridDim.x) {
        const int i0 = blk * 16;
#pragma unroll 1
        for (int q = 0; q < 6; ++q) {
            const int op = t + 512 * q, r = op / 192, g4 = op - r * 192, col = 1024 + 4 * g4;
            f32x4 x = xs4(c, i0 + r, col);
            int off;
            if (col < 1536) off = O_XV + r * S_XV + (col - 1024) * 2;
            else if (col < 1600) { off = O_TW + r * S_TW + (col - 1536) * 2; x = (f32x4){tanhf(x[0]), tanhf(x[1]), tanhf(x[2]), tanhf(x[3])}; }
            else if (col < 1664) off = O_AL + r * S_AL + (col - 1600) * 2;
            else { off = O_SG + r * S_SG + (col - 1664) * 2; x = (f32x4){sigmoidf_(x[0]), sigmoidf_(x[1]), sigmoidf_(x[2]), sigmoidf_(x[3])}; }
            u32x2 w; w.x = cvt_pk_bf16(x[0], x[1]); w.y = cvt_pk_bf16(x[2], x[3]);
            *(PG8_LAS u32x2*)(lds + off) = w;
        }
        if (t < 128) { const int r = t >> 3, c4 = (t & 7) * 4; u32x2 w = (u32x2){0u, 0u}; if (c4 < 16) w = *(const u32x2*)(c.projB + (size_t)(i0 + r) * 1792 + 1536 + c4); *(PG8_LAS u32x2*)(lds + O_FL + r * S_FL + c4 * 2) = w; }
        __syncthreads();
        bf16x8 pfrag = (bf16x8){0, 0, 0, 0, 0, 0, 0, 0};
        if (l > 0) {
            f32x4 accP0 = (f32x4){0.f, 0.f, 0.f, 0.f}, accP1 = accP0;
#pragma unroll 4
            for (int ks = 0; ks < 16; ++ks) {
                const bf16x8 af = *(const PG8_LAS bf16x8*)(lds + O_XV + fr * S_XV + (ks * 32 + fq * 8) * 2);
                accP0 = __builtin_amdgcn_mfma_f32_16x16x32_bf16(ldg_frag(v1T + (size_t)fr * 512 + ks * 32 + fq * 8), af, accP0, 0, 0, 0);
                accP1 = __builtin_amdgcn_mfma_f32_16x16x32_bf16(ldg_frag(v1T + (size_t)(16 + fr) * 512 + ks * 32 + fq * 8), af, accP1, 0, 0, 0);
            }
            const u32 w0_ = cvt_pk_bf16(accP0[0], accP0[1]), w1_ = cvt_pk_bf16(accP0[2], accP0[3]), w2_ = cvt_pk_bf16(accP1[0], accP1[1]), w3_ = cvt_pk_bf16(accP1[2], accP1[3]);
            const u32x4 pw = (u32x4){w0_, w1_, w2_, w3_};
            pfrag = __builtin_bit_cast(bf16x8, pw);
        }
        const int i = i0 + fr;
        float ss = 0.f;
#pragma unroll
        for (int n = 0; n < 4; ++n) { const int cb_ = h * 64 + 16 * n + 4 * fq; const f32x4 xk = xs4(c, i, 512 + cb_) * *(const f32x4*)(k_k + cb_); ss += (xk[0] * xk[0] + xk[1] * xk[1]) + (xk[2] * xk[2] + xk[3] * xk[3]); }
        ss += __shfl_xor(ss, 16); ss += __shfl_xor(ss, 32);
        const float inorm = rsqrtf(fmaxf(ss, 1e-24f));
        float rks = 0.f;
#pragma unroll 1
        for (int n = 0; n < 4; ++n) {
            const int cn = h * 64 + 16 * n, cb_ = cn + 4 * fq;
            f32x4 aW = (f32x4){0.f, 0.f, 0.f, 0.f}, aA = aW, aG = aW, aV = aW;
#pragma unroll
            for (int ks = 0; ks < 2; ++ks) {
                aW = __builtin_amdgcn_mfma_f32_16x16x32_bf16(ldg_frag(wlT + (size_t)(cn + fr) * 64 + ks * 32 + fq * 8), *(const PG8_LAS bf16x8*)(lds + O_TW + fr * S_TW + (ks * 32 + fq * 8) * 2), aW, 0, 0, 0);
                aA = __builtin_amdgcn_mfma_f32_16x16x32_bf16(ldg_frag(alT + (size_t)(cn + fr) * 64 + ks * 32 + fq * 8), *(const PG8_LAS bf16x8*)(lds + O_AL + fr * S_AL + (ks * 32 + fq * 8) * 2), aA, 0, 0, 0);
            }
#pragma unroll
            for (int ks = 0; ks < 4; ++ks)
                aG = __builtin_amdgcn_mfma_f32_16x16x32_bf16(ldg_frag(glT + (size_t)(cn + fr) * 128 + ks * 32 + fq * 8), *(const PG8_LAS bf16x8*)(lds + O_SG + fr * S_SG + (ks * 32 + fq * 8) * 2), aG, 0, 0, 0);
            if (l > 0) {
                const u32x2 va = *(const u32x2*)(v2T + (size_t)(cn + fr) * 32 + 4 * fq), vc = *(const u32x2*)(v2T + (size_t)(cn + fr) * 32 + 16 + 4 * fq);
                const u32x4 vw = (u32x4){va.x, va.y, vc.x, vc.y};
                aV = __builtin_amdgcn_mfma_f32_16x16x32_bf16(__builtin_bit_cast(bf16x8, vw), pfrag, aV, 0, 0, 0);
            }
            const f32x4 xr = xs4(c, i, cb_), xk = xs4(c, i, 512 + cb_), xv = xs4(c, i, 1024 + cb_);
            const f32x4 w0v = *(const f32x4*)(w0 + cb_), a0v = *(const f32x4*)(a0 + cb_), kkv = *(const f32x4*)(k_k + cb_), kav = *(const f32x4*)(k_a + cb_), rkv = *(const f32x4*)(r_k + cb_);
            f32x4 vp = xv;
            if (l == 0) st_bf4(vfirst + (size_t)i * 512 + cb_, xv);
            else { const f32x4 vf = ld_bf4(vfirst + (size_t)i * 512 + cb_); const f32x4 vbv = *(const f32x4*)(vb + cb_);
#pragma unroll
                for (int j = 0; j < 4; ++j) vp[j] = xv[j] + (vf[j] - xv[j]) * sigmoidf_(vbv[j] + aV[j]);
            }
            f32x4 dd, kt, kn, bb;
#pragma unroll
            for (int j = 0; j < 4; ++j) {
                const float wv = -softplusf_(-(w0v[j] + aW[j])) - 0.5f;
                dd[j] = __expf(-__expf(wv));
                const float a = sigmoidf_(a0v[j] + aA[j]);
                kn[j] = xk[j] * kkv[j] * inorm;
                kt[j] = xk[j] * (1.0f + (a - 1.0f) * kav[j]);
                bb[j] = kn[j] * a;
                rks += xr[j] * kt[j] * rkv[j];
            }
            const int p0 = 8 * n + 2 * fq;
            u32x4 rec0, rec1;
            rec0.x = cvt_pk_bf16(xr[0], xr[1]); rec0.y = cvt_pk_bf16(kt[0], kt[1]); rec0.z = cvt_pk_bf16(kn[0], kn[1]); rec0.w = cvt_pk_bf16(bb[0], bb[1]);
            rec1.x = cvt_pk_bf16(xr[2], xr[3]); rec1.y = cvt_pk_bf16(kt[2], kt[3]); rec1.z = cvt_pk_bf16(kn[2], kn[3]); rec1.w = cvt_pk_bf16(bb[2], bb[3]);
            u32x4* ap = A16 + ((size_t)i * 8 + h) * 32 + p0;
            ap[0] = rec0; ap[1] = rec1;
            *(f32x4*)(D8 + (size_t)i * 512 + cb_) = dd;
            st_bf4(vbuf + (size_t)i * 512 + cb_, vp);
            st_bf4(gbuf + (size_t)i * 512 + cb_, aG);
        }
        rks += __shfl_xor(rks, 16); rks += __shfl_xor(rks, 32);
        if (fq == 0) rkb[(size_t)i * 8 + h] = rks;
#pragma unroll
        for (int n2 = 0; n2 < 2; ++n2) {
            const int cn = 32 * h + 16 * n2;
            f32x4 aF = (f32x4){0.f, 0.f, 0.f, 0.f};
            aF = __builtin_amdgcn_mfma_f32_16x16x32_bf16(ldg_frag(fT + (size_t)(cn + fr) * 32 + fq * 8), *(const PG8_LAS bf16x8*)(lds + O_FL + fr * S_FL + (fq * 8) * 2), aF, 0, 0, 0);
            const f32x4 fb = *(const f32x4*)(fbias + cn + 4 * fq);
            f32x4 dc;
#pragma unroll
            for (int j = 0; j < 4; ++j) { const float z = aF[j] + fb[j]; dc[j] = __expf(-softplusf_(-z) * (1.0f / 16.0f)); }
            *(f32x4*)(decb + (size_t)i * 256 + cn + 4 * fq) = dc;
        }
        __syncthreads();
    }
}

struct ScanItem {
    int tok0, T, L;
    int h, q;
    int hg, cgp;
    const float* s0_rwkv; float* so_rwkv;
    const float* s0_gla; float* so_gla;
};
template <int LSEG>
__device__ __forceinline__ void scan_item(KP p, const ScanItem& it, PG8_LAS unsigned char* lds) {
    unsigned char* ws = p->ws;
    const u32x4* A16 = (const u32x4*)(ws + W_BUFB); const float* D8 = (const float*)(ws + W_D8); const u16* vbuf = (const u16*)(ws + W_VBUF);
    const u16* projB = (const u16*)(ws + W_PROJB); const float* decb = (const float*)(ws + W_DEC);
    u16* obufA = (u16*)(ws + W_OBUFA); u16* obufB = (u16*)(ws + W_OBUFB);
    const int t = opaque_tid(), wid = t >> 6, lane = t & 63, kq = lane & 15, rsel = lane >> 4;
    constexpr int BUF = 69632, OR = 0, OKT = 8192, OKN = 16384, OB = 24576, OD = 32768, OVR = 40960, OQ = 43008, OK = 51200, ODC = 59392, OVG = 67584;
    const int nchunk = it.T / TC;
    u32x4 sa0, sa1; f32x4 sd, sdec; u32x2 svr = (u32x2){0u, 0u}, sq, sk;
#define SC_GLOAD(ch_) do { const int tk_ = it.tok0 + (ch_) * TC; \
        { const int i0 = t, i1 = t + 512; sa0 = A16[((size_t)(tk_ + (i0 >> 5)) * 8 + it.h) * 32 + (i0 & 31)]; sa1 = A16[((size_t)(tk_ + (i1 >> 5)) * 8 + it.h) * 32 + (i1 & 31)]; } \
        { const int st = t >> 4, c4 = (t & 15) * 4; sd = *(const f32x4*)(D8 + (size_t)(tk_ + st) * 512 + it.h * 64 + c4); \
          sq = *(const u32x2*)(projB + (size_t)(tk_ + st) * 1792 + it.hg * 64 + c4); sk = *(const u32x2*)(projB + (size_t)(tk_ + st) * 1792 + 256 + it.hg * 64 + c4); \
          sdec = *(const f32x4*)(decb + (size_t)(tk_ + st) * 256 + it.hg * 64 + c4); } \
        if (t < 128) { const int st = t >> 2, c4 = (t & 3) * 4; svr = *(const u32x2*)(vbuf + (size_t)(tk_ + st) * 512 + it.h * 64 + it.q * 16 + c4); } \
        else if (t < 256) { const int tt = t - 128, st = tt >> 2, c4 = (tt & 3) * 4; svr = *(const u32x2*)(projB + (size_t)(tk_ + st) * 1792 + 512 + it.hg * 128 + it.cgp * 16 + c4); } } while (0)
#define SC_LSTORE(buf_) do { PG8_LAS unsigned char* b_ = lds + (buf_) * BUF; \
        { const int i0 = t, i1 = t + 512; \
          { const int st = i0 >> 5, pp = i0 & 31; const int o = (st * 64 + 2 * pp) * 4; \
            *(PG8_LAS f32x2*)(b_ + OR + o) = (f32x2){bflo(sa0.x), bfhi(sa0.x)}; *(PG8_LAS f32x2*)(b_ + OKT + o) = (f32x2){bflo(sa0.y), bfhi(sa0.y)}; \
            *(PG8_LAS f32x2*)(b_ + OKN + o) = (f32x2){bflo(sa0.z), bfhi(sa0.z)}; *(PG8_LAS f32x2*)(b_ + OB + o) = (f32x2){bflo(sa0.w), bfhi(sa0.w)}; } \
          { const int st = i1 >> 5, pp = i1 & 31; const int o = (st * 64 + 2 * pp) * 4; \
            *(PG8_LAS f32x2*)(b_ + OR + o) = (f32x2){bflo(sa1.x), bfhi(sa1.x)}; *(PG8_LAS f32x2*)(b_ + OKT + o) = (f32x2){bflo(sa1.y), bfhi(sa1.y)}; \
            *(PG8_LAS f32x2*)(b_ + OKN + o) = (f32x2){bflo(sa1.z), bfhi(sa1.z)}; *(PG8_LAS f32x2*)(b_ + OB + o) = (f32x2){bflo(sa1.w), bfhi(sa1.w)}; } } \
        { const int st = t >> 4, c4 = (t & 15) * 4; const int o = (st * 64 + c4) * 4; \
          *(PG8_LAS f32x4*)(b_ + OD + o) = sd; *(PG8_LAS f32x4*)(b_ + ODC + o) = sdec; \
          *(PG8_LAS f32x4*)(b_ + OQ + o) = (f32x4){bflo(sq.x), bfhi(sq.x), bflo(sq.y), bfhi(sq.y)} * 0.125f; \
          *(PG8_LAS f32x4*)(b_ + OK + o) = (f32x4){bflo(sk.x), bfhi(sk.x), bflo(sk.y), bfhi(sk.y)}; } \
        if (t < 128) { const int st = t >> 2, c4 = (t & 3) * 4; *(PG8_LAS f32x4*)(b_ + OVR + (st * 16 + c4) * 4) = (f32x4){bflo(svr.x), bfhi(svr.x), bflo(svr.y), bfhi(svr.y)}; } \
        else if (t < 256) { const int tt = t - 128, st = tt >> 2, c4 = (tt & 3) * 4; *(PG8_LAS f32x4*)(b_ + OVG + (st * 16 + c4) * 4) = (f32x4){bflo(svr.x), bfhi(svr.x), bflo(svr.y), bfhi(svr.y)}; } } while (0)
    const bool isR = wid < 4;
    const int w4 = wid & 3;
    const int row = it.q * 16 + 4 * w4 + rsel;
    const int col = it.cgp * 16 + 4 * w4 + rsel;
    f32x4 S = (f32x4){0.f, 0.f, 0.f, 0.f}, Sn = S;
#define SC_LOAD_STATE(dst_, seg_) do { const int sg_ = (seg_); \
        if (isR) { if (!it.s0_rwkv) dst_ = (f32x4){0.f, 0.f, 0.f, 0.f}; else dst_ = *(const f32x4*)(it.s0_rwkv + (size_t)sg_ * 8 * 4096 + row * 64 + 4 * kq); } \
        else if (!it.s0_gla) dst_ = (f32x4){0.f, 0.f, 0.f, 0.f}; \
        else { const float* sp_ = it.s0_gla + (size_t)sg_ * 4 * 8192 + (size_t)(4 * kq) * 128 + col; dst_ = (f32x4){sp_[0], sp_[128], sp_[256], sp_[384]}; } } while (0)
#define SC_STORE_STATE(seg_, s_) do { const int sg_ = (seg_); \
        if (isR) { *(f32x4*)(it.so_rwkv + (size_t)sg_ * 8 * 4096 + row * 64 + 4 * kq) = s_; } \
        else { float* sp_ = it.so_gla + (size_t)sg_ * 4 * 8192 + (size_t)(4 * kq) * 128 + col; sp_[0] = s_[0]; sp_[128] = s_[1]; sp_[256] = s_[2]; sp_[384] = s_[3]; } } while (0)
    SC_GLOAD(0);
    SC_LOAD_STATE(Sn, 0);
    SC_LSTORE(0);
    __syncthreads();
    u16* oAp = obufA + (size_t)it.tok0 * 512 + it.h * 64 + row;
    u16* oBp = obufB + (size_t)it.tok0 * 512 + it.hg * 128 + col;
    const int vsl = (4 * w4 + rsel) * 4;
#define SC_STEP_R(s_) do { const int o = ((s_) * 64 + 4 * kq) * 4; \
        const f32x4 r4 = *(const PG8_LAS f32x4*)(b + OR + o), k4 = *(const PG8_LAS f32x4*)(b + OKT + o), n4 = *(const PG8_LAS f32x4*)(b + OKN + o), b4 = *(const PG8_LAS f32x4*)(b + OB + o), d4 = *(const PG8_LAS f32x4*)(b + OD + o); \
        const float v = *(const PG8_LAS float*)(b + OVR + (s_) * 64 + vsl); \
        float dot = (S[0] * n4[0] + S[1] * n4[1]) + (S[2] * n4[2] + S[3] * n4[3]); \
        dot = red16(dot); \
        S = S * d4 - b4 * dot + k4 * v; \
        float o_ = (S[0] * r4[0] + S[1] * r4[1]) + (S[2] * r4[2] + S[3] * r4[3]); \
        o_ = red16(o_); \
        if (kq == 0) oAp[(size_t)(s_) * 512] = (u16)(cvt_pk_bf16(o_, 0.f) & 0xffffu); } while (0)
#define SC_STEP_G(s_) do { const int o = ((s_) * 64 + 4 * kq) * 4; \
        const f32x4 q4 = *(const PG8_LAS f32x4*)(b + OQ + o), k4 = *(const PG8_LAS f32x4*)(b + OK + o), d4 = *(const PG8_LAS f32x4*)(b + ODC + o); \
        const float v = *(const PG8_LAS float*)(b + OVG + (s_) * 64 + vsl); \
        S = S * d4 + k4 * v; \
        float o_ = (S[0] * q4[0] + S[1] * q4[1]) + (S[2] * q4[2] + S[3] * q4[3]); \
        o_ = red16(o_); \
        if (kq == 0) oBp[(size_t)(s_) * 512] = (u16)(cvt_pk_bf16(o_, 0.f) & 0xffffu); } while (0)
    for (int ch = 0; ch < nchunk; ++ch) {
        const bool more = ch + 1 < nchunk;
        if (more) SC_GLOAD(ch + 1);
        PG8_LAS unsigned char* b = lds + (ch & 1) * BUF;
        if (LSEG >= TC) {
            if (ch == 0) S = Sn;
            if (isR) {
#pragma unroll 8
                for (int s = 0; s < TC; ++s) SC_STEP_R(s);
            } else {
#pragma unroll 8
                for (int s = 0; s < TC; ++s) SC_STEP_G(s);
            }
            if (!more) SC_STORE_STATE(0, S);
        } else {
#pragma unroll 1
            for (int sgi = 0; sgi < TC / LSEG; ++sgi) {
                const int seg = ch * (TC / LSEG) + sgi;
                S = Sn;
                if ((seg + 1) * LSEG < it.T) SC_LOAD_STATE(Sn, seg + 1);
                if (isR) {
#pragma unroll
                    for (int s2 = 0; s2 < LSEG; ++s2) SC_STEP_R(sgi * LSEG + s2);
                } else {
#pragma unroll
                    for (int s2 = 0; s2 < LSEG; ++s2) SC_STEP_G(sgi * LSEG + s2);
                }
                SC_STORE_STATE(seg, S);
            }
        }
        oAp += (size_t)TC * 512; oBp += (size_t)TC * 512;
        if (more) SC_LSTORE((ch + 1) & 1);
        __syncthreads();
    }
#undef SC_STEP_R
#undef SC_STEP_G
}
__device__ void scan_phase(KP p, int l, PG8_LAS unsigned char* lds) {
    float* out = p->out;
    const int bid = opaque_bid();
    for (int i = bid; i < 256; i += gridDim.x) {
        ScanItem it; const int s = i >> 5;
        it.tok0 = s * 2048; it.T = 2048; it.L = 2048; it.h = (i >> 2) & 7; it.q = i & 3; it.hg = (i >> 3) & 3; it.cgp = i & 7;
        it.s0_rwkv = nullptr; it.so_rwkv = out + O_RWKV_P + ((size_t)(l * 8 + s) * 8 + it.h) * 4096;
        it.s0_gla = nullptr; it.so_gla = out + O_GLA_P + ((size_t)(l * 8 + s) * 4 + it.hg) * 8192;
        scan_item<2048>(p, it, lds);
    }
    for (int i = bid; i < 256; i += gridDim.x) {
        ScanItem it; const int bg = i >> 5, b0 = bg * 16;
        it.tok0 = MP + bg * 64; it.T = 64; it.L = 4; it.h = (i >> 2) & 7; it.q = i & 3; it.hg = (i >> 3) & 3; it.cgp = i & 7;
        it.s0_rwkv = p->in[I_SRWKV] + ((size_t)(l * 128 + b0) * 8 + it.h) * 4096; it.so_rwkv = out + O_RWKV_S + ((size_t)(l * 128 + b0) * 8 + it.h) * 4096;
        it.s0_gla = p->in[I_SGLA] + ((size_t)(l * 128 + b0) * 4 + it.hg) * 8192; it.so_gla = out + O_GLA_S + ((size_t)(l * 128 + b0) * 4 + it.hg) * 8192;
        scan_item<4>(p, it, lds);
    }
}

__device__ void post_phase(KP p, int l) {
    unsigned char* ws = p->ws;
    const u16* obufA = (const u16*)(ws + W_OBUFA); const u16* obufB = (const u16*)(ws + W_OBUFB); const u16* vbuf = (const u16*)(ws + W_VBUF); const u16* gbuf = (const u16*)(ws + W_GBUF);
    const float* rkb = (const float*)(ws + W_RK); const u16* projB = (const u16*)(ws + W_PROJB); u16* oab = (u16*)(ws + W_XB);
    const float* lg = p->in[I_LNXG] + l * 512; const float* lb = p->in[I_LNXB] + l * 512; const float* ng = p->in[I_NG] + l * 128;
    const int tt_ = opaque_tid();
    const int lane = tt_ & 63, gw = opaque_bid() * 8 + (tt_ >> 6), nw = gridDim.x * 8;
    const int c = lane * 8;
    float lgv[8], lbv[8], ngv[8];
#pragma unroll
    for (int j = 0; j < 8; ++j) { lgv[j] = lg[c + j]; lbv[j] = lb[c + j]; ngv[j] = ng[(c & 127) + j]; }
    for (int i = gw; i < MTOK; i += nw) {
        {
            const f32x4 o0 = ld_bf4(obufA + (size_t)i * 512 + c), o1 = ld_bf4(obufA + (size_t)i * 512 + c + 4);
            const f32x4 v0 = ld_bf4(vbuf + (size_t)i * 512 + c), v1 = ld_bf4(vbuf + (size_t)i * 512 + c + 4);
            const f32x4 g0 = ld_bf4(gbuf + (size_t)i * 512 + c), g1 = ld_bf4(gbuf + (size_t)i * 512 + c + 4);
            const float rk = rkb[(size_t)i * 8 + (lane >> 3)];
            float s = (o0[0] + o0[1]) + (o0[2] + o0[3]) + (o1[0] + o1[1]) + (o1[2] + o1[3]);
            s += __shfl_xor(s, 1); s += __shfl_xor(s, 2); s += __shfl_xor(s, 4);
            const float m = s * (1.0f / 64.0f);
            const f32x4 d0 = o0 - m, d1 = o1 - m;
            float q = (d0[0] * d0[0] + d0[1] * d0[1]) + (d0[2] * d0[2] + d0[3] * d0[3]) + (d1[0] * d1[0] + d1[1] * d1[1]) + (d1[2] * d1[2] + d1[3] * d1[3]);
            q += __shfl_xor(q, 1); q += __shfl_xor(q, 2); q += __shfl_xor(q, 4);
            const float rs = rsqrtf(q * (1.0f / 64.0f) + GN_EPS_A);
            f32x4 y0, y1;
#pragma unroll
            for (int j = 0; j < 4; ++j) { y0[j] = (d0[j] * rs * lgv[j] + lbv[j] + rk * v0[j]) * g0[j]; y1[j] = (d1[j] * rs * lgv[4 + j] + lbv[4 + j] + rk * v1[j]) * g1[j]; }
            u32x4 w; w.x = cvt_pk_bf16(y0[0], y0[1]); w.y = cvt_pk_bf16(y0[2], y0[3]); w.z = cvt_pk_bf16(y1[0], y1[1]); w.w = cvt_pk_bf16(y1[2], y1[3]);
            *(u32x4*)(oab + (size_t)i * 1024 + c) = w;
        }
        {
            const f32x4 o0 = ld_bf4(obufB + (size_t)i * 512 + c), o1 = ld_bf4(obufB + (size_t)i * 512 + c + 4);
            const f32x4 g0 = ld_bf4(projB + (size_t)i * 1792 + 1024 + c), g1 = ld_bf4(projB + (size_t)i * 1792 + 1024 + c + 4);
            float q = (o0[0] * o0[0] + o0[1] * o0[1]) + (o0[2] * o0[2] + o0[3] * o0[3]) + (o1[0] * o1[0] + o1[1] * o1[1]) + (o1[2] * o1[2] + o1[3] * o1[3]);
            q += __shfl_xor(q, 1); q += __shfl_xor(q, 2); q += __shfl_xor(q, 4); q += __shfl_xor(q, 8);
            const float rs = rsqrtf(q * (1.0f / 128.0f) + RMS_EPS);
            f32x4 y0, y1;
#pragma unroll
            for (int j = 0; j < 4; ++j) { y0[j] = o0[j] * rs * ngv[j] * (g0[j] * sigmoidf_(g0[j])); y1[j] = o1[j] * rs * ngv[4 + j] * (g1[j] * sigmoidf_(g1[j])); }
            u32x4 w; w.x = cvt_pk_bf16(y0[0], y0[1]); w.y = cvt_pk_bf16(y0[2], y0[3]); w.z = cvt_pk_bf16(y1[0], y1[1]); w.w = cvt_pk_bf16(y1[2], y1[3]);
            *(u32x4*)(oab + (size_t)i * 1024 + 512 + c) = w;
        }
    }
}

#define XB_TMO      128
#define XB_XCNT(j)  (256  + 64 * (j))
#define XB_XSUB(j)  (1280 + 64 * (j))
#define XB_XGEN(j)  (2304 + 64 * (j))
#define XB_TOP      3328
#define XB_TOPGEN   3392
#define XCD_BAR_WORDS 3456
#define XB_SPIN_CAP (1u << 18)
__device__ __forceinline__ unsigned xb_ld(unsigned* p)              { return __hip_atomic_load(p, __ATOMIC_RELAXED, __HIP_MEMORY_SCOPE_AGENT); }
__device__ __forceinline__ unsigned xb_add(unsigned* p, unsigned v) { return __hip_atomic_fetch_add(p, v, __ATOMIC_RELAXED, __HIP_MEMORY_SCOPE_AGENT); }
__device__ __forceinline__ unsigned xb_xcc_id() { return (unsigned)__builtin_amdgcn_s_getreg((3 << 11) | 20) & 0xFu; }
#define XB_SPIN(cond, bar) do { unsigned _sp = 0; while (cond) { __builtin_amdgcn_s_sleep(1); \
    if ((++_sp & 255u) == 0u) { if (xb_ld(&(bar)[XB_TMO])) break; if (_sp > XB_SPIN_CAP) { atomicAdd(&(bar)[XB_TMO], 1u); break; } } } } while (0)
__device__ __forceinline__ void xcd_barrier_complete(unsigned* bar, unsigned x, unsigned& nloc, unsigned& nx) {
    const unsigned G = gridDim.x * gridDim.y * gridDim.z;
    unsigned sum, cnt, mine, sp = 0u;
    for (;;) {
        sum = 0u; cnt = 0u; mine = 0u;
#pragma unroll
        for (unsigned j = 0; j < 16; ++j) { const unsigned c = xb_ld(&bar[XB_XCNT(j)]); sum += c; cnt += (c > 0u) ? 1u : 0u; mine = (j == x) ? c : mine; }
        if (sum == G) break;
        __builtin_amdgcn_s_sleep(1);
        if ((++sp & 255u) == 0u) { if (xb_ld(&bar[XB_TMO])) break; if (sp > XB_SPIN_CAP) { atomicAdd(&bar[XB_TMO], 1u); break; } }
    }
    nloc = mine > 0u ? mine : 1u; nx = cnt > 0u ? cnt : 1u;
}
__device__ __forceinline__ void xcd_barrier(unsigned* bar, volatile PG8_LAS unsigned* st) {
    asm volatile("s_waitcnt vmcnt(0)" ::: "memory");
    __syncthreads();
    if (threadIdx.x == 0) {
        const unsigned x = xb_xcc_id();
        __builtin_amdgcn_s_waitcnt(0);
        unsigned nloc = st[0], nx = st[1];
        if (nloc == 0u) { xcd_barrier_complete(bar, x, nloc, nx); st[0] = nloc; st[1] = nx; }
        const unsigned old = xb_add(&bar[XB_XSUB(x)], 1u);
        const unsigned gen = old / nloc;
        if (old + 1u == (gen + 1u) * nloc) {
            __builtin_amdgcn_fence(__ATOMIC_RELEASE, "agent");
            asm volatile("s_waitcnt vmcnt(0)" ::: "memory");
            const unsigned og = xb_add(&bar[XB_TOP], 1u);
            const unsigned tg = og / nx;
            if (og + 1u == (tg + 1u) * nx) xb_add(&bar[XB_TOPGEN], 1u);
            else XB_SPIN(xb_ld(&bar[XB_TOPGEN]) == tg, bar);
            __builtin_amdgcn_fence(__ATOMIC_ACQUIRE, "agent");
            xb_add(&bar[XB_XGEN(x)], 1u);
            asm volatile("s_waitcnt vmcnt(0)" ::: "memory");
        } else {
            XB_SPIN(xb_ld(&bar[XB_XGEN(x)]) == gen, bar);
            __builtin_amdgcn_fence(__ATOMIC_ACQUIRE, "agent");
            asm volatile("s_waitcnt vmcnt(0)" ::: "memory");
        }
    }
    __syncthreads();
}
__device__ __forceinline__ void gsync(cg::grid_group& grid) {
    asm volatile("s_waitcnt vmcnt(0)" ::: "memory");
    grid.sync();
    if (threadIdx.x < 64) { __builtin_amdgcn_fence(__ATOMIC_ACQUIRE, "agent"); asm volatile("s_waitcnt vmcnt(0)" ::: "memory"); }
    __syncthreads();
}

__global__ void __launch_bounds__(512, 2) mega(Params p_unused) {
    KP p = kparams();
    extern __shared__ __attribute__((aligned(16))) unsigned char smem[];
    PG8_LAS unsigned char* lds = (PG8_LAS unsigned char*)smem;
    cg::grid_group grid = cg::this_grid();
    unsigned char* ws = p->ws;
    float* bufA = p->out + O_Y; float* bufB = (float*)(ws + W_BUFB); u16* xb = (u16*)(ws + W_XB);
    pg8::StaticOrder S;
    volatile PG8_LAS unsigned* xst = (volatile PG8_LAS unsigned*)(lds + 139264);
    if (threadIdx.x == 0) { xst[0] = 0u; xst[1] = 0u; }
    gsync(grid);
    unsigned* xbar = (unsigned*)(kparams()->ws + W_BAR);
    if (threadIdx.x == 0) (void)xb_add(&xbar[XB_XCNT(xb_xcc_id())], 1u);
#define PHASE_END() xcd_barrier((unsigned*)(kparams()->ws + W_BAR), xst)
    convert_phase(kparams(), 0, (float*)smem);
    PHASE_END();
    for (int l = 0; l < NL; ++l) {
        {
            pg8::Gemm g; g.A = xb; g.Bt = (const u16*)(ws + W_WIN); g.M = MTOK; g.N = INP; g.K = 1024;
            EpiProj E; E.projA = (u16*)(ws + W_PROJA); E.projB = (u16*)(ws + W_PROJB); E.shift_p = p->out + O_SHIFT_P + (size_t)l * 8 * 1792; E.shift_s = p->out + O_SHIFT_S + (size_t)l * 128 * 1792;
            S.init(MTOK, INP, gridDim.x, opaque_bid()); pg8::gemm_phase(lds, g, S, E);
        }
        PHASE_END();
        prep_phase(kparams(), l, lds);
        PHASE_END();
        scan_phase(kparams(), l, lds);
        PHASE_END();
        post_phase(kparams(), l);
        PHASE_END();
        {
            pg8::Gemm g; g.A = xb; g.Bt = (const u16*)(ws + W_WOUT); g.M = MTOK; g.N = 1024; g.K = 1024;
            EpiResid E; E.base = bufA; E.out = bufB;
            S.init(MTOK, 1024, gridDim.x, opaque_bid()); pg8::gemm_phase(lds, g, S, E);
        }
        PHASE_END();
        ln_phase(bufB, xb, p->in[I_LN1G] + l * 1024, p->in[I_LN1B] + l * 1024);
        PHASE_END();
        {
            pg8::Gemm g; g.A = xb; g.Bt = (const u16*)(ws + W_WUP); g.M = MTOK; g.N = 5632; g.K = 1024;
            EpiUp E; E.gate = (u16*)(ws + W_GATE); E.val = (u16*)(ws + W_VAL); E.conv_p = p->out + O_CONV_P + (size_t)l * 8 * 2 * DFF; E.conv_s = p->out + O_CONV_S + (size_t)l * 128 * 2 * DFF;
            S.init(MTOK, 5632, gridDim.x, opaque_bid()); pg8::gemm_phase(lds, g, S, E);
        }
        PHASE_END();
        convglu_phase((const u16*)(ws + W_GATE), (u16*)(ws + W_VAL), p->in[I_SCONV] + (size_t)l * 128 * 2 * DFF, p->in[I_CW] + (size_t)l * 3 * DFF, p->in[I_CB] + (size_t)l * DFF);
        PHASE_END();
        {
            pg8::Gemm g; g.A = (const u16*)(ws + W_VAL); g.Bt = (const u16*)(ws + W_WDOWN); g.M = MTOK; g.N = 1024; g.K = DFF;
            EpiResid E; E.base = bufB; E.out = bufA;
            S.init(MTOK, 1024, gridDim.x, opaque_bid()); pg8::gemm_phase(lds, g, S, E);
        }
        PHASE_END();
        ln_phase(bufA, xb, p->in[I_LN2G] + l * 1024, p->in[I_LN2B] + l * 1024);
        if (l + 1 < NL) convert_phase(kparams(), l + 1, (float*)smem);
        PHASE_END();
    }
}

extern "C" void kernel_launch(void* const* d_in, const int* in_sizes, int n_in, void* d_out, int out_size, void* d_ws, size_t ws_size, hipStream_t stream) {
    static int grid_blocks = 0;
    if (!grid_blocks) {
        int dev = 0, cus = 0, per_cu = 0;
        (void)hipGetDevice(&dev);
        (void)hipDeviceGetAttribute(&cus, hipDeviceAttributeMultiprocessorCount, dev);
        (void)hipFuncSetAttribute((const void*)mega, hipFuncAttributeMaxDynamicSharedMemorySize, LDS_BYTES);
        (void)hipOccupancyMaxActiveBlocksPerMultiprocessor(&per_cu, (const void*)mega, 512, LDS_BYTES);
        grid_blocks = cus;
        if (n_in != 33 || (size_t)out_size != O_END || ws_size < W_TOTAL) { fprintf(stderr, "kernel_launch: unexpected sizes n_in %d out %d ws %zu (need %zu)\n", n_in, out_size, ws_size, (size_t)W_TOTAL); grid_blocks = -1; }
    }
    if (grid_blocks < 0) return;
    (void)hipMemsetAsync((unsigned char*)d_ws + W_BAR, 0, XCD_BAR_WORDS * sizeof(unsigned), stream);
    Params p{};
    for (int i = 0; i < 33; ++i) p.in[i] = (const float*)d_in[i];
    p.out = (float*)d_out; p.ws = (unsigned char*)d_ws;
    void* args[] = {&p};
    hipError_t e = hipLaunchCooperativeKernel((const void*)mega, dim3(grid_blocks), dim3(512), args, LDS_BYTES, stream);
    if (e != hipSuccess) fprintf(stderr, "cooperative launch failed: %s (grid %d)\n", hipGetErrorString(e), grid_blocks);
}
```

```cpp
#include <hip/hip_runtime.h>
#include <hip/hip_cooperative_groups.h>
#include <cstdio>
namespace cg = cooperative_groups;

#define PG8_LAS __attribute__((address_space(3)))
typedef unsigned short u16;
typedef unsigned int u32;
typedef unsigned short bf16_t;
typedef short bf16x8 __attribute__((ext_vector_type(8)));
typedef float f32x4 __attribute__((ext_vector_type(4)));
typedef float f32x2 __attribute__((ext_vector_type(2)));
typedef unsigned u32x4 __attribute__((ext_vector_type(4)));
typedef unsigned u32x2 __attribute__((ext_vector_type(2)));

constexpr int MTOK = 16896, MP = 16384, DM = 1024, NL = 4;
constexpr int SHIFT_W = 1792, INP = 3584, DFF = 2816;
constexpr float ALPHA = 1.6817928305074290f;
constexpr float GN_EPS_A = 64e-5f, RMS_EPS = 1e-5f, LN_EPS = 1e-5f;
constexpr int LDS_BYTES = 139264 + 16;
constexpr int TC = 32;
#define SC_PD 3

enum { I_XP = 0, I_XS, I_SRWKV, I_SSHIFT, I_SGLA, I_SCONV, I_WIN, I_MU, I_W0, I_WLU, I_A0, I_ALU, I_GLU, I_KK, I_KA, I_RK, I_LNXG, I_LNXB,
       I_VB, I_VD, I_VU, I_FUP, I_FB, I_NG, I_WOUT, I_LN1G, I_LN1B, I_WUP, I_CW, I_CB, I_WDOWN, I_LN2G, I_LN2B };

constexpr size_t O_Y = 0;
constexpr size_t O_RWKV_P = (size_t)MTOK * DM;
constexpr size_t O_RWKV_S = O_RWKV_P + (size_t)4 * 8 * 8 * 4096;
constexpr size_t O_SHIFT_P = O_RWKV_S + (size_t)4 * 128 * 8 * 4096;
constexpr size_t O_SHIFT_S = O_SHIFT_P + (size_t)4 * 8 * 1792;
constexpr size_t O_GLA_P = O_SHIFT_S + (size_t)4 * 128 * 1792;
constexpr size_t O_GLA_S = O_GLA_P + (size_t)4 * 8 * 4 * 8192;
constexpr size_t O_CONV_P = O_GLA_S + (size_t)4 * 128 * 4 * 8192;
constexpr size_t O_CONV_S = O_CONV_P + (size_t)4 * 8 * 2 * 2816;
constexpr size_t O_END = O_CONV_S + (size_t)4 * 128 * 2 * 2816;

constexpr size_t W_WIN = 0;
constexpr size_t W_WOUT = W_WIN + (size_t)INP * 1024 * 2;
constexpr size_t W_WUP = W_WOUT + (size_t)1024 * 1024 * 2;
constexpr size_t W_WDOWN = W_WUP + (size_t)5632 * 1024 * 2;
constexpr size_t W_WLT = W_WDOWN + (size_t)1024 * 2816 * 2;
constexpr size_t W_ALT = W_WLT + 512 * 64 * 2;
constexpr size_t W_GLT = W_ALT + 512 * 64 * 2;
constexpr size_t W_V1T = W_GLT + 512 * 128 * 2;
constexpr size_t W_V2T = W_V1T + 32 * 512 * 2;
constexpr size_t W_FT = W_V2T + 512 * 32 * 2;
constexpr size_t W_XB = W_FT + 256 * 32 * 2;
constexpr size_t W_VFIRST = W_XB + (size_t)MTOK * 1024 * 2;
constexpr size_t W_BUFB = W_VFIRST + (size_t)MTOK * 512 * 2;
constexpr size_t W_R = W_BUFB + (size_t)MTOK * 1024 * 4;
constexpr size_t W_PROJA = W_R;
constexpr size_t W_PROJB = W_PROJA + (size_t)MTOK * 1792 * 2;
constexpr size_t W_D8 = W_PROJB + (size_t)MTOK * 1792 * 2;
constexpr size_t W_VBUF = W_D8 + (size_t)MTOK * 512 * 4;
constexpr size_t W_GBUF = W_VBUF + (size_t)MTOK * 512 * 2;
constexpr size_t W_DEC = W_GBUF + (size_t)MTOK * 512 * 2;
constexpr size_t W_RK = W_DEC + (size_t)MTOK * 256 * 4;
constexpr size_t W_END1 = W_RK + (size_t)MTOK * 8 * 4;
constexpr size_t W_GATE = W_R;
constexpr size_t W_VAL = W_GATE + (size_t)MTOK * 2816 * 2;
constexpr size_t W_END2 = W_VAL + (size_t)MTOK * 2816 * 2;
constexpr size_t W_END = W_END1 > W_END2 ? W_END1 : W_END2;
constexpr size_t W_BAR = (W_END + 255) / 256 * 256;
constexpr size_t W_TOTAL = W_BAR + 16384;
constexpr size_t W_OBUFA = W_PROJA;
constexpr size_t W_OBUFB = W_PROJA + (size_t)MTOK * 512 * 2;

struct Params { const float* in[33]; float* out; unsigned char* ws; };
typedef const Params __attribute__((address_space(4)))* KP;
__device__ __forceinline__ KP kparams() { unsigned long long k = (unsigned long long)__builtin_amdgcn_kernarg_segment_ptr(); asm volatile("" : "+s"(k)); return (KP)k; }

typedef __bf16 bf16v2 __attribute__((ext_vector_type(2)));
__device__ __forceinline__ unsigned cvt_pk_bf16(float lo, float hi) { const f32x2 v = (f32x2){lo, hi}; const bf16v2 b = __builtin_convertvector(v, bf16v2); return __builtin_bit_cast(unsigned, b); }
__device__ __forceinline__ float bflo(u32 w) { return __uint_as_float(w << 16); }
__device__ __forceinline__ float bfhi(u32 w) { return __uint_as_float(w & 0xffff0000u); }
__device__ __forceinline__ f32x4 ld_bf4(const u16* p) { const u32x2 w = *(const u32x2*)p; return (f32x4){bflo(w.x), bfhi(w.x), bflo(w.y), bfhi(w.y)}; }
__device__ __forceinline__ unsigned cvt_pk_bf16_asm(float lo, float hi) { unsigned r; asm volatile("v_cvt_pk_bf16_f32 %0, %1, %2" : "=v"(r) : "v"(lo), "v"(hi)); return r; }
__device__ __forceinline__ void st_bf4_asm(u16* p, f32x4 v) { u32x2 w; w.x = cvt_pk_bf16_asm(v[0], v[1]); w.y = cvt_pk_bf16_asm(v[2], v[3]); *(u32x2*)p = w; }
__device__ __forceinline__ void st_bf4(u16* p, f32x4 v) { u32x2 w; w.x = cvt_pk_bf16(v[0], v[1]); w.y = cvt_pk_bf16(v[2], v[3]); *(u32x2*)p = w; }
__device__ __forceinline__ float sigmoidf_(float x) { return __builtin_amdgcn_rcpf(1.0f + __expf(-x)); }
__device__ __forceinline__ float tanhf_(float x) { return 1.0f - 2.0f * __builtin_amdgcn_rcpf(1.0f + __expf(2.0f * x)); }
__device__ __forceinline__ float softplusf_(float x) { return fmaxf(x, 0.f) + __logf(1.0f + __expf(-fabsf(x))); }
template <int CTRL> __device__ __forceinline__ float dppf(float x) { return __builtin_bit_cast(float, __builtin_amdgcn_update_dpp(0, __builtin_bit_cast(int, x), CTRL, 0xF, 0xF, true)); }
__device__ __forceinline__ float red16(float x) { x += dppf<0xB1>(x); x += dppf<0x4E>(x); x += dppf<0x141>(x); x += dppf<0x140>(x); return x; }

__device__ __forceinline__ int opaque_tid() { int t = threadIdx.x; asm volatile("" : "+v"(t)); return t; }
__device__ __forceinline__ int opaque_bid() { int b = blockIdx.x; asm volatile("" : "+s"(b)); return b; }

namespace pg8 {
constexpr int BM = 256, BK = 64, HALF = 128, HTB = HALF * BK * 2, STAGE_BYTES = 8 * HTB, NXCD = 8, WGM = 8;
__host__ __device__ __forceinline__ int lds_byte(int r, int c) { const int st = (r >> 4) * 2 + (c >> 5), rr = r & 15, cc = c & 31, ob = rr * 64 + cc * 2; return st * 1024 + (ob ^ (((ob >> 9) & 1) << 5)); }
__host__ __device__ __forceinline__ void stage_rc(int b, int& R, int& C) { const int st = b / 1024, sb = b % 1024, swz = sb ^ (((sb >> 9) & 1) << 5); R = (st >> 1) * 16 + swz / 64; C = (st & 1) * 32 + (swz % 64) / 2; }
struct Unit { int pm, pn; };
struct Gemm { const bf16_t* A; const bf16_t* Bt; int M, N, K; };
struct StaticOrder {
    int nM, nN, nwg, G, c;
    __host__ __device__ void init(int M, int N, int G_, int c_) { nM = M / BM; nN = N / BM; nwg = nM * nN; G = G_; c = c_; }
    __host__ __device__ bool next(int i, Unit& u) const {
        const long L = (long)i * G + c; if (L >= nwg) return false;
        int wgid = (int)L; { const int q = nwg / NXCD, r = nwg % NXCD, xcd = wgid % NXCD, off = wgid / NXCD; wgid = (xcd < r ? xcd * (q + 1) : r * (q + 1) + (xcd - r) * q) + off; }
        const int nig = WGM * nN, gid = wgid / nig, fm = gid * WGM, gsz = (nM - fm) < WGM ? (nM - fm) : WGM;
        u.pm = fm + ((wgid % nig) % gsz); u.pn = (wgid % nig) / gsz; return true;
    }
};

template <class Epi>
__device__ __forceinline__ void gemm_phase(PG8_LAS unsigned char* lds, const Gemm g, const StaticOrder& S, const Epi& E) {
    const int tid = opaque_tid(), wid = __builtin_amdgcn_readfirstlane(tid >> 6), lane = tid & 63, wr = wid >> 2, wc = wid & 3, fr = lane & 15, fq = lane >> 4;
    const int K = g.K, nt = K / BK;
    unsigned voffA[2], voffB[2];
#pragma unroll
    for (int i = 0; i < 2; ++i) { int R, C; stage_rc(tid * 16 + i * 8192, R, C); voffA[i] = (unsigned)(R * K + C) * 2u; voffB[i] = voffA[i]; }
    const size_t kstep = (size_t)(BK * 2);
    const size_t hstep = (size_t)HALF * K * 2;
    const size_t tstep = 2 * hstep;
    const unsigned ldsw = (unsigned)wid * 1024u;
    const int aoff = lds_byte(wr * 64 + fr, fq * 8), boff = lds_byte(wc * 32 + fr, fq * 8);
#define PG8_SA(b, h) (((b) * 2 + (h)) * HTB)
#define PG8_SB(b, h) ((4 + (b) * 2 + (h)) * HTB)
#define PG8_STAGE(bufoff, gbase, voff) do { _Pragma("unroll") for (int _i = 0; _i < 2; ++_i) \
        __builtin_amdgcn_global_load_lds((const unsigned*)((const char*)(gbase) + (voff)[_i]), (PG8_LAS unsigned*)(lds + (bufoff) + ldsw + _i * 8192), 16, 0, 0); } while (0)
#define PG8_LDA(dst, b, h) do { _Pragma("unroll") for (int m = 0; m < 4; ++m) _Pragma("unroll") for (int k = 0; k < 2; ++k) dst[m][k] = *(const PG8_LAS bf16x8*)(lds + PG8_SA(b, h) + aoff + m * 2048 + k * 1024); } while (0)
#define PG8_LDB(dst, b, h) do { _Pragma("unroll") for (int n = 0; n < 2; ++n) _Pragma("unroll") for (int k = 0; k < 2; ++k) dst[n][k] = *(const PG8_LAS bf16x8*)(lds + PG8_SB(b, h) + boff + n * 2048 + k * 1024); } while (0)
#define PG8_MMA(ai, bj, At, Bt) do { __builtin_amdgcn_s_setprio(1); _Pragma("unroll") for (int m = 0; m < 4; ++m) _Pragma("unroll") for (int n = 0; n < 2; ++n) _Pragma("unroll") for (int k = 0; k < 2; ++k) \
        acc[ai][bj][m][n] = __builtin_amdgcn_mfma_f32_16x16x32_bf16(Bt[n][k], At[m][k], acc[ai][bj][m][n], 0, 0, 0); __builtin_amdgcn_s_setprio(0); } while (0)
#define PG8_WAIT_V(n) asm volatile("s_waitcnt vmcnt(" #n ")" ::: "memory")
#define PG8_WAIT_L(n) asm volatile("s_waitcnt lgkmcnt(" #n ")" ::: "memory")
#define PG8_BAR __builtin_amdgcn_s_barrier()
#define PG8_SCHED __builtin_amdgcn_sched_barrier(0)
    Unit cur, nxt; int ui = 0;
    if (!S.next(0, cur)) return;
    f32x4 acc[2][2][4][2];
#pragma unroll
    for (int a = 0; a < 2; ++a)
#pragma unroll
        for (int b = 0; b < 2; ++b)
#pragma unroll
            for (int m = 0; m < 4; ++m)
#pragma unroll
                for (int n = 0; n < 2; ++n) acc[a][b][m][n] = (f32x4){0.f, 0.f, 0.f, 0.f};
    bf16x8 At[4][2], B0[2][2], B1[2][2];
    const char* cA = (const char*)g.A + (size_t)cur.pm * tstep; const char* cB = (const char*)g.Bt + (size_t)cur.pn * tstep;
    PG8_STAGE(PG8_SB(0, 0), cB, voffB); PG8_STAGE(PG8_SA(0, 0), cA, voffA); PG8_STAGE(PG8_SB(0, 1), cB + hstep, voffB); PG8_STAGE(PG8_SA(0, 1), cA + hstep, voffA);
    if (wr == 1) PG8_BAR;
    PG8_WAIT_V(4); PG8_BAR;
    PG8_STAGE(PG8_SB(1, 0), cB + kstep, voffB); PG8_STAGE(PG8_SA(1, 0), cA + kstep, voffA); PG8_STAGE(PG8_SB(1, 1), cB + hstep + kstep, voffB);
    PG8_WAIT_V(6); PG8_BAR;
    for (;;) {
        const bool has_next = S.next(ui + 1, nxt);
        const char* nA = has_next ? (const char*)g.A + (size_t)nxt.pm * tstep : cA; const char* nB = has_next ? (const char*)g.Bt + (size_t)nxt.pn * tstep : cB;
        for (int t = 0; t < nt; t += 2) {
            const bool last = (t == nt - 2);
            const char* a1 = cA + (size_t)(t + 1) * kstep;
            const char* a2 = last ? nA : cA + (size_t)(t + 2) * kstep; const char* b2 = last ? nB : cB + (size_t)(t + 2) * kstep;
            const char* a3 = a2 + kstep; const char* b3 = b2 + kstep;
            PG8_LDB(B0, 0, 0); PG8_SCHED; PG8_LDA(At, 0, 0); PG8_STAGE(PG8_SA(1, 1), a1 + hstep, voffA);
            PG8_WAIT_L(8); PG8_BAR; PG8_WAIT_L(0); PG8_MMA(0, 0, At, B0); PG8_BAR; PG8_SCHED;
            PG8_LDB(B1, 0, 1); PG8_STAGE(PG8_SB(0, 0), b2, voffB);
            PG8_BAR; PG8_WAIT_L(0); PG8_MMA(0, 1, At, B1); PG8_BAR;
            PG8_LDA(At, 0, 1); PG8_STAGE(PG8_SA(0, 0), a2, voffA);
            PG8_BAR; PG8_WAIT_L(0); PG8_MMA(1, 0, At, B0); PG8_BAR; PG8_SCHED;
            PG8_STAGE(PG8_SB(0, 1), b2 + hstep, voffB);
            PG8_WAIT_V(6); PG8_BAR; PG8_MMA(1, 1, At, B1); PG8_BAR;
            PG8_LDB(B0, 1, 0); PG8_SCHED; PG8_LDA(At, 1, 0); PG8_STAGE(PG8_SA(0, 1), a2 + hstep, voffA);
            PG8_WAIT_L(8); PG8_BAR; PG8_WAIT_L(0); PG8_MMA(0, 0, At, B0); PG8_BAR; PG8_SCHED;
            PG8_LDB(B1, 1, 1); PG8_STAGE(PG8_SB(1, 0), b3, voffB);
            PG8_BAR; PG8_WAIT_L(0); PG8_MMA(0, 1, At, B1); PG8_BAR;
            PG8_LDA(At, 1, 1); PG8_STAGE(PG8_SA(1, 0), a3, voffA);
            PG8_BAR; PG8_WAIT_L(0); PG8_MMA(1, 0, At, B0); PG8_BAR; PG8_SCHED;
            PG8_STAGE(PG8_SB(1, 1), b3 + hstep, voffB);
            PG8_WAIT_V(6); PG8_BAR; PG8_MMA(1, 1, At, B1); PG8_BAR;
        }
        asm volatile("s_nop 7\n\ts_nop 7\n\ts_nop 7" ::: "memory");
        E(acc, cur, wr, wc, fr, fq);
        if (!has_next) break;
#pragma unroll
        for (int a = 0; a < 2; ++a)
#pragma unroll
            for (int b = 0; b < 2; ++b)
#pragma unroll
                for (int m = 0; m < 4; ++m)
#pragma unroll
                    for (int n = 0; n < 2; ++n) acc[a][b][m][n] = (f32x4){0.f, 0.f, 0.f, 0.f};
        cur = nxt; cA = nA; cB = nB; ++ui;
    }
    PG8_WAIT_V(0);
    if (wr == 0) PG8_BAR;
    PG8_BAR;
#undef PG8_SA
#undef PG8_SB
#undef PG8_STAGE
#undef PG8_LDA
#undef PG8_LDB
#undef PG8_MMA
#undef PG8_WAIT_V
#undef PG8_WAIT_L
#undef PG8_BAR
#undef PG8_SCHED
}
}
using pg8::Unit;

struct EpiProj {
    u16* projA; u16* projB; float* shift_p; float* shift_s;
    __device__ __forceinline__ void operator()(const f32x4 (&acc)[2][2][4][2], const Unit& u, int wr, int wc, int fr, int fq) const {
        const int row0 = u.pm * 256 + wr * 64 + fr;
        const bool isA = u.pn < 7;
        u16* base = isA ? projA : projB;
        const int colt = (isA ? u.pn : u.pn - 7) * 256 + wc * 32 + 4 * fq;
#pragma unroll
        for (int ai = 0; ai < 2; ++ai)
#pragma unroll
            for (int m = 0; m < 4; ++m) {
                const int row = row0 + ai * 128 + m * 16;
                u16* rowp = base + (size_t)row * 1792 + colt;
#pragma unroll
                for (int bj = 0; bj < 2; ++bj)
#pragma unroll
                    for (int n = 0; n < 2; ++n) st_bf4_asm(rowp + bj * 128 + n * 16, acc[ai][bj][m][n]);
                if (isA) {
                    float* dst = nullptr;
                    if (row < MP) { if ((row & 2047) == 2047) dst = shift_p + (size_t)(row >> 11) * 1792; }
                    else { const int r = row - MP; if ((r & 3) == 3) dst = shift_s + (size_t)(r >> 2) * 1792; }
                    if (dst) {
#pragma unroll
                        for (int bj = 0; bj < 2; ++bj)
#pragma unroll
                            for (int n = 0; n < 2; ++n) *(f32x4*)(dst + colt + bj * 128 + n * 16) = acc[ai][bj][m][n];
                    }
                }
            }
    }
};
struct EpiResid {
    const float* base; float* out;
    __device__ __forceinline__ void operator()(const f32x4 (&acc)[2][2][4][2], const Unit& u, int wr, int wc, int fr, int fq) const {
        const int row0 = u.pm * 256 + wr * 64 + fr, col0 = u.pn * 256 + wc * 32 + 4 * fq;
#pragma unroll
        for (int ai = 0; ai < 2; ++ai)
#pragma unroll
            for (int m = 0; m < 4; ++m) {
                const size_t off = (size_t)(row0 + ai * 128 + m * 16) * 1024 + col0;
#pragma unroll
                for (int bj = 0; bj < 2; ++bj)
#pragma unroll
                    for (int n = 0; n < 2; ++n) { const f32x4 b = *(const f32x4*)(base + off + bj * 128 + n * 16); *(f32x4*)(out + off + bj * 128 + n * 16) = b * ALPHA + acc[ai][bj][m][n]; }
            }
    }
};
struct EpiUp {
    u16* gate; u16* val; float* conv_p; float* conv_s;
    __device__ __forceinline__ void operator()(const f32x4 (&acc)[2][2][4][2], const Unit& u, int wr, int wc, int fr, int fq) const {
        const int row0 = u.pm * 256 + wr * 64 + fr;
        const bool isG = u.pn < 11;
        u16* base = isG ? gate : val;
        const int colt = (isG ? u.pn : u.pn - 11) * 256 + wc * 32 + 4 * fq;
#pragma unroll
        for (int ai = 0; ai < 2; ++ai)
#pragma unroll
            for (int m = 0; m < 4; ++m) {
                const int row = row0 + ai * 128 + m * 16;
                u16* rowp = base + (size_t)row * DFF + colt;
#pragma unroll
                for (int bj = 0; bj < 2; ++bj)
#pragma unroll
                    for (int n = 0; n < 2; ++n) st_bf4_asm(rowp + bj * 128 + n * 16, acc[ai][bj][m][n]);
                if (isG) {
                    float* dst = nullptr;
                    if (row < MP) { const int t = row & 2047; if (t >= 2046) dst = conv_p + (size_t)((row >> 11) * 2 + (t - 2046)) * DFF; }
                    else { const int r = row - MP, t = r & 3; if (t >= 2) dst = conv_s + (size_t)((r >> 2) * 2 + (t - 2)) * DFF; }
                    if (dst) {
#pragma unroll
                        for (int bj = 0; bj < 2; ++bj)
#pragma unroll
                            for (int n = 0; n < 2; ++n) *(f32x4*)(dst + colt + bj * 128 + n * 16) = acc[ai][bj][m][n];
                    }
                }
            }
    }
};

__device__ __forceinline__ void transpose_tile(const float* __restrict__ src, u16* __restrict__ dst, int K, int N, int nT, int item, float* tile) {
    const int t = opaque_tid();
    const int kt = item / nT, ntile = item - kt * nT, k0 = kt * 64, n0 = ntile * 64;
    { const int row = t >> 3, c8 = (t & 7) * 8;
      f32x4 a = (f32x4){0.f, 0.f, 0.f, 0.f}, b = a;
      if (n0 + c8 < N) { const float* sp = src + (size_t)(k0 + row) * N + n0 + c8; a = *(const f32x4*)sp; b = *(const f32x4*)(sp + 4); }
      float* tp = tile + row * 65 + c8;
      tp[0] = a[0]; tp[1] = a[1]; tp[2] = a[2]; tp[3] = a[3]; tp[4] = b[0]; tp[5] = b[1]; tp[6] = b[2]; tp[7] = b[3]; }
    __syncthreads();
    { const int n = t >> 3, k8 = (t & 7) * 8;
      float v[8];
#pragma unroll
      for (int j = 0; j < 8; ++j) v[j] = tile[(k8 + j) * 65 + n];
      u32x4 w; w.x = cvt_pk_bf16(v[0], v[1]); w.y = cvt_pk_bf16(v[2], v[3]); w.z = cvt_pk_bf16(v[4], v[5]); w.w = cvt_pk_bf16(v[6], v[7]);
      *(u32x4*)(dst + (size_t)(n0 + n) * K + k0 + k8) = w; }
    __syncthreads();
}
__device__ __forceinline__ void small_transpose(const float* __restrict__ src, u16* __restrict__ dst, int K, int N, int Kpad, size_t gt, size_t nth) {
    for (size_t i = gt; i < (size_t)N * Kpad; i += nth) { const int n = (int)(i / Kpad), k = (int)(i - (size_t)n * Kpad); const float v = k < K ? src[(size_t)k * N + n] : 0.f; dst[i] = (u16)(cvt_pk_bf16(v, 0.f) & 0xffffu); }
}
__device__ void convert_phase(KP p, int l, float* tile) {
    unsigned char* ws = p->ws;
    const int bid = opaque_bid();
    const size_t gt = (size_t)bid * 512 + opaque_tid(), nth = (size_t)gridDim.x * 512;
    constexpr int n1 = 16 * 56, n2 = 16 * 16, n3 = 16 * 88, n4 = 44 * 16;
    for (int it = bid; it < n1 + n2 + n3 + n4; it += gridDim.x) {
        if (it < n1) transpose_tile(p->in[I_WIN] + (size_t)l * 1024 * 3344, (u16*)(ws + W_WIN), 1024, 3344, 56, it, tile);
        else if (it < n1 + n2) transpose_tile(p->in[I_WOUT] + (size_t)l * 1024 * 1024, (u16*)(ws + W_WOUT), 1024, 1024, 16, it - n1, tile);
        else if (it < n1 + n2 + n3) transpose_tile(p->in[I_WUP] + (size_t)l * 1024 * 5632, (u16*)(ws + W_WUP), 1024, 5632, 88, it - n1 - n2, tile);
        else transpose_tile(p->in[I_WDOWN] + (size_t)l * 2816 * 1024, (u16*)(ws + W_WDOWN), 2816, 1024, 16, it - n1 - n2 - n3, tile);
    }
    small_transpose(p->in[I_WLU] + (size_t)l * 64 * 512, (u16*)(ws + W_WLT), 64, 512, 64, gt, nth);
    small_transpose(p->in[I_ALU] + (size_t)l * 64 * 512, (u16*)(ws + W_ALT), 64, 512, 64, gt, nth);
    small_transpose(p->in[I_GLU] + (size_t)l * 128 * 512, (u16*)(ws + W_GLT), 128, 512, 128, gt, nth);
    if (l > 0) {
        small_transpose(p->in[I_VD] + (size_t)(l - 1) * 512 * 32, (u16*)(ws + W_V1T), 512, 32, 512, gt, nth);
        small_transpose(p->in[I_VU] + (size_t)(l - 1) * 32 * 512, (u16*)(ws + W_V2T), 32, 512, 32, gt, nth);
    }
    small_transpose(p->in[I_FUP] + (size_t)l * 16 * 256, (u16*)(ws + W_FT), 16, 256, 32, gt, nth);
    if (l == 0) {
        float* xa = p->out + O_Y; u16* xb = (u16*)(ws + W_XB);
        for (size_t i = gt; i < (size_t)MTOK * 256; i += nth) {
            const size_t e = i * 4;
            const f32x4 v = e < (size_t)MP * 1024 ? *(const f32x4*)(p->in[I_XP] + e) : *(const f32x4*)(p->in[I_XS] + (e - (size_t)MP * 1024));
            *(f32x4*)(xa + e) = v; st_bf4(xb + e, v);
        }
    }
}

__device__ void ln_phase(float* Y, u16* xb, const float* __restrict__ g, const float* __restrict__ b) {
    const int tt_ = opaque_tid();
    const int lane = tt_ & 63, gw = opaque_bid() * 8 + (tt_ >> 6), nw = gridDim.x * 8;
    f32x4 gv[4], bv[4];
#pragma unroll
    for (int i = 0; i < 4; ++i) { gv[i] = *(const f32x4*)(g + i * 256 + lane * 4); bv[i] = *(const f32x4*)(b + i * 256 + lane * 4); }
    for (int row = gw; row < MTOK; row += nw) {
        float* yp = Y + (size_t)row * 1024 + lane * 4;
        f32x4 v[4]; float s = 0.f;
#pragma unroll
        for (int i = 0; i < 4; ++i) { v[i] = *(const f32x4*)(yp + i * 256); s += (v[i][0] + v[i][1]) + (v[i][2] + v[i][3]); }
#pragma unroll
        for (int o = 32; o >= 1; o >>= 1) s += __shfl_xor(s, o);
        const float mu = s * (1.0f / 1024.0f); float q = 0.f;
#pragma unroll
        for (int i = 0; i < 4; ++i) { const f32x4 d = v[i] - mu; q += (d[0] * d[0] + d[1] * d[1]) + (d[2] * d[2] + d[3] * d[3]); }
#pragma unroll
        for (int o = 32; o >= 1; o >>= 1) q += __shfl_xor(q, o);
        const float rstd = rsqrtf(q * (1.0f / 1024.0f) + LN_EPS);
#pragma unroll
        for (int i = 0; i < 4; ++i) { const f32x4 o = (v[i] - mu) * rstd * gv[i] + bv[i]; *(f32x4*)(yp + i * 256) = o; st_bf4(xb + (size_t)row * 1024 + i * 256 + lane * 4, o); }
    }
}

__device__ __forceinline__ void unpack8(const u32x4 w, float* f) { f[0] = bflo(w.x); f[1] = bfhi(w.x); f[2] = bflo(w.y); f[3] = bfhi(w.y); f[4] = bflo(w.z); f[5] = bfhi(w.z); f[6] = bflo(w.w); f[7] = bfhi(w.w); }
__device__ __forceinline__ float gelu_as(float v) {
    const float av = fabsf(v), t = __builtin_amdgcn_rcpf(av * 0.2316418882f + 1.0f);
    float q = t * 0.5307027145f + (-0.7265760135f); q = q * t + 0.7107068705f; q = q * t + (-0.142248368f); q = q * t + 0.127414796f; q = q * t;
    const float e = __builtin_amdgcn_exp2f((v * v) * (-0.72134752044f));
    const float m = v * (q * e);
    return v < 0.f ? m : v - m;
}
__device__ void convglu_phase(const u16* __restrict__ gate, u16* val, const float* __restrict__ past  , const float* __restrict__ cw, const float* __restrict__ cb) {
    const size_t gt = (size_t)opaque_bid() * 512 + opaque_tid(), nth = (size_t)gridDim.x * 512;
    for (size_t idx = gt; idx < (size_t)(MTOK / 4) * 352; idx += nth) {
        const int rg = (int)(idx / 352), c = (int)(idx - (size_t)rg * 352) * 8, row0 = rg * 4;
        bool first; const float* pst = nullptr;
        if (row0 < MP) first = (row0 & 2047) == 0; else { first = true; pst = past + (size_t)((row0 - MP) >> 2) * 2 * DFF; }
        float w0[8], w1[8], w2[8], bb[8], gm2[8], gm1[8];
#pragma unroll
        for (int j = 0; j < 8; ++j) { w0[j] = cw[c + j]; w1[j] = cw[DFF + c + j]; w2[j] = cw[2 * DFF + c + j]; bb[j] = cb[c + j]; }
        if (!first) { unpack8(*(const u32x4*)(gate + (size_t)(row0 - 2) * DFF + c), gm2); unpack8(*(const u32x4*)(gate + (size_t)(row0 - 1) * DFF + c), gm1); }
        else {
#pragma unroll
            for (int j = 0; j < 8; ++j) { gm2[j] = pst ? pst[c + j] : 0.f; gm1[j] = pst ? pst[DFF + c + j] : 0.f; } }
#pragma unroll
        for (int r = 0; r < 4; ++r) {
            float g0[8], vv[8], h[8];
            unpack8(*(const u32x4*)(gate + (size_t)(row0 + r) * DFF + c), g0);
            unpack8(*(const u32x4*)(val + (size_t)(row0 + r) * DFF + c), vv);
#pragma unroll
            for (int j = 0; j < 8; ++j) { const float a = bb[j] + gm2[j] * w0[j] + gm1[j] * w1[j] + g0[j] * w2[j]; h[j] = gelu_as(a) * vv[j]; gm2[j] = gm1[j]; gm1[j] = g0[j]; }
            u32x4 w; w.x = cvt_pk_bf16(h[0], h[1]); w.y = cvt_pk_bf16(h[2], h[3]); w.z = cvt_pk_bf16(h[4], h[5]); w.w = cvt_pk_bf16(h[6], h[7]);
            *(u32x4*)(val + (size_t)(row0 + r) * DFF + c) = w;
        }
    }
}

struct PrepCtx {
    const u16* projA; const u16* projB; const float* mu; const float* sshift  ;
};
__device__ __forceinline__ f32x4 xs4(const PrepCtx& c, int i, int col) {
    const f32x4 cur = ld_bf4(c.projA + (size_t)i * 1792 + col);
    f32x4 prev;
    bool first; int b = 0;
    if (i < MP) first = (i & 2047) == 0; else { const int r = i - MP; first = (r & 3) == 0; b = r >> 2; }
    if (!first) prev = ld_bf4(c.projA + (size_t)(i - 1) * 1792 + col);
    else if (i < MP) prev = (f32x4){0.f, 0.f, 0.f, 0.f};
    else prev = *(const f32x4*)(c.sshift + (size_t)b * 1792 + col);
    const f32x4 m = *(const f32x4*)(c.mu + col);
    return cur + (prev - cur) * m;
}
__device__ __forceinline__ bf16x8 ldg_frag(const u16* p) { return *(const bf16x8*)p; }

__device__ void prep_phase(KP p, int l, PG8_LAS unsigned char* lds) {
    unsigned char* ws = p->ws;
    PrepCtx c; c.projA = (const u16*)(ws + W_PROJA); c.projB = (const u16*)(ws + W_PROJB); c.mu = p->in[I_MU] + (size_t)l * 1792; c.sshift = p->in[I_SSHIFT] + (size_t)l * 128 * 1792;
    const u16* wlT = (const u16*)(ws + W_WLT); const u16* alT = (const u16*)(ws + W_ALT); const u16* glT = (const u16*)(ws + W_GLT);
    const u16* v1T = (const u16*)(ws + W_V1T); const u16* v2T = (const u16*)(ws + W_V2T); const u16* fT = (const u16*)(ws + W_FT);
    u32x4* A16 = (u32x4*)(ws + W_BUFB); float* D8 = (float*)(ws + W_D8); u16* vbuf = (u16*)(ws + W_VBUF); u16* gbuf = (u16*)(ws + W_GBUF);
    float* decb = (float*)(ws + W_DEC); float* rkb = (float*)(ws + W_RK); u16* vfirst = (u16*)(ws + W_VFIRST);
    const float* w0 = p->in[I_W0] + l * 512; const float* a0 = p->in[I_A0] + l * 512; const float* k_k = p->in[I_KK] + l * 512; const float* k_a = p->in[I_KA] + l * 512;
    const float* r_k = p->in[I_RK] + l * 512; const float* vb = l > 0 ? p->in[I_VB] + (l - 1) * 512 : nullptr; const float* fbias = p->in[I_FB] + l * 256;
    constexpr int S_TW = 144, S_AL = 144, S_SG = 272, S_XV = 1040, S_FL = 80, S_PP = 80;
    constexpr int O_TW = 0, O_AL = O_TW + 16 * S_TW, O_SG = O_AL + 16 * S_AL, O_XV = O_SG + 16 * S_SG, O_FL = O_XV + 16 * S_XV, O_PP = O_FL + 16 * S_FL;
    const int t = opaque_tid(), wid = t >> 6, lane = t & 63, fr = lane & 15, fq = lane >> 4, h = wid;
    for (int blk = opaque_bid(); blk < MTOK / 16; blk += gridDim.x) {
        const int i0 = blk * 16;
#pragma unroll 1
        for (int q = 0; q < 6; ++q) {
            const int op = t + 512 * q, r = op / 192, g4 = op - r * 192, col = 1024 + 4 * g4;
            f32x4 x = xs4(c, i0 + r, col);
            int off;
            if (col < 1536) off = O_XV + r * S_XV + (col - 1024) * 2;
            else if (col < 1600) { off = O_TW + r * S_TW + (col - 1536) * 2; x = (f32x4){tanhf_(x[0]), tanhf_(x[1]), tanhf_(x[2]), tanhf_(x[3])}; }
            else if (col < 1664) off = O_AL + r * S_AL + (col - 1600) * 2;
            else { off = O_SG + r * S_SG + (col - 1664) * 2; x = (f32x4){sigmoidf_(x[0]), sigmoidf_(x[1]), sigmoidf_(x[2]), sigmoidf_(x[3])}; }
            u32x2 w; w.x = cvt_pk_bf16(x[0], x[1]); w.y = cvt_pk_bf16(x[2], x[3]);
            *(PG8_LAS u32x2*)(lds + off) = w;
        }
        if (t < 128) { const int r = t >> 3, c4 = (t & 7) * 4; u32x2 w = (u32x2){0u, 0u}; if (c4 < 16) w = *(const u32x2*)(c.projB + (size_t)(i0 + r) * 1792 + 1536 + c4); *(PG8_LAS u32x2*)(lds + O_FL + r * S_FL + c4 * 2) = w; }
        __syncthreads();
        bf16x8 pfrag = (bf16x8){0, 0, 0, 0, 0, 0, 0, 0};
        if (l > 0) {
            f32x4 accP0 = (f32x4){0.f, 0.f, 0.f, 0.f}, accP1 = accP0;
#pragma unroll 4
            for (int ks = 0; ks < 16; ++ks) {
                const bf16x8 af = *(const PG8_LAS bf16x8*)(lds + O_XV + fr * S_XV + (ks * 32 + fq * 8) * 2);
                accP0 = __builtin_amdgcn_mfma_f32_16x16x32_bf16(ldg_frag(v1T + (size_t)fr * 512 + ks * 32 + fq * 8), af, accP0, 0, 0, 0);
                accP1 = __builtin_amdgcn_mfma_f32_16x16x32_bf16(ldg_frag(v1T + (size_t)(16 + fr) * 512 + ks * 32 + fq * 8), af, accP1, 0, 0, 0);
            }
            const u32 w0_ = cvt_pk_bf16(accP0[0], accP0[1]), w1_ = cvt_pk_bf16(accP0[2], accP0[3]), w2_ = cvt_pk_bf16(accP1[0], accP1[1]), w3_ = cvt_pk_bf16(accP1[2], accP1[3]);
            const u32x4 pw = (u32x4){w0_, w1_, w2_, w3_};
            pfrag = __builtin_bit_cast(bf16x8, pw);
        }
        const int i = i0 + fr;
        float ss = 0.f;
#pragma unroll
        for (int n = 0; n < 4; ++n) { const int cb_ = h * 64 + 16 * n + 4 * fq; const f32x4 xk = xs4(c, i, 512 + cb_) * *(const f32x4*)(k_k + cb_); ss += (xk[0] * xk[0] + xk[1] * xk[1]) + (xk[2] * xk[2] + xk[3] * xk[3]); }
        ss += __shfl_xor(ss, 16); ss += __shfl_xor(ss, 32);
        const float inorm = rsqrtf(fmaxf(ss, 1e-24f));
        float rks = 0.f;
#pragma unroll 2
        for (int n = 0; n < 4; ++n) {
            const int cn = h * 64 + 16 * n, cb_ = cn + 4 * fq;
            f32x4 aW = (f32x4){0.f, 0.f, 0.f, 0.f}, aA = aW, aG = aW, aV = aW;
#pragma unroll
            for (int ks = 0; ks < 2; ++ks) {
                aW = __builtin_amdgcn_mfma_f32_16x16x32_bf16(ldg_frag(wlT + (size_t)(cn + fr) * 64 + ks * 32 + fq * 8), *(const PG8_LAS bf16x8*)(lds + O_TW + fr * S_TW + (ks * 32 + fq * 8) * 2), aW, 0, 0, 0);
                aA = __builtin_amdgcn_mfma_f32_16x16x32_bf16(ldg_frag(alT + (size_t)(cn + fr) * 64 + ks * 32 + fq * 8), *(const PG8_LAS bf16x8*)(lds + O_AL + fr * S_AL + (ks * 32 + fq * 8) * 2), aA, 0, 0, 0);
            }
#pragma unroll
            for (int ks = 0; ks < 4; ++ks)
                aG = __builtin_amdgcn_mfma_f32_16x16x32_bf16(ldg_frag(glT + (size_t)(cn + fr) * 128 + ks * 32 + fq * 8), *(const PG8_LAS bf16x8*)(lds + O_SG + fr * S_SG + (ks * 32 + fq * 8) * 2), aG, 0, 0, 0);
            if (l > 0) {
                const u32x2 va = *(const u32x2*)(v2T + (size_t)(cn + fr) * 32 + 4 * fq), vc = *(const u32x2*)(v2T + (size_t)(cn + fr) * 32 + 16 + 4 * fq);
                const u32x4 vw = (u32x4){va.x, va.y, vc.x, vc.y};
                aV = __builtin_amdgcn_mfma_f32_16x16x32_bf16(__builtin_bit_cast(bf16x8, vw), pfrag, aV, 0, 0, 0);
            }
            const f32x4 xr = xs4(c, i, cb_), xk = xs4(c, i, 512 + cb_), xv = xs4(c, i, 1024 + cb_);
            const f32x4 w0v = *(const f32x4*)(w0 + cb_), a0v = *(const f32x4*)(a0 + cb_), kkv = *(const f32x4*)(k_k + cb_), kav = *(const f32x4*)(k_a + cb_), rkv = *(const f32x4*)(r_k + cb_);
            f32x4 vp = xv;
            if (l == 0) st_bf4(vfirst + (size_t)i * 512 + cb_, xv);
            else { const f32x4 vf = ld_bf4(vfirst + (size_t)i * 512 + cb_); const f32x4 vbv = *(const f32x4*)(vb + cb_);
#pragma unroll
                for (int j = 0; j < 4; ++j) vp[j] = xv[j] + (vf[j] - xv[j]) * sigmoidf_(vbv[j] + aV[j]);
            }
            f32x4 dd, kt, kn, bb;
#pragma unroll
            for (int j = 0; j < 4; ++j) {
                const float wv = -softplusf_(-(w0v[j] + aW[j])) - 0.5f;
                dd[j] = __expf(-__expf(wv));
                const float a = sigmoidf_(a0v[j] + aA[j]);
                kn[j] = xk[j] * kkv[j] * inorm;
                kt[j] = xk[j] * (1.0f + (a - 1.0f) * kav[j]);
                bb[j] = kn[j] * a;
                rks += xr[j] * kt[j] * rkv[j];
            }
            const int p0 = 8 * n + 2 * fq;
            u32x4 rec0, rec1;
            rec0.x = cvt_pk_bf16(xr[0], xr[1]); rec0.y = cvt_pk_bf16(kt[0], kt[1]); rec0.z = cvt_pk_bf16(kn[0], kn[1]); rec0.w = cvt_pk_bf16(bb[0], bb[1]);
            rec1.x = cvt_pk_bf16(xr[2], xr[3]); rec1.y = cvt_pk_bf16(kt[2], kt[3]); rec1.z = cvt_pk_bf16(kn[2], kn[3]); rec1.w = cvt_pk_bf16(bb[2], bb[3]);
            u32x4* ap = A16 + ((size_t)i * 8 + h) * 32 + p0;
            ap[0] = rec0; ap[1] = rec1;
            *(f32x4*)(D8 + (size_t)i * 512 + cb_) = dd;
            st_bf4(vbuf + (size_t)i * 512 + cb_, vp);
            st_bf4(gbuf + (size_t)i * 512 + cb_, aG);
        }
        rks += __shfl_xor(rks, 16); rks += __shfl_xor(rks, 32);
        if (fq == 0) rkb[(size_t)i * 8 + h] = rks;
#pragma unroll
        for (int n2 = 0; n2 < 2; ++n2) {
            const int cn = 32 * h + 16 * n2;
            f32x4 aF = (f32x4){0.f, 0.f, 0.f, 0.f};
            aF = __builtin_amdgcn_mfma_f32_16x16x32_bf16(ldg_frag(fT + (size_t)(cn + fr) * 32 + fq * 8), *(const PG8_LAS bf16x8*)(lds + O_FL + fr * S_FL + (fq * 8) * 2), aF, 0, 0, 0);
            const f32x4 fb = *(const f32x4*)(fbias + cn + 4 * fq);
            f32x4 dc;
#pragma unroll
            for (int j = 0; j < 4; ++j) { const float z = aF[j] + fb[j]; dc[j] = __expf(-softplusf_(-z) * (1.0f / 16.0f)); }
            *(f32x4*)(decb + (size_t)i * 256 + cn + 4 * fq) = dc;
        }
        __syncthreads();
    }
}

struct ScanItem {
    int tok0, T, L;
    int h, q;
    int hg, cgp;
    const float* s0_rwkv; float* so_rwkv;
    const float* s0_gla; float* so_gla;
};
template <int LSEG>
__device__ __forceinline__ void scan_item(KP p, const ScanItem& it, PG8_LAS unsigned char* lds) {
    unsigned char* ws = p->ws;
    const u32x4* A16 = (const u32x4*)(ws + W_BUFB); const float* D8 = (const float*)(ws + W_D8); const u16* vbuf = (const u16*)(ws + W_VBUF);
    const u16* projB = (const u16*)(ws + W_PROJB); const float* decb = (const float*)(ws + W_DEC);
    u16* obufA = (u16*)(ws + W_OBUFA); u16* obufB = (u16*)(ws + W_OBUFB);
    const int t = opaque_tid(), wid = t >> 6, lane = t & 63, kq = lane & 15, rsel = lane >> 4;
    constexpr int BUF = 69632, OR = 0, OKT = 8192, OKN = 16384, OB = 24576, OD = 32768, OVR = 40960, OQ = 43008, OK = 51200, ODC = 59392, OVG = 67584;
    const int nchunk = it.T / TC;
    u32x4 sa0, sa1; f32x4 sd, sdec; u32x2 svr = (u32x2){0u, 0u}, sq, sk;
#define SC_GLOAD(ch_) do { const int tk_ = it.tok0 + (ch_) * TC; \
        { const int i0 = t, i1 = t + 512; sa0 = A16[((size_t)(tk_ + (i0 >> 5)) * 8 + it.h) * 32 + (i0 & 31)]; sa1 = A16[((size_t)(tk_ + (i1 >> 5)) * 8 + it.h) * 32 + (i1 & 31)]; } \
        { const int st = t >> 4, c4 = (t & 15) * 4; sd = *(const f32x4*)(D8 + (size_t)(tk_ + st) * 512 + it.h * 64 + c4); \
          sq = *(const u32x2*)(projB + (size_t)(tk_ + st) * 1792 + it.hg * 64 + c4); sk = *(const u32x2*)(projB + (size_t)(tk_ + st) * 1792 + 256 + it.hg * 64 + c4); \
          sdec = *(const f32x4*)(decb + (size_t)(tk_ + st) * 256 + it.hg * 64 + c4); } \
        if (t < 128) { const int st = t >> 2, c4 = (t & 3) * 4; svr = *(const u32x2*)(vbuf + (size_t)(tk_ + st) * 512 + it.h * 64 + it.q * 16 + c4); } \
        else if (t < 256) { const int tt = t - 128, st = tt >> 2, c4 = (tt & 3) * 4; svr = *(const u32x2*)(projB + (size_t)(tk_ + st) * 1792 + 512 + it.hg * 128 + it.cgp * 16 + c4); } } while (0)
#define SC_LSTORE(buf_) do { PG8_LAS unsigned char* b_ = lds + (buf_) * BUF; \
        { const int i0 = t, i1 = t + 512; \
          { const int st = i0 >> 5, pp = i0 & 31; const int o = (st * 64 + 2 * pp) * 4; \
            *(PG8_LAS f32x2*)(b_ + OR + o) = (f32x2){bflo(sa0.x), bfhi(sa0.x)}; *(PG8_LAS f32x2*)(b_ + OKT + o) = (f32x2){bflo(sa0.y), bfhi(sa0.y)}; \
            *(PG8_LAS f32x2*)(b_ + OKN + o) = (f32x2){bflo(sa0.z), bfhi(sa0.z)}; *(PG8_LAS f32x2*)(b_ + OB + o) = (f32x2){bflo(sa0.w), bfhi(sa0.w)}; } \
          { const int st = i1 >> 5, pp = i1 & 31; const int o = (st * 64 + 2 * pp) * 4; \
            *(PG8_LAS f32x2*)(b_ + OR + o) = (f32x2){bflo(sa1.x), bfhi(sa1.x)}; *(PG8_LAS f32x2*)(b_ + OKT + o) = (f32x2){bflo(sa1.y), bfhi(sa1.y)}; \
            *(PG8_LAS f32x2*)(b_ + OKN + o) = (f32x2){bflo(sa1.z), bfhi(sa1.z)}; *(PG8_LAS f32x2*)(b_ + OB + o) = (f32x2){bflo(sa1.w), bfhi(sa1.w)}; } } \
        { const int st = t >> 4, c4 = (t & 15) * 4; const int o = (st * 64 + c4) * 4; \
          *(PG8_LAS f32x4*)(b_ + OD + o) = sd; *(PG8_LAS f32x4*)(b_ + ODC + o) = sdec; \
          *(PG8_LAS f32x4*)(b_ + OQ + o) = (f32x4){bflo(sq.x), bfhi(sq.x), bflo(sq.y), bfhi(sq.y)} * 0.125f; \
          *(PG8_LAS f32x4*)(b_ + OK + o) = (f32x4){bflo(sk.x), bfhi(sk.x), bflo(sk.y), bfhi(sk.y)}; } \
        if (t < 128) { const int st = t >> 2, c4 = (t & 3) * 4; *(PG8_LAS f32x4*)(b_ + OVR + (st * 16 + c4) * 4) = (f32x4){bflo(svr.x), bfhi(svr.x), bflo(svr.y), bfhi(svr.y)}; } \
        else if (t < 256) { const int tt = t - 128, st = tt >> 2, c4 = (tt & 3) * 4; *(PG8_LAS f32x4*)(b_ + OVG + (st * 16 + c4) * 4) = (f32x4){bflo(svr.x), bfhi(svr.x), bflo(svr.y), bfhi(svr.y)}; } } while (0)
    const bool isR = wid < 4;
    const int w4 = wid & 3;
    const int row = it.q * 16 + 4 * w4 + rsel;
    const int col = it.cgp * 16 + 4 * w4 + rsel;
    f32x4 S = (f32x4){0.f, 0.f, 0.f, 0.f}, Sn = S;
#define SC_LOAD_STATE(dst_, seg_) do { const int sg_ = (seg_); \
        if (isR) { if (!it.s0_rwkv) dst_ = (f32x4){0.f, 0.f, 0.f, 0.f}; else dst_ = *(const f32x4*)(it.s0_rwkv + (size_t)sg_ * 8 * 4096 + row * 64 + 4 * kq); } \
        else if (!it.s0_gla) dst_ = (f32x4){0.f, 0.f, 0.f, 0.f}; \
        else { const float* sp_ = it.s0_gla + (size_t)sg_ * 4 * 8192 + (size_t)(4 * kq) * 128 + col; dst_ = (f32x4){sp_[0], sp_[128], sp_[256], sp_[384]}; } } while (0)
#define SC_STORE_STATE(seg_, s_) do { const int sg_ = (seg_); \
        if (isR) { *(f32x4*)(it.so_rwkv + (size_t)sg_ * 8 * 4096 + row * 64 + 4 * kq) = s_; } \
        else { float* sp_ = it.so_gla + (size_t)sg_ * 4 * 8192 + (size_t)(4 * kq) * 128 + col; sp_[0] = s_[0]; sp_[128] = s_[1]; sp_[256] = s_[2]; sp_[384] = s_[3]; } } while (0)
    SC_GLOAD(0);
    SC_LOAD_STATE(Sn, 0);
    SC_LSTORE(0);
    __syncthreads();
    u16* oAp = obufA + (size_t)it.tok0 * 512 + it.h * 64 + row;
    u16* oBp = obufB + (size_t)it.tok0 * 512 + it.hg * 128 + col;
    const int vsl = (4 * w4 + rsel) * 4;
#define SC_STEP_R(s_, ov_) do { const int o = ((s_) * 64 + 4 * kq) * 4; \
        const f32x4 r4 = *(const PG8_LAS f32x4*)(b + OR + o), k4 = *(const PG8_LAS f32x4*)(b + OKT + o), n4 = *(const PG8_LAS f32x4*)(b + OKN + o), b4 = *(const PG8_LAS f32x4*)(b + OB + o), d4 = *(const PG8_LAS f32x4*)(b + OD + o); \
        const float v = *(const PG8_LAS float*)(b + OVR + (s_) * 64 + vsl); \
        float dot = (S[0] * n4[0] + S[1] * n4[1]) + (S[2] * n4[2] + S[3] * n4[3]); \
        dot = red16(dot); \
        S = S * d4 - b4 * dot + k4 * v; \
        float o_ = (S[0] * r4[0] + S[1] * r4[1]) + (S[2] * r4[2] + S[3] * r4[3]); \
        (ov_) = red16(o_); } while (0)
#define SC_STEP_G(s_, ov_) do { const int o = ((s_) * 64 + 4 * kq) * 4; \
        const f32x4 q4 = *(const PG8_LAS f32x4*)(b + OQ + o), k4 = *(const PG8_LAS f32x4*)(b + OK + o), d4 = *(const PG8_LAS f32x4*)(b + ODC + o); \
        const float v = *(const PG8_LAS float*)(b + OVG + (s_) * 64 + vsl); \
        S = S * d4 + k4 * v; \
        float o_ = (S[0] * q4[0] + S[1] * q4[1]) + (S[2] * q4[2] + S[3] * q4[3]); \
        (ov_) = red16(o_); } while (0)
#define SC_BLOCK(STEP_, s0_, NB_, optr_) do { float ov[NB_]; \
        _Pragma("unroll") for (int j_ = 0; j_ < (NB_); ++j_) STEP_((s0_) + j_, ov[j_]); \
        float outv = ov[0]; \
        _Pragma("unroll") for (int j_ = 1; j_ < (NB_); ++j_) outv = (kq == j_) ? ov[j_] : outv; \
        if (kq < (NB_)) (optr_)[(size_t)((s0_) + kq) * 512] = (u16)(cvt_pk_bf16(outv, 0.f) & 0xffffu); } while (0)
    for (int ch = 0; ch < nchunk; ++ch) {
        const bool more = ch + 1 < nchunk;
        if (more) SC_GLOAD(ch + 1);
        PG8_LAS unsigned char* b = lds + (ch & 1) * BUF;
        if (LSEG >= TC) {
            if (ch == 0) S = Sn;
            if (isR) {
                {
                    struct InR { f32x4 r4, k4, n4, b4, d4; float v; };
                    InR in_[TC]; float ov[8];
#define LD_R(s_) do { const int o = ((s_) * 64 + 4 * kq) * 4; in_[s_].r4 = *(const PG8_LAS f32x4*)(b + OR + o); in_[s_].k4 = *(const PG8_LAS f32x4*)(b + OKT + o); in_[s_].n4 = *(const PG8_LAS f32x4*)(b + OKN + o); \
                        in_[s_].b4 = *(const PG8_LAS f32x4*)(b + OB + o); in_[s_].d4 = *(const PG8_LAS f32x4*)(b + OD + o); in_[s_].v = *(const PG8_LAS float*)(b + OVR + (s_) * 64 + vsl); } while (0)
#pragma unroll
                    for (int j = 0; j < SC_PD; ++j) LD_R(j);
#pragma unroll
                    for (int s = 0; s < TC; ++s) {
                        float dot = (S[0] * in_[s].n4[0] + S[1] * in_[s].n4[1]) + (S[2] * in_[s].n4[2] + S[3] * in_[s].n4[3]);
                        dot = red16(dot);
                        S = S * in_[s].d4 - in_[s].b4 * dot + in_[s].k4 * in_[s].v;
                        float o_ = (S[0] * in_[s].r4[0] + S[1] * in_[s].r4[1]) + (S[2] * in_[s].r4[2] + S[3] * in_[s].r4[3]);
                        ov[s & 7] = red16(o_);
                        if (s + SC_PD < TC) LD_R(s + SC_PD);
                        __builtin_amdgcn_sched_barrier(0);
                        if ((s & 7) == 7) { float outv = ov[0];
#pragma unroll
                            for (int j = 1; j < 8; ++j) outv = (kq == j) ? ov[j] : outv;
                            if (kq < 8) oAp[(size_t)((s & ~7) + kq) * 512] = (u16)(cvt_pk_bf16(outv, 0.f) & 0xffffu); }
                    }
#undef LD_R
                }
            } else {
                {
                    struct InG { f32x4 q4, k4, d4; float v; };
                    InG in_[TC]; float ov[8];
#define LD_G(s_) do { const int o = ((s_) * 64 + 4 * kq) * 4; in_[s_].q4 = *(const PG8_LAS f32x4*)(b + OQ + o); in_[s_].k4 = *(const PG8_LAS f32x4*)(b + OK + o); in_[s_].d4 = *(const PG8_LAS f32x4*)(b + ODC + o); \
                        in_[s_].v = *(const PG8_LAS float*)(b + OVG + (s_) * 64 + vsl); } while (0)
#pragma unroll
                    for (int j = 0; j < SC_PD; ++j) LD_G(j);
#pragma unroll
                    for (int s = 0; s < TC; ++s) {
                        S = S * in_[s].d4 + in_[s].k4 * in_[s].v;
                        float o_ = (S[0] * in_[s].q4[0] + S[1] * in_[s].q4[1]) + (S[2] * in_[s].q4[2] + S[3] * in_[s].q4[3]);
                        ov[s & 7] = red16(o_);
                        if (s + SC_PD < TC) LD_G(s + SC_PD);
                        __builtin_amdgcn_sched_barrier(0);
                        if ((s & 7) == 7) { float outv = ov[0];
#pragma unroll
                            for (int j = 1; j < 8; ++j) outv = (kq == j) ? ov[j] : outv;
                            if (kq < 8) oBp[(size_t)((s & ~7) + kq) * 512] = (u16)(cvt_pk_bf16(outv, 0.f) & 0xffffu); }
                    }
#undef LD_G
                }
            }
            if (!more) SC_STORE_STATE(0, S);
        } else {
#pragma unroll 1
            for (int sgi = 0; sgi < TC / LSEG; ++sgi) {
                const int seg = ch * (TC / LSEG) + sgi;
                S = Sn;
                if ((seg + 1) * LSEG < it.T) SC_LOAD_STATE(Sn, seg + 1);
                if (isR) {
                    SC_BLOCK(SC_STEP_R, sgi * LSEG, (LSEG < TC ? LSEG : 1), oAp);
                } else {
                    SC_BLOCK(SC_STEP_G, sgi * LSEG, (LSEG < TC ? LSEG : 1), oBp);
                }
                SC_STORE_STATE(seg, S);
            }
        }
        oAp += (size_t)TC * 512; oBp += (size_t)TC * 512;
        if (more) SC_LSTORE((ch + 1) & 1);
        __syncthreads();
    }
#undef SC_BLOCK
#undef SC_STEP_R
#undef SC_STEP_G
}
__device__ void scan_phase(KP p, int l, PG8_LAS unsigned char* lds) {
    float* out = p->out;
    const int bid = opaque_bid();
    for (int i = bid; i < 256; i += gridDim.x) {
        ScanItem it; const int s = i >> 5;
        it.tok0 = s * 2048; it.T = 2048; it.L = 2048; it.h = (i >> 2) & 7; it.q = i & 3; it.hg = (i >> 3) & 3; it.cgp = i & 7;
        it.s0_rwkv = nullptr; it.so_rwkv = out + O_RWKV_P + ((size_t)(l * 8 + s) * 8 + it.h) * 4096;
        it.s0_gla = nullptr; it.so_gla = out + O_GLA_P + ((size_t)(l * 8 + s) * 4 + it.hg) * 8192;
        scan_item<2048>(p, it, lds);
    }
    for (int i = bid; i < 256; i += gridDim.x) {
        ScanItem it; const int bg = i >> 5, b0 = bg * 16;
        it.tok0 = MP + bg * 64; it.T = 64; it.L = 4; it.h = (i >> 2) & 7; it.q = i & 3; it.hg = (i >> 3) & 3; it.cgp = i & 7;
        it.s0_rwkv = p->in[I_SRWKV] + ((size_t)(l * 128 + b0) * 8 + it.h) * 4096; it.so_rwkv = out + O_RWKV_S + ((size_t)(l * 128 + b0) * 8 + it.h) * 4096;
        it.s0_gla = p->in[I_SGLA] + ((size_t)(l * 128 + b0) * 4 + it.hg) * 8192; it.so_gla = out + O_GLA_S + ((size_t)(l * 128 + b0) * 4 + it.hg) * 8192;
        scan_item<4>(p, it, lds);
    }
}

__device__ void post_phase(KP p, int l) {
    unsigned char* ws = p->ws;
    const u16* obufA = (const u16*)(ws + W_OBUFA); const u16* obufB = (const u16*)(ws + W_OBUFB); const u16* vbuf = (const u16*)(ws + W_VBUF); const u16* gbuf = (const u16*)(ws + W_GBUF);
    const float* rkb = (const float*)(ws + W_RK); const u16* projB = (const u16*)(ws + W_PROJB); u16* oab = (u16*)(ws + W_XB);
    const float* lg = p->in[I_LNXG] + l * 512; const float* lb = p->in[I_LNXB] + l * 512; const float* ng = p->in[I_NG] + l * 128;
    const int tt_ = opaque_tid();
    const int lane = tt_ & 63, gw = opaque_bid() * 8 + (tt_ >> 6), nw = gridDim.x * 8;
    const int c = lane * 8;
    float lgv[8], lbv[8], ngv[8];
#pragma unroll
    for (int j = 0; j < 8; ++j) { lgv[j] = lg[c + j]; lbv[j] = lb[c + j]; ngv[j] = ng[(c & 127) + j]; }
    for (int i = gw; i < MTOK; i += nw) {
        {
            const f32x4 o0 = ld_bf4(obufA + (size_t)i * 512 + c), o1 = ld_bf4(obufA + (size_t)i * 512 + c + 4);
            const f32x4 v0 = ld_bf4(vbuf + (size_t)i * 512 + c), v1 = ld_bf4(vbuf + (size_t)i * 512 + c + 4);
            const f32x4 g0 = ld_bf4(gbuf + (size_t)i * 512 + c), g1 = ld_bf4(gbuf + (size_t)i * 512 + c + 4);
            const float rk = rkb[(size_t)i * 8 + (lane >> 3)];
            float s = (o0[0] + o0[1]) + (o0[2] + o0[3]) + (o1[0] + o1[1]) + (o1[2] + o1[3]);
            s += __shfl_xor(s, 1); s += __shfl_xor(s, 2); s += __shfl_xor(s, 4);
            const float m = s * (1.0f / 64.0f);
            const f32x4 d0 = o0 - m, d1 = o1 - m;
            float q = (d0[0] * d0[0] + d0[1] * d0[1]) + (d0[2] * d0[2] + d0[3] * d0[3]) + (d1[0] * d1[0] + d1[1] * d1[1]) + (d1[2] * d1[2] + d1[3] * d1[3]);
            q += __shfl_xor(q, 1); q += __shfl_xor(q, 2); q += __shfl_xor(q, 4);
            const float rs = rsqrtf(q * (1.0f / 64.0f) + GN_EPS_A);
            f32x4 y0, y1;
#pragma unroll
            for (int j = 0; j < 4; ++j) { y0[j] = (d0[j] * rs * lgv[j] + lbv[j] + rk * v0[j]) * g0[j]; y1[j] = (d1[j] * rs * lgv[4 + j] + lbv[4 + j] + rk * v1[j]) * g1[j]; }
            u32x4 w; w.x = cvt_pk_bf16(y0[0], y0[1]); w.y = cvt_pk_bf16(y0[2], y0[3]); w.z = cvt_pk_bf16(y1[0], y1[1]); w.w = cvt_pk_bf16(y1[2], y1[3]);
            *(u32x4*)(oab + (size_t)i * 1024 + c) = w;
        }
        {
            const f32x4 o0 = ld_bf4(obufB + (size_t)i * 512 + c), o1 = ld_bf4(obufB + (size_t)i * 512 + c + 4);
            const f32x4 g0 = ld_bf4(projB + (size_t)i * 1792 + 1024 + c), g1 = ld_bf4(projB + (size_t)i * 1792 + 1024 + c + 4);
            float q = (o0[0] * o0[0] + o0[1] * o0[1]) + (o0[2] * o0[2] + o0[3] * o0[3]) + (o1[0] * o1[0] + o1[1] * o1[1]) + (o1[2] * o1[2] + o1[3] * o1[3]);
            q += __shfl_xor(q, 1); q += __shfl_xor(q, 2); q += __shfl_xor(q, 4); q += __shfl_xor(q, 8);
            const float rs = rsqrtf(q * (1.0f / 128.0f) + RMS_EPS);
            f32x4 y0, y1;
#pragma unroll
            for (int j = 0; j < 4; ++j) { y0[j] = o0[j] * rs * ngv[j] * (g0[j] * sigmoidf_(g0[j])); y1[j] = o1[j] * rs * ngv[4 + j] * (g1[j] * sigmoidf_(g1[j])); }
            u32x4 w; w.x = cvt_pk_bf16(y0[0], y0[1]); w.y = cvt_pk_bf16(y0[2], y0[3]); w.z = cvt_pk_bf16(y1[0], y1[1]); w.w = cvt_pk_bf16(y1[2], y1[3]);
            *(u32x4*)(oab + (size_t)i * 1024 + 512 + c) = w;
        }
    }
}

#define XB_TMO      128
#define XB_XCNT(j)  (256  + 64 * (j))
#define XB_XSUB(j)  (1280 + 64 * (j))
#define XB_XGEN(j)  (2304 + 64 * (j))
#define XB_TOP      3328
#define XB_TOPGEN   3392
#define XCD_BAR_WORDS 3456
#define XB_SPIN_CAP (1u << 18)
__device__ __forceinline__ unsigned xb_ld(unsigned* p)              { return __hip_atomic_load(p, __ATOMIC_RELAXED, __HIP_MEMORY_SCOPE_AGENT); }
__device__ __forceinline__ unsigned xb_add(unsigned* p, unsigned v) { return __hip_atomic_fetch_add(p, v, __ATOMIC_RELAXED, __HIP_MEMORY_SCOPE_AGENT); }
__device__ __forceinline__ unsigned xb_xcc_id() { return (unsigned)__builtin_amdgcn_s_getreg((3 << 11) | 20) & 0xFu; }
#define XB_SPIN(cond, bar) do { unsigned _sp = 0; while (cond) { __builtin_amdgcn_s_sleep(1); \
    if ((++_sp & 255u) == 0u) { if (xb_ld(&(bar)[XB_TMO])) break; if (_sp > XB_SPIN_CAP) { atomicAdd(&(bar)[XB_TMO], 1u); break; } } } } while (0)
__device__ __forceinline__ void xcd_barrier_complete(unsigned* bar, unsigned x, unsigned& nloc, unsigned& nx) {
    const unsigned G = gridDim.x * gridDim.y * gridDim.z;
    unsigned sum, cnt, mine, sp = 0u;
    for (;;) {
        sum = 0u; cnt = 0u; mine = 0u;
#pragma unroll
        for (unsigned j = 0; j < 16; ++j) { const unsigned c = xb_ld(&bar[XB_XCNT(j)]); sum += c; cnt += (c > 0u) ? 1u : 0u; mine = (j == x) ? c : mine; }
        if (sum == G) break;
        __builtin_amdgcn_s_sleep(1);
        if ((++sp & 255u) == 0u) { if (xb_ld(&bar[XB_TMO])) break; if (sp > XB_SPIN_CAP) { atomicAdd(&bar[XB_TMO], 1u); break; } }
    }
    nloc = mine > 0u ? mine : 1u; nx = cnt > 0u ? cnt : 1u;
}
__device__ __forceinline__ void xcd_barrier(unsigned* bar, volatile PG8_LAS unsigned* st) {
    asm volatile("s_waitcnt vmcnt(0)" ::: "memory");
    __syncthreads();
    if (threadIdx.x == 0) {
        const unsigned x = xb_xcc_id();
        __builtin_amdgcn_s_waitcnt(0);
        unsigned nloc = st[0], nx = st[1];
        if (nloc == 0u) { xcd_barrier_complete(bar, x, nloc, nx); st[0] = nloc; st[1] = nx; }
        const unsigned old = xb_add(&bar[XB_XSUB(x)], 1u);
        const unsigned gen = old / nloc;
        if (old + 1u == (gen + 1u) * nloc) {
            __builtin_amdgcn_fence(__ATOMIC_RELEASE, "agent");
            asm volatile("s_waitcnt vmcnt(0)" ::: "memory");
            const unsigned og = xb_add(&bar[XB_TOP], 1u);
            const unsigned tg = og / nx;
            if (og + 1u == (tg + 1u) * nx) xb_add(&bar[XB_TOPGEN], 1u);
            else XB_SPIN(xb_ld(&bar[XB_TOPGEN]) == tg, bar);
            __builtin_amdgcn_fence(__ATOMIC_ACQUIRE, "agent");
            xb_add(&bar[XB_XGEN(x)], 1u);
            asm volatile("s_waitcnt vmcnt(0)" ::: "memory");
        } else {
            XB_SPIN(xb_ld(&bar[XB_XGEN(x)]) == gen, bar);
            __builtin_amdgcn_fence(__ATOMIC_ACQUIRE, "agent");
            asm volatile("s_waitcnt vmcnt(0)" ::: "memory");
        }
    }
    __syncthreads();
}
__device__ __forceinline__ void gsync(cg::grid_group& grid) {
    asm volatile("s_waitcnt vmcnt(0)" ::: "memory");
    grid.sync();
    if (threadIdx.x < 64) { __builtin_amdgcn_fence(__ATOMIC_ACQUIRE, "agent"); asm volatile("s_waitcnt vmcnt(0)" ::: "memory"); }
    __syncthreads();
}

__global__ void __launch_bounds__(512, 2) mega(Params p_unused) {
    KP p = kparams();
    extern __shared__ __attribute__((aligned(16))) unsigned char smem[];
    PG8_LAS unsigned char* lds = (PG8_LAS unsigned char*)smem;
    cg::grid_group grid = cg::this_grid();
    unsigned char* ws = p->ws;
    float* bufA = p->out + O_Y; float* bufB = (float*)(ws + W_BUFB); u16* xb = (u16*)(ws + W_XB);
    pg8::StaticOrder S;
    volatile PG8_LAS unsigned* xst = (volatile PG8_LAS unsigned*)(lds + 139264);
    if (threadIdx.x == 0) { xst[0] = 0u; xst[1] = 0u; }
    gsync(grid);
    unsigned* xbar = (unsigned*)(kparams()->ws + W_BAR);
    if (threadIdx.x == 0) (void)xb_add(&xbar[XB_XCNT(xb_xcc_id())], 1u);
#define PHASE_END() xcd_barrier((unsigned*)(kparams()->ws + W_BAR), xst)
    convert_phase(kparams(), 0, (float*)smem);
    PHASE_END();
    for (int l = 0; l < NL; ++l) {
        {
            pg8::Gemm g; g.A = xb; g.Bt = (const u16*)(ws + W_WIN); g.M = MTOK; g.N = INP; g.K = 1024;
            EpiProj E; E.projA = (u16*)(ws + W_PROJA); E.projB = (u16*)(ws + W_PROJB); E.shift_p = p->out + O_SHIFT_P + (size_t)l * 8 * 1792; E.shift_s = p->out + O_SHIFT_S + (size_t)l * 128 * 1792;
            S.init(MTOK, INP, gridDim.x, opaque_bid()); pg8::gemm_phase(lds, g, S, E);
        }
        PHASE_END();
        prep_phase(kparams(), l, lds);
        PHASE_END();
        scan_phase(kparams(), l, lds);
        PHASE_END();
        post_phase(kparams(), l);
        PHASE_END();
        {
            pg8::Gemm g; g.A = xb; g.Bt = (const u16*)(ws + W_WOUT); g.M = MTOK; g.N = 1024; g.K = 1024;
            EpiResid E; E.base = bufA; E.out = bufB;
            S.init(MTOK, 1024, gridDim.x, opaque_bid()); pg8::gemm_phase(lds, g, S, E);
        }
        PHASE_END();
        ln_phase(bufB, xb, p->in[I_LN1G] + l * 1024, p->in[I_LN1B] + l * 1024);
        PHASE_END();
        {
            pg8::Gemm g; g.A = xb; g.Bt = (const u16*)(ws + W_WUP); g.M = MTOK; g.N = 5632; g.K = 1024;
            EpiUp E; E.gate = (u16*)(ws + W_GATE); E.val = (u16*)(ws + W_VAL); E.conv_p = p->out + O_CONV_P + (size_t)l * 8 * 2 * DFF; E.conv_s = p->out + O_CONV_S + (size_t)l * 128 * 2 * DFF;
            S.init(MTOK, 5632, gridDim.x, opaque_bid()); pg8::gemm_phase(lds, g, S, E);
        }
        PHASE_END();
        convglu_phase((const u16*)(ws + W_GATE), (u16*)(ws + W_VAL), p->in[I_SCONV] + (size_t)l * 128 * 2 * DFF, p->in[I_CW] + (size_t)l * 3 * DFF, p->in[I_CB] + (size_t)l * DFF);
        PHASE_END();
        {
            pg8::Gemm g; g.A = (const u16*)(ws + W_VAL); g.Bt = (const u16*)(ws + W_WDOWN); g.M = MTOK; g.N = 1024; g.K = DFF;
            EpiResid E; E.base = bufB; E.out = bufA;
            S.init(MTOK, 1024, gridDim.x, opaque_bid()); pg8::gemm_phase(lds, g, S, E);
        }
        PHASE_END();
        ln_phase(bufA, xb, p->in[I_LN2G] + l * 1024, p->in[I_LN2B] + l * 1024);
        if (l + 1 < NL) convert_phase(kparams(), l + 1, (float*)smem);
        PHASE_END();
    }
}

extern "C" void kernel_launch(void* const* d_in, const int* in_sizes, int n_in, void* d_out, int out_size, void* d_ws, size_t ws_size, hipStream_t stream) {
    static int grid_blocks = 0;
    if (!grid_blocks) {
        int dev = 0, cus = 0, per_cu = 0;
        (void)hipGetDevice(&dev);
        (void)hipDeviceGetAttribute(&cus, hipDeviceAttributeMultiprocessorCount, dev);
        (void)hipFuncSetAttribute((const void*)mega, hipFuncAttributeMaxDynamicSharedMemorySize, LDS_BYTES);
        (void)hipOccupancyMaxActiveBlocksPerMultiprocessor(&per_cu, (const void*)mega, 512, LDS_BYTES);
        grid_blocks = cus;
        if (n_in != 33 || (size_t)out_size != O_END || ws_size < W_TOTAL) { fprintf(stderr, "kernel_launch: unexpected sizes n_in %d out %d ws %zu (need %zu)\n", n_in, out_size, ws_size, (size_t)W_TOTAL); grid_blocks = -1; }
    }
    if (grid_blocks < 0) return;
    (void)hipMemsetAsync((unsigned char*)d_ws + W_BAR, 0, XCD_BAR_WORDS * sizeof(unsigned), stream);
    Params p{};
    for (int i = 0; i < 33; ++i) p.in[i] = (const float*)d_in[i];
    p.out = (float*)d_out; p.ws = (unsigned char*)d_ws;
    void* args[] = {&p};
    hipError_t e = hipLaunchCooperativeKernel((const void*)mega, dim3(grid_blocks), dim3(512), args, LDS_BYTES, stream);
    if (e != hipSuccess) fprintf(stderr, "cooperative launch failed: %s (grid %d)\n", hipGetErrorString(e), grid_blocks);
}
```

```cpp
#include <hip/hip_runtime.h>
#include <hip/hip_cooperative_groups.h>
#include <cstdio>
namespace cg = cooperative_groups;

#define PG8_LAS __attribute__((address_space(3)))
typedef unsigned short u16;
typedef unsigned int u32;
typedef unsigned short bf16_t;
typedef short bf16x8 __attribute__((ext_vector_type(8)));
typedef float f32x4 __attribute__((ext_vector_type(4)));
typedef float f32x2 __attribute__((ext_vector_type(2)));
typedef unsigned u32x4 __attribute__((ext_vector_type(4)));
typedef unsigned u32x2 __attribute__((ext_vector_type(2)));

constexpr int MTOK = 16896, MP = 16384, DM = 1024, NL = 4;
constexpr int SHIFT_W = 1792, INP = 3584, DFF = 2816;
constexpr float ALPHA = 1.6817928305074290f;
constexpr float GN_EPS_A = 64e-5f, RMS_EPS = 1e-5f, LN_EPS = 1e-5f;
constexpr int LDS_BYTES = 139264 + 16;
constexpr int TC = 32;
#define SC_PD 3

enum { I_XP = 0, I_XS, I_SRWKV, I_SSHIFT, I_SGLA, I_SCONV, I_WIN, I_MU, I_W0, I_WLU, I_A0, I_ALU, I_GLU, I_KK, I_KA, I_RK, I_LNXG, I_LNXB,
       I_VB, I_VD, I_VU, I_FUP, I_FB, I_NG, I_WOUT, I_LN1G, I_LN1B, I_WUP, I_CW, I_CB, I_WDOWN, I_LN2G, I_LN2B };

constexpr size_t O_Y = 0;
constexpr size_t O_RWKV_P = (size_t)MTOK * DM;
constexpr size_t O_RWKV_S = O_RWKV_P + (size_t)4 * 8 * 8 * 4096;
constexpr size_t O_SHIFT_P = O_RWKV_S + (size_t)4 * 128 * 8 * 4096;
constexpr size_t O_SHIFT_S = O_SHIFT_P + (size_t)4 * 8 * 1792;
constexpr size_t O_GLA_P = O_SHIFT_S + (size_t)4 * 128 * 1792;
constexpr size_t O_GLA_S = O_GLA_P + (size_t)4 * 8 * 4 * 8192;
constexpr size_t O_CONV_P = O_GLA_S + (size_t)4 * 128 * 4 * 8192;
constexpr size_t O_CONV_S = O_CONV_P + (size_t)4 * 8 * 2 * 2816;
constexpr size_t O_END = O_CONV_S + (size_t)4 * 128 * 2 * 2816;

constexpr size_t W_WIN = 0;
constexpr size_t W_WOUT = W_WIN + (size_t)INP * 1024 * 2;
constexpr size_t W_WUP = W_WOUT + (size_t)1024 * 1024 * 2;
constexpr size_t W_WDOWN = W_WUP + (size_t)5632 * 1024 * 2;
constexpr size_t W_WLT = W_WDOWN + (size_t)1024 * 2816 * 2;
constexpr size_t W_ALT = W_WLT + 512 * 64 * 2;
constexpr size_t W_GLT = W_ALT + 512 * 64 * 2;
constexpr size_t W_V1T = W_GLT + 512 * 128 * 2;
constexpr size_t W_V2T = W_V1T + 32 * 512 * 2;
constexpr size_t W_FT = W_V2T + 512 * 32 * 2;
constexpr size_t W_XB = W_FT + 256 * 32 * 2;
constexpr size_t W_VFIRST = W_XB + (size_t)MTOK * 1024 * 2;
constexpr size_t W_BUFB = W_VFIRST + (size_t)MTOK * 512 * 2;
constexpr size_t W_R = W_BUFB + (size_t)MTOK * 1024 * 4;
constexpr size_t W_PROJA = W_R;
constexpr size_t W_PROJB = W_PROJA + (size_t)MTOK * 1792 * 2;
constexpr size_t W_D8 = W_PROJB + (size_t)MTOK * 1792 * 2;
constexpr size_t W_VBUF = W_D8 + (size_t)MTOK * 512 * 4;
constexpr size_t W_GBUF = W_VBUF + (size_t)MTOK * 512 * 2;
constexpr size_t W_DEC = W_GBUF + (size_t)MTOK * 512 * 2;
constexpr size_t W_RK = W_DEC + (size_t)MTOK * 256 * 4;
constexpr size_t W_END1 = W_RK + (size_t)MTOK * 8 * 4;
constexpr size_t W_GATE = W_R;
constexpr size_t W_VAL = W_GATE + (size_t)MTOK * 2816 * 2;
constexpr size_t W_END2 = W_VAL + (size_t)MTOK * 2816 * 2;
constexpr size_t W_END = W_END1 > W_END2 ? W_END1 : W_END2;
constexpr size_t W_BAR = (W_END + 255) / 256 * 256;
constexpr size_t W_TOTAL = W_BAR + 16384;
constexpr size_t W_OBUFA = W_PROJA;
constexpr size_t W_OBUFB = W_PROJA + (size_t)MTOK * 512 * 2;

struct Params { const float* in[33]; float* out; unsigned char* ws; };
typedef const Params __attribute__((address_space(4)))* KP;
__device__ __forceinline__ KP kparams() { unsigned long long k = (unsigned long long)__builtin_amdgcn_kernarg_segment_ptr(); asm volatile("" : "+s"(k)); return (KP)k; }

typedef __bf16 bf16v2 __attribute__((ext_vector_type(2)));
__device__ __forceinline__ unsigned cvt_pk_bf16(float lo, float hi) { const f32x2 v = (f32x2){lo, hi}; const bf16v2 b = __builtin_convertvector(v, bf16v2); return __builtin_bit_cast(unsigned, b); }
__device__ __forceinline__ float bflo(u32 w) { return __uint_as_float(w << 16); }
__device__ __forceinline__ float bfhi(u32 w) { return __uint_as_float(w & 0xffff0000u); }
__device__ __forceinline__ f32x4 ld_bf4(const u16* p) { const u32x2 w = *(const u32x2*)p; return (f32x4){bflo(w.x), bfhi(w.x), bflo(w.y), bfhi(w.y)}; }
__device__ __forceinline__ unsigned cvt_pk_bf16_asm(float lo, float hi) { unsigned r; asm volatile("v_cvt_pk_bf16_f32 %0, %1, %2" : "=v"(r) : "v"(lo), "v"(hi)); return r; }
__device__ __forceinline__ void st_bf4_asm(u16* p, f32x4 v) { u32x2 w; w.x = cvt_pk_bf16_asm(v[0], v[1]); w.y = cvt_pk_bf16_asm(v[2], v[3]); *(u32x2*)p = w; }
__device__ __forceinline__ void st_bf4(u16* p, f32x4 v) { u32x2 w; w.x = cvt_pk_bf16(v[0], v[1]); w.y = cvt_pk_bf16(v[2], v[3]); *(u32x2*)p = w; }
__device__ __forceinline__ float sigmoidf_(float x) { return __builtin_amdgcn_rcpf(1.0f + __expf(-x)); }
__device__ __forceinline__ float tanhf_(float x) { return 1.0f - 2.0f * __builtin_amdgcn_rcpf(1.0f + __expf(2.0f * x)); }
__device__ __forceinline__ float softplusf_(float x) { return fmaxf(x, 0.f) + __logf(1.0f + __expf(-fabsf(x))); }
template <int CTRL> __device__ __forceinline__ float dppf(float x) { return __builtin_bit_cast(float, __builtin_amdgcn_update_dpp(0, __builtin_bit_cast(int, x), CTRL, 0xF, 0xF, true)); }
__device__ __forceinline__ float red16(float x) { x += dppf<0xB1>(x); x += dppf<0x4E>(x); x += dppf<0x141>(x); x += dppf<0x140>(x); return x; }

__device__ __forceinline__ int opaque_tid() { int t = threadIdx.x; asm volatile("" : "+v"(t)); return t; }
__device__ __forceinline__ int opaque_bid() { int b = blockIdx.x; asm volatile("" : "+s"(b)); return b; }

namespace pg8 {
constexpr int BM = 256, BK = 64, HALF = 128, HTB = HALF * BK * 2, STAGE_BYTES = 8 * HTB, NXCD = 8, WGM = 8;
__host__ __device__ __forceinline__ int lds_byte(int r, int c) { const int st = (r >> 4) * 2 + (c >> 5), rr = r & 15, cc = c & 31, ob = rr * 64 + cc * 2; return st * 1024 + (ob ^ (((ob >> 9) & 1) << 5)); }
__host__ __device__ __forceinline__ void stage_rc(int b, int& R, int& C) { const int st = b / 1024, sb = b % 1024, swz = sb ^ (((sb >> 9) & 1) << 5); R = (st >> 1) * 16 + swz / 64; C = (st & 1) * 32 + (swz % 64) / 2; }
struct Unit { int pm, pn; };
struct Gemm { const bf16_t* A; const bf16_t* Bt; int M, N, K; };
struct StaticOrder {
    int nM, nN, nwg, G, c;
    __host__ __device__ void init(int M, int N, int G_, int c_) { nM = M / BM; nN = N / BM; nwg = nM * nN; G = G_; c = c_; }
    __host__ __device__ bool next(int i, Unit& u) const {
        const long L = (long)i * G + c; if (L >= nwg) return false;
        int wgid = (int)L; { const int q = nwg / NXCD, r = nwg % NXCD, xcd = wgid % NXCD, off = wgid / NXCD; wgid = (xcd < r ? xcd * (q + 1) : r * (q + 1) + (xcd - r) * q) + off; }
        const int nig = WGM * nN, gid = wgid / nig, fm = gid * WGM, gsz = (nM - fm) < WGM ? (nM - fm) : WGM;
        u.pm = fm + ((wgid % nig) % gsz); u.pn = (wgid % nig) / gsz; return true;
    }
};

template <class Epi>
__device__ __forceinline__ void gemm_phase(PG8_LAS unsigned char* lds, const Gemm g, const StaticOrder& S, const Epi& E) {
    const int tid = opaque_tid(), wid = __builtin_amdgcn_readfirstlane(tid >> 6), lane = tid & 63, wr = wid >> 2, wc = wid & 3, fr = lane & 15, fq = lane >> 4;
    const int K = g.K, nt = K / BK;
    unsigned voffA[2], voffB[2];
#pragma unroll
    for (int i = 0; i < 2; ++i) { int R, C; stage_rc(tid * 16 + i * 8192, R, C); voffA[i] = (unsigned)(R * K + C) * 2u; voffB[i] = voffA[i]; }
    const size_t kstep = (size_t)(BK * 2);
    const size_t hstep = (size_t)HALF * K * 2;
    const size_t tstep = 2 * hstep;
    const unsigned ldsw = (unsigned)wid * 1024u;
    const int aoff = lds_byte(wr * 64 + fr, fq * 8), boff = lds_byte(wc * 32 + fr, fq * 8);
#define PG8_SA(b, h) (((b) * 2 + (h)) * HTB)
#define PG8_SB(b, h) ((4 + (b) * 2 + (h)) * HTB)
#define PG8_STAGE(bufoff, gbase, voff) do { _Pragma("unroll") for (int _i = 0; _i < 2; ++_i) \
        __builtin_amdgcn_global_load_lds((const unsigned*)((const char*)(gbase) + (voff)[_i]), (PG8_LAS unsigned*)(lds + (bufoff) + ldsw + _i * 8192), 16, 0, 0); } while (0)
#define PG8_LDA(dst, b, h) do { _Pragma("unroll") for (int m = 0; m < 4; ++m) _Pragma("unroll") for (int k = 0; k < 2; ++k) dst[m][k] = *(const PG8_LAS bf16x8*)(lds + PG8_SA(b, h) + aoff + m * 2048 + k * 1024); } while (0)
#define PG8_LDB(dst, b, h) do { _Pragma("unroll") for (int n = 0; n < 2; ++n) _Pragma("unroll") for (int k = 0; k < 2; ++k) dst[n][k] = *(const PG8_LAS bf16x8*)(lds + PG8_SB(b, h) + boff + n * 2048 + k * 1024); } while (0)
#define PG8_MMA(ai, bj, At, Bt) do { __builtin_amdgcn_s_setprio(1); _Pragma("unroll") for (int m = 0; m < 4; ++m) _Pragma("unroll") for (int n = 0; n < 2; ++n) _Pragma("unroll") for (int k = 0; k < 2; ++k) \
        acc[ai][bj][m][n] = __builtin_amdgcn_mfma_f32_16x16x32_bf16(Bt[n][k], At[m][k], acc[ai][bj][m][n], 0, 0, 0); __builtin_amdgcn_s_setprio(0); } while (0)
#define PG8_WAIT_V(n) asm volatile("s_waitcnt vmcnt(" #n ")" ::: "memory")
#define PG8_WAIT_L(n) asm volatile("s_waitcnt lgkmcnt(" #n ")" ::: "memory")
#define PG8_BAR __builtin_amdgcn_s_barrier()
#define PG8_SCHED __builtin_amdgcn_sched_barrier(0)
    Unit cur, nxt; int ui = 0;
    if (!S.next(0, cur)) return;
    f32x4 acc[2][2][4][2];
#pragma unroll
    for (int a = 0; a < 2; ++a)
#pragma unroll
        for (int b = 0; b < 2; ++b)
#pragma unroll
            for (int m = 0; m < 4; ++m)
#pragma unroll
                for (int n = 0; n < 2; ++n) acc[a][b][m][n] = (f32x4){0.f, 0.f, 0.f, 0.f};
    bf16x8 At[4][2], B0[2][2], B1[2][2];
    const char* cA = (const char*)g.A + (size_t)cur.pm * tstep; const char* cB = (const char*)g.Bt + (size_t)cur.pn * tstep;
    PG8_STAGE(PG8_SB(0, 0), cB, voffB); PG8_STAGE(PG8_SA(0, 0), cA, voffA); PG8_STAGE(PG8_SB(0, 1), cB + hstep, voffB); PG8_STAGE(PG8_SA(0, 1), cA + hstep, voffA);
    if (wr == 1) PG8_BAR;
    PG8_WAIT_V(4); PG8_BAR;
    PG8_STAGE(PG8_SB(1, 0), cB + kstep, voffB); PG8_STAGE(PG8_SA(1, 0), cA + kstep, voffA); PG8_STAGE(PG8_SB(1, 1), cB + hstep + kstep, voffB);
    PG8_WAIT_V(6); PG8_BAR;
    for (;;) {
        const bool has_next = S.next(ui + 1, nxt);
        const char* nA = has_next ? (const char*)g.A + (size_t)nxt.pm * tstep : cA; const char* nB = has_next ? (const char*)g.Bt + (size_t)nxt.pn * tstep : cB;
        for (int t = 0; t < nt; t += 2) {
            const bool last = (t == nt - 2);
            const char* a1 = cA + (size_t)(t + 1) * kstep;
            const char* a2 = last ? nA : cA + (size_t)(t + 2) * kstep; const char* b2 = last ? nB : cB + (size_t)(t + 2) * kstep;
            const char* a3 = a2 + kstep; const char* b3 = b2 + kstep;
            PG8_LDB(B0, 0, 0); PG8_SCHED; PG8_LDA(At, 0, 0); PG8_STAGE(PG8_SA(1, 1), a1 + hstep, voffA);
            PG8_WAIT_L(8); PG8_BAR; PG8_WAIT_L(0); PG8_MMA(0, 0, At, B0); PG8_BAR; PG8_SCHED;
            PG8_LDB(B1, 0, 1); PG8_STAGE(PG8_SB(0, 0), b2, voffB);
            PG8_BAR; PG8_WAIT_L(0); PG8_MMA(0, 1, At, B1); PG8_BAR;
            PG8_LDA(At, 0, 1); PG8_STAGE(PG8_SA(0, 0), a2, voffA);
            PG8_BAR; PG8_WAIT_L(0); PG8_MMA(1, 0, At, B0); PG8_BAR; PG8_SCHED;
            PG8_STAGE(PG8_SB(0, 1), b2 + hstep, voffB);
            PG8_WAIT_V(6); PG8_BAR; PG8_MMA(1, 1, At, B1); PG8_BAR;
            PG8_LDB(B0, 1, 0); PG8_SCHED; PG8_LDA(At, 1, 0); PG8_STAGE(PG8_SA(0, 1), a2 + hstep, voffA);
            PG8_WAIT_L(8); PG8_BAR; PG8_WAIT_L(0); PG8_MMA(0, 0, At, B0); PG8_BAR; PG8_SCHED;
            PG8_LDB(B1, 1, 1); PG8_STAGE(PG8_SB(1, 0), b3, voffB);
            PG8_BAR; PG8_WAIT_L(0); PG8_MMA(0, 1, At, B1); PG8_BAR;
            PG8_LDA(At, 1, 1); PG8_STAGE(PG8_SA(1, 0), a3, voffA);
            PG8_BAR; PG8_WAIT_L(0); PG8_MMA(1, 0, At, B0); PG8_BAR; PG8_SCHED;
            PG8_STAGE(PG8_SB(1, 1), b3 + hstep, voffB);
            PG8_WAIT_V(6); PG8_BAR; PG8_MMA(1, 1, At, B1); PG8_BAR;
        }
        asm volatile("s_nop 7\n\ts_nop 7\n\ts_nop 7" ::: "memory");
        E(acc, cur, wr, wc, fr, fq);
        if (!has_next) break;
#pragma unroll
        for (int a = 0; a < 2; ++a)
#pragma unroll
            for (int b = 0; b < 2; ++b)
#pragma unroll
                for (int m = 0; m < 4; ++m)
#pragma unroll
                    for (int n = 0; n < 2; ++n) acc[a][b][m][n] = (f32x4){0.f, 0.f, 0.f, 0.f};
        cur = nxt; cA = nA; cB = nB; ++ui;
    }
    PG8_WAIT_V(0);
    if (wr == 0) PG8_BAR;
    PG8_BAR;
#undef PG8_SA
#undef PG8_SB
#undef PG8_STAGE
#undef PG8_LDA
#undef PG8_LDB
#undef PG8_MMA
#undef PG8_WAIT_V
#undef PG8_WAIT_L
#undef PG8_BAR
#undef PG8_SCHED
}
}
using pg8::Unit;

struct EpiProj {
    u16* projA; u16* projB; float* shift_p; float* shift_s;
    __device__ __forceinline__ void operator()(const f32x4 (&acc)[2][2][4][2], const Unit& u, int wr, int wc, int fr, int fq) const {
        const int row0 = u.pm * 256 + wr * 64 + fr;
        const bool isA = u.pn < 7;
        u16* base = isA ? projA : projB;
        const int colt = (isA ? u.pn : u.pn - 7) * 256 + wc * 32 + 4 * fq;
#pragma unroll
        for (int ai = 0; ai < 2; ++ai)
#pragma unroll
            for (int m = 0; m < 4; ++m) {
                const int row = row0 + ai * 128 + m * 16;
                u16* rowp = base + (size_t)row * 1792 + colt;
#pragma unroll
                for (int bj = 0; bj < 2; ++bj)
#pragma unroll
                    for (int n = 0; n < 2; ++n) st_bf4_asm(rowp + bj * 128 + n * 16, acc[ai][bj][m][n]);
                if (isA) {
                    float* dst = nullptr;
                    if (row < MP) { if ((row & 2047) == 2047) dst = shift_p + (size_t)(row >> 11) * 1792; }
                    else { const int r = row - MP; if ((r & 3) == 3) dst = shift_s + (size_t)(r >> 2) * 1792; }
                    if (dst) {
#pragma unroll
                        for (int bj = 0; bj < 2; ++bj)
#pragma unroll
                            for (int n = 0; n < 2; ++n) *(f32x4*)(dst + colt + bj * 128 + n * 16) = acc[ai][bj][m][n];
                    }
                }
            }
    }
};
struct EpiResid {
    const float* base; float* out;
    __device__ __forceinline__ void operator()(const f32x4 (&acc)[2][2][4][2], const Unit& u, int wr, int wc, int fr, int fq) const {
        const int row0 = u.pm * 256 + wr * 64 + fr, col0 = u.pn * 256 + wc * 32 + 4 * fq;
#pragma unroll
        for (int ai = 0; ai < 2; ++ai)
#pragma unroll
            for (int m = 0; m < 4; ++m) {
                const size_t off = (size_t)(row0 + ai * 128 + m * 16) * 1024 + col0;
#pragma unroll
                for (int bj = 0; bj < 2; ++bj)
#pragma unroll
                    for (int n = 0; n < 2; ++n) { const f32x4 b = *(const f32x4*)(base + off + bj * 128 + n * 16); *(f32x4*)(out + off + bj * 128 + n * 16) = b * ALPHA + acc[ai][bj][m][n]; }
            }
    }
};
struct EpiUp {
    u16* gate; u16* val; float* conv_p; float* conv_s;
    __device__ __forceinline__ void operator()(const f32x4 (&acc)[2][2][4][2], const Unit& u, int wr, int wc, int fr, int fq) const {
        const int row0 = u.pm * 256 + wr * 64 + fr;
        const bool isG = u.pn < 11;
        u16* base = isG ? gate : val;
        const int colt = (isG ? u.pn : u.pn - 11) * 256 + wc * 32 + 4 * fq;
#pragma unroll
        for (int ai = 0; ai < 2; ++ai)
#pragma unroll
            for (int m = 0; m < 4; ++m) {
                const int row = row0 + ai * 128 + m * 16;
                u16* rowp = base + (size_t)row * DFF + colt;
#pragma unroll
                for (int bj = 0; bj < 2; ++bj)
#pragma unroll
                    for (int n = 0; n < 2; ++n) st_bf4_asm(rowp + bj * 128 + n * 16, acc[ai][bj][m][n]);
                if (isG) {
                    float* dst = nullptr;
                    if (row < MP) { const int t = row & 2047; if (t >= 2046) dst = conv_p + (size_t)((row >> 11) * 2 + (t - 2046)) * DFF; }
                    else { const int r = row - MP, t = r & 3; if (t >= 2) dst = conv_s + (size_t)((r >> 2) * 2 + (t - 2)) * DFF; }
                    if (dst) {
#pragma unroll
                        for (int bj = 0; bj < 2; ++bj)
#pragma unroll
                            for (int n = 0; n < 2; ++n) *(f32x4*)(dst + colt + bj * 128 + n * 16) = acc[ai][bj][m][n];
                    }
                }
            }
    }
};

__device__ void small_gemm_resid(const u16* __restrict__ A, const u16* __restrict__ Bt, int K, const float* __restrict__ base, float* __restrict__ out, PG8_LAS unsigned char* lds) {
    const int t = opaque_tid(), wid = t >> 6, lane = t & 63, fr = lane & 15, fq = lane >> 4;
    const int kw = K >> 3, nks = kw >> 5;
    for (int tile = opaque_bid(); tile < 256; tile += gridDim.x) {
        const int r0 = MP + (tile >> 4) * 32, c0 = (tile & 15) * 64;
        f32x4 acc[2][4];
#pragma unroll
        for (int mi = 0; mi < 2; ++mi)
#pragma unroll
            for (int ni = 0; ni < 4; ++ni) acc[mi][ni] = (f32x4){0.f, 0.f, 0.f, 0.f};
#pragma unroll 2
        for (int ks = 0; ks < nks; ++ks) {
            const int k = wid * kw + ks * 32 + fq * 8;
            bf16x8 a[2], b[4];
#pragma unroll
            for (int mi = 0; mi < 2; ++mi) a[mi] = *(const bf16x8*)(A + (size_t)(r0 + mi * 16 + fr) * K + k);
#pragma unroll
            for (int ni = 0; ni < 4; ++ni) b[ni] = *(const bf16x8*)(Bt + (size_t)(c0 + ni * 16 + fr) * K + k);
#pragma unroll
            for (int mi = 0; mi < 2; ++mi)
#pragma unroll
                for (int ni = 0; ni < 4; ++ni) acc[mi][ni] = __builtin_amdgcn_mfma_f32_16x16x32_bf16(b[ni], a[mi], acc[mi][ni], 0, 0, 0);
        }
        PG8_LAS f32x4* red = (PG8_LAS f32x4*)lds;
#pragma unroll
        for (int mi = 0; mi < 2; ++mi)
#pragma unroll
            for (int ni = 0; ni < 4; ++ni) red[(wid * 8 + mi * 4 + ni) * 64 + lane] = acc[mi][ni];
        __syncthreads();
        {
            f32x4 sum = (f32x4){0.f, 0.f, 0.f, 0.f};
#pragma unroll
            for (int w = 0; w < 8; ++w) sum += red[(w * 8 + wid) * 64 + lane];
            const int mi = wid >> 2, ni = wid & 3;
            const size_t off = (size_t)(r0 + mi * 16 + fr) * 1024 + c0 + ni * 16 + 4 * fq;
            *(f32x4*)(out + off) = *(const f32x4*)(base + off) * ALPHA + sum;
        }
        __syncthreads();
    }
}

__device__ __forceinline__ void transpose_tile(const float* __restrict__ src, u16* __restrict__ dst, int K, int N, int nT, int item, float* tile) {
    const int t = opaque_tid();
    const int kt = item / nT, ntile = item - kt * nT, k0 = kt * 64, n0 = ntile * 64;
    { const int row = t >> 3, c8 = (t & 7) * 8;
      f32x4 a = (f32x4){0.f, 0.f, 0.f, 0.f}, b = a;
      if (n0 + c8 < N) { const float* sp = src + (size_t)(k0 + row) * N + n0 + c8; a = *(const f32x4*)sp; b = *(const f32x4*)(sp + 4); }
      float* tp = tile + row * 65 + c8;
      tp[0] = a[0]; tp[1] = a[1]; tp[2] = a[2]; tp[3] = a[3]; tp[4] = b[0]; tp[5] = b[1]; tp[6] = b[2]; tp[7] = b[3]; }
    __syncthreads();
    { const int n = t >> 3, k8 = (t & 7) * 8;
      float v[8];
#pragma unroll
      for (int j = 0; j < 8; ++j) v[j] = tile[(k8 + j) * 65 + n];
      u32x4 w; w.x = cvt_pk_bf16(v[0], v[1]); w.y = cvt_pk_bf16(v[2], v[3]); w.z = cvt_pk_bf16(v[4], v[5]); w.w = cvt_pk_bf16(v[6], v[7]);
      *(u32x4*)(dst + (size_t)(n0 + n) * K + k0 + k8) = w; }
    __syncthreads();
}
__device__ __forceinline__ void small_transpose(const float* __restrict__ src, u16* __restrict__ dst, int K, int N, int Kpad, size_t gt, size_t nth) {
    for (size_t i = gt; i < (size_t)N * Kpad; i += nth) { const int n = (int)(i / Kpad), k = (int)(i - (size_t)n * Kpad); const float v = k < K ? src[(size_t)k * N + n] : 0.f; dst[i] = (u16)(cvt_pk_bf16(v, 0.f) & 0xffffu); }
}
__device__ void convert_phase(KP p, int l, float* tile) {
    unsigned char* ws = p->ws;
    const int bid = opaque_bid();
    const size_t gt = (size_t)bid * 512 + opaque_tid(), nth = (size_t)gridDim.x * 512;
    constexpr int n1 = 16 * 56, n2 = 16 * 16, n3 = 16 * 88, n4 = 44 * 16;
    for (int it = bid; it < n1 + n2 + n3 + n4; it += gridDim.x) {
        if (it < n1) transpose_tile(p->in[I_WIN] + (size_t)l * 1024 * 3344, (u16*)(ws + W_WIN), 1024, 3344, 56, it, tile);
        else if (it < n1 + n2) transpose_tile(p->in[I_WOUT] + (size_t)l * 1024 * 1024, (u16*)(ws + W_WOUT), 1024, 1024, 16, it - n1, tile);
        else if (it < n1 + n2 + n3) transpose_tile(p->in[I_WUP] + (size_t)l * 1024 * 5632, (u16*)(ws + W_WUP), 1024, 5632, 88, it - n1 - n2, tile);
        else transpose_tile(p->in[I_WDOWN] + (size_t)l * 2816 * 1024, (u16*)(ws + W_WDOWN), 2816, 1024, 16, it - n1 - n2 - n3, tile);
    }
    small_transpose(p->in[I_WLU] + (size_t)l * 64 * 512, (u16*)(ws + W_WLT), 64, 512, 64, gt, nth);
    small_transpose(p->in[I_ALU] + (size_t)l * 64 * 512, (u16*)(ws + W_ALT), 64, 512, 64, gt, nth);
    small_transpose(p->in[I_GLU] + (size_t)l * 128 * 512, (u16*)(ws + W_GLT), 128, 512, 128, gt, nth);
    if (l > 0) {
        small_transpose(p->in[I_VD] + (size_t)(l - 1) * 512 * 32, (u16*)(ws + W_V1T), 512, 32, 512, gt, nth);
        small_transpose(p->in[I_VU] + (size_t)(l - 1) * 32 * 512, (u16*)(ws + W_V2T), 32, 512, 32, gt, nth);
    }
    small_transpose(p->in[I_FUP] + (size_t)l * 16 * 256, (u16*)(ws + W_FT), 16, 256, 32, gt, nth);
    if (l == 0) {
        float* xa = p->out + O_Y; u16* xb = (u16*)(ws + W_XB);
        for (size_t i = gt; i < (size_t)MTOK * 256; i += nth) {
            const size_t e = i * 4;
            const f32x4 v = e < (size_t)MP * 1024 ? *(const f32x4*)(p->in[I_XP] + e) : *(const f32x4*)(p->in[I_XS] + (e - (size_t)MP * 1024));
            *(f32x4*)(xa + e) = v; st_bf4(xb + e, v);
        }
    }
}

__device__ void ln_phase(float* Y, u16* xb, const float* __restrict__ g, const float* __restrict__ b) {
    const int tt_ = opaque_tid();
    const int lane = tt_ & 63, gw = opaque_bid() * 8 + (tt_ >> 6), nw = gridDim.x * 8;
    f32x4 gv[4], bv[4];
#pragma unroll
    for (int i = 0; i < 4; ++i) { gv[i] = *(const f32x4*)(g + i * 256 + lane * 4); bv[i] = *(const f32x4*)(b + i * 256 + lane * 4); }
    for (int row = gw; row < MTOK; row += nw) {
        float* yp = Y + (size_t)row * 1024 + lane * 4;
        f32x4 v[4]; float s = 0.f;
#pragma unroll
        for (int i = 0; i < 4; ++i) { v[i] = *(const f32x4*)(yp + i * 256); s += (v[i][0] + v[i][1]) + (v[i][2] + v[i][3]); }
#pragma unroll
        for (int o = 32; o >= 1; o >>= 1) s += __shfl_xor(s, o);
        const float mu = s * (1.0f / 1024.0f); float q = 0.f;
#pragma unroll
        for (int i = 0; i < 4; ++i) { const f32x4 d = v[i] - mu; q += (d[0] * d[0] + d[1] * d[1]) + (d[2] * d[2] + d[3] * d[3]); }
#pragma unroll
        for (int o = 32; o >= 1; o >>= 1) q += __shfl_xor(q, o);
        const float rstd = rsqrtf(q * (1.0f / 1024.0f) + LN_EPS);
#pragma unroll
        for (int i = 0; i < 4; ++i) { const f32x4 o = (v[i] - mu) * rstd * gv[i] + bv[i]; *(f32x4*)(yp + i * 256) = o; st_bf4(xb + (size_t)row * 1024 + i * 256 + lane * 4, o); }
    }
}

__device__ __forceinline__ void unpack8(const u32x4 w, float* f) { f[0] = bflo(w.x); f[1] = bfhi(w.x); f[2] = bflo(w.y); f[3] = bfhi(w.y); f[4] = bflo(w.z); f[5] = bfhi(w.z); f[6] = bflo(w.w); f[7] = bfhi(w.w); }
__device__ __forceinline__ float gelu_as(float v) {
    const float av = fabsf(v), t = __builtin_amdgcn_rcpf(av * 0.2316418882f + 1.0f);
    float q = t * 0.5307027145f + (-0.7265760135f); q = q * t + 0.7107068705f; q = q * t + (-0.142248368f); q = q * t + 0.127414796f; q = q * t;
    const float e = __builtin_amdgcn_exp2f((v * v) * (-0.72134752044f));
    const float m = v * (q * e);
    return v < 0.f ? m : v - m;
}
__device__ void convglu_phase(const u16* __restrict__ gate, u16* val, const float* __restrict__ past  , const float* __restrict__ cw, const float* __restrict__ cb) {
    const size_t gt = (size_t)opaque_bid() * 512 + opaque_tid(), nth = (size_t)gridDim.x * 512;
    for (size_t idx = gt; idx < (size_t)(MTOK / 4) * 352; idx += nth) {
        const int rg = (int)(idx / 352), c = (int)(idx - (size_t)rg * 352) * 8, row0 = rg * 4;
        bool first; const float* pst = nullptr;
        if (row0 < MP) first = (row0 & 2047) == 0; else { first = true; pst = past + (size_t)((row0 - MP) >> 2) * 2 * DFF; }
        float w0[8], w1[8], w2[8], bb[8], gm2[8], gm1[8];
#pragma unroll
        for (int j = 0; j < 8; ++j) { w0[j] = cw[c + j]; w1[j] = cw[DFF + c + j]; w2[j] = cw[2 * DFF + c + j]; bb[j] = cb[c + j]; }
        if (!first) { unpack8(*(const u32x4*)(gate + (size_t)(row0 - 2) * DFF + c), gm2); unpack8(*(const u32x4*)(gate + (size_t)(row0 - 1) * DFF + c), gm1); }
        else {
#pragma unroll
            for (int j = 0; j < 8; ++j) { gm2[j] = pst ? pst[c + j] : 0.f; gm1[j] = pst ? pst[DFF + c + j] : 0.f; } }
#pragma unroll
        for (int r = 0; r < 4; ++r) {
            float g0[8], vv[8], h[8];
            unpack8(*(const u32x4*)(gate + (size_t)(row0 + r) * DFF + c), g0);
            unpack8(*(const u32x4*)(val + (size_t)(row0 + r) * DFF + c), vv);
#pragma unroll
            for (int j = 0; j < 8; ++j) { const float a = bb[j] + gm2[j] * w0[j] + gm1[j] * w1[j] + g0[j] * w2[j]; h[j] = gelu_as(a) * vv[j]; gm2[j] = gm1[j]; gm1[j] = g0[j]; }
            u32x4 w; w.x = cvt_pk_bf16(h[0], h[1]); w.y = cvt_pk_bf16(h[2], h[3]); w.z = cvt_pk_bf16(h[4], h[5]); w.w = cvt_pk_bf16(h[6], h[7]);
            *(u32x4*)(val + (size_t)(row0 + r) * DFF + c) = w;
        }
    }
}

struct PrepCtx {
    const u16* projA; const u16* projB; const float* mu; const float* sshift  ;
};
__device__ __forceinline__ f32x4 xs4(const PrepCtx& c, int i, int col) {
    const f32x4 cur = ld_bf4(c.projA + (size_t)i * 1792 + col);
    f32x4 prev;
    bool first; int b = 0;
    if (i < MP) first = (i & 2047) == 0; else { const int r = i - MP; first = (r & 3) == 0; b = r >> 2; }
    if (!first) prev = ld_bf4(c.projA + (size_t)(i - 1) * 1792 + col);
    else if (i < MP) prev = (f32x4){0.f, 0.f, 0.f, 0.f};
    else prev = *(const f32x4*)(c.sshift + (size_t)b * 1792 + col);
    const f32x4 m = *(const f32x4*)(c.mu + col);
    return cur + (prev - cur) * m;
}
__device__ __forceinline__ bf16x8 ldg_frag(const u16* p) { return *(const bf16x8*)p; }

__device__ void prep_phase(KP p, int l, PG8_LAS unsigned char* lds) {
    unsigned char* ws = p->ws;
    PrepCtx c; c.projA = (const u16*)(ws + W_PROJA); c.projB = (const u16*)(ws + W_PROJB); c.mu = p->in[I_MU] + (size_t)l * 1792; c.sshift = p->in[I_SSHIFT] + (size_t)l * 128 * 1792;
    const u16* wlT = (const u16*)(ws + W_WLT); const u16* alT = (const u16*)(ws + W_ALT); const u16* glT = (const u16*)(ws + W_GLT);
    const u16* v1T = (const u16*)(ws + W_V1T); const u16* v2T = (const u16*)(ws + W_V2T); const u16* fT = (const u16*)(ws + W_FT);
    u32x4* A16 = (u32x4*)(ws + W_BUFB); float* D8 = (float*)(ws + W_D8); u16* vbuf = (u16*)(ws + W_VBUF); u16* gbuf = (u16*)(ws + W_GBUF);
    float* decb = (float*)(ws + W_DEC); float* rkb = (float*)(ws + W_RK); u16* vfirst = (u16*)(ws + W_VFIRST);
    const float* w0 = p->in[I_W0] + l * 512; const float* a0 = p->in[I_A0] + l * 512; const float* k_k = p->in[I_KK] + l * 512; const float* k_a = p->in[I_KA] + l * 512;
    const float* r_k = p->in[I_RK] + l * 512; const float* vb = l > 0 ? p->in[I_VB] + (l - 1) * 512 : nullptr; const float* fbias = p->in[I_FB] + l * 256;
    constexpr int S_TW = 144, S_AL = 144, S_SG = 272, S_XV = 1040, S_FL = 80, S_PP = 80;
    constexpr int O_TW = 0, O_AL = O_TW + 16 * S_TW, O_SG = O_AL + 16 * S_AL, O_XV = O_SG + 16 * S_SG, O_FL = O_XV + 16 * S_XV, O_PP = O_FL + 16 * S_FL;
    const int t = opaque_tid(), wid = t >> 6, lane = t & 63, fr = lane & 15, fq = lane >> 4, h = wid;
    for (int blk = opaque_bid(); blk < MTOK / 16; blk += gridDim.x) {
        const int i0 = blk * 16;
#pragma unroll 1
        for (int q = 0; q < 6; ++q) {
            const int op = t + 512 * q, r = op / 192, g4 = op - r * 192, col = 1024 + 4 * g4;
            f32x4 x = xs4(c, i0 + r, col);
            int off;
            if (col < 1536) off = O_XV + r * S_XV + (col - 1024) * 2;
            else if (col < 1600) { off = O_TW + r * S_TW + (col - 1536) * 2; x = (f32x4){tanhf_(x[0]), tanhf_(x[1]), tanhf_(x[2]), tanhf_(x[3])}; }
            else if (col < 1664) off = O_AL + r * S_AL + (col - 1600) * 2;
            else { off = O_SG + r * S_SG + (col - 1664) * 2; x = (f32x4){sigmoidf_(x[0]), sigmoidf_(x[1]), sigmoidf_(x[2]), sigmoidf_(x[3])}; }
            u32x2 w; w.x = cvt_pk_bf16(x[0], x[1]); w.y = cvt_pk_bf16(x[2], x[3]);
            *(PG8_LAS u32x2*)(lds + off) = w;
        }
        if (t < 128) { const int r = t >> 3, c4 = (t & 7) * 4; u32x2 w = (u32x2){0u, 0u}; if (c4 < 16) w = *(const u32x2*)(c.projB + (size_t)(i0 + r) * 1792 + 1536 + c4); *(PG8_LAS u32x2*)(lds + O_FL + r * S_FL + c4 * 2) = w; }
        __syncthreads();
        bf16x8 pfrag = (bf16x8){0, 0, 0, 0, 0, 0, 0, 0};
        if (l > 0) {
            f32x4 accP0 = (f32x4){0.f, 0.f, 0.f, 0.f}, accP1 = accP0;
#pragma unroll 4
            for (int ks = 0; ks < 16; ++ks) {
                const bf16x8 af = *(const PG8_LAS bf16x8*)(lds + O_XV + fr * S_XV + (ks * 32 + fq * 8) * 2);
                accP0 = __builtin_amdgcn_mfma_f32_16x16x32_bf16(ldg_frag(v1T + (size_t)fr * 512 + ks * 32 + fq * 8), af, accP0, 0, 0, 0);
                accP1 = __builtin_amdgcn_mfma_f32_16x16x32_bf16(ldg_frag(v1T + (size_t)(16 + fr) * 512 + ks * 32 + fq * 8), af, accP1, 0, 0, 0);
            }
            const u32 w0_ = cvt_pk_bf16(accP0[0], accP0[1]), w1_ = cvt_pk_bf16(accP0[2], accP0[3]), w2_ = cvt_pk_bf16(accP1[0], accP1[1]), w3_ = cvt_pk_bf16(accP1[2], accP1[3]);
            const u32x4 pw = (u32x4){w0_, w1_, w2_, w3_};
            pfrag = __builtin_bit_cast(bf16x8, pw);
        }
        const int i = i0 + fr;
        float ss = 0.f;
#pragma unroll
        for (int n = 0; n < 4; ++n) { const int cb_ = h * 64 + 16 * n + 4 * fq; const f32x4 xk = xs4(c, i, 512 + cb_) * *(const f32x4*)(k_k + cb_); ss += (xk[0] * xk[0] + xk[1] * xk[1]) + (xk[2] * xk[2] + xk[3] * xk[3]); }
        ss += __shfl_xor(ss, 16); ss += __shfl_xor(ss, 32);
        const float inorm = rsqrtf(fmaxf(ss, 1e-24f));
        float rks = 0.f;
#pragma unroll 2
        for (int n = 0; n < 4; ++n) {
            const int cn = h * 64 + 16 * n, cb_ = cn + 4 * fq;
            f32x4 aW = (f32x4){0.f, 0.f, 0.f, 0.f}, aA = aW, aG = aW, aV = aW;
#pragma unroll
            for (int ks = 0; ks < 2; ++ks) {
                aW = __builtin_amdgcn_mfma_f32_16x16x32_bf16(ldg_frag(wlT + (size_t)(cn + fr) * 64 + ks * 32 + fq * 8), *(const PG8_LAS bf16x8*)(lds + O_TW + fr * S_TW + (ks * 32 + fq * 8) * 2), aW, 0, 0, 0);
                aA = __builtin_amdgcn_mfma_f32_16x16x32_bf16(ldg_frag(alT + (size_t)(cn + fr) * 64 + ks * 32 + fq * 8), *(const PG8_LAS bf16x8*)(lds + O_AL + fr * S_AL + (ks * 32 + fq * 8) * 2), aA, 0, 0, 0);
            }
#pragma unroll
            for (int ks = 0; ks < 4; ++ks)
                aG = __builtin_amdgcn_mfma_f32_16x16x32_bf16(ldg_frag(glT + (size_t)(cn + fr) * 128 + ks * 32 + fq * 8), *(const PG8_LAS bf16x8*)(lds + O_SG + fr * S_SG + (ks * 32 + fq * 8) * 2), aG, 0, 0, 0);
            if (l > 0) {
                const u32x2 va = *(const u32x2*)(v2T + (size_t)(cn + fr) * 32 + 4 * fq), vc = *(const u32x2*)(v2T + (size_t)(cn + fr) * 32 + 16 + 4 * fq);
                const u32x4 vw = (u32x4){va.x, va.y, vc.x, vc.y};
                aV = __builtin_amdgcn_mfma_f32_16x16x32_bf16(__builtin_bit_cast(bf16x8, vw), pfrag, aV, 0, 0, 0);
            }
            const f32x4 xr = xs4(c, i, cb_), xk = xs4(c, i, 512 + cb_), xv = xs4(c, i, 1024 + cb_);
            const f32x4 w0v = *(const f32x4*)(w0 + cb_), a0v = *(const f32x4*)(a0 + cb_), kkv = *(const f32x4*)(k_k + cb_), kav = *(const f32x4*)(k_a + cb_), rkv = *(const f32x4*)(r_k + cb_);
            f32x4 vp = xv;
            if (l == 0) st_bf4(vfirst + (size_t)i * 512 + cb_, xv);
            else { const f32x4 vf = ld_bf4(vfirst + (size_t)i * 512 + cb_); const f32x4 vbv = *(const f32x4*)(vb + cb_);
#pragma unroll
                for (int j = 0; j < 4; ++j) vp[j] = xv[j] + (vf[j] - xv[j]) * sigmoidf_(vbv[j] + aV[j]);
            }
            f32x4 dd, kt, kn, bb;
#pragma unroll
            for (int j = 0; j < 4; ++j) {
                const float wv = -softplusf_(-(w0v[j] + aW[j])) - 0.5f;
                dd[j] = __expf(-__expf(wv));
                const float a = sigmoidf_(a0v[j] + aA[j]);
                kn[j] = xk[j] * kkv[j] * inorm;
                kt[j] = xk[j] * (1.0f + (a - 1.0f) * kav[j]);
                bb[j] = kn[j] * a;
                rks += xr[j] * kt[j] * rkv[j];
            }
            const int p0 = 8 * n + 2 * fq;
            u32x4 rec0, rec1;
            rec0.x = cvt_pk_bf16(xr[0], xr[1]); rec0.y = cvt_pk_bf16(kt[0], kt[1]); rec0.z = cvt_pk_bf16(kn[0], kn[1]); rec0.w = cvt_pk_bf16(bb[0], bb[1]);
            rec1.x = cvt_pk_bf16(xr[2], xr[3]); rec1.y = cvt_pk_bf16(kt[2], kt[3]); rec1.z = cvt_pk_bf16(kn[2], kn[3]); rec1.w = cvt_pk_bf16(bb[2], bb[3]);
            u32x4* ap = A16 + ((size_t)i * 8 + h) * 32 + p0;
            ap[0] = rec0; ap[1] = rec1;
            *(f32x4*)(D8 + (size_t)i * 512 + cb_) = dd;
            st_bf4(vbuf + (size_t)i * 512 + cb_, vp);
            st_bf4(gbuf + (size_t)i * 512 + cb_, aG);
        }
        rks += __shfl_xor(rks, 16); rks += __shfl_xor(rks, 32);
        if (fq == 0) rkb[(size_t)i * 8 + h] = rks;
#pragma unroll
        for (int n2 = 0; n2 < 2; ++n2) {
            const int cn = 32 * h + 16 * n2;
            f32x4 aF = (f32x4){0.f, 0.f, 0.f, 0.f};
            aF = __builtin_amdgcn_mfma_f32_16x16x32_bf16(ldg_frag(fT + (size_t)(cn + fr) * 32 + fq * 8), *(const PG8_LAS bf16x8*)(lds + O_FL + fr * S_FL + (fq * 8) * 2), aF, 0, 0, 0);
            const f32x4 fb = *(const f32x4*)(fbias + cn + 4 * fq);
            f32x4 dc;
#pragma unroll
            for (int j = 0; j < 4; ++j) { const float z = aF[j] + fb[j]; dc[j] = __expf(-softplusf_(-z) * (1.0f / 16.0f)); }
            *(f32x4*)(decb + (size_t)i * 256 + cn + 4 * fq) = dc;
        }
        __syncthreads();
    }
}

struct ScanItem {
    int tok0, T, L;
    int h, q;
    int hg, cgp;
    const float* s0_rwkv; float* so_rwkv;
    const float* s0_gla; float* so_gla;
};
template <int LSEG>
__device__ __forceinline__ void scan_item(KP p, const ScanItem& it, PG8_LAS unsigned char* lds) {
    unsigned char* ws = p->ws;
    const u32x4* A16 = (const u32x4*)(ws + W_BUFB); const float* D8 = (const float*)(ws + W_D8); const u16* vbuf = (const u16*)(ws + W_VBUF);
    const u16* projB = (const u16*)(ws + W_PROJB); const float* decb = (const float*)(ws + W_DEC);
    u16* obufA = (u16*)(ws + W_OBUFA); u16* obufB = (u16*)(ws + W_OBUFB);
    const int t = opaque_tid(), wid = t >> 6, lane = t & 63, kq = lane & 15, rsel = lane >> 4;
    constexpr int BUF = 69632, OR = 0, OKT = 8192, OKN = 16384, OB = 24576, OD = 32768, OVR = 40960, OQ = 43008, OK = 51200, ODC = 59392, OVG = 67584;
    const int nchunk = it.T / TC;
    u32x4 sa0, sa1; f32x4 sd, sdec; u32x2 svr = (u32x2){0u, 0u}, sq, sk;
#define SC_GLOAD(ch_) do { const int tk_ = it.tok0 + (ch_) * TC; \
        { const int i0 = t, i1 = t + 512; sa0 = A16[((size_t)(tk_ + (i0 >> 5)) * 8 + it.h) * 32 + (i0 & 31)]; sa1 = A16[((size_t)(tk_ + (i1 >> 5)) * 8 + it.h) * 32 + (i1 & 31)]; } \
        { const int st = t >> 4, c4 = (t & 15) * 4; sd = *(const f32x4*)(D8 + (size_t)(tk_ + st) * 512 + it.h * 64 + c4); \
          sq = *(const u32x2*)(projB + (size_t)(tk_ + st) * 1792 + it.hg * 64 + c4); sk = *(const u32x2*)(projB + (size_t)(tk_ + st) * 1792 + 256 + it.hg * 64 + c4); \
          sdec = *(const f32x4*)(decb + (size_t)(tk_ + st) * 256 + it.hg * 64 + c4); } \
        if (t < 128) { const int st = t >> 2, c4 = (t & 3) * 4; svr = *(const u32x2*)(vbuf + (size_t)(tk_ + st) * 512 + it.h * 64 + it.q * 16 + c4); } \
        else if (t < 256) { const int tt = t - 128, st = tt >> 2, c4 = (tt & 3) * 4; svr = *(const u32x2*)(projB + (size_t)(tk_ + st) * 1792 + 512 + it.hg * 128 + it.cgp * 16 + c4); } } while (0)
#define SC_LSTORE(buf_) do { PG8_LAS unsigned char* b_ = lds + (buf_) * BUF; \
        { const int i0 = t, i1 = t + 512; \
          { const int st = i0 >> 5, pp = i0 & 31; const int o = (st * 64 + 2 * pp) * 4; \
            *(PG8_LAS f32x2*)(b_ + OR + o) = (f32x2){bflo(sa0.x), bfhi(sa0.x)}; *(PG8_LAS f32x2*)(b_ + OKT + o) = (f32x2){bflo(sa0.y), bfhi(sa0.y)}; \
            *(PG8_LAS f32x2*)(b_ + OKN + o) = (f32x2){bflo(sa0.z), bfhi(sa0.z)}; *(PG8_LAS f32x2*)(b_ + OB + o) = (f32x2){bflo(sa0.w), bfhi(sa0.w)}; } \
          { const int st = i1 >> 5, pp = i1 & 31; const int o = (st * 64 + 2 * pp) * 4; \
            *(PG8_LAS f32x2*)(b_ + OR + o) = (f32x2){bflo(sa1.x), bfhi(sa1.x)}; *(PG8_LAS f32x2*)(b_ + OKT + o) = (f32x2){bflo(sa1.y), bfhi(sa1.y)}; \
            *(PG8_LAS f32x2*)(b_ + OKN + o) = (f32x2){bflo(sa1.z), bfhi(sa1.z)}; *(PG8_LAS f32x2*)(b_ + OB + o) = (f32x2){bflo(sa1.w), bfhi(sa1.w)}; } } \
        { const int st = t >> 4, c4 = (t & 15) * 4; const int o = (st * 64 + c4) * 4; \
          *(PG8_LAS f32x4*)(b_ + OD + o) = sd; *(PG8_LAS f32x4*)(b_ + ODC + o) = sdec; \
          *(PG8_LAS f32x4*)(b_ + OQ + o) = (f32x4){bflo(sq.x), bfhi(sq.x), bflo(sq.y), bfhi(sq.y)} * 0.125f; \
          *(PG8_LAS f32x4*)(b_ + OK + o) = (f32x4){bflo(sk.x), bfhi(sk.x), bflo(sk.y), bfhi(sk.y)}; } \
        if (t < 128) { const int st = t >> 2, c4 = (t & 3) * 4; *(PG8_LAS f32x4*)(b_ + OVR + (st * 16 + c4) * 4) = (f32x4){bflo(svr.x), bfhi(svr.x), bflo(svr.y), bfhi(svr.y)}; } \
        else if (t < 256) { const int tt = t - 128, st = tt >> 2, c4 = (tt & 3) * 4; *(PG8_LAS f32x4*)(b_ + OVG + (st * 16 + c4) * 4) = (f32x4){bflo(svr.x), bfhi(svr.x), bflo(svr.y), bfhi(svr.y)}; } } while (0)
    const bool isR = wid < 4;
    const int w4 = wid & 3;
    const int row = it.q * 16 + 4 * w4 + rsel;
    const int col = it.cgp * 16 + 4 * w4 + rsel;
    f32x4 S = (f32x4){0.f, 0.f, 0.f, 0.f}, Sn = S;
#define SC_LOAD_STATE(dst_, seg_) do { const int sg_ = (seg_); \
        if (isR) { if (!it.s0_rwkv) dst_ = (f32x4){0.f, 0.f, 0.f, 0.f}; else dst_ = *(const f32x4*)(it.s0_rwkv + (size_t)sg_ * 8 * 4096 + row * 64 + 4 * kq); } \
        else if (!it.s0_gla) dst_ = (f32x4){0.f, 0.f, 0.f, 0.f}; \
        else { const float* sp_ = it.s0_gla + (size_t)sg_ * 4 * 8192 + (size_t)(4 * kq) * 128 + col; dst_ = (f32x4){sp_[0], sp_[128], sp_[256], sp_[384]}; } } while (0)
#define SC_STORE_STATE(seg_, s_) do { const int sg_ = (seg_); \
        if (isR) { *(f32x4*)(it.so_rwkv + (size_t)sg_ * 8 * 4096 + row * 64 + 4 * kq) = s_; } \
        else { float* sp_ = it.so_gla + (size_t)sg_ * 4 * 8192 + (size_t)(4 * kq) * 128 + col; sp_[0] = s_[0]; sp_[128] = s_[1]; sp_[256] = s_[2]; sp_[384] = s_[3]; } } while (0)
    SC_GLOAD(0);
    SC_LOAD_STATE(Sn, 0);
    SC_LSTORE(0);
    __syncthreads();
    u16* oAp = obufA + (size_t)it.tok0 * 512 + it.h * 64 + row;
    u16* oBp = obufB + (size_t)it.tok0 * 512 + it.hg * 128 + col;
    const int vsl = (4 * w4 + rsel) * 4;
#define SC_STEP_R(s_, ov_) do { const int o = ((s_) * 64 + 4 * kq) * 4; \
        const f32x4 r4 = *(const PG8_LAS f32x4*)(b + OR + o), k4 = *(const PG8_LAS f32x4*)(b + OKT + o), n4 = *(const PG8_LAS f32x4*)(b + OKN + o), b4 = *(const PG8_LAS f32x4*)(b + OB + o), d4 = *(const PG8_LAS f32x4*)(b + OD + o); \
        const float v = *(const PG8_LAS float*)(b + OVR + (s_) * 64 + vsl); \
        float dot = (S[0] * n4[0] + S[1] * n4[1]) + (S[2] * n4[2] + S[3] * n4[3]); \
        dot = red16(dot); \
        S = S * d4 - b4 * dot + k4 * v; \
        float o_ = (S[0] * r4[0] + S[1] * r4[1]) + (S[2] * r4[2] + S[3] * r4[3]); \
        (ov_) = red16(o_); } while (0)
#define SC_STEP_G(s_, ov_) do { const int o = ((s_) * 64 + 4 * kq) * 4; \
        const f32x4 q4 = *(const PG8_LAS f32x4*)(b + OQ + o), k4 = *(const PG8_LAS f32x4*)(b + OK + o), d4 = *(const PG8_LAS f32x4*)(b + ODC + o); \
        const float v = *(const PG8_LAS float*)(b + OVG + (s_) * 64 + vsl); \
        S = S * d4 + k4 * v; \
        float o_ = (S[0] * q4[0] + S[1] * q4[1]) + (S[2] * q4[2] + S[3] * q4[3]); \
        (ov_) = red16(o_); } while (0)
#define SC_BLOCK(STEP_, s0_, NB_, optr_) do { float ov[NB_]; \
        _Pragma("unroll") for (int j_ = 0; j_ < (NB_); ++j_) STEP_((s0_) + j_, ov[j_]); \
        float outv = ov[0]; \
        _Pragma("unroll") for (int j_ = 1; j_ < (NB_); ++j_) outv = (kq == j_) ? ov[j_] : outv; \
        if (kq < (NB_)) (optr_)[(size_t)((s0_) + kq) * 512] = (u16)(cvt_pk_bf16(outv, 0.f) & 0xffffu); } while (0)
    for (int ch = 0; ch < nchunk; ++ch) {
        const bool more = ch + 1 < nchunk;
        if (more) SC_GLOAD(ch + 1);
        PG8_LAS unsigned char* b = lds + (ch & 1) * BUF;
        if (LSEG >= TC) {
            if (ch == 0) S = Sn;
            if (isR) {
                {
                    struct InR { f32x4 r4, k4, n4, b4, d4; float v; };
                    InR in_[TC]; float ov[8];
#define LD_R(s_) do { const int o = ((s_) * 64 + 4 * kq) * 4; in_[s_].r4 = *(const PG8_LAS f32x4*)(b + OR + o); in_[s_].k4 = *(const PG8_LAS f32x4*)(b + OKT + o); in_[s_].n4 = *(const PG8_LAS f32x4*)(b + OKN + o); \
                        in_[s_].b4 = *(const PG8_LAS f32x4*)(b + OB + o); in_[s_].d4 = *(const PG8_LAS f32x4*)(b + OD + o); in_[s_].v = *(const PG8_LAS float*)(b + OVR + (s_) * 64 + vsl); } while (0)
#pragma unroll
                    for (int j = 0; j < SC_PD; ++j) LD_R(j);
#pragma unroll
                    for (int s = 0; s < TC; ++s) {
                        float dot = (S[0] * in_[s].n4[0] + S[1] * in_[s].n4[1]) + (S[2] * in_[s].n4[2] + S[3] * in_[s].n4[3]);
                        dot = red16(dot);
                        S = S * in_[s].d4 - in_[s].b4 * dot + in_[s].k4 * in_[s].v;
                        float o_ = (S[0] * in_[s].r4[0] + S[1] * in_[s].r4[1]) + (S[2] * in_[s].r4[2] + S[3] * in_[s].r4[3]);
                        ov[s & 7] = red16(o_);
                        if (s + SC_PD < TC) LD_R(s + SC_PD);
                        __builtin_amdgcn_sched_barrier(0);
                        if ((s & 7) == 7) { float outv = ov[0];
#pragma unroll
                            for (int j = 1; j < 8; ++j) outv = (kq == j) ? ov[j] : outv;
                            if (kq < 8) oAp[(size_t)((s & ~7) + kq) * 512] = (u16)(cvt_pk_bf16(outv, 0.f) & 0xffffu); }
                    }
#undef LD_R
                }
            } else {
                {
                    struct InG { f32x4 q4, k4, d4; float v; };
                    InG in_[TC]; float ov[8];
#define LD_G(s_) do { const int o = ((s_) * 64 + 4 * kq) * 4; in_[s_].q4 = *(const PG8_LAS f32x4*)(b + OQ + o); in_[s_].k4 = *(const PG8_LAS f32x4*)(b + OK + o); in_[s_].d4 = *(const PG8_LAS f32x4*)(b + ODC + o); \
                        in_[s_].v = *(const PG8_LAS float*)(b + OVG + (s_) * 64 + vsl); } while (0)
#pragma unroll
                    for (int j = 0; j < SC_PD; ++j) LD_G(j);
#pragma unroll
                    for (int s = 0; s < TC; ++s) {
                        S = S * in_[s].d4 + in_[s].k4 * in_[s].v;
                        float o_ = (S[0] * in_[s].q4[0] + S[1] * in_[s].q4[1]) + (S[2] * in_[s].q4[2] + S[3] * in_[s].q4[3]);
                        ov[s & 7] = red16(o_);
                        if (s + SC_PD < TC) LD_G(s + SC_PD);
                        __builtin_amdgcn_sched_barrier(0);
                        if ((s & 7) == 7) { float outv = ov[0];
#pragma unroll
                            for (int j = 1; j < 8; ++j) outv = (kq == j) ? ov[j] : outv;
                            if (kq < 8) oBp[(size_t)((s & ~7) + kq) * 512] = (u16)(cvt_pk_bf16(outv, 0.f) & 0xffffu); }
                    }
#undef LD_G
                }
            }
            if (!more) SC_STORE_STATE(0, S);
        } else {
#pragma unroll 1
            for (int sgi = 0; sgi < TC / LSEG; ++sgi) {
                const int seg = ch * (TC / LSEG) + sgi;
                S = Sn;
                if ((seg + 1) * LSEG < it.T) SC_LOAD_STATE(Sn, seg + 1);
                if (isR) {
                    SC_BLOCK(SC_STEP_R, sgi * LSEG, (LSEG < TC ? LSEG : 1), oAp);
                } else {
                    SC_BLOCK(SC_STEP_G, sgi * LSEG, (LSEG < TC ? LSEG : 1), oBp);
                }
                SC_STORE_STATE(seg, S);
            }
        }
        oAp += (size_t)TC * 512; oBp += (size_t)TC * 512;
        if (more) SC_LSTORE((ch + 1) & 1);
        __syncthreads();
    }
#undef SC_BLOCK
#undef SC_STEP_R
#undef SC_STEP_G
}
__device__ void scan_phase(KP p, int l, PG8_LAS unsigned char* lds) {
    float* out = p->out;
    const int bid = opaque_bid();
    for (int i = bid; i < 256; i += gridDim.x) {
        ScanItem it; const int s = i >> 5;
        it.tok0 = s * 2048; it.T = 2048; it.L = 2048; it.h = (i >> 2) & 7; it.q = i & 3; it.hg = (i >> 3) & 3; it.cgp = i & 7;
        it.s0_rwkv = nullptr; it.so_rwkv = out + O_RWKV_P + ((size_t)(l * 8 + s) * 8 + it.h) * 4096;
        it.s0_gla = nullptr; it.so_gla = out + O_GLA_P + ((size_t)(l * 8 + s) * 4 + it.hg) * 8192;
        scan_item<2048>(p, it, lds);
    }
    for (int i = bid; i < 256; i += gridDim.x) {
        ScanItem it; const int bg = i >> 5, b0 = bg * 16;
        it.tok0 = MP + bg * 64; it.T = 64; it.L = 4; it.h = (i >> 2) & 7; it.q = i & 3; it.hg = (i >> 3) & 3; it.cgp = i & 7;
        it.s0_rwkv = p->in[I_SRWKV] + ((size_t)(l * 128 + b0) * 8 + it.h) * 4096; it.so_rwkv = out + O_RWKV_S + ((size_t)(l * 128 + b0) * 8 + it.h) * 4096;
        it.s0_gla = p->in[I_SGLA] + ((size_t)(l * 128 + b0) * 4 + it.hg) * 8192; it.so_gla = out + O_GLA_S + ((size_t)(l * 128 + b0) * 4 + it.hg) * 8192;
        scan_item<4>(p, it, lds);
    }
}

__device__ void post_phase(KP p, int l) {
    unsigned char* ws = p->ws;
    const u16* obufA = (const u16*)(ws + W_OBUFA); const u16* obufB = (const u16*)(ws + W_OBUFB); const u16* vbuf = (const u16*)(ws + W_VBUF); const u16* gbuf = (const u16*)(ws + W_GBUF);
    const float* rkb = (const float*)(ws + W_RK); const u16* projB = (const u16*)(ws + W_PROJB); u16* oab = (u16*)(ws + W_XB);
    const float* lg = p->in[I_LNXG] + l * 512; const float* lb = p->in[I_LNXB] + l * 512; const float* ng = p->in[I_NG] + l * 128;
    const int tt_ = opaque_tid();
    const int lane = tt_ & 63, gw = opaque_bid() * 8 + (tt_ >> 6), nw = gridDim.x * 8;
    const int c = lane * 8;
    float lgv[8], lbv[8], ngv[8];
#pragma unroll
    for (int j = 0; j < 8; ++j) { lgv[j] = lg[c + j]; lbv[j] = lb[c + j]; ngv[j] = ng[(c & 127) + j]; }
    for (int i = gw; i < MTOK; i += nw) {
        {
            const f32x4 o0 = ld_bf4(obufA + (size_t)i * 512 + c), o1 = ld_bf4(obufA + (size_t)i * 512 + c + 4);
            const f32x4 v0 = ld_bf4(vbuf + (size_t)i * 512 + c), v1 = ld_bf4(vbuf + (size_t)i * 512 + c + 4);
            const f32x4 g0 = ld_bf4(gbuf + (size_t)i * 512 + c), g1 = ld_bf4(gbuf + (size_t)i * 512 + c + 4);
            const float rk = rkb[(size_t)i * 8 + (lane >> 3)];
            float s = (o0[0] + o0[1]) + (o0[2] + o0[3]) + (o1[0] + o1[1]) + (o1[2] + o1[3]);
            s += __shfl_xor(s, 1); s += __shfl_xor(s, 2); s += __shfl_xor(s, 4);
            const float m = s * (1.0f / 64.0f);
            const f32x4 d0 = o0 - m, d1 = o1 - m;
            float q = (d0[0] * d0[0] + d0[1] * d0[1]) + (d0[2] * d0[2] + d0[3] * d0[3]) + (d1[0] * d1[0] + d1[1] * d1[1]) + (d1[2] * d1[2] + d1[3] * d1[3]);
            q += __shfl_xor(q, 1); q += __shfl_xor(q, 2); q += __shfl_xor(q, 4);
            const float rs = rsqrtf(q * (1.0f / 64.0f) + GN_EPS_A);
            f32x4 y0, y1;
#pragma unroll
            for (int j = 0; j < 4; ++j) { y0[j] = (d0[j] * rs * lgv[j] + lbv[j] + rk * v0[j]) * g0[j]; y1[j] = (d1[j] * rs * lgv[4 + j] + lbv[4 + j] + rk * v1[j]) * g1[j]; }
            u32x4 w; w.x = cvt_pk_bf16(y0[0], y0[1]); w.y = cvt_pk_bf16(y0[2], y0[3]); w.z = cvt_pk_bf16(y1[0], y1[1]); w.w = cvt_pk_bf16(y1[2], y1[3]);
            *(u32x4*)(oab + (size_t)i * 1024 + c) = w;
        }
        {
            const f32x4 o0 = ld_bf4(obufB + (size_t)i * 512 + c), o1 = ld_bf4(obufB + (size_t)i * 512 + c + 4);
            const f32x4 g0 = ld_bf4(projB + (size_t)i * 1792 + 1024 + c), g1 = ld_bf4(projB + (size_t)i * 1792 + 1024 + c + 4);
            float q = (o0[0] * o0[0] + o0[1] * o0[1]) + (o0[2] * o0[2] + o0[3] * o0[3]) + (o1[0] * o1[0] + o1[1] * o1[1]) + (o1[2] * o1[2] + o1[3] * o1[3]);
            q += __shfl_xor(q, 1); q += __shfl_xor(q, 2); q += __shfl_xor(q, 4); q += __shfl_xor(q, 8);
            const float rs = rsqrtf(q * (1.0f / 128.0f) + RMS_EPS);
            f32x4 y0, y1;
#pragma unroll
            for (int j = 0; j < 4; ++j) { y0[j] = o0[j] * rs * ngv[j] * (g0[j] * sigmoidf_(g0[j])); y1[j] = o1[j] * rs * ngv[4 + j] * (g1[j] * sigmoidf_(g1[j])); }
            u32x4 w; w.x = cvt_pk_bf16(y0[0], y0[1]); w.y = cvt_pk_bf16(y0[2], y0[3]); w.z = cvt_pk_bf16(y1[0], y1[1]); w.w = cvt_pk_bf16(y1[2], y1[3]);
            *(u32x4*)(oab + (size_t)i * 1024 + 512 + c) = w;
        }
    }
}

#define XB_TMO      128
#define XB_XCNT(j)  (256  + 64 * (j))
#define XB_XSUB(j)  (1280 + 64 * (j))
#define XB_XGEN(j)  (2304 + 64 * (j))
#define XB_TOP      3328
#define XB_TOPGEN   3392
#define XCD_BAR_WORDS 3456
#define XB_SPIN_CAP (1u << 18)
__device__ __forceinline__ unsigned xb_ld(unsigned* p)              { return __hip_atomic_load(p, __ATOMIC_RELAXED, __HIP_MEMORY_SCOPE_AGENT); }
__device__ __forceinline__ unsigned xb_add(unsigned* p, unsigned v) { return __hip_atomic_fetch_add(p, v, __ATOMIC_RELAXED, __HIP_MEMORY_SCOPE_AGENT); }
__device__ __forceinline__ unsigned xb_xcc_id() { return (unsigned)__builtin_amdgcn_s_getreg((3 << 11) | 20) & 0xFu; }
#define XB_SPIN(cond, bar) do { unsigned _sp = 0; while (cond) { __builtin_amdgcn_s_sleep(1); \
    if ((++_sp & 255u) == 0u) { if (xb_ld(&(bar)[XB_TMO])) break; if (_sp > XB_SPIN_CAP) { atomicAdd(&(bar)[XB_TMO], 1u); break; } } } } while (0)
__device__ __forceinline__ void xcd_barrier_complete(unsigned* bar, unsigned x, unsigned& nloc, unsigned& nx) {
    const unsigned G = gridDim.x * gridDim.y * gridDim.z;
    unsigned sum, cnt, mine, sp = 0u;
    for (;;) {
        sum = 0u; cnt = 0u; mine = 0u;
#pragma unroll
        for (unsigned j = 0; j < 16; ++j) { const unsigned c = xb_ld(&bar[XB_XCNT(j)]); sum += c; cnt += (c > 0u) ? 1u : 0u; mine = (j == x) ? c : mine; }
        if (sum == G) break;
        __builtin_amdgcn_s_sleep(1);
        if ((++sp & 255u) == 0u) { if (xb_ld(&bar[XB_TMO])) break; if (sp > XB_SPIN_CAP) { atomicAdd(&bar[XB_TMO], 1u); break; } }
    }
    nloc = mine > 0u ? mine : 1u; nx = cnt > 0u ? cnt : 1u;
}
__device__ __forceinline__ void xcd_barrier(unsigned* bar, volatile PG8_LAS unsigned* st) {
    asm volatile("s_waitcnt vmcnt(0)" ::: "memory");
    __syncthreads();
    if (threadIdx.x == 0) {
        const unsigned x = xb_xcc_id();
        __builtin_amdgcn_s_waitcnt(0);
        unsigned nloc = st[0], nx = st[1];
        if (nloc == 0u) { xcd_barrier_complete(bar, x, nloc, nx); st[0] = nloc; st[1] = nx; }
        const unsigned old = xb_add(&bar[XB_XSUB(x)], 1u);
        const unsigned gen = old / nloc;
        if (old + 1u == (gen + 1u) * nloc) {
            __builtin_amdgcn_fence(__ATOMIC_RELEASE, "agent");
            asm volatile("s_waitcnt vmcnt(0)" ::: "memory");
            const unsigned og = xb_add(&bar[XB_TOP], 1u);
            const unsigned tg = og / nx;
            if (og + 1u == (tg + 1u) * nx) xb_add(&bar[XB_TOPGEN], 1u);
            else XB_SPIN(xb_ld(&bar[XB_TOPGEN]) == tg, bar);
            __builtin_amdgcn_fence(__ATOMIC_ACQUIRE, "agent");
            xb_add(&bar[XB_XGEN(x)], 1u);
            asm volatile("s_waitcnt vmcnt(0)" ::: "memory");
        } else {
            XB_SPIN(xb_ld(&bar[XB_XGEN(x)]) == gen, bar);
            __builtin_amdgcn_fence(__ATOMIC_ACQUIRE, "agent");
            asm volatile("s_waitcnt vmcnt(0)" ::: "memory");
        }
    }
    __syncthreads();
}
__device__ __forceinline__ void gsync(cg::grid_group& grid) {
    asm volatile("s_waitcnt vmcnt(0)" ::: "memory");
    grid.sync();
    if (threadIdx.x < 64) { __builtin_amdgcn_fence(__ATOMIC_ACQUIRE, "agent"); asm volatile("s_waitcnt vmcnt(0)" ::: "memory"); }
    __syncthreads();
}

__global__ void __launch_bounds__(512, 2) mega(Params p_unused) {
    KP p = kparams();
    extern __shared__ __attribute__((aligned(16))) unsigned char smem[];
    PG8_LAS unsigned char* lds = (PG8_LAS unsigned char*)smem;
    cg::grid_group grid = cg::this_grid();
    unsigned char* ws = p->ws;
    float* bufA = p->out + O_Y; float* bufB = (float*)(ws + W_BUFB); u16* xb = (u16*)(ws + W_XB);
    pg8::StaticOrder S;
    volatile PG8_LAS unsigned* xst = (volatile PG8_LAS unsigned*)(lds + 139264);
    if (threadIdx.x == 0) { xst[0] = 0u; xst[1] = 0u; }
    gsync(grid);
    unsigned* xbar = (unsigned*)(kparams()->ws + W_BAR);
    if (threadIdx.x == 0) (void)xb_add(&xbar[XB_XCNT(xb_xcc_id())], 1u);
#define PHASE_END() xcd_barrier((unsigned*)(kparams()->ws + W_BAR), xst)
    convert_phase(kparams(), 0, (float*)smem);
    PHASE_END();
    for (int l = 0; l < NL; ++l) {
        {
            pg8::Gemm g; g.A = xb; g.Bt = (const u16*)(ws + W_WIN); g.M = MTOK; g.N = INP; g.K = 1024;
            EpiProj E; E.projA = (u16*)(ws + W_PROJA); E.projB = (u16*)(ws + W_PROJB); E.shift_p = p->out + O_SHIFT_P + (size_t)l * 8 * 1792; E.shift_s = p->out + O_SHIFT_S + (size_t)l * 128 * 1792;
            S.init(MTOK, INP, gridDim.x, opaque_bid()); pg8::gemm_phase(lds, g, S, E);
        }
        PHASE_END();
        prep_phase(kparams(), l, lds);
        PHASE_END();
        scan_phase(kparams(), l, lds);
        PHASE_END();
        post_phase(kparams(), l);
        PHASE_END();
        {
            pg8::Gemm g; g.A = xb; g.Bt = (const u16*)(ws + W_WOUT); g.M = MTOK; g.N = 1024; g.K = 1024;
            EpiResid E; E.base = bufA; E.out = bufB;
            g.M = MP; S.init(MP, 1024, gridDim.x, opaque_bid()); pg8::gemm_phase(lds, g, S, E);
            small_gemm_resid(g.A, g.Bt, 1024, E.base, E.out, lds);
        }
        PHASE_END();
        ln_phase(bufB, xb, p->in[I_LN1G] + l * 1024, p->in[I_LN1B] + l * 1024);
        PHASE_END();
        {
            pg8::Gemm g; g.A = xb; g.Bt = (const u16*)(ws + W_WUP); g.M = MTOK; g.N = 5632; g.K = 1024;
            EpiUp E; E.gate = (u16*)(ws + W_GATE); E.val = (u16*)(ws + W_VAL); E.conv_p = p->out + O_CONV_P + (size_t)l * 8 * 2 * DFF; E.conv_s = p->out + O_CONV_S + (size_t)l * 128 * 2 * DFF;
            S.init(MTOK, 5632, gridDim.x, opaque_bid()); pg8::gemm_phase(lds, g, S, E);
        }
        PHASE_END();
        convglu_phase((const u16*)(ws + W_GATE), (u16*)(ws + W_VAL), p->in[I_SCONV] + (size_t)l * 128 * 2 * DFF, p->in[I_CW] + (size_t)l * 3 * DFF, p->in[I_CB] + (size_t)l * DFF);
        PHASE_END();
        {
            pg8::Gemm g; g.A = (const u16*)(ws + W_VAL); g.Bt = (const u16*)(ws + W_WDOWN); g.M = MTOK; g.N = 1024; g.K = DFF;
            EpiResid E; E.base = bufB; E.out = bufA;
            g.M = MP; S.init(MP, 1024, gridDim.x, opaque_bid()); pg8::gemm_phase(lds, g, S, E);
            small_gemm_resid(g.A, g.Bt, DFF, E.base, E.out, lds);
        }
        PHASE_END();
        ln_phase(bufA, xb, p->in[I_LN2G] + l * 1024, p->in[I_LN2B] + l * 1024);
        if (l + 1 < NL) convert_phase(kparams(), l + 1, (float*)smem);
        PHASE_END();
    }
}

extern "C" void kernel_launch(void* const* d_in, const int* in_sizes, int n_in, void* d_out, int out_size, void* d_ws, size_t ws_size, hipStream_t stream) {
    static int grid_blocks = 0;
    if (!grid_blocks) {
        int dev = 0, cus = 0, per_cu = 0;
        (void)hipGetDevice(&dev);
        (void)hipDeviceGetAttribute(&cus, hipDeviceAttributeMultiprocessorCount, dev);
        (void)hipFuncSetAttribute((const void*)mega, hipFuncAttributeMaxDynamicSharedMemorySize, LDS_BYTES);
        (void)hipOccupancyMaxActiveBlocksPerMultiprocessor(&per_cu, (const void*)mega, 512, LDS_BYTES);
        grid_blocks = cus;
        if (n_in != 33 || (size_t)out_size != O_END || ws_size < W_TOTAL) { fprintf(stderr, "kernel_launch: unexpected sizes n_in %d out %d ws %zu (need %zu)\n", n_in, out_size, ws_size, (size_t)W_TOTAL); grid_blocks = -1; }
    }
    if (grid_blocks < 0) return;
    (void)hipMemsetAsync((unsigned char*)d_ws + W_BAR, 0, XCD_BAR_WORDS * sizeof(unsigned), stream);
    Params p{};
    for (int i = 0; i < 33; ++i) p.in[i] = (const float*)d_in[i];
    p.out = (float*)d_out; p.ws = (unsigned char*)d_ws;
    void* args[] = {&p};
    hipError_t e = hipLaunchCooperativeKernel((const void*)mega, dim3(grid_blocks), dim3(512), args, LDS_BYTES, stream);
    if (e != hipSuccess) fprintf(stderr, "cooperative launch failed: %s (grid %d)\n", hipGetErrorString(e), grid_blocks);
}
```

```cpp
#include <hip/hip_runtime.h>
#include <hip/hip_cooperative_groups.h>
#include <cstdio>
namespace cg = cooperative_groups;

#define PG8_LAS __attribute__((address_space(3)))
typedef unsigned short u16;
typedef unsigned int u32;
typedef unsigned short bf16_t;
typedef short bf16x8 __attribute__((ext_vector_type(8)));
typedef float f32x4 __attribute__((ext_vector_type(4)));
typedef float f32x2 __attribute__((ext_vector_type(2)));
typedef unsigned u32x4 __attribute__((ext_vector_type(4)));
typedef unsigned u32x2 __attribute__((ext_vector_type(2)));

constexpr int MTOK = 16896, MP = 16384, DM = 1024, NL = 4;
constexpr int SHIFT_W = 1792, INP = 3584, DFF = 2816;
constexpr float ALPHA = 1.6817928305074290f;
constexpr float GN_EPS_A = 64e-5f, RMS_EPS = 1e-5f, LN_EPS = 1e-5f;
constexpr int LDS_BYTES = 139264 + 16;
constexpr int TC = 32;
#define SC_PD 3

enum { I_XP = 0, I_XS, I_SRWKV, I_SSHIFT, I_SGLA, I_SCONV, I_WIN, I_MU, I_W0, I_WLU, I_A0, I_ALU, I_GLU, I_KK, I_KA, I_RK, I_LNXG, I_LNXB,
       I_VB, I_VD, I_VU, I_FUP, I_FB, I_NG, I_WOUT, I_LN1G, I_LN1B, I_WUP, I_CW, I_CB, I_WDOWN, I_LN2G, I_LN2B };

constexpr size_t O_Y = 0;
constexpr size_t O_RWKV_P = (size_t)MTOK * DM;
constexpr size_t O_RWKV_S = O_RWKV_P + (size_t)4 * 8 * 8 * 4096;
constexpr size_t O_SHIFT_P = O_RWKV_S + (size_t)4 * 128 * 8 * 4096;
constexpr size_t O_SHIFT_S = O_SHIFT_P + (size_t)4 * 8 * 1792;
constexpr size_t O_GLA_P = O_SHIFT_S + (size_t)4 * 128 * 1792;
constexpr size_t O_GLA_S = O_GLA_P + (size_t)4 * 8 * 4 * 8192;
constexpr size_t O_CONV_P = O_GLA_S + (size_t)4 * 128 * 4 * 8192;
constexpr size_t O_CONV_S = O_CONV_P + (size_t)4 * 8 * 2 * 2816;
constexpr size_t O_END = O_CONV_S + (size_t)4 * 128 * 2 * 2816;

constexpr size_t W_WIN = 0;
constexpr size_t W_WOUT = W_WIN + (size_t)INP * 1024 * 2;
constexpr size_t W_WUP = W_WOUT + (size_t)1024 * 1024 * 2;
constexpr size_t W_WDOWN = W_WUP + (size_t)5632 * 1024 * 2;
constexpr size_t W_WLT = W_WDOWN + (size_t)1024 * 2816 * 2;
constexpr size_t W_ALT = W_WLT + 512 * 64 * 2;
constexpr size_t W_GLT = W_ALT + 512 * 64 * 2;
constexpr size_t W_V1T = W_GLT + 512 * 128 * 2;
constexpr size_t W_V2T = W_V1T + 32 * 512 * 2;
constexpr size_t W_FT = W_V2T + 512 * 32 * 2;
constexpr size_t W_XB = W_FT + 256 * 32 * 2;
constexpr size_t W_VFIRST = W_XB + (size_t)MTOK * 1024 * 2;
constexpr size_t W_BUFB = W_VFIRST + (size_t)MTOK * 512 * 2;
constexpr size_t W_R = W_BUFB + (size_t)MTOK * 1024 * 4;
constexpr size_t W_PROJA = W_R;
constexpr size_t W_PROJB = W_PROJA + (size_t)MTOK * 1792 * 2;
constexpr size_t W_D8 = W_PROJB + (size_t)MTOK * 1792 * 2;
constexpr size_t W_VBUF = W_D8 + (size_t)MTOK * 512 * 4;
constexpr size_t W_GBUF = W_VBUF + (size_t)MTOK * 512 * 2;
constexpr size_t W_DEC = W_GBUF + (size_t)MTOK * 512 * 2;
constexpr size_t W_RK = W_DEC + (size_t)MTOK * 256 * 4;
constexpr size_t W_END1 = W_RK + (size_t)MTOK * 8 * 4;
constexpr size_t W_GATE = W_R;
constexpr size_t W_VAL = W_GATE + (size_t)MTOK * 2816 * 2;
constexpr size_t W_END2 = W_VAL + (size_t)MTOK * 2816 * 2;
constexpr size_t W_END = W_END1 > W_END2 ? W_END1 : W_END2;
constexpr size_t W_BAR = (W_END + 255) / 256 * 256;
constexpr size_t W_TOTAL = W_BAR + 16384;
constexpr size_t W_OBUFA = W_PROJA;
constexpr size_t W_OBUFB = W_PROJA + (size_t)MTOK * 512 * 2;

struct Params { const float* in[33]; float* out; unsigned char* ws; };
typedef const Params __attribute__((address_space(4)))* KP;
__device__ __forceinline__ KP kparams() { unsigned long long k = (unsigned long long)__builtin_amdgcn_kernarg_segment_ptr(); asm volatile("" : "+s"(k)); return (KP)k; }

typedef __bf16 bf16v2 __attribute__((ext_vector_type(2)));
__device__ __forceinline__ unsigned cvt_pk_bf16(float lo, float hi) { const f32x2 v = (f32x2){lo, hi}; const bf16v2 b = __builtin_convertvector(v, bf16v2); return __builtin_bit_cast(unsigned, b); }
__device__ __forceinline__ float bflo(u32 w) { return __uint_as_float(w << 16); }
__device__ __forceinline__ float bfhi(u32 w) { return __uint_as_float(w & 0xffff0000u); }
__device__ __forceinline__ f32x4 ld_bf4(const u16* p) { const u32x2 w = *(const u32x2*)p; return (f32x4){bflo(w.x), bfhi(w.x), bflo(w.y), bfhi(w.y)}; }
__device__ __forceinline__ unsigned cvt_pk_bf16_asm(float lo, float hi) { unsigned r; asm volatile("v_cvt_pk_bf16_f32 %0, %1, %2" : "=v"(r) : "v"(lo), "v"(hi)); return r; }
__device__ __forceinline__ void st_bf4_asm(u16* p, f32x4 v) { u32x2 w; w.x = cvt_pk_bf16_asm(v[0], v[1]); w.y = cvt_pk_bf16_asm(v[2], v[3]); *(u32x2*)p = w; }
__device__ __forceinline__ void st_bf4(u16* p, f32x4 v) { u32x2 w; w.x = cvt_pk_bf16(v[0], v[1]); w.y = cvt_pk_bf16(v[2], v[3]); *(u32x2*)p = w; }
__device__ __forceinline__ float sigmoidf_(float x) { return __builtin_amdgcn_rcpf(1.0f + __expf(-x)); }
__device__ __forceinline__ float tanhf_(float x) { return 1.0f - 2.0f * __builtin_amdgcn_rcpf(1.0f + __expf(2.0f * x)); }
__device__ __forceinline__ float softplusf_(float x) { return fmaxf(x, 0.f) + __logf(1.0f + __expf(-fabsf(x))); }
template <int CTRL> __device__ __forceinline__ float dppf(float x) { return __builtin_bit_cast(float, __builtin_amdgcn_update_dpp(0, __builtin_bit_cast(int, x), CTRL, 0xF, 0xF, true)); }
__device__ __forceinline__ float dot4pk(f32x4 a, f32x4 b) { f32x2 p = (f32x2){a[0], a[1]} * (f32x2){b[0], b[1]}; p = (f32x2){a[2], a[3]} * (f32x2){b[2], b[3]} + p; return p.x + p.y; }
__device__ __forceinline__ float red16(float x) { x += dppf<0xB1>(x); x += dppf<0x4E>(x); x += dppf<0x141>(x); x += dppf<0x140>(x); return x; }

__device__ __forceinline__ int opaque_tid() { int t = threadIdx.x; asm volatile("" : "+v"(t)); return t; }
__device__ __forceinline__ int opaque_bid() { int b = blockIdx.x; asm volatile("" : "+s"(b)); return b; }

namespace pg8 {
constexpr int BM = 256, BK = 64, HALF = 128, HTB = HALF * BK * 2, STAGE_BYTES = 8 * HTB, NXCD = 8, WGM = 8;
__host__ __device__ __forceinline__ int lds_byte(int r, int c) { const int st = (r >> 4) * 2 + (c >> 5), rr = r & 15, cc = c & 31, ob = rr * 64 + cc * 2; return st * 1024 + (ob ^ (((ob >> 9) & 1) << 5)); }
__host__ __device__ __forceinline__ void stage_rc(int b, int& R, int& C) { const int st = b / 1024, sb = b % 1024, swz = sb ^ (((sb >> 9) & 1) << 5); R = (st >> 1) * 16 + swz / 64; C = (st & 1) * 32 + (swz % 64) / 2; }
struct Unit { int pm, pn; };
struct Gemm { const bf16_t* A; const bf16_t* Bt; int M, N, K; };
struct StaticOrder {
    int nM, nN, nwg, G, c;
    __host__ __device__ void init(int M, int N, int G_, int c_) { nM = M / BM; nN = N / BM; nwg = nM * nN; G = G_; c = c_; }
    __host__ __device__ bool next(int i, Unit& u) const {
        const long L = (long)i * G + c; if (L >= nwg) return false;
        int wgid = (int)L; { const int q = nwg / NXCD, r = nwg % NXCD, xcd = wgid % NXCD, off = wgid / NXCD; wgid = (xcd < r ? xcd * (q + 1) : r * (q + 1) + (xcd - r) * q) + off; }
        const int nig = WGM * nN, gid = wgid / nig, fm = gid * WGM, gsz = (nM - fm) < WGM ? (nM - fm) : WGM;
        u.pm = fm + ((wgid % nig) % gsz); u.pn = (wgid % nig) / gsz; return true;
    }
};

template <class Epi>
__device__ __forceinline__ void gemm_phase(PG8_LAS unsigned char* lds, const Gemm g, const StaticOrder& S, const Epi& E) {
    const int tid = opaque_tid(), wid = __builtin_amdgcn_readfirstlane(tid >> 6), lane = tid & 63, wr = wid >> 2, wc = wid & 3, fr = lane & 15, fq = lane >> 4;
    const int K = g.K, nt = K / BK;
    unsigned voffA[2], voffB[2];
#pragma unroll
    for (int i = 0; i < 2; ++i) { int R, C; stage_rc(tid * 16 + i * 8192, R, C); voffA[i] = (unsigned)(R * K + C) * 2u; voffB[i] = voffA[i]; }
    const size_t kstep = (size_t)(BK * 2);
    const size_t hstep = (size_t)HALF * K * 2;
    const size_t tstep = 2 * hstep;
    const unsigned ldsw = (unsigned)wid * 1024u;
    const int aoff = lds_byte(wr * 64 + fr, fq * 8), boff = lds_byte(wc * 32 + fr, fq * 8);
#define PG8_SA(b, h) (((b) * 2 + (h)) * HTB)
#define PG8_SB(b, h) ((4 + (b) * 2 + (h)) * HTB)
#define PG8_STAGE(bufoff, gbase, voff) do { _Pragma("unroll") for (int _i = 0; _i < 2; ++_i) \
        __builtin_amdgcn_global_load_lds((const unsigned*)((const char*)(gbase) + (voff)[_i]), (PG8_LAS unsigned*)(lds + (bufoff) + ldsw + _i * 8192), 16, 0, 0); } while (0)
#define PG8_LDA(dst, b, h) do { _Pragma("unroll") for (int m = 0; m < 4; ++m) _Pragma("unroll") for (int k = 0; k < 2; ++k) dst[m][k] = *(const PG8_LAS bf16x8*)(lds + PG8_SA(b, h) + aoff + m * 2048 + k * 1024); } while (0)
#define PG8_LDB(dst, b, h) do { _Pragma("unroll") for (int n = 0; n < 2; ++n) _Pragma("unroll") for (int k = 0; k < 2; ++k) dst[n][k] = *(const PG8_LAS bf16x8*)(lds + PG8_SB(b, h) + boff + n * 2048 + k * 1024); } while (0)
#define PG8_MMA(ai, bj, At, Bt) do { __builtin_amdgcn_s_setprio(1); _Pragma("unroll") for (int m = 0; m < 4; ++m) _Pragma("unroll") for (int n = 0; n < 2; ++n) _Pragma("unroll") for (int k = 0; k < 2; ++k) \
        acc[ai][bj][m][n] = __builtin_amdgcn_mfma_f32_16x16x32_bf16(Bt[n][k], At[m][k], acc[ai][bj][m][n], 0, 0, 0); __builtin_amdgcn_s_setprio(0); } while (0)
#define PG8_WAIT_V(n) asm volatile("s_waitcnt vmcnt(" #n ")" ::: "memory")
#define PG8_WAIT_L(n) asm volatile("s_waitcnt lgkmcnt(" #n ")" ::: "memory")
#define PG8_BAR __builtin_amdgcn_s_barrier()
#define PG8_SCHED __builtin_amdgcn_sched_barrier(0)
    Unit cur, nxt; int ui = 0;
    if (!S.next(0, cur)) return;
    f32x4 acc[2][2][4][2];
#pragma unroll
    for (int a = 0; a < 2; ++a)
#pragma unroll
        for (int b = 0; b < 2; ++b)
#pragma unroll
            for (int m = 0; m < 4; ++m)
#pragma unroll
                for (int n = 0; n < 2; ++n) acc[a][b][m][n] = (f32x4){0.f, 0.f, 0.f, 0.f};
    bf16x8 At[4][2], B0[2][2], B1[2][2];
    const char* cA = (const char*)g.A + (size_t)cur.pm * tstep; const char* cB = (const char*)g.Bt + (size_t)cur.pn * tstep;
    PG8_STAGE(PG8_SB(0, 0), cB, voffB); PG8_STAGE(PG8_SA(0, 0), cA, voffA); PG8_STAGE(PG8_SB(0, 1), cB + hstep, voffB); PG8_STAGE(PG8_SA(0, 1), cA + hstep, voffA);
    if (wr == 1) PG8_BAR;
    PG8_WAIT_V(4); PG8_BAR;
    PG8_STAGE(PG8_SB(1, 0), cB + kstep, voffB); PG8_STAGE(PG8_SA(1, 0), cA + kstep, voffA); PG8_STAGE(PG8_SB(1, 1), cB + hstep + kstep, voffB);
    PG8_WAIT_V(6); PG8_BAR;
    for (;;) {
        const bool has_next = S.next(ui + 1, nxt);
        const char* nA = has_next ? (const char*)g.A + (size_t)nxt.pm * tstep : cA; const char* nB = has_next ? (const char*)g.Bt + (size_t)nxt.pn * tstep : cB;
        for (int t = 0; t < nt; t += 2) {
            const bool last = (t == nt - 2);
            const char* a1 = cA + (size_t)(t + 1) * kstep;
            const char* a2 = last ? nA : cA + (size_t)(t + 2) * kstep; const char* b2 = last ? nB : cB + (size_t)(t + 2) * kstep;
            const char* a3 = a2 + kstep; const char* b3 = b2 + kstep;
            PG8_LDB(B0, 0, 0); PG8_SCHED; PG8_LDA(At, 0, 0); PG8_STAGE(PG8_SA(1, 1), a1 + hstep, voffA);
            PG8_WAIT_L(8); PG8_BAR; PG8_WAIT_L(0); PG8_MMA(0, 0, At, B0); PG8_BAR; PG8_SCHED;
            PG8_LDB(B1, 0, 1); PG8_STAGE(PG8_SB(0, 0), b2, voffB);
            PG8_BAR; PG8_WAIT_L(0); PG8_MMA(0, 1, At, B1); PG8_BAR;
            PG8_LDA(At, 0, 1); PG8_STAGE(PG8_SA(0, 0), a2, voffA);
            PG8_BAR; PG8_WAIT_L(0); PG8_MMA(1, 0, At, B0); PG8_BAR; PG8_SCHED;
            PG8_STAGE(PG8_SB(0, 1), b2 + hstep, voffB);
            PG8_WAIT_V(6); PG8_BAR; PG8_MMA(1, 1, At, B1); PG8_BAR;
            PG8_LDB(B0, 1, 0); PG8_SCHED; PG8_LDA(At, 1, 0); PG8_STAGE(PG8_SA(0, 1), a2 + hstep, voffA);
            PG8_WAIT_L(8); PG8_BAR; PG8_WAIT_L(0); PG8_MMA(0, 0, At, B0); PG8_BAR; PG8_SCHED;
            PG8_LDB(B1, 1, 1); PG8_STAGE(PG8_SB(1, 0), b3, voffB);
            PG8_BAR; PG8_WAIT_L(0); PG8_MMA(0, 1, At, B1); PG8_BAR;
            PG8_LDA(At, 1, 1); PG8_STAGE(PG8_SA(1, 0), a3, voffA);
            PG8_BAR; PG8_WAIT_L(0); PG8_MMA(1, 0, At, B0); PG8_BAR; PG8_SCHED;
            PG8_STAGE(PG8_SB(1, 1), b3 + hstep, voffB);
            PG8_WAIT_V(6); PG8_BAR; PG8_MMA(1, 1, At, B1); PG8_BAR;
        }
        asm volatile("s_nop 7\n\ts_nop 7\n\ts_nop 7" ::: "memory");
        E(acc, cur, wr, wc, fr, fq);
        if (!has_next) break;
#pragma unroll
        for (int a = 0; a < 2; ++a)
#pragma unroll
            for (int b = 0; b < 2; ++b)
#pragma unroll
                for (int m = 0; m < 4; ++m)
#pragma unroll
                    for (int n = 0; n < 2; ++n) acc[a][b][m][n] = (f32x4){0.f, 0.f, 0.f, 0.f};
        cur = nxt; cA = nA; cB = nB; ++ui;
    }
    PG8_WAIT_V(0);
    if (wr == 0) PG8_BAR;
    PG8_BAR;
#undef PG8_SA
#undef PG8_SB
#undef PG8_STAGE
#undef PG8_LDA
#undef PG8_LDB
#undef PG8_MMA
#undef PG8_WAIT_V
#undef PG8_WAIT_L
#undef PG8_BAR
#undef PG8_SCHED
}
}
using pg8::Unit;

struct EpiProj {
    u16* projA; u16* projB; float* shift_p; float* shift_s;
    __device__ __forceinline__ void operator()(const f32x4 (&acc)[2][2][4][2], const Unit& u, int wr, int wc, int fr, int fq) const {
        const int row0 = u.pm * 256 + wr * 64 + fr;
        const bool isA = u.pn < 7;
        u16* base = isA ? projA : projB;
        const int colt = (isA ? u.pn : u.pn - 7) * 256 + wc * 32 + 4 * fq;
#pragma unroll
        for (int ai = 0; ai < 2; ++ai)
#pragma unroll
            for (int m = 0; m < 4; ++m) {
                const int row = row0 + ai * 128 + m * 16;
                u16* rowp = base + (size_t)row * 1792 + colt;
#pragma unroll
                for (int bj = 0; bj < 2; ++bj)
#pragma unroll
                    for (int n = 0; n < 2; ++n) st_bf4_asm(rowp + bj * 128 + n * 16, acc[ai][bj][m][n]);
                if (isA) {
                    float* dst = nullptr;
                    if (row < MP) { if ((row & 2047) == 2047) dst = shift_p + (size_t)(row >> 11) * 1792; }
                    else { const int r = row - MP; if ((r & 3) == 3) dst = shift_s + (size_t)(r >> 2) * 1792; }
                    if (dst) {
#pragma unroll
                        for (int bj = 0; bj < 2; ++bj)
#pragma unroll
                            for (int n = 0; n < 2; ++n) *(f32x4*)(dst + colt + bj * 128 + n * 16) = acc[ai][bj][m][n];
                    }
                }
            }
    }
};
struct EpiResid {
    const float* base; float* out;
    __device__ __forceinline__ void operator()(const f32x4 (&acc)[2][2][4][2], const Unit& u, int wr, int wc, int fr, int fq) const {
        const int row0 = u.pm * 256 + wr * 64 + fr, col0 = u.pn * 256 + wc * 32 + 4 * fq;
#pragma unroll
        for (int ai = 0; ai < 2; ++ai)
#pragma unroll
            for (int m = 0; m < 4; ++m) {
                const size_t off = (size_t)(row0 + ai * 128 + m * 16) * 1024 + col0;
#pragma unroll
                for (int bj = 0; bj < 2; ++bj)
#pragma unroll
                    for (int n = 0; n < 2; ++n) { const f32x4 b = *(const f32x4*)(base + off + bj * 128 + n * 16); *(f32x4*)(out + off + bj * 128 + n * 16) = b * ALPHA + acc[ai][bj][m][n]; }
            }
    }
};
struct EpiUp {
    u16* gate; u16* val; float* conv_p; float* conv_s;
    __device__ __forceinline__ void operator()(const f32x4 (&acc)[2][2][4][2], const Unit& u, int wr, int wc, int fr, int fq) const {
        const int row0 = u.pm * 256 + wr * 64 + fr;
        const bool isG = u.pn < 11;
        u16* base = isG ? gate : val;
        const int colt = (isG ? u.pn : u.pn - 11) * 256 + wc * 32 + 4 * fq;
#pragma unroll
        for (int ai = 0; ai < 2; ++ai)
#pragma unroll
            for (int m = 0; m < 4; ++m) {
                const int row = row0 + ai * 128 + m * 16;
                u16* rowp = base + (size_t)row * DFF + colt;
#pragma unroll
                for (int bj = 0; bj < 2; ++bj)
#pragma unroll
                    for (int n = 0; n < 2; ++n) st_bf4_asm(rowp + bj * 128 + n * 16, acc[ai][bj][m][n]);
                if (isG) {
                    float* dst = nullptr;
                    if (row < MP) { const int t = row & 2047; if (t >= 2046) dst = conv_p + (size_t)((row >> 11) * 2 + (t - 2046)) * DFF; }
                    else { const int r = row - MP, t = r & 3; if (t >= 2) dst = conv_s + (size_t)((r >> 2) * 2 + (t - 2)) * DFF; }
                    if (dst) {
#pragma unroll
                        for (int bj = 0; bj < 2; ++bj)
#pragma unroll
                            for (int n = 0; n < 2; ++n) *(f32x4*)(dst + colt + bj * 128 + n * 16) = acc[ai][bj][m][n];
                    }
                }
            }
    }
};

__device__ void small_gemm_resid(const u16* __restrict__ A, const u16* __restrict__ Bt, int K, const float* __restrict__ base, float* __restrict__ out, PG8_LAS unsigned char* lds) {
    const int t = opaque_tid(), wid = t >> 6, lane = t & 63, fr = lane & 15, fq = lane >> 4;
    const int kw = K >> 3, nks = kw >> 5;
    for (int tile = opaque_bid(); tile < 256; tile += gridDim.x) {
        const int r0 = MP + (tile >> 4) * 32, c0 = (tile & 15) * 64;
        f32x4 acc[2][4];
#pragma unroll
        for (int mi = 0; mi < 2; ++mi)
#pragma unroll
            for (int ni = 0; ni < 4; ++ni) acc[mi][ni] = (f32x4){0.f, 0.f, 0.f, 0.f};
#pragma unroll 2
        for (int ks = 0; ks < nks; ++ks) {
            const int k = wid * kw + ks * 32 + fq * 8;
            bf16x8 a[2], b[4];
#pragma unroll
            for (int mi = 0; mi < 2; ++mi) a[mi] = *(const bf16x8*)(A + (size_t)(r0 + mi * 16 + fr) * K + k);
#pragma unroll
            for (int ni = 0; ni < 4; ++ni) b[ni] = *(const bf16x8*)(Bt + (size_t)(c0 + ni * 16 + fr) * K + k);
#pragma unroll
            for (int mi = 0; mi < 2; ++mi)
#pragma unroll
                for (int ni = 0; ni < 4; ++ni) acc[mi][ni] = __builtin_amdgcn_mfma_f32_16x16x32_bf16(b[ni], a[mi], acc[mi][ni], 0, 0, 0);
        }
        PG8_LAS f32x4* red = (PG8_LAS f32x4*)lds;
#pragma unroll
        for (int mi = 0; mi < 2; ++mi)
#pragma unroll
            for (int ni = 0; ni < 4; ++ni) red[(wid * 8 + mi * 4 + ni) * 64 + lane] = acc[mi][ni];
        __syncthreads();
        {
            f32x4 sum = (f32x4){0.f, 0.f, 0.f, 0.f};
#pragma unroll
            for (int w = 0; w < 8; ++w) sum += red[(w * 8 + wid) * 64 + lane];
            const int mi = wid >> 2, ni = wid & 3;
            const size_t off = (size_t)(r0 + mi * 16 + fr) * 1024 + c0 + ni * 16 + 4 * fq;
            *(f32x4*)(out + off) = *(const f32x4*)(base + off) * ALPHA + sum;
        }
        __syncthreads();
    }
}

__device__ __forceinline__ void transpose_tile(const float* __restrict__ src, u16* __restrict__ dst, int K, int N, int nT, int item, float* tile) {
    const int t = opaque_tid();
    const int kt = item / nT, ntile = item - kt * nT, k0 = kt * 64, n0 = ntile * 64;
    { const int row = t >> 3, c8 = (t & 7) * 8;
      f32x4 a = (f32x4){0.f, 0.f, 0.f, 0.f}, b = a;
      if (n0 + c8 < N) { const float* sp = src + (size_t)(k0 + row) * N + n0 + c8; a = *(const f32x4*)sp; b = *(const f32x4*)(sp + 4); }
      float* tp = tile + row * 65 + c8;
      tp[0] = a[0]; tp[1] = a[1]; tp[2] = a[2]; tp[3] = a[3]; tp[4] = b[0]; tp[5] = b[1]; tp[6] = b[2]; tp[7] = b[3]; }
    __syncthreads();
    { const int n = t >> 3, k8 = (t & 7) * 8;
      float v[8];
#pragma unroll
      for (int j = 0; j < 8; ++j) v[j] = tile[(k8 + j) * 65 + n];
      u32x4 w; w.x = cvt_pk_bf16(v[0], v[1]); w.y = cvt_pk_bf16(v[2], v[3]); w.z = cvt_pk_bf16(v[4], v[5]); w.w = cvt_pk_bf16(v[6], v[7]);
      *(u32x4*)(dst + (size_t)(n0 + n) * K + k0 + k8) = w; }
    __syncthreads();
}
__device__ __forceinline__ void small_transpose(const float* __restrict__ src, u16* __restrict__ dst, int K, int N, int Kpad, size_t gt, size_t nth) {
    for (size_t i = gt; i < (size_t)N * Kpad; i += nth) { const int n = (int)(i / Kpad), k = (int)(i - (size_t)n * Kpad); const float v = k < K ? src[(size_t)k * N + n] : 0.f; dst[i] = (u16)(cvt_pk_bf16(v, 0.f) & 0xffffu); }
}
__device__ void convert_phase(KP p, int l, float* tile) {
    unsigned char* ws = p->ws;
    const int bid = opaque_bid();
    const size_t gt = (size_t)bid * 512 + opaque_tid(), nth = (size_t)gridDim.x * 512;
    constexpr int n1 = 16 * 56, n2 = 16 * 16, n3 = 16 * 88, n4 = 44 * 16;
    for (int it = bid; it < n1 + n2 + n3 + n4; it += gridDim.x) {
        if (it < n1) transpose_tile(p->in[I_WIN] + (size_t)l * 1024 * 3344, (u16*)(ws + W_WIN), 1024, 3344, 56, it, tile);
        else if (it < n1 + n2) transpose_tile(p->in[I_WOUT] + (size_t)l * 1024 * 1024, (u16*)(ws + W_WOUT), 1024, 1024, 16, it - n1, tile);
        else if (it < n1 + n2 + n3) transpose_tile(p->in[I_WUP] + (size_t)l * 1024 * 5632, (u16*)(ws + W_WUP), 1024, 5632, 88, it - n1 - n2, tile);
        else transpose_tile(p->in[I_WDOWN] + (size_t)l * 2816 * 1024, (u16*)(ws + W_WDOWN), 2816, 1024, 16, it - n1 - n2 - n3, tile);
    }
    small_transpose(p->in[I_WLU] + (size_t)l * 64 * 512, (u16*)(ws + W_WLT), 64, 512, 64, gt, nth);
    small_transpose(p->in[I_ALU] + (size_t)l * 64 * 512, (u16*)(ws + W_ALT), 64, 512, 64, gt, nth);
    small_transpose(p->in[I_GLU] + (size_t)l * 128 * 512, (u16*)(ws + W_GLT), 128, 512, 128, gt, nth);
    if (l > 0) {
        small_transpose(p->in[I_VD] + (size_t)(l - 1) * 512 * 32, (u16*)(ws + W_V1T), 512, 32, 512, gt, nth);
        small_transpose(p->in[I_VU] + (size_t)(l - 1) * 32 * 512, (u16*)(ws + W_V2T), 32, 512, 32, gt, nth);
    }
    small_transpose(p->in[I_FUP] + (size_t)l * 16 * 256, (u16*)(ws + W_FT), 16, 256, 32, gt, nth);
    if (l == 0) {
        float* xa = p->out + O_Y; u16* xb = (u16*)(ws + W_XB);
        for (size_t i = gt; i < (size_t)MTOK * 256; i += nth) {
            const size_t e = i * 4;
            const f32x4 v = e < (size_t)MP * 1024 ? *(const f32x4*)(p->in[I_XP] + e) : *(const f32x4*)(p->in[I_XS] + (e - (size_t)MP * 1024));
            *(f32x4*)(xa + e) = v; st_bf4(xb + e, v);
        }
    }
}

__device__ void ln_phase(float* Y, u16* xb, const float* __restrict__ g, const float* __restrict__ b) {
    const int tt_ = opaque_tid();
    const int lane = tt_ & 63, gw = opaque_bid() * 8 + (tt_ >> 6), nw = gridDim.x * 8;
    f32x4 gv[4], bv[4];
#pragma unroll
    for (int i = 0; i < 4; ++i) { gv[i] = *(const f32x4*)(g + i * 256 + lane * 4); bv[i] = *(const f32x4*)(b + i * 256 + lane * 4); }
    for (int row = gw; row < MTOK; row += nw) {
        float* yp = Y + (size_t)row * 1024 + lane * 4;
        f32x4 v[4]; float s = 0.f;
#pragma unroll
        for (int i = 0; i < 4; ++i) { v[i] = *(const f32x4*)(yp + i * 256); s += (v[i][0] + v[i][1]) + (v[i][2] + v[i][3]); }
#pragma unroll
        for (int o = 32; o >= 1; o >>= 1) s += __shfl_xor(s, o);
        const float mu = s * (1.0f / 1024.0f); float q = 0.f;
#pragma unroll
        for (int i = 0; i < 4; ++i) { const f32x4 d = v[i] - mu; q += (d[0] * d[0] + d[1] * d[1]) + (d[2] * d[2] + d[3] * d[3]); }
#pragma unroll
        for (int o = 32; o >= 1; o >>= 1) q += __shfl_xor(q, o);
        const float rstd = rsqrtf(q * (1.0f / 1024.0f) + LN_EPS);
#pragma unroll
        for (int i = 0; i < 4; ++i) { const f32x4 o = (v[i] - mu) * rstd * gv[i] + bv[i]; *(f32x4*)(yp + i * 256) = o; st_bf4(xb + (size_t)row * 1024 + i * 256 + lane * 4, o); }
    }
}

__device__ __forceinline__ void unpack8(const u32x4 w, float* f) { f[0] = bflo(w.x); f[1] = bfhi(w.x); f[2] = bflo(w.y); f[3] = bfhi(w.y); f[4] = bflo(w.z); f[5] = bfhi(w.z); f[6] = bflo(w.w); f[7] = bfhi(w.w); }
__device__ __forceinline__ float gelu_as(float v) {
    const float av = fabsf(v), t = __builtin_amdgcn_rcpf(av * 0.2316418882f + 1.0f);
    float q = t * 0.5307027145f + (-0.7265760135f); q = q * t + 0.7107068705f; q = q * t + (-0.142248368f); q = q * t + 0.127414796f; q = q * t;
    const float e = __builtin_amdgcn_exp2f((v * v) * (-0.72134752044f));
    const float m = v * (q * e);
    return v < 0.f ? m : v - m;
}
__device__ void convglu_phase(const u16* __restrict__ gate, u16* val, const float* __restrict__ past  , const float* __restrict__ cw, const float* __restrict__ cb) {
    const size_t gt = (size_t)opaque_bid() * 512 + opaque_tid(), nth = (size_t)gridDim.x * 512;
    for (size_t idx = gt; idx < (size_t)(MTOK / 4) * 352; idx += nth) {
        const int rg = (int)(idx / 352), c = (int)(idx - (size_t)rg * 352) * 8, row0 = rg * 4;
        bool first; const float* pst = nullptr;
        if (row0 < MP) first = (row0 & 2047) == 0; else { first = true; pst = past + (size_t)((row0 - MP) >> 2) * 2 * DFF; }
        float w0[8], w1[8], w2[8], bb[8], gm2[8], gm1[8];
#pragma unroll
        for (int j = 0; j < 8; ++j) { w0[j] = cw[c + j]; w1[j] = cw[DFF + c + j]; w2[j] = cw[2 * DFF + c + j]; bb[j] = cb[c + j]; }
        if (!first) { unpack8(*(const u32x4*)(gate + (size_t)(row0 - 2) * DFF + c), gm2); unpack8(*(const u32x4*)(gate + (size_t)(row0 - 1) * DFF + c), gm1); }
        else {
#pragma unroll
            for (int j = 0; j < 8; ++j) { gm2[j] = pst ? pst[c + j] : 0.f; gm1[j] = pst ? pst[DFF + c + j] : 0.f; } }
#pragma unroll
        for (int r = 0; r < 4; ++r) {
            float g0[8], vv[8], h[8];
            unpack8(*(const u32x4*)(gate + (size_t)(row0 + r) * DFF + c), g0);
            unpack8(*(const u32x4*)(val + (size_t)(row0 + r) * DFF + c), vv);
#pragma unroll
            for (int j = 0; j < 8; ++j) { const float a = bb[j] + gm2[j] * w0[j] + gm1[j] * w1[j] + g0[j] * w2[j]; h[j] = gelu_as(a) * vv[j]; gm2[j] = gm1[j]; gm1[j] = g0[j]; }
            u32x4 w; w.x = cvt_pk_bf16(h[0], h[1]); w.y = cvt_pk_bf16(h[2], h[3]); w.z = cvt_pk_bf16(h[4], h[5]); w.w = cvt_pk_bf16(h[6], h[7]);
            *(u32x4*)(val + (size_t)(row0 + r) * DFF + c) = w;
        }
    }
}

struct PrepCtx {
    const u16* projA; const u16* projB; const float* mu; const float* sshift  ;
};
__device__ __forceinline__ f32x4 xs4(const PrepCtx& c, int i, int col) {
    const f32x4 cur = ld_bf4(c.projA + (size_t)i * 1792 + col);
    f32x4 prev;
    bool first; int b = 0;
    if (i < MP) first = (i & 2047) == 0; else { const int r = i - MP; first = (r & 3) == 0; b = r >> 2; }
    if (!first) prev = ld_bf4(c.projA + (size_t)(i - 1) * 1792 + col);
    else if (i < MP) prev = (f32x4){0.f, 0.f, 0.f, 0.f};
    else prev = *(const f32x4*)(c.sshift + (size_t)b * 1792 + col);
    const f32x4 m = *(const f32x4*)(c.mu + col);
    return cur + (prev - cur) * m;
}
__device__ __forceinline__ bf16x8 ldg_frag(const u16* p) { return *(const bf16x8*)p; }

__device__ void prep_phase(KP p, int l, PG8_LAS unsigned char* lds) {
    unsigned char* ws = p->ws;
    PrepCtx c; c.projA = (const u16*)(ws + W_PROJA); c.projB = (const u16*)(ws + W_PROJB); c.mu = p->in[I_MU] + (size_t)l * 1792; c.sshift = p->in[I_SSHIFT] + (size_t)l * 128 * 1792;
    const u16* wlT = (const u16*)(ws + W_WLT); const u16* alT = (const u16*)(ws + W_ALT); const u16* glT = (const u16*)(ws + W_GLT);
    const u16* v1T = (const u16*)(ws + W_V1T); const u16* v2T = (const u16*)(ws + W_V2T); const u16* fT = (const u16*)(ws + W_FT);
    u32x4* A16 = (u32x4*)(ws + W_BUFB); float* D8 = (float*)(ws + W_D8); u16* vbuf = (u16*)(ws + W_VBUF); u16* gbuf = (u16*)(ws + W_GBUF);
    float* decb = (float*)(ws + W_DEC); float* rkb = (float*)(ws + W_RK); u16* vfirst = (u16*)(ws + W_VFIRST);
    const float* w0 = p->in[I_W0] + l * 512; const float* a0 = p->in[I_A0] + l * 512; const float* k_k = p->in[I_KK] + l * 512; const float* k_a = p->in[I_KA] + l * 512;
    const float* r_k = p->in[I_RK] + l * 512; const float* vb = l > 0 ? p->in[I_VB] + (l - 1) * 512 : nullptr; const float* fbias = p->in[I_FB] + l * 256;
    constexpr int S_TW = 144, S_AL = 144, S_SG = 272, S_XV = 1040, S_FL = 80, S_PP = 80;
    constexpr int O_TW = 0, O_AL = O_TW + 16 * S_TW, O_SG = O_AL + 16 * S_AL, O_XV = O_SG + 16 * S_SG, O_FL = O_XV + 16 * S_XV, O_PP = O_FL + 16 * S_FL;
    const int t = opaque_tid(), wid = t >> 6, lane = t & 63, fr = lane & 15, fq = lane >> 4, h = wid;
    for (int blk = opaque_bid(); blk < MTOK / 16; blk += gridDim.x) {
        const int i0 = blk * 16;
#pragma unroll 1
        for (int q = 0; q < 6; ++q) {
            const int op = t + 512 * q, r = op / 192, g4 = op - r * 192, col = 1024 + 4 * g4;
            f32x4 x = xs4(c, i0 + r, col);
            int off;
            if (col < 1536) off = O_XV + r * S_XV + (col - 1024) * 2;
            else if (col < 1600) { off = O_TW + r * S_TW + (col - 1536) * 2; x = (f32x4){tanhf_(x[0]), tanhf_(x[1]), tanhf_(x[2]), tanhf_(x[3])}; }
            else if (col < 1664) off = O_AL + r * S_AL + (col - 1600) * 2;
            else { off = O_SG + r * S_SG + (col - 1664) * 2; x = (f32x4){sigmoidf_(x[0]), sigmoidf_(x[1]), sigmoidf_(x[2]), sigmoidf_(x[3])}; }
            u32x2 w; w.x = cvt_pk_bf16(x[0], x[1]); w.y = cvt_pk_bf16(x[2], x[3]);
            *(PG8_LAS u32x2*)(lds + off) = w;
        }
        if (t < 128) { const int r = t >> 3, c4 = (t & 7) * 4; u32x2 w = (u32x2){0u, 0u}; if (c4 < 16) w = *(const u32x2*)(c.projB + (size_t)(i0 + r) * 1792 + 1536 + c4); *(PG8_LAS u32x2*)(lds + O_FL + r * S_FL + c4 * 2) = w; }
        __syncthreads();
        bf16x8 pfrag = (bf16x8){0, 0, 0, 0, 0, 0, 0, 0};
        if (l > 0) {
            f32x4 accP0 = (f32x4){0.f, 0.f, 0.f, 0.f}, accP1 = accP0;
#pragma unroll 4
            for (int ks = 0; ks < 16; ++ks) {
                const bf16x8 af = *(const PG8_LAS bf16x8*)(lds + O_XV + fr * S_XV + (ks * 32 + fq * 8) * 2);
                accP0 = __builtin_amdgcn_mfma_f32_16x16x32_bf16(ldg_frag(v1T + (size_t)fr * 512 + ks * 32 + fq * 8), af, accP0, 0, 0, 0);
                accP1 = __builtin_amdgcn_mfma_f32_16x16x32_bf16(ldg_frag(v1T + (size_t)(16 + fr) * 512 + ks * 32 + fq * 8), af, accP1, 0, 0, 0);
            }
            const u32 w0_ = cvt_pk_bf16(accP0[0], accP0[1]), w1_ = cvt_pk_bf16(accP0[2], accP0[3]), w2_ = cvt_pk_bf16(accP1[0], accP1[1]), w3_ = cvt_pk_bf16(accP1[2], accP1[3]);
            const u32x4 pw = (u32x4){w0_, w1_, w2_, w3_};
            pfrag = __builtin_bit_cast(bf16x8, pw);
        }
        const int i = i0 + fr;
        float ss = 0.f;
#pragma unroll
        for (int n = 0; n < 4; ++n) { const int cb_ = h * 64 + 16 * n + 4 * fq; const f32x4 xk = xs4(c, i, 512 + cb_) * *(const f32x4*)(k_k + cb_); ss += (xk[0] * xk[0] + xk[1] * xk[1]) + (xk[2] * xk[2] + xk[3] * xk[3]); }
        ss += __shfl_xor(ss, 16); ss += __shfl_xor(ss, 32);
        const float inorm = rsqrtf(fmaxf(ss, 1e-24f));
        float rks = 0.f;
#pragma unroll 2
        for (int n = 0; n < 4; ++n) {
            const int cn = h * 64 + 16 * n, cb_ = cn + 4 * fq;
            f32x4 aW = (f32x4){0.f, 0.f, 0.f, 0.f}, aA = aW, aG = aW, aV = aW;
#pragma unroll
            for (int ks = 0; ks < 2; ++ks) {
                aW = __builtin_amdgcn_mfma_f32_16x16x32_bf16(ldg_frag(wlT + (size_t)(cn + fr) * 64 + ks * 32 + fq * 8), *(const PG8_LAS bf16x8*)(lds + O_TW + fr * S_TW + (ks * 32 + fq * 8) * 2), aW, 0, 0, 0);
                aA = __builtin_amdgcn_mfma_f32_16x16x32_bf16(ldg_frag(alT + (size_t)(cn + fr) * 64 + ks * 32 + fq * 8), *(const PG8_LAS bf16x8*)(lds + O_AL + fr * S_AL + (ks * 32 + fq * 8) * 2), aA, 0, 0, 0);
            }
#pragma unroll
            for (int ks = 0; ks < 4; ++ks)
                aG = __builtin_amdgcn_mfma_f32_16x16x32_bf16(ldg_frag(glT + (size_t)(cn + fr) * 128 + ks * 32 + fq * 8), *(const PG8_LAS bf16x8*)(lds + O_SG + fr * S_SG + (ks * 32 + fq * 8) * 2), aG, 0, 0, 0);
            if (l > 0) {
                const u32x2 va = *(const u32x2*)(v2T + (size_t)(cn + fr) * 32 + 4 * fq), vc = *(const u32x2*)(v2T + (size_t)(cn + fr) * 32 + 16 + 4 * fq);
                const u32x4 vw = (u32x4){va.x, va.y, vc.x, vc.y};
                aV = __builtin_amdgcn_mfma_f32_16x16x32_bf16(__builtin_bit_cast(bf16x8, vw), pfrag, aV, 0, 0, 0);
            }
            const f32x4 xr = xs4(c, i, cb_), xk = xs4(c, i, 512 + cb_), xv = xs4(c, i, 1024 + cb_);
            const f32x4 w0v = *(const f32x4*)(w0 + cb_), a0v = *(const f32x4*)(a0 + cb_), kkv = *(const f32x4*)(k_k + cb_), kav = *(const f32x4*)(k_a + cb_), rkv = *(const f32x4*)(r_k + cb_);
            f32x4 vp = xv;
            if (l == 0) st_bf4(vfirst + (size_t)i * 512 + cb_, xv);
            else { const f32x4 vf = ld_bf4(vfirst + (size_t)i * 512 + cb_); const f32x4 vbv = *(const f32x4*)(vb + cb_);
#pragma unroll
                for (int j = 0; j < 4; ++j) vp[j] = xv[j] + (vf[j] - xv[j]) * sigmoidf_(vbv[j] + aV[j]);
            }
            f32x4 dd, kt, kn, bb;
#pragma unroll
            for (int j = 0; j < 4; ++j) {
                const float wv = -softplusf_(-(w0v[j] + aW[j])) - 0.5f;
                dd[j] = __expf(-__expf(wv));
                const float a = sigmoidf_(a0v[j] + aA[j]);
                kn[j] = xk[j] * kkv[j] * inorm;
                kt[j] = xk[j] * (1.0f + (a - 1.0f) * kav[j]);
                bb[j] = kn[j] * a;
                rks += xr[j] * kt[j] * rkv[j];
            }
            const int p0 = 8 * n + 2 * fq;
            u32x4 rec0, rec1;
            rec0.x = cvt_pk_bf16(xr[0], xr[1]); rec0.y = cvt_pk_bf16(kt[0], kt[1]); rec0.z = cvt_pk_bf16(kn[0], kn[1]); rec0.w = cvt_pk_bf16(bb[0], bb[1]);
            rec1.x = cvt_pk_bf16(xr[2], xr[3]); rec1.y = cvt_pk_bf16(kt[2], kt[3]); rec1.z = cvt_pk_bf16(kn[2], kn[3]); rec1.w = cvt_pk_bf16(bb[2], bb[3]);
            u32x4* ap = A16 + ((size_t)i * 8 + h) * 32 + p0;
            ap[0] = rec0; ap[1] = rec1;
            *(f32x4*)(D8 + (size_t)i * 512 + cb_) = dd;
            st_bf4(vbuf + (size_t)i * 512 + cb_, vp);
            st_bf4(gbuf + (size_t)i * 512 + cb_, aG);
        }
        rks += __shfl_xor(rks, 16); rks += __shfl_xor(rks, 32);
        if (fq == 0) rkb[(size_t)i * 8 + h] = rks;
#pragma unroll
        for (int n2 = 0; n2 < 2; ++n2) {
            const int cn = 32 * h + 16 * n2;
            f32x4 aF = (f32x4){0.f, 0.f, 0.f, 0.f};
            aF = __builtin_amdgcn_mfma_f32_16x16x32_bf16(ldg_frag(fT + (size_t)(cn + fr) * 32 + fq * 8), *(const PG8_LAS bf16x8*)(lds + O_FL + fr * S_FL + (fq * 8) * 2), aF, 0, 0, 0);
            const f32x4 fb = *(const f32x4*)(fbias + cn + 4 * fq);
            f32x4 dc;
#pragma unroll
            for (int j = 0; j < 4; ++j) { const float z = aF[j] + fb[j]; dc[j] = __expf(-softplusf_(-z) * (1.0f / 16.0f)); }
            *(f32x4*)(decb + (size_t)i * 256 + cn + 4 * fq) = dc;
        }
        __syncthreads();
    }
}

struct ScanItem {
    int tok0, T, L;
    int h, q;
    int hg, cgp;
    const float* s0_rwkv; float* so_rwkv;
    const float* s0_gla; float* so_gla;
};
template <int LSEG>
__device__ __forceinline__ void scan_item(KP p, const ScanItem& it, PG8_LAS unsigned char* lds) {
    unsigned char* ws = p->ws;
    const u32x4* A16 = (const u32x4*)(ws + W_BUFB); const float* D8 = (const float*)(ws + W_D8); const u16* vbuf = (const u16*)(ws + W_VBUF);
    const u16* projB = (const u16*)(ws + W_PROJB); const float* decb = (const float*)(ws + W_DEC);
    u16* obufA = (u16*)(ws + W_OBUFA); u16* obufB = (u16*)(ws + W_OBUFB);
    const int t = opaque_tid(), wid = t >> 6, lane = t & 63, kq = lane & 15, rsel = lane >> 4;
    constexpr int BUF = 69632, OR = 0, OKT = 8192, OKN = 16384, OB = 24576, OD = 32768, OVR = 40960, OQ = 43008, OK = 51200, ODC = 59392, OVG = 67584;
    const int nchunk = it.T / TC;
    u32x4 sa0, sa1; f32x4 sd, sdec; u32x2 svr = (u32x2){0u, 0u}, sq, sk;
#define SC_GLOAD(ch_) do { const int tk_ = it.tok0 + (ch_) * TC; \
        { const int i0 = t, i1 = t + 512; sa0 = A16[((size_t)(tk_ + (i0 >> 5)) * 8 + it.h) * 32 + (i0 & 31)]; sa1 = A16[((size_t)(tk_ + (i1 >> 5)) * 8 + it.h) * 32 + (i1 & 31)]; } \
        { const int st = t >> 4, c4 = (t & 15) * 4; sd = *(const f32x4*)(D8 + (size_t)(tk_ + st) * 512 + it.h * 64 + c4); \
          sq = *(const u32x2*)(projB + (size_t)(tk_ + st) * 1792 + it.hg * 64 + c4); sk = *(const u32x2*)(projB + (size_t)(tk_ + st) * 1792 + 256 + it.hg * 64 + c4); \
          sdec = *(const f32x4*)(decb + (size_t)(tk_ + st) * 256 + it.hg * 64 + c4); } \
        if (t < 128) { const int st = t >> 2, c4 = (t & 3) * 4; svr = *(const u32x2*)(vbuf + (size_t)(tk_ + st) * 512 + it.h * 64 + it.q * 16 + c4); } \
        else if (t < 256) { const int tt = t - 128, st = tt >> 2, c4 = (tt & 3) * 4; svr = *(const u32x2*)(projB + (size_t)(tk_ + st) * 1792 + 512 + it.hg * 128 + it.cgp * 16 + c4); } } while (0)
#define SC_LSTORE(buf_) do { PG8_LAS unsigned char* b_ = lds + (buf_) * BUF; \
        { const int i0 = t, i1 = t + 512; \
          { const int st = i0 >> 5, pp = i0 & 31; const int o = (st * 64 + 2 * pp) * 4; \
            *(PG8_LAS f32x2*)(b_ + OR + o) = (f32x2){bflo(sa0.x), bfhi(sa0.x)}; *(PG8_LAS f32x2*)(b_ + OKT + o) = (f32x2){bflo(sa0.y), bfhi(sa0.y)}; \
            *(PG8_LAS f32x2*)(b_ + OKN + o) = (f32x2){bflo(sa0.z), bfhi(sa0.z)}; *(PG8_LAS f32x2*)(b_ + OB + o) = (f32x2){bflo(sa0.w), bfhi(sa0.w)}; } \
          { const int st = i1 >> 5, pp = i1 & 31; const int o = (st * 64 + 2 * pp) * 4; \
            *(PG8_LAS f32x2*)(b_ + OR + o) = (f32x2){bflo(sa1.x), bfhi(sa1.x)}; *(PG8_LAS f32x2*)(b_ + OKT + o) = (f32x2){bflo(sa1.y), bfhi(sa1.y)}; \
            *(PG8_LAS f32x2*)(b_ + OKN + o) = (f32x2){bflo(sa1.z), bfhi(sa1.z)}; *(PG8_LAS f32x2*)(b_ + OB + o) = (f32x2){bflo(sa1.w), bfhi(sa1.w)}; } } \
        { const int st = t >> 4, c4 = (t & 15) * 4; const int o = (st * 64 + c4) * 4; \
          *(PG8_LAS f32x4*)(b_ + OD + o) = sd; *(PG8_LAS f32x4*)(b_ + ODC + o) = sdec; \
          *(PG8_LAS f32x4*)(b_ + OQ + o) = (f32x4){bflo(sq.x), bfhi(sq.x), bflo(sq.y), bfhi(sq.y)} * 0.125f; \
          *(PG8_LAS f32x4*)(b_ + OK + o) = (f32x4){bflo(sk.x), bfhi(sk.x), bflo(sk.y), bfhi(sk.y)}; } \
        if (t < 128) { const int st = t >> 2, c4 = (t & 3) * 4; *(PG8_LAS f32x4*)(b_ + OVR + (st * 16 + c4) * 4) = (f32x4){bflo(svr.x), bfhi(svr.x), bflo(svr.y), bfhi(svr.y)}; } \
        else if (t < 256) { const int tt = t - 128, st = tt >> 2, c4 = (tt & 3) * 4; *(PG8_LAS f32x4*)(b_ + OVG + (st * 16 + c4) * 4) = (f32x4){bflo(svr.x), bfhi(svr.x), bflo(svr.y), bfhi(svr.y)}; } } while (0)
    const bool isR = wid < 4;
    const int w4 = wid & 3;
    const int row = it.q * 16 + 4 * w4 + rsel;
    const int col = it.cgp * 16 + 4 * w4 + rsel;
    f32x4 S = (f32x4){0.f, 0.f, 0.f, 0.f}, Sn = S;
#define SC_LOAD_STATE(dst_, seg_) do { const int sg_ = (seg_); \
        if (isR) { if (!it.s0_rwkv) dst_ = (f32x4){0.f, 0.f, 0.f, 0.f}; else dst_ = *(const f32x4*)(it.s0_rwkv + (size_t)sg_ * 8 * 4096 + row * 64 + 4 * kq); } \
        else if (!it.s0_gla) dst_ = (f32x4){0.f, 0.f, 0.f, 0.f}; \
        else { const float* sp_ = it.s0_gla + (size_t)sg_ * 4 * 8192 + (size_t)(4 * kq) * 128 + col; dst_ = (f32x4){sp_[0], sp_[128], sp_[256], sp_[384]}; } } while (0)
#define SC_STORE_STATE(seg_, s_) do { const int sg_ = (seg_); \
        if (isR) { *(f32x4*)(it.so_rwkv + (size_t)sg_ * 8 * 4096 + row * 64 + 4 * kq) = s_; } \
        else { float* sp_ = it.so_gla + (size_t)sg_ * 4 * 8192 + (size_t)(4 * kq) * 128 + col; sp_[0] = s_[0]; sp_[128] = s_[1]; sp_[256] = s_[2]; sp_[384] = s_[3]; } } while (0)
    SC_GLOAD(0);
    SC_LOAD_STATE(Sn, 0);
    SC_LSTORE(0);
    __syncthreads();
    u16* oAp = obufA + (size_t)it.tok0 * 512 + it.h * 64 + row;
    u16* oBp = obufB + (size_t)it.tok0 * 512 + it.hg * 128 + col;
    const int vsl = (4 * w4 + rsel) * 4;
#define SC_STEP_R(s_, ov_) do { const int o = ((s_) * 64 + 4 * kq) * 4; \
        const f32x4 r4 = *(const PG8_LAS f32x4*)(b + OR + o), k4 = *(const PG8_LAS f32x4*)(b + OKT + o), n4 = *(const PG8_LAS f32x4*)(b + OKN + o), b4 = *(const PG8_LAS f32x4*)(b + OB + o), d4 = *(const PG8_LAS f32x4*)(b + OD + o); \
        const float v = *(const PG8_LAS float*)(b + OVR + (s_) * 64 + vsl); \
        float dot = dot4pk(S, n4); \
        dot = red16(dot); \
        S = S * d4 - b4 * dot + k4 * v; \
        float o_ = dot4pk(S, r4); \
        (ov_) = red16(o_); } while (0)
#define SC_STEP_G(s_, ov_) do { const int o = ((s_) * 64 + 4 * kq) * 4; \
        const f32x4 q4 = *(const PG8_LAS f32x4*)(b + OQ + o), k4 = *(const PG8_LAS f32x4*)(b + OK + o), d4 = *(const PG8_LAS f32x4*)(b + ODC + o); \
        const float v = *(const PG8_LAS float*)(b + OVG + (s_) * 64 + vsl); \
        S = S * d4 + k4 * v; \
        float o_ = dot4pk(S, q4); \
        (ov_) = red16(o_); } while (0)
#define SC_BLOCK(STEP_, s0_, NB_, optr_) do { float ov[NB_]; \
        _Pragma("unroll") for (int j_ = 0; j_ < (NB_); ++j_) STEP_((s0_) + j_, ov[j_]); \
        float outv = ov[0]; \
        _Pragma("unroll") for (int j_ = 1; j_ < (NB_); ++j_) outv = (kq == j_) ? ov[j_] : outv; \
        if (kq < (NB_)) (optr_)[(size_t)((s0_) + kq) * 512] = (u16)(cvt_pk_bf16(outv, 0.f) & 0xffffu); } while (0)
    for (int ch = 0; ch < nchunk; ++ch) {
        const bool more = ch + 1 < nchunk;
        if (more) SC_GLOAD(ch + 1);
        PG8_LAS unsigned char* b = lds + (ch & 1) * BUF;
        if (LSEG >= TC) {
            if (ch == 0) S = Sn;
            if (isR) {
                {
                    struct InR { f32x4 r4, k4, n4, b4, d4; float v; };
                    InR in_[TC]; float ov[8]; float op = 0.f;
#define LD_R(s_) do { const int o = ((s_) * 64 + 4 * kq) * 4; in_[s_].r4 = *(const PG8_LAS f32x4*)(b + OR + o); in_[s_].k4 = *(const PG8_LAS f32x4*)(b + OKT + o); in_[s_].n4 = *(const PG8_LAS f32x4*)(b + OKN + o); \
                        in_[s_].b4 = *(const PG8_LAS f32x4*)(b + OB + o); in_[s_].d4 = *(const PG8_LAS f32x4*)(b + OD + o); in_[s_].v = *(const PG8_LAS float*)(b + OVR + (s_) * 64 + vsl); } while (0)
#pragma unroll
                    for (int j = 0; j < SC_PD; ++j) LD_R(j);
#pragma unroll
                    for (int s = 0; s < TC; ++s) {
                        float dot = dot4pk(S, in_[s].n4);
                        dot += dppf<0xB1>(dot); op += dppf<0xB1>(op);
                        dot += dppf<0x4E>(dot); op += dppf<0x4E>(op);
                        dot += dppf<0x141>(dot); op += dppf<0x141>(op);
                        dot += dppf<0x140>(dot); op += dppf<0x140>(op);
                        if (s > 0) ov[(s - 1) & 7] = op;
                        if (s > 0 && (s & 7) == 0) { float outv = ov[0];
#pragma unroll
                            for (int j = 1; j < 8; ++j) outv = (kq == j) ? ov[j] : outv;
                            if (kq < 8) oAp[(size_t)(s - 8 + kq) * 512] = (u16)(cvt_pk_bf16(outv, 0.f) & 0xffffu); }
                        S = S * in_[s].d4 - in_[s].b4 * dot + in_[s].k4 * in_[s].v;
                        op = dot4pk(S, in_[s].r4);
                        if (s + SC_PD < TC) LD_R(s + SC_PD);
                        __builtin_amdgcn_sched_barrier(0);
                    }
                    ov[7] = red16(op);
                    { float outv = ov[0];
#pragma unroll
                      for (int j = 1; j < 8; ++j) outv = (kq == j) ? ov[j] : outv;
                      if (kq < 8) oAp[(size_t)(TC - 8 + kq) * 512] = (u16)(cvt_pk_bf16(outv, 0.f) & 0xffffu); }
#undef LD_R
                }
            } else {
                {
                    struct InG { f32x4 q4, k4, d4; float v; };
                    InG in_[TC]; float ov[8];
#define LD_G(s_) do { const int o = ((s_) * 64 + 4 * kq) * 4; in_[s_].q4 = *(const PG8_LAS f32x4*)(b + OQ + o); in_[s_].k4 = *(const PG8_LAS f32x4*)(b + OK + o); in_[s_].d4 = *(const PG8_LAS f32x4*)(b + ODC + o); \
                        in_[s_].v = *(const PG8_LAS float*)(b + OVG + (s_) * 64 + vsl); } while (0)
#pragma unroll
                    for (int j = 0; j < SC_PD; ++j) LD_G(j);
#pragma unroll
                    for (int s = 0; s < TC; ++s) {
                        S = S * in_[s].d4 + in_[s].k4 * in_[s].v;
                        float o_ = dot4pk(S, in_[s].q4);
                        ov[s & 7] = red16(o_);
                        if (s + SC_PD < TC) LD_G(s + SC_PD);
                        __builtin_amdgcn_sched_barrier(0);
                        if ((s & 7) == 7) { float outv = ov[0];
#pragma unroll
                            for (int j = 1; j < 8; ++j) outv = (kq == j) ? ov[j] : outv;
                            if (kq < 8) oBp[(size_t)((s & ~7) + kq) * 512] = (u16)(cvt_pk_bf16(outv, 0.f) & 0xffffu); }
                    }
#undef LD_G
                }
            }
            if (!more) SC_STORE_STATE(0, S);
        } else {
#pragma unroll 1
            for (int sgi = 0; sgi < TC / LSEG; ++sgi) {
                const int seg = ch * (TC / LSEG) + sgi;
                S = Sn;
                if ((seg + 1) * LSEG < it.T) SC_LOAD_STATE(Sn, seg + 1);
                if (isR) {
                    SC_BLOCK(SC_STEP_R, sgi * LSEG, (LSEG < TC ? LSEG : 1), oAp);
                } else {
                    SC_BLOCK(SC_STEP_G, sgi * LSEG, (LSEG < TC ? LSEG : 1), oBp);
                }
                SC_STORE_STATE(seg, S);
            }
        }
        oAp += (size_t)TC * 512; oBp += (size_t)TC * 512;
        if (more) SC_LSTORE((ch + 1) & 1);
        __syncthreads();
    }
#undef SC_BLOCK
#undef SC_STEP_R
#undef SC_STEP_G
}
__device__ void scan_phase(KP p, int l, PG8_LAS unsigned char* lds) {
    float* out = p->out;
    const int bid = opaque_bid();
    for (int i = bid; i < 256; i += gridDim.x) {
        ScanItem it; const int s = i >> 5;
        it.tok0 = s * 2048; it.T = 2048; it.L = 2048; it.h = (i >> 2) & 7; it.q = i & 3; it.hg = (i >> 3) & 3; it.cgp = i & 7;
        it.s0_rwkv = nullptr; it.so_rwkv = out + O_RWKV_P + ((size_t)(l * 8 + s) * 8 + it.h) * 4096;
        it.s0_gla = nullptr; it.so_gla = out + O_GLA_P + ((size_t)(l * 8 + s) * 4 + it.hg) * 8192;
        scan_item<2048>(p, it, lds);
    }
    for (int i = bid; i < 256; i += gridDim.x) {
        ScanItem it; const int bg = i >> 5, b0 = bg * 16;
        it.tok0 = MP + bg * 64; it.T = 64; it.L = 4; it.h = (i >> 2) & 7; it.q = i & 3; it.hg = (i >> 3) & 3; it.cgp = i & 7;
        it.s0_rwkv = p->in[I_SRWKV] + ((size_t)(l * 128 + b0) * 8 + it.h) * 4096; it.so_rwkv = out + O_RWKV_S + ((size_t)(l * 128 + b0) * 8 + it.h) * 4096;
        it.s0_gla = p->in[I_SGLA] + ((size_t)(l * 128 + b0) * 4 + it.hg) * 8192; it.so_gla = out + O_GLA_S + ((size_t)(l * 128 + b0) * 4 + it.hg) * 8192;
        scan_item<4>(p, it, lds);
    }
}

__device__ void post_phase(KP p, int l) {
    unsigned char* ws = p->ws;
    const u16* obufA = (const u16*)(ws + W_OBUFA); const u16* obufB = (const u16*)(ws + W_OBUFB); const u16* vbuf = (const u16*)(ws + W_VBUF); const u16* gbuf = (const u16*)(ws + W_GBUF);
    const float* rkb = (const float*)(ws + W_RK); const u16* projB = (const u16*)(ws + W_PROJB); u16* oab = (u16*)(ws + W_XB);
    const float* lg = p->in[I_LNXG] + l * 512; const float* lb = p->in[I_LNXB] + l * 512; const float* ng = p->in[I_NG] + l * 128;
    const int tt_ = opaque_tid();
    const int lane = tt_ & 63, gw = opaque_bid() * 8 + (tt_ >> 6), nw = gridDim.x * 8;
    const int c = lane * 8;
    float lgv[8], lbv[8], ngv[8];
#pragma unroll
    for (int j = 0; j < 8; ++j) { lgv[j] = lg[c + j]; lbv[j] = lb[c + j]; ngv[j] = ng[(c & 127) + j]; }
    for (int i = gw; i < MTOK; i += nw) {
        {
            const f32x4 o0 = ld_bf4(obufA + (size_t)i * 512 + c), o1 = ld_bf4(obufA + (size_t)i * 512 + c + 4);
            const f32x4 v0 = ld_bf4(vbuf + (size_t)i * 512 + c), v1 = ld_bf4(vbuf + (size_t)i * 512 + c + 4);
            const f32x4 g0 = ld_bf4(gbuf + (size_t)i * 512 + c), g1 = ld_bf4(gbuf + (size_t)i * 512 + c + 4);
            const float rk = rkb[(size_t)i * 8 + (lane >> 3)];
            float s = (o0[0] + o0[1]) + (o0[2] + o0[3]) + (o1[0] + o1[1]) + (o1[2] + o1[3]);
            s += __shfl_xor(s, 1); s += __shfl_xor(s, 2); s += __shfl_xor(s, 4);
            const float m = s * (1.0f / 64.0f);
            const f32x4 d0 = o0 - m, d1 = o1 - m;
            float q = (d0[0] * d0[0] + d0[1] * d0[1]) + (d0[2] * d0[2] + d0[3] * d0[3]) + (d1[0] * d1[0] + d1[1] * d1[1]) + (d1[2] * d1[2] + d1[3] * d1[3]);
            q += __shfl_xor(q, 1); q += __shfl_xor(q, 2); q += __shfl_xor(q, 4);
            const float rs = rsqrtf(q * (1.0f / 64.0f) + GN_EPS_A);
            f32x4 y0, y1;
#pragma unroll
            for (int j = 0; j < 4; ++j) { y0[j] = (d0[j] * rs * lgv[j] + lbv[j] + rk * v0[j]) * g0[j]; y1[j] = (d1[j] * rs * lgv[4 + j] + lbv[4 + j] + rk * v1[j]) * g1[j]; }
            u32x4 w; w.x = cvt_pk_bf16(y0[0], y0[1]); w.y = cvt_pk_bf16(y0[2], y0[3]); w.z = cvt_pk_bf16(y1[0], y1[1]); w.w = cvt_pk_bf16(y1[2], y1[3]);
            *(u32x4*)(oab + (size_t)i * 1024 + c) = w;
        }
        {
            const f32x4 o0 = ld_bf4(obufB + (size_t)i * 512 + c), o1 = ld_bf4(obufB + (size_t)i * 512 + c + 4);
            const f32x4 g0 = ld_bf4(projB + (size_t)i * 1792 + 1024 + c), g1 = ld_bf4(projB + (size_t)i * 1792 + 1024 + c + 4);
            float q = (o0[0] * o0[0] + o0[1] * o0[1]) + (o0[2] * o0[2] + o0[3] * o0[3]) + (o1[0] * o1[0] + o1[1] * o1[1]) + (o1[2] * o1[2] + o1[3] * o1[3]);
            q += __shfl_xor(q, 1); q += __shfl_xor(q, 2); q += __shfl_xor(q, 4); q += __shfl_xor(q, 8);
            const float rs = rsqrtf(q * (1.0f / 128.0f) + RMS_EPS);
            f32x4 y0, y1;
#pragma unroll
            for (int j = 0; j < 4; ++j) { y0[j] = o0[j] * rs * ngv[j] * (g0[j] * sigmoidf_(g0[j])); y1[j] = o1[j] * rs * ngv[4 + j] * (g1[j] * sigmoidf_(g1[j])); }
            u32x4 w; w.x = cvt_pk_bf16(y0[0], y0[1]); w.y = cvt_pk_bf16(y0[2], y0[3]); w.z = cvt_pk_bf16(y1[0], y1[1]); w.w = cvt_pk_bf16(y1[2], y1[3]);
            *(u32x4*)(oab + (size_t)i * 1024 + 512 + c) = w;
        }
    }
}

#define XB_TMO      128
#define XB_XCNT(j)  (256  + 64 * (j))
#define XB_XSUB(j)  (1280 + 64 * (j))
#define XB_XGEN(j)  (2304 + 64 * (j))
#define XB_TOP      3328
#define XB_TOPGEN   3392
#define XCD_BAR_WORDS 3456
#define XB_SPIN_CAP (1u << 18)
__device__ __forceinline__ unsigned xb_ld(unsigned* p)              { return __hip_atomic_load(p, __ATOMIC_RELAXED, __HIP_MEMORY_SCOPE_AGENT); }
__device__ __forceinline__ unsigned xb_add(unsigned* p, unsigned v) { return __hip_atomic_fetch_add(p, v, __ATOMIC_RELAXED, __HIP_MEMORY_SCOPE_AGENT); }
__device__ __forceinline__ unsigned xb_xcc_id() { return (unsigned)__builtin_amdgcn_s_getreg((3 << 11) | 20) & 0xFu; }
#define XB_SPIN(cond, bar) do { unsigned _sp = 0; while (cond) { __builtin_amdgcn_s_sleep(1); \
    if ((++_sp & 255u) == 0u) { if (xb_ld(&(bar)[XB_TMO])) break; if (_sp > XB_SPIN_CAP) { atomicAdd(&(bar)[XB_TMO], 1u); break; } } } } while (0)
__device__ __forceinline__ void xcd_barrier_complete(unsigned* bar, unsigned x, unsigned& nloc, unsigned& nx) {
    const unsigned G = gridDim.x * gridDim.y * gridDim.z;
    unsigned sum, cnt, mine, sp = 0u;
    for (;;) {
        sum = 0u; cnt = 0u; mine = 0u;
#pragma unroll
        for (unsigned j = 0; j < 16; ++j) { const unsigned c = xb_ld(&bar[XB_XCNT(j)]); sum += c; cnt += (c > 0u) ? 1u : 0u; mine = (j == x) ? c : mine; }
        if (sum == G) break;
        __builtin_amdgcn_s_sleep(1);
        if ((++sp & 255u) == 0u) { if (xb_ld(&bar[XB_TMO])) break; if (sp > XB_SPIN_CAP) { atomicAdd(&bar[XB_TMO], 1u); break; } }
    }
    nloc = mine > 0u ? mine : 1u; nx = cnt > 0u ? cnt : 1u;
}
__device__ __forceinline__ void xcd_barrier(unsigned* bar, volatile PG8_LAS unsigned* st) {
    asm volatile("s_waitcnt vmcnt(0)" ::: "memory");
    __syncthreads();
    if (threadIdx.x == 0) {
        const unsigned x = xb_xcc_id();
        __builtin_amdgcn_s_waitcnt(0);
        unsigned nloc = st[0], nx = st[1];
        if (nloc == 0u) { xcd_barrier_complete(bar, x, nloc, nx); st[0] = nloc; st[1] = nx; }
        const unsigned old = xb_add(&bar[XB_XSUB(x)], 1u);
        const unsigned gen = old / nloc;
        if (old + 1u == (gen + 1u) * nloc) {
            __builtin_amdgcn_fence(__ATOMIC_RELEASE, "agent");
            asm volatile("s_waitcnt vmcnt(0)" ::: "memory");
            const unsigned og = xb_add(&bar[XB_TOP], 1u);
            const unsigned tg = og / nx;
            if (og + 1u == (tg + 1u) * nx) xb_add(&bar[XB_TOPGEN], 1u);
            else XB_SPIN(xb_ld(&bar[XB_TOPGEN]) == tg, bar);
            __builtin_amdgcn_fence(__ATOMIC_ACQUIRE, "agent");
            xb_add(&bar[XB_XGEN(x)], 1u);
            asm volatile("s_waitcnt vmcnt(0)" ::: "memory");
        } else {
            XB_SPIN(xb_ld(&bar[XB_XGEN(x)]) == gen, bar);
            __builtin_amdgcn_fence(__ATOMIC_ACQUIRE, "agent");
            asm volatile("s_waitcnt vmcnt(0)" ::: "memory");
        }
    }
    __syncthreads();
}
__device__ __forceinline__ void gsync(cg::grid_group& grid) {
    asm volatile("s_waitcnt vmcnt(0)" ::: "memory");
    grid.sync();
    if (threadIdx.x < 64) { __builtin_amdgcn_fence(__ATOMIC_ACQUIRE, "agent"); asm volatile("s_waitcnt vmcnt(0)" ::: "memory"); }
    __syncthreads();
}

__global__ void __launch_bounds__(512, 2) mega(Params p_unused) {
    KP p = kparams();
    extern __shared__ __attribute__((aligned(16))) unsigned char smem[];
    PG8_LAS unsigned char* lds = (PG8_LAS unsigned char*)smem;
    cg::grid_group grid = cg::this_grid();
    unsigned char* ws = p->ws;
    float* bufA = p->out + O_Y; float* bufB = (float*)(ws + W_BUFB); u16* xb = (u16*)(ws + W_XB);
    pg8::StaticOrder S;
    volatile PG8_LAS unsigned* xst = (volatile PG8_LAS unsigned*)(lds + 139264);
    if (threadIdx.x == 0) { xst[0] = 0u; xst[1] = 0u; }
    gsync(grid);
    unsigned* xbar = (unsigned*)(kparams()->ws + W_BAR);
    if (threadIdx.x == 0) (void)xb_add(&xbar[XB_XCNT(xb_xcc_id())], 1u);
#define PHASE_END() xcd_barrier((unsigned*)(kparams()->ws + W_BAR), xst)
    convert_phase(kparams(), 0, (float*)smem);
    PHASE_END();
    for (int l = 0; l < NL; ++l) {
        {
            pg8::Gemm g; g.A = xb; g.Bt = (const u16*)(ws + W_WIN); g.M = MTOK; g.N = INP; g.K = 1024;
            EpiProj E; E.projA = (u16*)(ws + W_PROJA); E.projB = (u16*)(ws + W_PROJB); E.shift_p = p->out + O_SHIFT_P + (size_t)l * 8 * 1792; E.shift_s = p->out + O_SHIFT_S + (size_t)l * 128 * 1792;
            S.init(MTOK, INP, gridDim.x, opaque_bid()); pg8::gemm_phase(lds, g, S, E);
        }
        PHASE_END();
        prep_phase(kparams(), l, lds);
        PHASE_END();
        scan_phase(kparams(), l, lds);
        PHASE_END();
        post_phase(kparams(), l);
        PHASE_END();
        {
            pg8::Gemm g; g.A = xb; g.Bt = (const u16*)(ws + W_WOUT); g.M = MTOK; g.N = 1024; g.K = 1024;
            EpiResid E; E.base = bufA; E.out = bufB;
            g.M = MP; S.init(MP, 1024, gridDim.x, opaque_bid()); pg8::gemm_phase(lds, g, S, E);
            small_gemm_resid(g.A, g.Bt, 1024, E.base, E.out, lds);
        }
        PHASE_END();
        ln_phase(bufB, xb, p->in[I_LN1G] + l * 1024, p->in[I_LN1B] + l * 1024);
        PHASE_END();
        {
            pg8::Gemm g; g.A = xb; g.Bt = (const u16*)(ws + W_WUP); g.M = MTOK; g.N = 5632; g.K = 1024;
            EpiUp E; E.gate = (u16*)(ws + W_GATE); E.val = (u16*)(ws + W_VAL); E.conv_p = p->out + O_CONV_P + (size_t)l * 8 * 2 * DFF; E.conv_s = p->out + O_CONV_S + (size_t)l * 128 * 2 * DFF;
            S.init(MTOK, 5632, gridDim.x, opaque_bid()); pg8::gemm_phase(lds, g, S, E);
        }
        PHASE_END();
        convglu_phase((const u16*)(ws + W_GATE), (u16*)(ws + W_VAL), p->in[I_SCONV] + (size_t)l * 128 * 2 * DFF, p->in[I_CW] + (size_t)l * 3 * DFF, p->in[I_CB] + (size_t)l * DFF);
        PHASE_END();
        {
            pg8::Gemm g; g.A = (const u16*)(ws + W_VAL); g.Bt = (const u16*)(ws + W_WDOWN); g.M = MTOK; g.N = 1024; g.K = DFF;
            EpiResid E; E.base = bufB; E.out = bufA;
            g.M = MP; S.init(MP, 1024, gridDim.x, opaque_bid()); pg8::gemm_phase(lds, g, S, E);
            small_gemm_resid(g.A, g.Bt, DFF, E.base, E.out, lds);
        }
        PHASE_END();
        ln_phase(bufA, xb, p->in[I_LN2G] + l * 1024, p->in[I_LN2B] + l * 1024);
        if (l + 1 < NL) convert_phase(kparams(), l + 1, (float*)smem);
        PHASE_END();
    }
}

extern "C" void kernel_launch(void* const* d_in, const int* in_sizes, int n_in, void* d_out, int out_size, void* d_ws, size_t ws_size, hipStream_t stream) {
    static int grid_blocks = 0;
    if (!grid_blocks) {
        int dev = 0, cus = 0, per_cu = 0;
        (void)hipGetDevice(&dev);
        (void)hipDeviceGetAttribute(&cus, hipDeviceAttributeMultiprocessorCount, dev);
        (void)hipFuncSetAttribute((const void*)mega, hipFuncAttributeMaxDynamicSharedMemorySize, LDS_BYTES);
        (void)hipOccupancyMaxActiveBlocksPerMultiprocessor(&per_cu, (const void*)mega, 512, LDS_BYTES);
        grid_blocks = cus;
        if (n_in != 33 || (size_t)out_size != O_END || ws_size < W_TOTAL) { fprintf(stderr, "kernel_launch: unexpected sizes n_in %d out %d ws %zu (need %zu)\n", n_in, out_size, ws_size, (size_t)W_TOTAL); grid_blocks = -1; }
    }
    if (grid_blocks < 0) return;
    (void)hipMemsetAsync((unsigned char*)d_ws + W_BAR, 0, XCD_BAR_WORDS * sizeof(unsigned), stream);
    Params p{};
    for (int i = 0; i < 33; ++i) p.in[i] = (const float*)d_in[i];
    p.out = (float*)d_out; p.ws = (unsigned char*)d_ws;
    void* args[] = {&p};
    hipError_t e = hipLaunchCooperativeKernel((const void*)mega, dim3(grid_blocks), dim3(512), args, LDS_BYTES, stream);
    if (e != hipSuccess) fprintf(stderr, "cooperative launch failed: %s (grid %d)\n", hipGetErrorString(e), grid_blocks);
}
```

```cpp
#include <hip/hip_runtime.h>
#include <hip/hip_cooperative_groups.h>
#include <cstdio>
namespace cg = cooperative_groups;

#define PG8_LAS __attribute__((address_space(3)))
typedef unsigned short u16;
typedef unsigned int u32;
typedef unsigned short bf16_t;
typedef short bf16x8 __attribute__((ext_vector_type(8)));
typedef float f32x4 __attribute__((ext_vector_type(4)));
typedef float f32x2 __attribute__((ext_vector_type(2)));
typedef unsigned u32x4 __attribute__((ext_vector_type(4)));
typedef unsigned u32x2 __attribute__((ext_vector_type(2)));

constexpr int MTOK = 16896, MP = 16384, DM = 1024, NL = 4;
constexpr int SHIFT_W = 1792, INP = 3584, DFF = 2816;
constexpr float ALPHA = 1.6817928305074290f;
constexpr float GN_EPS_A = 64e-5f, RMS_EPS = 1e-5f, LN_EPS = 1e-5f;
constexpr int LDS_BYTES = 139264 + 16;
constexpr int TC = 32;
#define SC_PD 3

enum { I_XP = 0, I_XS, I_SRWKV, I_SSHIFT, I_SGLA, I_SCONV, I_WIN, I_MU, I_W0, I_WLU, I_A0, I_ALU, I_GLU, I_KK, I_KA, I_RK, I_LNXG, I_LNXB,
       I_VB, I_VD, I_VU, I_FUP, I_FB, I_NG, I_WOUT, I_LN1G, I_LN1B, I_WUP, I_CW, I_CB, I_WDOWN, I_LN2G, I_LN2B };

constexpr size_t O_Y = 0;
constexpr size_t O_RWKV_P = (size_t)MTOK * DM;
constexpr size_t O_RWKV_S = O_RWKV_P + (size_t)4 * 8 * 8 * 4096;
constexpr size_t O_SHIFT_P = O_RWKV_S + (size_t)4 * 128 * 8 * 4096;
constexpr size_t O_SHIFT_S = O_SHIFT_P + (size_t)4 * 8 * 1792;
constexpr size_t O_GLA_P = O_SHIFT_S + (size_t)4 * 128 * 1792;
constexpr size_t O_GLA_S = O_GLA_P + (size_t)4 * 8 * 4 * 8192;
constexpr size_t O_CONV_P = O_GLA_S + (size_t)4 * 128 * 4 * 8192;
constexpr size_t O_CONV_S = O_CONV_P + (size_t)4 * 8 * 2 * 2816;
constexpr size_t O_END = O_CONV_S + (size_t)4 * 128 * 2 * 2816;

constexpr size_t W_WIN = 0;
constexpr size_t W_WOUT = W_WIN + (size_t)INP * 1024 * 2;
constexpr size_t W_WUP = W_WOUT + (size_t)1024 * 1024 * 2;
constexpr size_t W_WDOWN = W_WUP + (size_t)5632 * 1024 * 2;
constexpr size_t W_WLT = W_WDOWN + (size_t)1024 * 2816 * 2;
constexpr size_t W_ALT = W_WLT + 512 * 64 * 2;
constexpr size_t W_GLT = W_ALT + 512 * 64 * 2;
constexpr size_t W_V1T = W_GLT + 512 * 128 * 2;
constexpr size_t W_V2T = W_V1T + 32 * 512 * 2;
constexpr size_t W_FT = W_V2T + 512 * 32 * 2;
constexpr size_t W_XB = W_FT + 256 * 32 * 2;
constexpr size_t W_VFIRST = W_XB + (size_t)MTOK * 1024 * 2;
constexpr size_t W_BUFB = W_VFIRST + (size_t)MTOK * 512 * 2;
constexpr size_t W_R = W_BUFB + (size_t)MTOK * 1024 * 4;
constexpr size_t W_PROJA = W_R;
constexpr size_t W_PROJB = W_PROJA + (size_t)MTOK * 1792 * 2;
constexpr size_t W_D8 = W_PROJB + (size_t)MTOK * 1792 * 2;
constexpr size_t W_VBUF = W_D8 + (size_t)MTOK * 512 * 4;
constexpr size_t W_GBUF = W_VBUF + (size_t)MTOK * 512 * 2;
constexpr size_t W_DEC = W_GBUF + (size_t)MTOK * 512 * 2;
constexpr size_t W_RK = W_DEC + (size_t)MTOK * 256 * 4;
constexpr size_t W_END1 = W_RK + (size_t)MTOK * 8 * 4;
constexpr size_t W_GATE = W_R;
constexpr size_t W_VAL = W_GATE + (size_t)MTOK * 2816 * 2;
constexpr size_t W_END2 = W_VAL + (size_t)MTOK * 2816 * 2;
constexpr size_t W_END = W_END1 > W_END2 ? W_END1 : W_END2;
constexpr size_t W_BAR = (W_END + 255) / 256 * 256;
constexpr size_t W_TOTAL = W_BAR + 16384;
constexpr size_t W_OBUFA = W_PROJA;
constexpr size_t W_OBUFB = W_PROJA + (size_t)MTOK * 512 * 2;

struct Params { const float* in[33]; float* out; unsigned char* ws; };
typedef const Params __attribute__((address_space(4)))* KP;
__device__ __forceinline__ KP kparams() { unsigned long long k = (unsigned long long)__builtin_amdgcn_kernarg_segment_ptr(); asm volatile("" : "+s"(k)); return (KP)k; }

typedef __bf16 bf16v2 __attribute__((ext_vector_type(2)));
__device__ __forceinline__ unsigned cvt_pk_bf16(float lo, float hi) { const f32x2 v = (f32x2){lo, hi}; const bf16v2 b = __builtin_convertvector(v, bf16v2); return __builtin_bit_cast(unsigned, b); }
__device__ __forceinline__ float bflo(u32 w) { return __uint_as_float(w << 16); }
__device__ __forceinline__ float bfhi(u32 w) { return __uint_as_float(w & 0xffff0000u); }
__device__ __forceinline__ f32x4 ld_bf4(const u16* p) { const u32x2 w = *(const u32x2*)p; return (f32x4){bflo(w.x), bfhi(w.x), bflo(w.y), bfhi(w.y)}; }
__device__ __forceinline__ unsigned cvt_pk_bf16_asm(float lo, float hi) { unsigned r; asm volatile("v_cvt_pk_bf16_f32 %0, %1, %2" : "=v"(r) : "v"(lo), "v"(hi)); return r; }
__device__ __forceinline__ void st_bf4_asm(u16* p, f32x4 v) { u32x2 w; w.x = cvt_pk_bf16_asm(v[0], v[1]); w.y = cvt_pk_bf16_asm(v[2], v[3]); *(u32x2*)p = w; }
__device__ __forceinline__ void st_bf4(u16* p, f32x4 v) { u32x2 w; w.x = cvt_pk_bf16(v[0], v[1]); w.y = cvt_pk_bf16(v[2], v[3]); *(u32x2*)p = w; }
__device__ __forceinline__ float sigmoidf_(float x) { return __builtin_amdgcn_rcpf(1.0f + __expf(-x)); }
__device__ __forceinline__ float tanhf_(float x) { return 1.0f - 2.0f * __builtin_amdgcn_rcpf(1.0f + __expf(2.0f * x)); }
__device__ __forceinline__ float softplusf_(float x) { return fmaxf(x, 0.f) + __logf(1.0f + __expf(-fabsf(x))); }
template <int CTRL> __device__ __forceinline__ float dppf(float x) { return __builtin_bit_cast(float, __builtin_amdgcn_update_dpp(0, __builtin_bit_cast(int, x), CTRL, 0xF, 0xF, true)); }
__device__ __forceinline__ float dot4pk(f32x4 a, f32x4 b) { f32x2 p = (f32x2){a[0], a[1]} * (f32x2){b[0], b[1]}; p = (f32x2){a[2], a[3]} * (f32x2){b[2], b[3]} + p; return p.x + p.y; }
__device__ __forceinline__ float red16(float x) { x += dppf<0xB1>(x); x += dppf<0x4E>(x); x += dppf<0x141>(x); x += dppf<0x140>(x); return x; }

__device__ __forceinline__ int opaque_tid() { int t = threadIdx.x; asm volatile("" : "+v"(t)); return t; }
__device__ __forceinline__ int opaque_bid() { int b = blockIdx.x; asm volatile("" : "+s"(b)); return b; }

namespace pg8 {
constexpr int BM = 256, BK = 64, HALF = 128, HTB = HALF * BK * 2, STAGE_BYTES = 8 * HTB, NXCD = 8, WGM = 8;
__host__ __device__ __forceinline__ int lds_byte(int r, int c) { const int st = (r >> 4) * 2 + (c >> 5), rr = r & 15, cc = c & 31, ob = rr * 64 + cc * 2; return st * 1024 + (ob ^ (((ob >> 9) & 1) << 5)); }
__host__ __device__ __forceinline__ void stage_rc(int b, int& R, int& C) { const int st = b / 1024, sb = b % 1024, swz = sb ^ (((sb >> 9) & 1) << 5); R = (st >> 1) * 16 + swz / 64; C = (st & 1) * 32 + (swz % 64) / 2; }
struct Unit { int pm, pn; };
struct Gemm { const bf16_t* A; const bf16_t* Bt; int M, N, K; };
struct StaticOrder {
    int nM, nN, nwg, G, c;
    __host__ __device__ void init(int M, int N, int G_, int c_) { nM = M / BM; nN = N / BM; nwg = nM * nN; G = G_; c = c_; }
    __host__ __device__ bool next(int i, Unit& u) const {
        const long L = (long)i * G + c; if (L >= nwg) return false;
        int wgid = (int)L; { const int q = nwg / NXCD, r = nwg % NXCD, xcd = wgid % NXCD, off = wgid / NXCD; wgid = (xcd < r ? xcd * (q + 1) : r * (q + 1) + (xcd - r) * q) + off; }
        const int nig = WGM * nN, gid = wgid / nig, fm = gid * WGM, gsz = (nM - fm) < WGM ? (nM - fm) : WGM;
        u.pm = fm + ((wgid % nig) % gsz); u.pn = (wgid % nig) / gsz; return true;
    }
};

template <class Epi>
__device__ __forceinline__ void gemm_phase(PG8_LAS unsigned char* lds, const Gemm g, const StaticOrder& S, const Epi& E) {
    const int tid = opaque_tid(), wid = __builtin_amdgcn_readfirstlane(tid >> 6), lane = tid & 63, wr = wid >> 2, wc = wid & 3, fr = lane & 15, fq = lane >> 4;
    const int K = g.K, nt = K / BK;
    unsigned voffA[2], voffB[2];
#pragma unroll
    for (int i = 0; i < 2; ++i) { int R, C; stage_rc(tid * 16 + i * 8192, R, C); voffA[i] = (unsigned)(R * K + C) * 2u; voffB[i] = voffA[i]; }
    const size_t kstep = (size_t)(BK * 2);
    const size_t hstep = (size_t)HALF * K * 2;
    const size_t tstep = 2 * hstep;
    const unsigned ldsw = (unsigned)wid * 1024u;
    const int aoff = lds_byte(wr * 64 + fr, fq * 8), boff = lds_byte(wc * 32 + fr, fq * 8);
#define PG8_SA(b, h) (((b) * 2 + (h)) * HTB)
#define PG8_SB(b, h) ((4 + (b) * 2 + (h)) * HTB)
#define PG8_STAGE(bufoff, gbase, voff) do { _Pragma("unroll") for (int _i = 0; _i < 2; ++_i) \
        __builtin_amdgcn_global_load_lds((const unsigned*)((const char*)(gbase) + (voff)[_i]), (PG8_LAS unsigned*)(lds + (bufoff) + ldsw + _i * 8192), 16, 0, 0); } while (0)
#define PG8_LDA(dst, b, h) do { _Pragma("unroll") for (int m = 0; m < 4; ++m) _Pragma("unroll") for (int k = 0; k < 2; ++k) dst[m][k] = *(const PG8_LAS bf16x8*)(lds + PG8_SA(b, h) + aoff + m * 2048 + k * 1024); } while (0)
#define PG8_LDB(dst, b, h) do { _Pragma("unroll") for (int n = 0; n < 2; ++n) _Pragma("unroll") for (int k = 0; k < 2; ++k) dst[n][k] = *(const PG8_LAS bf16x8*)(lds + PG8_SB(b, h) + boff + n * 2048 + k * 1024); } while (0)
#define PG8_MMA(ai, bj, At, Bt) do { __builtin_amdgcn_s_setprio(1); _Pragma("unroll") for (int m = 0; m < 4; ++m) _Pragma("unroll") for (int n = 0; n < 2; ++n) _Pragma("unroll") for (int k = 0; k < 2; ++k) \
        acc[ai][bj][m][n] = __builtin_amdgcn_mfma_f32_16x16x32_bf16(Bt[n][k], At[m][k], acc[ai][bj][m][n], 0, 0, 0); __builtin_amdgcn_s_setprio(0); } while (0)
#define PG8_WAIT_V(n) asm volatile("s_waitcnt vmcnt(" #n ")" ::: "memory")
#define PG8_WAIT_L(n) asm volatile("s_waitcnt lgkmcnt(" #n ")" ::: "memory")
#define PG8_BAR __builtin_amdgcn_s_barrier()
#define PG8_SCHED __builtin_amdgcn_sched_barrier(0)
    Unit cur, nxt; int ui = 0;
    if (!S.next(0, cur)) return;
    f32x4 acc[2][2][4][2];
#pragma unroll
    for (int a = 0; a < 2; ++a)
#pragma unroll
        for (int b = 0; b < 2; ++b)
#pragma unroll
            for (int m = 0; m < 4; ++m)
#pragma unroll
                for (int n = 0; n < 2; ++n) acc[a][b][m][n] = (f32x4){0.f, 0.f, 0.f, 0.f};
    bf16x8 At[4][2], B0[2][2], B1[2][2];
    const char* cA = (const char*)g.A + (size_t)cur.pm * tstep; const char* cB = (const char*)g.Bt + (size_t)cur.pn * tstep;
    PG8_STAGE(PG8_SB(0, 0), cB, voffB); PG8_STAGE(PG8_SA(0, 0), cA, voffA); PG8_STAGE(PG8_SB(0, 1), cB + hstep, voffB); PG8_STAGE(PG8_SA(0, 1), cA + hstep, voffA);
    if (wr == 1) PG8_BAR;
    PG8_WAIT_V(4); PG8_BAR;
    PG8_STAGE(PG8_SB(1, 0), cB + kstep, voffB); PG8_STAGE(PG8_SA(1, 0), cA + kstep, voffA); PG8_STAGE(PG8_SB(1, 1), cB + hstep + kstep, voffB);
    PG8_WAIT_V(6); PG8_BAR;
    for (;;) {
        const bool has_next = S.next(ui + 1, nxt);
        const char* nA = has_next ? (const char*)g.A + (size_t)nxt.pm * tstep : cA; const char* nB = has_next ? (const char*)g.Bt + (size_t)nxt.pn * tstep : cB;
        for (int t = 0; t < nt; t += 2) {
            const bool last = (t == nt - 2);
            const char* a1 = cA + (size_t)(t + 1) * kstep;
            const char* a2 = last ? nA : cA + (size_t)(t + 2) * kstep; const char* b2 = last ? nB : cB + (size_t)(t + 2) * kstep;
            const char* a3 = a2 + kstep; const char* b3 = b2 + kstep;
            PG8_LDB(B0, 0, 0); PG8_SCHED; PG8_LDA(At, 0, 0); PG8_STAGE(PG8_SA(1, 1), a1 + hstep, voffA);
            PG8_WAIT_L(8); PG8_BAR; PG8_WAIT_L(0); PG8_MMA(0, 0, At, B0); PG8_BAR; PG8_SCHED;
            PG8_LDB(B1, 0, 1); PG8_STAGE(PG8_SB(0, 0), b2, voffB);
            PG8_BAR; PG8_WAIT_L(0); PG8_MMA(0, 1, At, B1); PG8_BAR;
            PG8_LDA(At, 0, 1); PG8_STAGE(PG8_SA(0, 0), a2, voffA);
            PG8_BAR; PG8_WAIT_L(0); PG8_MMA(1, 0, At, B0); PG8_BAR; PG8_SCHED;
            PG8_STAGE(PG8_SB(0, 1), b2 + hstep, voffB);
            PG8_WAIT_V(6); PG8_BAR; PG8_MMA(1, 1, At, B1); PG8_BAR;
            PG8_LDB(B0, 1, 0); PG8_SCHED; PG8_LDA(At, 1, 0); PG8_STAGE(PG8_SA(0, 1), a2 + hstep, voffA);
            PG8_WAIT_L(8); PG8_BAR; PG8_WAIT_L(0); PG8_MMA(0, 0, At, B0); PG8_BAR; PG8_SCHED;
            PG8_LDB(B1, 1, 1); PG8_STAGE(PG8_SB(1, 0), b3, voffB);
            PG8_BAR; PG8_WAIT_L(0); PG8_MMA(0, 1, At, B1); PG8_BAR;
            PG8_LDA(At, 1, 1); PG8_STAGE(PG8_SA(1, 0), a3, voffA);
            PG8_BAR; PG8_WAIT_L(0); PG8_MMA(1, 0, At, B0); PG8_BAR; PG8_SCHED;
            PG8_STAGE(PG8_SB(1, 1), b3 + hstep, voffB);
            PG8_WAIT_V(6); PG8_BAR; PG8_MMA(1, 1, At, B1); PG8_BAR;
        }
        asm volatile("s_nop 7\n\ts_nop 7\n\ts_nop 7" ::: "memory");
        E(acc, cur, wr, wc, fr, fq);
        if (!has_next) break;
#pragma unroll
        for (int a = 0; a < 2; ++a)
#pragma unroll
            for (int b = 0; b < 2; ++b)
#pragma unroll
                for (int m = 0; m < 4; ++m)
#pragma unroll
                    for (int n = 0; n < 2; ++n) acc[a][b][m][n] = (f32x4){0.f, 0.f, 0.f, 0.f};
        cur = nxt; cA = nA; cB = nB; ++ui;
    }
    PG8_WAIT_V(0);
    if (wr == 0) PG8_BAR;
    PG8_BAR;
#undef PG8_SA
#undef PG8_SB
#undef PG8_STAGE
#undef PG8_LDA
#undef PG8_LDB
#undef PG8_MMA
#undef PG8_WAIT_V
#undef PG8_WAIT_L
#undef PG8_BAR
#undef PG8_SCHED
}
}
using pg8::Unit;

struct EpiProj {
    u16* projA; u16* projB; float* shift_p; float* shift_s;
    __device__ __forceinline__ void operator()(const f32x4 (&acc)[2][2][4][2], const Unit& u, int wr, int wc, int fr, int fq) const {
        const int row0 = u.pm * 256 + wr * 64 + fr;
        const bool isA = u.pn < 7;
        u16* base = isA ? projA : projB;
        const int colt = (isA ? u.pn : u.pn - 7) * 256 + wc * 32 + 4 * fq;
#pragma unroll
        for (int ai = 0; ai < 2; ++ai)
#pragma unroll
            for (int m = 0; m < 4; ++m) {
                const int row = row0 + ai * 128 + m * 16;
                u16* rowp = base + (size_t)row * 1792 + colt;
#pragma unroll
                for (int bj = 0; bj < 2; ++bj)
#pragma unroll
                    for (int n = 0; n < 2; ++n) st_bf4_asm(rowp + bj * 128 + n * 16, acc[ai][bj][m][n]);
                if (isA) {
                    float* dst = nullptr;
                    if (row < MP) { if ((row & 2047) == 2047) dst = shift_p + (size_t)(row >> 11) * 1792; }
                    else { const int r = row - MP; if ((r & 3) == 3) dst = shift_s + (size_t)(r >> 2) * 1792; }
                    if (dst) {
#pragma unroll
                        for (int bj = 0; bj < 2; ++bj)
#pragma unroll
                            for (int n = 0; n < 2; ++n) *(f32x4*)(dst + colt + bj * 128 + n * 16) = acc[ai][bj][m][n];
                    }
                }
            }
    }
};
struct EpiResid {
    const float* base; float* out;
    __device__ __forceinline__ void operator()(const f32x4 (&acc)[2][2][4][2], const Unit& u, int wr, int wc, int fr, int fq) const {
        const int row0 = u.pm * 256 + wr * 64 + fr, col0 = u.pn * 256 + wc * 32 + 4 * fq;
#pragma unroll
        for (int ai = 0; ai < 2; ++ai)
#pragma unroll
            for (int m = 0; m < 4; ++m) {
                const size_t off = (size_t)(row0 + ai * 128 + m * 16) * 1024 + col0;
#pragma unroll
                for (int bj = 0; bj < 2; ++bj)
#pragma unroll
                    for (int n = 0; n < 2; ++n) { const f32x4 b = *(const f32x4*)(base + off + bj * 128 + n * 16); *(f32x4*)(out + off + bj * 128 + n * 16) = b * ALPHA + acc[ai][bj][m][n]; }
            }
    }
};
struct EpiResidB {
    const u16* base; float* out;
    __device__ __forceinline__ void operator()(const f32x4 (&acc)[2][2][4][2], const Unit& u, int wr, int wc, int fr, int fq) const {
        const int row0 = u.pm * 256 + wr * 64 + fr, col0 = u.pn * 256 + wc * 32 + 4 * fq;
#pragma unroll
        for (int ai = 0; ai < 2; ++ai)
#pragma unroll
            for (int m = 0; m < 4; ++m) {
                const size_t off = (size_t)(row0 + ai * 128 + m * 16) * 1024 + col0;
#pragma unroll
                for (int bj = 0; bj < 2; ++bj)
#pragma unroll
                    for (int n = 0; n < 2; ++n) { const f32x4 b = ld_bf4(base + off + bj * 128 + n * 16); *(f32x4*)(out + off + bj * 128 + n * 16) = b * ALPHA + acc[ai][bj][m][n]; }
            }
    }
};
struct EpiUp {
    u16* gate; u16* val; float* conv_p; float* conv_s;
    __device__ __forceinline__ void operator()(const f32x4 (&acc)[2][2][4][2], const Unit& u, int wr, int wc, int fr, int fq) const {
        const int row0 = u.pm * 256 + wr * 64 + fr;
        const bool isG = u.pn < 11;
        u16* base = isG ? gate : val;
        const int colt = (isG ? u.pn : u.pn - 11) * 256 + wc * 32 + 4 * fq;
#pragma unroll
        for (int ai = 0; ai < 2; ++ai)
#pragma unroll
            for (int m = 0; m < 4; ++m) {
                const int row = row0 + ai * 128 + m * 16;
                u16* rowp = base + (size_t)row * DFF + colt;
#pragma unroll
                for (int bj = 0; bj < 2; ++bj)
#pragma unroll
                    for (int n = 0; n < 2; ++n) st_bf4_asm(rowp + bj * 128 + n * 16, acc[ai][bj][m][n]);
                if (isG) {
                    float* dst = nullptr;
                    if (row < MP) { const int t = row & 2047; if (t >= 2046) dst = conv_p + (size_t)((row >> 11) * 2 + (t - 2046)) * DFF; }
                    else { const int r = row - MP, t = r & 3; if (t >= 2) dst = conv_s + (size_t)((r >> 2) * 2 + (t - 2)) * DFF; }
                    if (dst) {
#pragma unroll
                        for (int bj = 0; bj < 2; ++bj)
#pragma unroll
                            for (int n = 0; n < 2; ++n) *(f32x4*)(dst + colt + bj * 128 + n * 16) = acc[ai][bj][m][n];
                    }
                }
            }
    }
};

template <bool BASE_BF16>
__device__ void small_gemm_resid(const u16* __restrict__ A, const u16* __restrict__ Bt, int K, const void* __restrict__ base, float* __restrict__ out, PG8_LAS unsigned char* lds) {
    const int t = opaque_tid(), wid = t >> 6, lane = t & 63, fr = lane & 15, fq = lane >> 4;
    const int kw = K >> 3, nks = kw >> 5;
    for (int tile = opaque_bid(); tile < 256; tile += gridDim.x) {
        const int r0 = MP + (tile >> 4) * 32, c0 = (tile & 15) * 64;
        f32x4 acc[2][4];
#pragma unroll
        for (int mi = 0; mi < 2; ++mi)
#pragma unroll
            for (int ni = 0; ni < 4; ++ni) acc[mi][ni] = (f32x4){0.f, 0.f, 0.f, 0.f};
#pragma unroll 2
        for (int ks = 0; ks < nks; ++ks) {
            const int k = wid * kw + ks * 32 + fq * 8;
            bf16x8 a[2], b[4];
#pragma unroll
            for (int mi = 0; mi < 2; ++mi) a[mi] = *(const bf16x8*)(A + (size_t)(r0 + mi * 16 + fr) * K + k);
#pragma unroll
            for (int ni = 0; ni < 4; ++ni) b[ni] = *(const bf16x8*)(Bt + (size_t)(c0 + ni * 16 + fr) * K + k);
#pragma unroll
            for (int mi = 0; mi < 2; ++mi)
#pragma unroll
                for (int ni = 0; ni < 4; ++ni) acc[mi][ni] = __builtin_amdgcn_mfma_f32_16x16x32_bf16(b[ni], a[mi], acc[mi][ni], 0, 0, 0);
        }
        PG8_LAS f32x4* red = (PG8_LAS f32x4*)lds;
#pragma unroll
        for (int mi = 0; mi < 2; ++mi)
#pragma unroll
            for (int ni = 0; ni < 4; ++ni) red[(wid * 8 + mi * 4 + ni) * 64 + lane] = acc[mi][ni];
        __syncthreads();
        {
            f32x4 sum = (f32x4){0.f, 0.f, 0.f, 0.f};
#pragma unroll
            for (int w = 0; w < 8; ++w) sum += red[(w * 8 + wid) * 64 + lane];
            const int mi = wid >> 2, ni = wid & 3;
            const size_t off = (size_t)(r0 + mi * 16 + fr) * 1024 + c0 + ni * 16 + 4 * fq;
            const f32x4 bs = BASE_BF16 ? ld_bf4((const u16*)base + off) : *(const f32x4*)((const float*)base + off);
            *(f32x4*)(out + off) = bs * ALPHA + sum;
        }
        __syncthreads();
    }
}

__device__ __forceinline__ void transpose_tile(const float* __restrict__ src, u16* __restrict__ dst, int K, int N, int nT, int item, float* tile) {
    const int t = opaque_tid();
    const int kt = item / nT, ntile = item - kt * nT, k0 = kt * 64, n0 = ntile * 64;
    { const int row = t >> 3, c8 = (t & 7) * 8;
      f32x4 a = (f32x4){0.f, 0.f, 0.f, 0.f}, b = a;
      if (n0 + c8 < N) { const float* sp = src + (size_t)(k0 + row) * N + n0 + c8; a = *(const f32x4*)sp; b = *(const f32x4*)(sp + 4); }
      float* tp = tile + row * 65 + c8;
      tp[0] = a[0]; tp[1] = a[1]; tp[2] = a[2]; tp[3] = a[3]; tp[4] = b[0]; tp[5] = b[1]; tp[6] = b[2]; tp[7] = b[3]; }
    __syncthreads();
    { const int n = t >> 3, k8 = (t & 7) * 8;
      float v[8];
#pragma unroll
      for (int j = 0; j < 8; ++j) v[j] = tile[(k8 + j) * 65 + n];
      u32x4 w; w.x = cvt_pk_bf16(v[0], v[1]); w.y = cvt_pk_bf16(v[2], v[3]); w.z = cvt_pk_bf16(v[4], v[5]); w.w = cvt_pk_bf16(v[6], v[7]);
      *(u32x4*)(dst + (size_t)(n0 + n) * K + k0 + k8) = w; }
    __syncthreads();
}
__device__ __forceinline__ void small_transpose(const float* __restrict__ src, u16* __restrict__ dst, int K, int N, int Kpad, size_t gt, size_t nth) {
    for (size_t i = gt; i < (size_t)N * Kpad; i += nth) { const int n = (int)(i / Kpad), k = (int)(i - (size_t)n * Kpad); const float v = k < K ? src[(size_t)k * N + n] : 0.f; dst[i] = (u16)(cvt_pk_bf16(v, 0.f) & 0xffffu); }
}
__device__ void convert_phase(KP p, int l, float* tile) {
    unsigned char* ws = p->ws;
    const int bid = opaque_bid();
    const size_t gt = (size_t)bid * 512 + opaque_tid(), nth = (size_t)gridDim.x * 512;
    constexpr int n1 = 16 * 56, n2 = 16 * 16, n3 = 16 * 88, n4 = 44 * 16;
    for (int it = bid; it < n1 + n2 + n3 + n4; it += gridDim.x) {
        if (it < n1) transpose_tile(p->in[I_WIN] + (size_t)l * 1024 * 3344, (u16*)(ws + W_WIN), 1024, 3344, 56, it, tile);
        else if (it < n1 + n2) transpose_tile(p->in[I_WOUT] + (size_t)l * 1024 * 1024, (u16*)(ws + W_WOUT), 1024, 1024, 16, it - n1, tile);
        else if (it < n1 + n2 + n3) transpose_tile(p->in[I_WUP] + (size_t)l * 1024 * 5632, (u16*)(ws + W_WUP), 1024, 5632, 88, it - n1 - n2, tile);
        else transpose_tile(p->in[I_WDOWN] + (size_t)l * 2816 * 1024, (u16*)(ws + W_WDOWN), 2816, 1024, 16, it - n1 - n2 - n3, tile);
    }
    small_transpose(p->in[I_WLU] + (size_t)l * 64 * 512, (u16*)(ws + W_WLT), 64, 512, 64, gt, nth);
    small_transpose(p->in[I_ALU] + (size_t)l * 64 * 512, (u16*)(ws + W_ALT), 64, 512, 64, gt, nth);
    small_transpose(p->in[I_GLU] + (size_t)l * 128 * 512, (u16*)(ws + W_GLT), 128, 512, 128, gt, nth);
    if (l > 0) {
        small_transpose(p->in[I_VD] + (size_t)(l - 1) * 512 * 32, (u16*)(ws + W_V1T), 512, 32, 512, gt, nth);
        small_transpose(p->in[I_VU] + (size_t)(l - 1) * 32 * 512, (u16*)(ws + W_V2T), 32, 512, 32, gt, nth);
    }
    small_transpose(p->in[I_FUP] + (size_t)l * 16 * 256, (u16*)(ws + W_FT), 16, 256, 32, gt, nth);
    if (l == 0) {
        float* xa = p->out + O_Y; u16* xb = (u16*)(ws + W_XB);
        for (size_t i = gt; i < (size_t)MTOK * 256; i += nth) {
            const size_t e = i * 4;
            const f32x4 v = e < (size_t)MP * 1024 ? *(const f32x4*)(p->in[I_XP] + e) : *(const f32x4*)(p->in[I_XS] + (e - (size_t)MP * 1024));
            *(f32x4*)(xa + e) = v; st_bf4(xb + e, v);
        }
    }
}

template <bool WRITE_F32>
__device__ void ln_phase(float* Y, u16* xb, const float* __restrict__ g, const float* __restrict__ b) {
    const int tt_ = opaque_tid();
    const int lane = tt_ & 63, gw = opaque_bid() * 8 + (tt_ >> 6), nw = gridDim.x * 8;
    f32x4 gv[4], bv[4];
#pragma unroll
    for (int i = 0; i < 4; ++i) { gv[i] = *(const f32x4*)(g + i * 256 + lane * 4); bv[i] = *(const f32x4*)(b + i * 256 + lane * 4); }
    for (int row = gw; row < MTOK; row += nw) {
        float* yp = Y + (size_t)row * 1024 + lane * 4;
        f32x4 v[4]; float s = 0.f;
#pragma unroll
        for (int i = 0; i < 4; ++i) { v[i] = *(const f32x4*)(yp + i * 256); s += (v[i][0] + v[i][1]) + (v[i][2] + v[i][3]); }
#pragma unroll
        for (int o = 32; o >= 1; o >>= 1) s += __shfl_xor(s, o);
        const float mu = s * (1.0f / 1024.0f); float q = 0.f;
#pragma unroll
        for (int i = 0; i < 4; ++i) { const f32x4 d = v[i] - mu; q += (d[0] * d[0] + d[1] * d[1]) + (d[2] * d[2] + d[3] * d[3]); }
#pragma unroll
        for (int o = 32; o >= 1; o >>= 1) q += __shfl_xor(q, o);
        const float rstd = rsqrtf(q * (1.0f / 1024.0f) + LN_EPS);
#pragma unroll
        for (int i = 0; i < 4; ++i) { const f32x4 o = (v[i] - mu) * rstd * gv[i] + bv[i]; if (WRITE_F32) *(f32x4*)(yp + i * 256) = o; st_bf4(xb + (size_t)row * 1024 + i * 256 + lane * 4, o); }
    }
}

__device__ __forceinline__ void unpack8(const u32x4 w, float* f) { f[0] = bflo(w.x); f[1] = bfhi(w.x); f[2] = bflo(w.y); f[3] = bfhi(w.y); f[4] = bflo(w.z); f[5] = bfhi(w.z); f[6] = bflo(w.w); f[7] = bfhi(w.w); }
__device__ __forceinline__ float gelu_as(float v) {
    const float av = fabsf(v), t = __builtin_amdgcn_rcpf(av * 0.2316418882f + 1.0f);
    float q = t * 0.5307027145f + (-0.7265760135f); q = q * t + 0.7107068705f; q = q * t + (-0.142248368f); q = q * t + 0.127414796f; q = q * t;
    const float e = __builtin_amdgcn_exp2f((v * v) * (-0.72134752044f));
    const float m = v * (q * e);
    return v < 0.f ? m : v - m;
}
__device__ void convglu_phase(const u16* __restrict__ gate, u16* val, const float* __restrict__ past  , const float* __restrict__ cw, const float* __restrict__ cb) {
    const size_t gt = (size_t)opaque_bid() * 512 + opaque_tid(), nth = (size_t)gridDim.x * 512;
    for (size_t idx = gt; idx < (size_t)(MTOK / 4) * 352; idx += nth) {
        const int rg = (int)(idx / 352), c = (int)(idx - (size_t)rg * 352) * 8, row0 = rg * 4;
        bool first; const float* pst = nullptr;
        if (row0 < MP) first = (row0 & 2047) == 0; else { first = true; pst = past + (size_t)((row0 - MP) >> 2) * 2 * DFF; }
        float w0[8], w1[8], w2[8], bb[8], gm2[8], gm1[8];
#pragma unroll
        for (int j = 0; j < 8; ++j) { w0[j] = cw[c + j]; w1[j] = cw[DFF + c + j]; w2[j] = cw[2 * DFF + c + j]; bb[j] = cb[c + j]; }
        if (!first) { unpack8(*(const u32x4*)(gate + (size_t)(row0 - 2) * DFF + c), gm2); unpack8(*(const u32x4*)(gate + (size_t)(row0 - 1) * DFF + c), gm1); }
        else {
#pragma unroll
            for (int j = 0; j < 8; ++j) { gm2[j] = pst ? pst[c + j] : 0.f; gm1[j] = pst ? pst[DFF + c + j] : 0.f; } }
#pragma unroll
        for (int r = 0; r < 4; ++r) {
            float g0[8], vv[8], h[8];
            unpack8(*(const u32x4*)(gate + (size_t)(row0 + r) * DFF + c), g0);
            unpack8(*(const u32x4*)(val + (size_t)(row0 + r) * DFF + c), vv);
#pragma unroll
            for (int j = 0; j < 8; ++j) { const float a = bb[j] + gm2[j] * w0[j] + gm1[j] * w1[j] + g0[j] * w2[j]; h[j] = gelu_as(a) * vv[j]; gm2[j] = gm1[j]; gm1[j] = g0[j]; }
            u32x4 w; w.x = cvt_pk_bf16(h[0], h[1]); w.y = cvt_pk_bf16(h[2], h[3]); w.z = cvt_pk_bf16(h[4], h[5]); w.w = cvt_pk_bf16(h[6], h[7]);
            *(u32x4*)(val + (size_t)(row0 + r) * DFF + c) = w;
        }
    }
}

struct PrepCtx {
    const u16* projA; const u16* projB; const float* mu; const float* sshift  ;
};
__device__ __forceinline__ f32x4 xs4(const PrepCtx& c, int i, int col) {
    const f32x4 cur = ld_bf4(c.projA + (size_t)i * 1792 + col);
    f32x4 prev;
    bool first; int b = 0;
    if (i < MP) first = (i & 2047) == 0; else { const int r = i - MP; first = (r & 3) == 0; b = r >> 2; }
    if (!first) prev = ld_bf4(c.projA + (size_t)(i - 1) * 1792 + col);
    else if (i < MP) prev = (f32x4){0.f, 0.f, 0.f, 0.f};
    else prev = *(const f32x4*)(c.sshift + (size_t)b * 1792 + col);
    const f32x4 m = *(const f32x4*)(c.mu + col);
    return cur + (prev - cur) * m;
}
__device__ __forceinline__ bf16x8 ldg_frag(const u16* p) { return *(const bf16x8*)p; }

__device__ void prep_phase(KP p, int l, PG8_LAS unsigned char* lds) {
    unsigned char* ws = p->ws;
    PrepCtx c; c.projA = (const u16*)(ws + W_PROJA); c.projB = (const u16*)(ws + W_PROJB); c.mu = p->in[I_MU] + (size_t)l * 1792; c.sshift = p->in[I_SSHIFT] + (size_t)l * 128 * 1792;
    const u16* wlT = (const u16*)(ws + W_WLT); const u16* alT = (const u16*)(ws + W_ALT); const u16* glT = (const u16*)(ws + W_GLT);
    const u16* v1T = (const u16*)(ws + W_V1T); const u16* v2T = (const u16*)(ws + W_V2T); const u16* fT = (const u16*)(ws + W_FT);
    u32x4* A16 = (u32x4*)(ws + W_BUFB); float* D8 = (float*)(ws + W_D8); u16* vbuf = (u16*)(ws + W_VBUF); u16* gbuf = (u16*)(ws + W_GBUF);
    float* decb = (float*)(ws + W_DEC); float* rkb = (float*)(ws + W_RK); u16* vfirst = (u16*)(ws + W_VFIRST);
    const float* w0 = p->in[I_W0] + l * 512; const float* a0 = p->in[I_A0] + l * 512; const float* k_k = p->in[I_KK] + l * 512; const float* k_a = p->in[I_KA] + l * 512;
    const float* r_k = p->in[I_RK] + l * 512; const float* vb = l > 0 ? p->in[I_VB] + (l - 1) * 512 : nullptr; const float* fbias = p->in[I_FB] + l * 256;
    constexpr int S_TW = 144, S_AL = 144, S_SG = 272, S_XV = 1040, S_FL = 80, S_PP = 80;
    constexpr int O_TW = 0, O_AL = O_TW + 16 * S_TW, O_SG = O_AL + 16 * S_AL, O_XV = O_SG + 16 * S_SG, O_FL = O_XV + 16 * S_XV, O_PP = O_FL + 16 * S_FL;
    const int t = opaque_tid(), wid = t >> 6, lane = t & 63, fr = lane & 15, fq = lane >> 4, h = wid;
    for (int blk = opaque_bid(); blk < MTOK / 16; blk += gridDim.x) {
        const int i0 = blk * 16;
#pragma unroll 1
        for (int q = 0; q < 6; ++q) {
            const int op = t + 512 * q, r = op / 192, g4 = op - r * 192, col = 1024 + 4 * g4;
            f32x4 x = xs4(c, i0 + r, col);
            int off;
            if (col < 1536) off = O_XV + r * S_XV + (col - 1024) * 2;
            else if (col < 1600) { off = O_TW + r * S_TW + (col - 1536) * 2; x = (f32x4){tanhf_(x[0]), tanhf_(x[1]), tanhf_(x[2]), tanhf_(x[3])}; }
            else if (col < 1664) off = O_AL + r * S_AL + (col - 1600) * 2;
            else { off = O_SG + r * S_SG + (col - 1664) * 2; x = (f32x4){sigmoidf_(x[0]), sigmoidf_(x[1]), sigmoidf_(x[2]), sigmoidf_(x[3])}; }
            u32x2 w; w.x = cvt_pk_bf16(x[0], x[1]); w.y = cvt_pk_bf16(x[2], x[3]);
            *(PG8_LAS u32x2*)(lds + off) = w;
        }
        if (t < 128) { const int r = t >> 3, c4 = (t & 7) * 4; u32x2 w = (u32x2){0u, 0u}; if (c4 < 16) w = *(const u32x2*)(c.projB + (size_t)(i0 + r) * 1792 + 1536 + c4); *(PG8_LAS u32x2*)(lds + O_FL + r * S_FL + c4 * 2) = w; }
        __syncthreads();
        bf16x8 pfrag = (bf16x8){0, 0, 0, 0, 0, 0, 0, 0};
        if (l > 0) {
            f32x4 accP0 = (f32x4){0.f, 0.f, 0.f, 0.f}, accP1 = accP0;
#pragma unroll 4
            for (int ks = 0; ks < 16; ++ks) {
                const bf16x8 af = *(const PG8_LAS bf16x8*)(lds + O_XV + fr * S_XV + (ks * 32 + fq * 8) * 2);
                accP0 = __builtin_amdgcn_mfma_f32_16x16x32_bf16(ldg_frag(v1T + (size_t)fr * 512 + ks * 32 + fq * 8), af, accP0, 0, 0, 0);
                accP1 = __builtin_amdgcn_mfma_f32_16x16x32_bf16(ldg_frag(v1T + (size_t)(16 + fr) * 512 + ks * 32 + fq * 8), af, accP1, 0, 0, 0);
            }
            const u32 w0_ = cvt_pk_bf16(accP0[0], accP0[1]), w1_ = cvt_pk_bf16(accP0[2], accP0[3]), w2_ = cvt_pk_bf16(accP1[0], accP1[1]), w3_ = cvt_pk_bf16(accP1[2], accP1[3]);
            const u32x4 pw = (u32x4){w0_, w1_, w2_, w3_};
            pfrag = __builtin_bit_cast(bf16x8, pw);
        }
        const int i = i0 + fr;
        float ss = 0.f;
#pragma unroll
        for (int n = 0; n < 4; ++n) { const int cb_ = h * 64 + 16 * n + 4 * fq; const f32x4 xk = xs4(c, i, 512 + cb_) * *(const f32x4*)(k_k + cb_); ss += (xk[0] * xk[0] + xk[1] * xk[1]) + (xk[2] * xk[2] + xk[3] * xk[3]); }
        ss += __shfl_xor(ss, 16); ss += __shfl_xor(ss, 32);
        const float inorm = rsqrtf(fmaxf(ss, 1e-24f));
        float rks = 0.f;
#pragma unroll 2
        for (int n = 0; n < 4; ++n) {
            const int cn = h * 64 + 16 * n, cb_ = cn + 4 * fq;
            f32x4 aW = (f32x4){0.f, 0.f, 0.f, 0.f}, aA = aW, aG = aW, aV = aW;
#pragma unroll
            for (int ks = 0; ks < 2; ++ks) {
                aW = __builtin_amdgcn_mfma_f32_16x16x32_bf16(ldg_frag(wlT + (size_t)(cn + fr) * 64 + ks * 32 + fq * 8), *(const PG8_LAS bf16x8*)(lds + O_TW + fr * S_TW + (ks * 32 + fq * 8) * 2), aW, 0, 0, 0);
                aA = __builtin_amdgcn_mfma_f32_16x16x32_bf16(ldg_frag(alT + (size_t)(cn + fr) * 64 + ks * 32 + fq * 8), *(const PG8_LAS bf16x8*)(lds + O_AL + fr * S_AL + (ks * 32 + fq * 8) * 2), aA, 0, 0, 0);
            }
#pragma unroll
            for (int ks = 0; ks < 4; ++ks)
                aG = __builtin_amdgcn_mfma_f32_16x16x32_bf16(ldg_frag(glT + (size_t)(cn + fr) * 128 + ks * 32 + fq * 8), *(const PG8_LAS bf16x8*)(lds + O_SG + fr * S_SG + (ks * 32 + fq * 8) * 2), aG, 0, 0, 0);
            if (l > 0) {
                const u32x2 va = *(const u32x2*)(v2T + (size_t)(cn + fr) * 32 + 4 * fq), vc = *(const u32x2*)(v2T + (size_t)(cn + fr) * 32 + 16 + 4 * fq);
                const u32x4 vw = (u32x4){va.x, va.y, vc.x, vc.y};
                aV = __builtin_amdgcn_mfma_f32_16x16x32_bf16(__builtin_bit_cast(bf16x8, vw), pfrag, aV, 0, 0, 0);
            }
            const f32x4 xr = xs4(c, i, cb_), xk = xs4(c, i, 512 + cb_), xv = xs4(c, i, 1024 + cb_);
            const f32x4 w0v = *(const f32x4*)(w0 + cb_), a0v = *(const f32x4*)(a0 + cb_), kkv = *(const f32x4*)(k_k + cb_), kav = *(const f32x4*)(k_a + cb_), rkv = *(const f32x4*)(r_k + cb_);
            f32x4 vp = xv;
            if (l == 0) st_bf4(vfirst + (size_t)i * 512 + cb_, xv);
            else { const f32x4 vf = ld_bf4(vfirst + (size_t)i * 512 + cb_); const f32x4 vbv = *(const f32x4*)(vb + cb_);
#pragma unroll
                for (int j = 0; j < 4; ++j) vp[j] = xv[j] + (vf[j] - xv[j]) * sigmoidf_(vbv[j] + aV[j]);
            }
            f32x4 dd, kt, kn, bb;
#pragma unroll
            for (int j = 0; j < 4; ++j) {
                const float wv = -softplusf_(-(w0v[j] + aW[j])) - 0.5f;
                dd[j] = __expf(-__expf(wv));
                const float a = sigmoidf_(a0v[j] + aA[j]);
                kn[j] = xk[j] * kkv[j] * inorm;
                kt[j] = xk[j] * (1.0f + (a - 1.0f) * kav[j]);
                bb[j] = kn[j] * a;
                rks += xr[j] * kt[j] * rkv[j];
            }
            const int p0 = 8 * n + 2 * fq;
            u32x4 rec0, rec1;
            rec0.x = cvt_pk_bf16(xr[0], xr[1]); rec0.y = cvt_pk_bf16(kt[0], kt[1]); rec0.z = cvt_pk_bf16(kn[0], kn[1]); rec0.w = cvt_pk_bf16(bb[0], bb[1]);
            rec1.x = cvt_pk_bf16(xr[2], xr[3]); rec1.y = cvt_pk_bf16(kt[2], kt[3]); rec1.z = cvt_pk_bf16(kn[2], kn[3]); rec1.w = cvt_pk_bf16(bb[2], bb[3]);
            u32x4* ap = A16 + ((size_t)i * 8 + h) * 32 + p0;
            ap[0] = rec0; ap[1] = rec1;
            *(f32x4*)(D8 + (size_t)i * 512 + cb_) = dd;
            st_bf4(vbuf + (size_t)i * 512 + cb_, vp);
            st_bf4(gbuf + (size_t)i * 512 + cb_, aG);
        }
        rks += __shfl_xor(rks, 16); rks += __shfl_xor(rks, 32);
        if (fq == 0) rkb[(size_t)i * 8 + h] = rks;
#pragma unroll
        for (int n2 = 0; n2 < 2; ++n2) {
            const int cn = 32 * h + 16 * n2;
            f32x4 aF = (f32x4){0.f, 0.f, 0.f, 0.f};
            aF = __builtin_amdgcn_mfma_f32_16x16x32_bf16(ldg_frag(fT + (size_t)(cn + fr) * 32 + fq * 8), *(const PG8_LAS bf16x8*)(lds + O_FL + fr * S_FL + (fq * 8) * 2), aF, 0, 0, 0);
            const f32x4 fb = *(const f32x4*)(fbias + cn + 4 * fq);
            f32x4 dc;
#pragma unroll
            for (int j = 0; j < 4; ++j) { const float z = aF[j] + fb[j]; dc[j] = __expf(-softplusf_(-z) * (1.0f / 16.0f)); }
            *(f32x4*)(decb + (size_t)i * 256 + cn + 4 * fq) = dc;
        }
        __syncthreads();
    }
}

struct ScanItem {
    int tok0, T, L;
    int h, q;
    int hg, cgp;
    const float* s0_rwkv; float* so_rwkv;
    const float* s0_gla; float* so_gla;
};
template <int LSEG>
__device__ __forceinline__ void scan_item(KP p, const ScanItem& it, PG8_LAS unsigned char* lds) {
    unsigned char* ws = p->ws;
    const u32x4* A16 = (const u32x4*)(ws + W_BUFB); const float* D8 = (const float*)(ws + W_D8); const u16* vbuf = (const u16*)(ws + W_VBUF);
    const u16* projB = (const u16*)(ws + W_PROJB); const float* decb = (const float*)(ws + W_DEC);
    u16* obufA = (u16*)(ws + W_OBUFA); u16* obufB = (u16*)(ws + W_OBUFB);
    const int t = opaque_tid(), wid = t >> 6, lane = t & 63, kq = lane & 15, rsel = lane >> 4;
    constexpr int BUF = 69632, OR = 0, OKT = 8192, OKN = 16384, OB = 24576, OD = 32768, OVR = 40960, OQ = 43008, OK = 51200, ODC = 59392, OVG = 67584;
    const int nchunk = it.T / TC;
    u32x4 sa0, sa1; f32x4 sd, sdec; u32x2 svr = (u32x2){0u, 0u}, sq, sk;
#define SC_GLOAD(ch_) do { const int tk_ = it.tok0 + (ch_) * TC; \
        { const int i0 = t, i1 = t + 512; sa0 = A16[((size_t)(tk_ + (i0 >> 5)) * 8 + it.h) * 32 + (i0 & 31)]; sa1 = A16[((size_t)(tk_ + (i1 >> 5)) * 8 + it.h) * 32 + (i1 & 31)]; } \
        { const int st = t >> 4, c4 = (t & 15) * 4; sd = *(const f32x4*)(D8 + (size_t)(tk_ + st) * 512 + it.h * 64 + c4); \
          sq = *(const u32x2*)(projB + (size_t)(tk_ + st) * 1792 + it.hg * 64 + c4); sk = *(const u32x2*)(projB + (size_t)(tk_ + st) * 1792 + 256 + it.hg * 64 + c4); \
          sdec = *(const f32x4*)(decb + (size_t)(tk_ + st) * 256 + it.hg * 64 + c4); } \
        if (t < 128) { const int st = t >> 2, c4 = (t & 3) * 4; svr = *(const u32x2*)(vbuf + (size_t)(tk_ + st) * 512 + it.h * 64 + it.q * 16 + c4); } \
        else if (t < 256) { const int tt = t - 128, st = tt >> 2, c4 = (tt & 3) * 4; svr = *(const u32x2*)(projB + (size_t)(tk_ + st) * 1792 + 512 + it.hg * 128 + it.cgp * 16 + c4); } } while (0)
#define SC_LSTORE(buf_) do { PG8_LAS unsigned char* b_ = lds + (buf_) * BUF; \
        { const int i0 = t, i1 = t + 512; \
          { const int st = i0 >> 5, pp = i0 & 31; const int o = (st * 64 + 2 * pp) * 4; \
            *(PG8_LAS f32x2*)(b_ + OR + o) = (f32x2){bflo(sa0.x), bfhi(sa0.x)}; *(PG8_LAS f32x2*)(b_ + OKT + o) = (f32x2){bflo(sa0.y), bfhi(sa0.y)}; \
            *(PG8_LAS f32x2*)(b_ + OKN + o) = (f32x2){bflo(sa0.z), bfhi(sa0.z)}; *(PG8_LAS f32x2*)(b_ + OB + o) = (f32x2){bflo(sa0.w), bfhi(sa0.w)}; } \
          { const int st = i1 >> 5, pp = i1 & 31; const int o = (st * 64 + 2 * pp) * 4; \
            *(PG8_LAS f32x2*)(b_ + OR + o) = (f32x2){bflo(sa1.x), bfhi(sa1.x)}; *(PG8_LAS f32x2*)(b_ + OKT + o) = (f32x2){bflo(sa1.y), bfhi(sa1.y)}; \
            *(PG8_LAS f32x2*)(b_ + OKN + o) = (f32x2){bflo(sa1.z), bfhi(sa1.z)}; *(PG8_LAS f32x2*)(b_ + OB + o) = (f32x2){bflo(sa1.w), bfhi(sa1.w)}; } } \
        { const int st = t >> 4, c4 = (t & 15) * 4; const int o = (st * 64 + c4) * 4; \
          *(PG8_LAS f32x4*)(b_ + OD + o) = sd; *(PG8_LAS f32x4*)(b_ + ODC + o) = sdec; \
          *(PG8_LAS f32x4*)(b_ + OQ + o) = (f32x4){bflo(sq.x), bfhi(sq.x), bflo(sq.y), bfhi(sq.y)} * 0.125f; \
          *(PG8_LAS f32x4*)(b_ + OK + o) = (f32x4){bflo(sk.x), bfhi(sk.x), bflo(sk.y), bfhi(sk.y)}; } \
        if (t < 128) { const int st = t >> 2, c4 = (t & 3) * 4; *(PG8_LAS f32x4*)(b_ + OVR + (st * 16 + c4) * 4) = (f32x4){bflo(svr.x), bfhi(svr.x), bflo(svr.y), bfhi(svr.y)}; } \
        else if (t < 256) { const int tt = t - 128, st = tt >> 2, c4 = (tt & 3) * 4; *(PG8_LAS f32x4*)(b_ + OVG + (st * 16 + c4) * 4) = (f32x4){bflo(svr.x), bfhi(svr.x), bflo(svr.y), bfhi(svr.y)}; } } while (0)
    const bool isR = wid < 4;
    const int w4 = wid & 3;
    const int row = it.q * 16 + 4 * w4 + rsel;
    const int col = it.cgp * 16 + 4 * w4 + rsel;
    f32x4 S = (f32x4){0.f, 0.f, 0.f, 0.f}, Sn = S;
#define SC_LOAD_STATE(dst_, seg_) do { const int sg_ = (seg_); \
        if (isR) { if (!it.s0_rwkv) dst_ = (f32x4){0.f, 0.f, 0.f, 0.f}; else dst_ = *(const f32x4*)(it.s0_rwkv + (size_t)sg_ * 8 * 4096 + row * 64 + 4 * kq); } \
        else if (!it.s0_gla) dst_ = (f32x4){0.f, 0.f, 0.f, 0.f}; \
        else { const float* sp_ = it.s0_gla + (size_t)sg_ * 4 * 8192 + (size_t)(4 * kq) * 128 + col; dst_ = (f32x4){sp_[0], sp_[128], sp_[256], sp_[384]}; } } while (0)
#define SC_STORE_STATE(seg_, s_) do { const int sg_ = (seg_); \
        if (isR) { *(f32x4*)(it.so_rwkv + (size_t)sg_ * 8 * 4096 + row * 64 + 4 * kq) = s_; } \
        else { float* sp_ = it.so_gla + (size_t)sg_ * 4 * 8192 + (size_t)(4 * kq) * 128 + col; sp_[0] = s_[0]; sp_[128] = s_[1]; sp_[256] = s_[2]; sp_[384] = s_[3]; } } while (0)
    SC_GLOAD(0);
    SC_LOAD_STATE(Sn, 0);
    SC_LSTORE(0);
    __syncthreads();
    u16* oAp = obufA + (size_t)it.tok0 * 512 + it.h * 64 + row;
    u16* oBp = obufB + (size_t)it.tok0 * 512 + it.hg * 128 + col;
    const int vsl = (4 * w4 + rsel) * 4;
#define SC_STEP_R(s_, ov_) do { const int o = ((s_) * 64 + 4 * kq) * 4; \
        const f32x4 r4 = *(const PG8_LAS f32x4*)(b + OR + o), k4 = *(const PG8_LAS f32x4*)(b + OKT + o), n4 = *(const PG8_LAS f32x4*)(b + OKN + o), b4 = *(const PG8_LAS f32x4*)(b + OB + o), d4 = *(const PG8_LAS f32x4*)(b + OD + o); \
        const float v = *(const PG8_LAS float*)(b + OVR + (s_) * 64 + vsl); \
        float dot = dot4pk(S, n4); \
        dot = red16(dot); \
        S = S * d4 - b4 * dot + k4 * v; \
        float o_ = dot4pk(S, r4); \
        (ov_) = red16(o_); } while (0)
#define SC_STEP_G(s_, ov_) do { const int o = ((s_) * 64 + 4 * kq) * 4; \
        const f32x4 q4 = *(const PG8_LAS f32x4*)(b + OQ + o), k4 = *(const PG8_LAS f32x4*)(b + OK + o), d4 = *(const PG8_LAS f32x4*)(b + ODC + o); \
        const float v = *(const PG8_LAS float*)(b + OVG + (s_) * 64 + vsl); \
        S = S * d4 + k4 * v; \
        float o_ = dot4pk(S, q4); \
        (ov_) = red16(o_); } while (0)
#define SC_BLOCK(STEP_, s0_, NB_, optr_) do { float ov[NB_]; \
        _Pragma("unroll") for (int j_ = 0; j_ < (NB_); ++j_) STEP_((s0_) + j_, ov[j_]); \
        float outv = ov[0]; \
        _Pragma("unroll") for (int j_ = 1; j_ < (NB_); ++j_) outv = (kq == j_) ? ov[j_] : outv; \
        if (kq < (NB_)) (optr_)[(size_t)((s0_) + kq) * 512] = (u16)(cvt_pk_bf16(outv, 0.f) & 0xffffu); } while (0)
    for (int ch = 0; ch < nchunk; ++ch) {
        const bool more = ch + 1 < nchunk;
        if (more) SC_GLOAD(ch + 1);
        PG8_LAS unsigned char* b = lds + (ch & 1) * BUF;
        if (LSEG >= TC) {
            if (ch == 0) S = Sn;
            if (isR) {
                {
                    struct InR { f32x4 r4, k4, n4, b4, d4; float v; };
                    InR in_[TC]; float ov[8]; float op = 0.f;
#define LD_R(s_) do { const int o = ((s_) * 64 + 4 * kq) * 4; in_[s_].r4 = *(const PG8_LAS f32x4*)(b + OR + o); in_[s_].k4 = *(const PG8_LAS f32x4*)(b + OKT + o); in_[s_].n4 = *(const PG8_LAS f32x4*)(b + OKN + o); \
                        in_[s_].b4 = *(const PG8_LAS f32x4*)(b + OB + o); in_[s_].d4 = *(const PG8_LAS f32x4*)(b + OD + o); in_[s_].v = *(const PG8_LAS float*)(b + OVR + (s_) * 64 + vsl); } while (0)
#pragma unroll
                    for (int j = 0; j < SC_PD; ++j) LD_R(j);
#pragma unroll
                    for (int s = 0; s < TC; ++s) {
                        float dot = dot4pk(S, in_[s].n4);
                        dot += dppf<0xB1>(dot); op += dppf<0xB1>(op);
                        dot += dppf<0x4E>(dot); op += dppf<0x4E>(op);
                        dot += dppf<0x141>(dot); op += dppf<0x141>(op);
                        dot += dppf<0x140>(dot); op += dppf<0x140>(op);
                        if (s > 0) ov[(s - 1) & 7] = op;
                        if (s > 0 && (s & 7) == 0) { float outv = ov[0];
#pragma unroll
                            for (int j = 1; j < 8; ++j) outv = (kq == j) ? ov[j] : outv;
                            if (kq < 8) oAp[(size_t)(s - 8 + kq) * 512] = (u16)(cvt_pk_bf16(outv, 0.f) & 0xffffu); }
                        S = S * in_[s].d4 - in_[s].b4 * dot + in_[s].k4 * in_[s].v;
                        op = dot4pk(S, in_[s].r4);
                        if (s + SC_PD < TC) LD_R(s + SC_PD);
                        __builtin_amdgcn_sched_barrier(0);
                    }
                    ov[7] = red16(op);
                    { float outv = ov[0];
#pragma unroll
                      for (int j = 1; j < 8; ++j) outv = (kq == j) ? ov[j] : outv;
                      if (kq < 8) oAp[(size_t)(TC - 8 + kq) * 512] = (u16)(cvt_pk_bf16(outv, 0.f) & 0xffffu); }
#undef LD_R
                }
            } else {
                {
                    struct InG { f32x4 q4, k4, d4; float v; };
                    InG in_[TC]; float ov[8];
#define LD_G(s_) do { const int o = ((s_) * 64 + 4 * kq) * 4; in_[s_].q4 = *(const PG8_LAS f32x4*)(b + OQ + o); in_[s_].k4 = *(const PG8_LAS f32x4*)(b + OK + o); in_[s_].d4 = *(const PG8_LAS f32x4*)(b + ODC + o); \
                        in_[s_].v = *(const PG8_LAS float*)(b + OVG + (s_) * 64 + vsl); } while (0)
#pragma unroll
                    for (int j = 0; j < SC_PD; ++j) LD_G(j);
#pragma unroll
                    for (int s = 0; s < TC; ++s) {
                        S = S * in_[s].d4 + in_[s].k4 * in_[s].v;
                        float o_ = dot4pk(S, in_[s].q4);
                        ov[s & 7] = red16(o_);
                        if (s + SC_PD < TC) LD_G(s + SC_PD);
                        __builtin_amdgcn_sched_barrier(0);
                        if ((s & 7) == 7) { float outv = ov[0];
#pragma unroll
                            for (int j = 1; j < 8; ++j) outv = (kq == j) ? ov[j] : outv;
                            if (kq < 8) oBp[(size_t)((s & ~7) + kq) * 512] = (u16)(cvt_pk_bf16(outv, 0.f) & 0xffffu); }
                    }
#undef LD_G
                }
            }
            if (!more) SC_STORE_STATE(0, S);
        } else {
#pragma unroll 1
            for (int sgi = 0; sgi < TC / LSEG; ++sgi) {
                const int seg = ch * (TC / LSEG) + sgi;
                S = Sn;
                if ((seg + 1) * LSEG < it.T) SC_LOAD_STATE(Sn, seg + 1);
                if (isR) {
                    SC_BLOCK(SC_STEP_R, sgi * LSEG, (LSEG < TC ? LSEG : 1), oAp);
                } else {
                    SC_BLOCK(SC_STEP_G, sgi * LSEG, (LSEG < TC ? LSEG : 1), oBp);
                }
                SC_STORE_STATE(seg, S);
            }
        }
        oAp += (size_t)TC * 512; oBp += (size_t)TC * 512;
        if (more) SC_LSTORE((ch + 1) & 1);
        __syncthreads();
    }
#undef SC_BLOCK
#undef SC_STEP_R
#undef SC_STEP_G
}
__device__ void scan_phase(KP p, int l, PG8_LAS unsigned char* lds) {
    float* out = p->out;
    const int bid = opaque_bid();
    for (int i = bid; i < 256; i += gridDim.x) {
        ScanItem it; const int s = i >> 5;
        it.tok0 = s * 2048; it.T = 2048; it.L = 2048; it.h = (i >> 2) & 7; it.q = i & 3; it.hg = (i >> 3) & 3; it.cgp = i & 7;
        it.s0_rwkv = nullptr; it.so_rwkv = out + O_RWKV_P + ((size_t)(l * 8 + s) * 8 + it.h) * 4096;
        it.s0_gla = nullptr; it.so_gla = out + O_GLA_P + ((size_t)(l * 8 + s) * 4 + it.hg) * 8192;
        scan_item<2048>(p, it, lds);
    }
    for (int i = bid; i < 256; i += gridDim.x) {
        ScanItem it; const int bg = i >> 5, b0 = bg * 16;
        it.tok0 = MP + bg * 64; it.T = 64; it.L = 4; it.h = (i >> 2) & 7; it.q = i & 3; it.hg = (i >> 3) & 3; it.cgp = i & 7;
        it.s0_rwkv = p->in[I_SRWKV] + ((size_t)(l * 128 + b0) * 8 + it.h) * 4096; it.so_rwkv = out + O_RWKV_S + ((size_t)(l * 128 + b0) * 8 + it.h) * 4096;
        it.s0_gla = p->in[I_SGLA] + ((size_t)(l * 128 + b0) * 4 + it.hg) * 8192; it.so_gla = out + O_GLA_S + ((size_t)(l * 128 + b0) * 4 + it.hg) * 8192;
        scan_item<4>(p, it, lds);
    }
}

__device__ void post_phase(KP p, int l) {
    unsigned char* ws = p->ws;
    const u16* obufA = (const u16*)(ws + W_OBUFA); const u16* obufB = (const u16*)(ws + W_OBUFB); const u16* vbuf = (const u16*)(ws + W_VBUF); const u16* gbuf = (const u16*)(ws + W_GBUF);
    const float* rkb = (const float*)(ws + W_RK); const u16* projB = (const u16*)(ws + W_PROJB); u16* oab = (u16*)(ws + W_XB);
    const float* lg = p->in[I_LNXG] + l * 512; const float* lb = p->in[I_LNXB] + l * 512; const float* ng = p->in[I_NG] + l * 128;
    const int tt_ = opaque_tid();
    const int lane = tt_ & 63, gw = opaque_bid() * 8 + (tt_ >> 6), nw = gridDim.x * 8;
    const int c = lane * 8;
    float lgv[8], lbv[8], ngv[8];
#pragma unroll
    for (int j = 0; j < 8; ++j) { lgv[j] = lg[c + j]; lbv[j] = lb[c + j]; ngv[j] = ng[(c & 127) + j]; }
    for (int i = gw; i < MTOK; i += nw) {
        {
            const f32x4 o0 = ld_bf4(obufA + (size_t)i * 512 + c), o1 = ld_bf4(obufA + (size_t)i * 512 + c + 4);
            const f32x4 v0 = ld_bf4(vbuf + (size_t)i * 512 + c), v1 = ld_bf4(vbuf + (size_t)i * 512 + c + 4);
            const f32x4 g0 = ld_bf4(gbuf + (size_t)i * 512 + c), g1 = ld_bf4(gbuf + (size_t)i * 512 + c + 4);
            const float rk = rkb[(size_t)i * 8 + (lane >> 3)];
            float s = (o0[0] + o0[1]) + (o0[2] + o0[3]) + (o1[0] + o1[1]) + (o1[2] + o1[3]);
            s += __shfl_xor(s, 1); s += __shfl_xor(s, 2); s += __shfl_xor(s, 4);
            const float m = s * (1.0f / 64.0f);
            const f32x4 d0 = o0 - m, d1 = o1 - m;
            float q = (d0[0] * d0[0] + d0[1] * d0[1]) + (d0[2] * d0[2] + d0[3] * d0[3]) + (d1[0] * d1[0] + d1[1] * d1[1]) + (d1[2] * d1[2] + d1[3] * d1[3]);
            q += __shfl_xor(q, 1); q += __shfl_xor(q, 2); q += __shfl_xor(q, 4);
            const float rs = rsqrtf(q * (1.0f / 64.0f) + GN_EPS_A);
            f32x4 y0, y1;
#pragma unroll
            for (int j = 0; j < 4; ++j) { y0[j] = (d0[j] * rs * lgv[j] + lbv[j] + rk * v0[j]) * g0[j]; y1[j] = (d1[j] * rs * lgv[4 + j] + lbv[4 + j] + rk * v1[j]) * g1[j]; }
            u32x4 w; w.x = cvt_pk_bf16(y0[0], y0[1]); w.y = cvt_pk_bf16(y0[2], y0[3]); w.z = cvt_pk_bf16(y1[0], y1[1]); w.w = cvt_pk_bf16(y1[2], y1[3]);
            *(u32x4*)(oab + (size_t)i * 1024 + c) = w;
        }
        {
            const f32x4 o0 = ld_bf4(obufB + (size_t)i * 512 + c), o1 = ld_bf4(obufB + (size_t)i * 512 + c + 4);
            const f32x4 g0 = ld_bf4(projB + (size_t)i * 1792 + 1024 + c), g1 = ld_bf4(projB + (size_t)i * 1792 + 1024 + c + 4);
            float q = (o0[0] * o0[0] + o0[1] * o0[1]) + (o0[2] * o0[2] + o0[3] * o0[3]) + (o1[0] * o1[0] + o1[1] * o1[1]) + (o1[2] * o1[2] + o1[3] * o1[3]);
            q += __shfl_xor(q, 1); q += __shfl_xor(q, 2); q += __shfl_xor(q, 4); q += __shfl_xor(q, 8);
            const float rs = rsqrtf(q * (1.0f / 128.0f) + RMS_EPS);
            f32x4 y0, y1;
#pragma unroll
            for (int j = 0; j < 4; ++j) { y0[j] = o0[j] * rs * ngv[j] * (g0[j] * sigmoidf_(g0[j])); y1[j] = o1[j] * rs * ngv[4 + j] * (g1[j] * sigmoidf_(g1[j])); }
            u32x4 w; w.x = cvt_pk_bf16(y0[0], y0[1]); w.y = cvt_pk_bf16(y0[2], y0[3]); w.z = cvt_pk_bf16(y1[0], y1[1]); w.w = cvt_pk_bf16(y1[2], y1[3]);
            *(u32x4*)(oab + (size_t)i * 1024 + 512 + c) = w;
        }
    }
}

#define XB_TMO      128
#define XB_XCNT(j)  (256  + 64 * (j))
#define XB_XSUB(j)  (1280 + 64 * (j))
#define XB_XGEN(j)  (2304 + 64 * (j))
#define XB_TOP      3328
#define XB_TOPGEN   3392
#define XCD_BAR_WORDS 3456
#define XB_SPIN_CAP (1u << 18)
__device__ __forceinline__ unsigned xb_ld(unsigned* p)              { return __hip_atomic_load(p, __ATOMIC_RELAXED, __HIP_MEMORY_SCOPE_AGENT); }
__device__ __forceinline__ unsigned xb_add(unsigned* p, unsigned v) { return __hip_atomic_fetch_add(p, v, __ATOMIC_RELAXED, __HIP_MEMORY_SCOPE_AGENT); }
__device__ __forceinline__ unsigned xb_xcc_id() { return (unsigned)__builtin_amdgcn_s_getreg((3 << 11) | 20) & 0xFu; }
#define XB_SPIN(cond, bar) do { unsigned _sp = 0; while (cond) { __builtin_amdgcn_s_sleep(1); \
    if ((++_sp & 255u) == 0u) { if (xb_ld(&(bar)[XB_TMO])) break; if (_sp > XB_SPIN_CAP) { atomicAdd(&(bar)[XB_TMO], 1u); break; } } } } while (0)
__device__ __forceinline__ void xcd_barrier_complete(unsigned* bar, unsigned x, unsigned& nloc, unsigned& nx) {
    const unsigned G = gridDim.x * gridDim.y * gridDim.z;
    unsigned sum, cnt, mine, sp = 0u;
    for (;;) {
        sum = 0u; cnt = 0u; mine = 0u;
#pragma unroll
        for (unsigned j = 0; j < 16; ++j) { const unsigned c = xb_ld(&bar[XB_XCNT(j)]); sum += c; cnt += (c > 0u) ? 1u : 0u; mine = (j == x) ? c : mine; }
        if (sum == G) break;
        __builtin_amdgcn_s_sleep(1);
        if ((++sp & 255u) == 0u) { if (xb_ld(&bar[XB_TMO])) break; if (sp > XB_SPIN_CAP) { atomicAdd(&bar[XB_TMO], 1u); break; } }
    }
    nloc = mine > 0u ? mine : 1u; nx = cnt > 0u ? cnt : 1u;
}
__device__ __forceinline__ void xcd_barrier(unsigned* bar, volatile PG8_LAS unsigned* st) {
    asm volatile("s_waitcnt vmcnt(0)" ::: "memory");
    __syncthreads();
    if (threadIdx.x == 0) {
        const unsigned x = xb_xcc_id();
        __builtin_amdgcn_s_waitcnt(0);
        unsigned nloc = st[0], nx = st[1];
        if (nloc == 0u) { xcd_barrier_complete(bar, x, nloc, nx); st[0] = nloc; st[1] = nx; }
        const unsigned old = xb_add(&bar[XB_XSUB(x)], 1u);
        const unsigned gen = old / nloc;
        if (old + 1u == (gen + 1u) * nloc) {
            __builtin_amdgcn_fence(__ATOMIC_RELEASE, "agent");
            asm volatile("s_waitcnt vmcnt(0)" ::: "memory");
            const unsigned og = xb_add(&bar[XB_TOP], 1u);
            const unsigned tg = og / nx;
            if (og + 1u == (tg + 1u) * nx) xb_add(&bar[XB_TOPGEN], 1u);
            else XB_SPIN(xb_ld(&bar[XB_TOPGEN]) == tg, bar);
            __builtin_amdgcn_fence(__ATOMIC_ACQUIRE, "agent");
            xb_add(&bar[XB_XGEN(x)], 1u);
            asm volatile("s_waitcnt vmcnt(0)" ::: "memory");
        } else {
            XB_SPIN(xb_ld(&bar[XB_XGEN(x)]) == gen, bar);
            __builtin_amdgcn_fence(__ATOMIC_ACQUIRE, "agent");
            asm volatile("s_waitcnt vmcnt(0)" ::: "memory");
        }
    }
    __syncthreads();
}
__device__ __forceinline__ void gsync(cg::grid_group& grid) {
    asm volatile("s_waitcnt vmcnt(0)" ::: "memory");
    grid.sync();
    if (threadIdx.x < 64) { __builtin_amdgcn_fence(__ATOMIC_ACQUIRE, "agent"); asm volatile("s_waitcnt vmcnt(0)" ::: "memory"); }
    __syncthreads();
}

__global__ void __launch_bounds__(512, 2) mega(Params p_unused) {
    KP p = kparams();
    extern __shared__ __attribute__((aligned(16))) unsigned char smem[];
    PG8_LAS unsigned char* lds = (PG8_LAS unsigned char*)smem;
    cg::grid_group grid = cg::this_grid();
    unsigned char* ws = p->ws;
    float* bufA = p->out + O_Y; float* bufB = (float*)(ws + W_BUFB); u16* xb = (u16*)(ws + W_XB);
    pg8::StaticOrder S;
    volatile PG8_LAS unsigned* xst = (volatile PG8_LAS unsigned*)(lds + 139264);
    if (threadIdx.x == 0) { xst[0] = 0u; xst[1] = 0u; }
    gsync(grid);
    unsigned* xbar = (unsigned*)(kparams()->ws + W_BAR);
    if (threadIdx.x == 0) (void)xb_add(&xbar[XB_XCNT(xb_xcc_id())], 1u);
#define PHASE_END() xcd_barrier((unsigned*)(kparams()->ws + W_BAR), xst)
    convert_phase(kparams(), 0, (float*)smem);
    PHASE_END();
    for (int l = 0; l < NL; ++l) {
        {
            pg8::Gemm g; g.A = xb; g.Bt = (const u16*)(ws + W_WIN); g.M = MTOK; g.N = INP; g.K = 1024;
            EpiProj E; E.projA = (u16*)(ws + W_PROJA); E.projB = (u16*)(ws + W_PROJB); E.shift_p = p->out + O_SHIFT_P + (size_t)l * 8 * 1792; E.shift_s = p->out + O_SHIFT_S + (size_t)l * 128 * 1792;
            S.init(MTOK, INP, gridDim.x, opaque_bid()); pg8::gemm_phase(lds, g, S, E);
        }
        PHASE_END();
        prep_phase(kparams(), l, lds);
        PHASE_END();
        scan_phase(kparams(), l, lds);
        PHASE_END();
        post_phase(kparams(), l);
        PHASE_END();
        {
            pg8::Gemm g; g.A = xb; g.Bt = (const u16*)(ws + W_WOUT); g.M = MTOK; g.N = 1024; g.K = 1024;
            EpiResid E; E.base = bufA; E.out = bufB;
            g.M = MP; S.init(MP, 1024, gridDim.x, opaque_bid()); pg8::gemm_phase(lds, g, S, E);
            small_gemm_resid<false>(g.A, g.Bt, 1024, E.base, E.out, lds);
        }
        PHASE_END();
        ln_phase<false>(bufB, xb, p->in[I_LN1G] + l * 1024, p->in[I_LN1B] + l * 1024);
        PHASE_END();
        {
            pg8::Gemm g; g.A = xb; g.Bt = (const u16*)(ws + W_WUP); g.M = MTOK; g.N = 5632; g.K = 1024;
            EpiUp E; E.gate = (u16*)(ws + W_GATE); E.val = (u16*)(ws + W_VAL); E.conv_p = p->out + O_CONV_P + (size_t)l * 8 * 2 * DFF; E.conv_s = p->out + O_CONV_S + (size_t)l * 128 * 2 * DFF;
            S.init(MTOK, 5632, gridDim.x, opaque_bid()); pg8::gemm_phase(lds, g, S, E);
        }
        PHASE_END();
        convglu_phase((const u16*)(ws + W_GATE), (u16*)(ws + W_VAL), p->in[I_SCONV] + (size_t)l * 128 * 2 * DFF, p->in[I_CW] + (size_t)l * 3 * DFF, p->in[I_CB] + (size_t)l * DFF);
        PHASE_END();
        {
            pg8::Gemm g; g.A = (const u16*)(ws + W_VAL); g.Bt = (const u16*)(ws + W_WDOWN); g.M = MTOK; g.N = 1024; g.K = DFF;
            EpiResidB E; E.base = xb; E.out = bufA;
            g.M = MP; S.init(MP, 1024, gridDim.x, opaque_bid()); pg8::gemm_phase(lds, g, S, E);
            small_gemm_resid<true>(g.A, g.Bt, DFF, E.base, E.out, lds);
        }
        PHASE_END();
        ln_phase<true>(bufA, xb, p->in[I_LN2G] + l * 1024, p->in[I_LN2B] + l * 1024);
        if (l + 1 < NL) convert_phase(kparams(), l + 1, (float*)smem);
        PHASE_END();
    }
}

extern "C" void kernel_launch(void* const* d_in, const int* in_sizes, int n_in, void* d_out, int out_size, void* d_ws, size_t ws_size, hipStream_t stream) {
    static int grid_blocks = 0;
    if (!grid_blocks) {
        int dev = 0, cus = 0, per_cu = 0;
        (void)hipGetDevice(&dev);
        (void)hipDeviceGetAttribute(&cus, hipDeviceAttributeMultiprocessorCount, dev);
        (void)hipFuncSetAttribute((const void*)mega, hipFuncAttributeMaxDynamicSharedMemorySize, LDS_BYTES);
        (void)hipOccupancyMaxActiveBlocksPerMultiprocessor(&per_cu, (const void*)mega, 512, LDS_BYTES);
        grid_blocks = cus;
        if (n_in != 33 || (size_t)out_size != O_END || ws_size < W_TOTAL) { fprintf(stderr, "kernel_launch: unexpected sizes n_in %d out %d ws %zu (need %zu)\n", n_in, out_size, ws_size, (size_t)W_TOTAL); grid_blocks = -1; }
    }
    if (grid_blocks < 0) return;
    (void)hipMemsetAsync((unsigned char*)d_ws + W_BAR, 0, XCD_BAR_WORDS * sizeof(unsigned), stream);
    Params p{};
    for (int i = 0; i < 33; ++i) p.in[i] = (const float*)d_in[i];
    p.out = (float*)d_out; p.ws = (unsigned char*)d_ws;
    void* args[] = {&p};
    hipError_t e = hipLaunchCooperativeKernel((const void*)mega, dim3(grid_blocks), dim3(512), args, LDS_BYTES, stream);
    if (e != hipSuccess) fprintf(stderr, "cooperative launch failed: %s (grid %d)\n", hipGetErrorString(e), grid_blocks);
}
```

```cpp
#include <hip/hip_runtime.h>
#include <hip/hip_cooperative_groups.h>
#include <cstdio>
namespace cg = cooperative_groups;

#define PG8_LAS __attribute__((address_space(3)))
typedef unsigned short u16;
typedef unsigned int u32;
typedef unsigned short bf16_t;
typedef short bf16x8 __attribute__((ext_vector_type(8)));
typedef float f32x4 __attribute__((ext_vector_type(4)));
typedef float f32x2 __attribute__((ext_vector_type(2)));
typedef unsigned u32x4 __attribute__((ext_vector_type(4)));
typedef unsigned u32x2 __attribute__((ext_vector_type(2)));

constexpr int MTOK = 16896, MP = 16384, DM = 1024, NL = 4;
constexpr int SHIFT_W = 1792, INP = 3584, DFF = 2816;
constexpr float ALPHA = 1.6817928305074290f;
constexpr float GN_EPS_A = 64e-5f, RMS_EPS = 1e-5f, LN_EPS = 1e-5f;
constexpr int LDS_BYTES = 139264 + 16;
constexpr int TC = 32;
#define SC_PD 3

enum { I_XP = 0, I_XS, I_SRWKV, I_SSHIFT, I_SGLA, I_SCONV, I_WIN, I_MU, I_W0, I_WLU, I_A0, I_ALU, I_GLU, I_KK, I_KA, I_RK, I_LNXG, I_LNXB,
       I_VB, I_VD, I_VU, I_FUP, I_FB, I_NG, I_WOUT, I_LN1G, I_LN1B, I_WUP, I_CW, I_CB, I_WDOWN, I_LN2G, I_LN2B };

constexpr size_t O_Y = 0;
constexpr size_t O_RWKV_P = (size_t)MTOK * DM;
constexpr size_t O_RWKV_S = O_RWKV_P + (size_t)4 * 8 * 8 * 4096;
constexpr size_t O_SHIFT_P = O_RWKV_S + (size_t)4 * 128 * 8 * 4096;
constexpr size_t O_SHIFT_S = O_SHIFT_P + (size_t)4 * 8 * 1792;
constexpr size_t O_GLA_P = O_SHIFT_S + (size_t)4 * 128 * 1792;
constexpr size_t O_GLA_S = O_GLA_P + (size_t)4 * 8 * 4 * 8192;
constexpr size_t O_CONV_P = O_GLA_S + (size_t)4 * 128 * 4 * 8192;
constexpr size_t O_CONV_S = O_CONV_P + (size_t)4 * 8 * 2 * 2816;
constexpr size_t O_END = O_CONV_S + (size_t)4 * 128 * 2 * 2816;

constexpr size_t W_WIN = 0;
constexpr size_t W_WOUT = W_WIN + (size_t)INP * 1024 * 2;
constexpr size_t W_WUP = W_WOUT + (size_t)1024 * 1024 * 2;
constexpr size_t W_WDOWN = W_WUP + (size_t)5632 * 1024 * 2;
constexpr size_t W_WLT = W_WDOWN + (size_t)1024 * 2816 * 2;
constexpr size_t W_ALT = W_WLT + 512 * 64 * 2;
constexpr size_t W_GLT = W_ALT + 512 * 64 * 2;
constexpr size_t W_V1T = W_GLT + 512 * 128 * 2;
constexpr size_t W_V2T = W_V1T + 32 * 512 * 2;
constexpr size_t W_FT = W_V2T + 512 * 32 * 2;
constexpr size_t W_XB = W_FT + 256 * 32 * 2;
constexpr size_t W_VFIRST = W_XB + (size_t)MTOK * 1024 * 2;
constexpr size_t W_BUFB = W_VFIRST + (size_t)MTOK * 512 * 2;
constexpr size_t W_R = W_BUFB + (size_t)MTOK * 1024 * 4;
constexpr size_t W_PROJA = W_R;
constexpr size_t W_PROJB = W_PROJA + (size_t)MTOK * 1792 * 2;
constexpr size_t W_D8 = W_PROJB + (size_t)MTOK * 1792 * 2;
constexpr size_t W_VBUF = W_D8 + (size_t)MTOK * 512 * 4;
constexpr size_t W_GBUF = W_VBUF + (size_t)MTOK * 512 * 2;
constexpr size_t W_DEC = W_GBUF + (size_t)MTOK * 512 * 2;
constexpr size_t W_RK = W_DEC + (size_t)MTOK * 256 * 4;
constexpr size_t W_END1 = W_RK + (size_t)MTOK * 8 * 4;
constexpr size_t W_GATE = W_R;
constexpr size_t W_VAL = W_GATE + (size_t)MTOK * 2816 * 2;
constexpr size_t W_END2 = W_VAL + (size_t)MTOK * 2816 * 2;
constexpr size_t W_END = W_END1 > W_END2 ? W_END1 : W_END2;
constexpr size_t W_BAR = (W_END + 255) / 256 * 256;
constexpr size_t W_TOTAL = W_BAR + 16384;
constexpr size_t W_OBUFA = W_PROJA;
constexpr size_t W_OBUFB = W_PROJA + (size_t)MTOK * 512 * 2;

struct Params { const float* in[33]; float* out; unsigned char* ws; };
typedef const Params __attribute__((address_space(4)))* KP;
__device__ __forceinline__ KP kparams() { unsigned long long k = (unsigned long long)__builtin_amdgcn_kernarg_segment_ptr(); asm volatile("" : "+s"(k)); return (KP)k; }

typedef __bf16 bf16v2 __attribute__((ext_vector_type(2)));
__device__ __forceinline__ unsigned cvt_pk_bf16(float lo, float hi) { const f32x2 v = (f32x2){lo, hi}; const bf16v2 b = __builtin_convertvector(v, bf16v2); return __builtin_bit_cast(unsigned, b); }
__device__ __forceinline__ float bflo(u32 w) { return __uint_as_float(w << 16); }
__device__ __forceinline__ float bfhi(u32 w) { return __uint_as_float(w & 0xffff0000u); }
__device__ __forceinline__ f32x4 ld_bf4(const u16* p) { const u32x2 w = *(const u32x2*)p; return (f32x4){bflo(w.x), bfhi(w.x), bflo(w.y), bfhi(w.y)}; }
__device__ __forceinline__ unsigned cvt_pk_bf16_asm(float lo, float hi) { unsigned r; asm volatile("v_cvt_pk_bf16_f32 %0, %1, %2" : "=v"(r) : "v"(lo), "v"(hi)); return r; }
__device__ __forceinline__ void st_bf4_asm(u16* p, f32x4 v) { u32x2 w; w.x = cvt_pk_bf16_asm(v[0], v[1]); w.y = cvt_pk_bf16_asm(v[2], v[3]); *(u32x2*)p = w; }
__device__ __forceinline__ void st_bf4(u16* p, f32x4 v) { u32x2 w; w.x = cvt_pk_bf16(v[0], v[1]); w.y = cvt_pk_bf16(v[2], v[3]); *(u32x2*)p = w; }
__device__ __forceinline__ float sigmoidf_(float x) { return __builtin_amdgcn_rcpf(1.0f + __expf(-x)); }
__device__ __forceinline__ float tanhf_(float x) { return 1.0f - 2.0f * __builtin_amdgcn_rcpf(1.0f + __expf(2.0f * x)); }
__device__ __forceinline__ float softplusf_(float x) { return fmaxf(x, 0.f) + __logf(1.0f + __expf(-fabsf(x))); }
template <int CTRL> __device__ __forceinline__ float dppf(float x) { return __builtin_bit_cast(float, __builtin_amdgcn_update_dpp(0, __builtin_bit_cast(int, x), CTRL, 0xF, 0xF, true)); }
__device__ __forceinline__ float dot4pk(f32x4 a, f32x4 b) { f32x2 p = (f32x2){a[0], a[1]} * (f32x2){b[0], b[1]}; p = (f32x2){a[2], a[3]} * (f32x2){b[2], b[3]} + p; return p.x + p.y; }
__device__ __forceinline__ float red16(float x) { x += dppf<0xB1>(x); x += dppf<0x4E>(x); x += dppf<0x141>(x); x += dppf<0x140>(x); return x; }

__device__ __forceinline__ int opaque_tid() { int t = threadIdx.x; asm volatile("" : "+v"(t)); return t; }
__device__ __forceinline__ int opaque_bid() { int b = blockIdx.x; asm volatile("" : "+s"(b)); return b; }

namespace pg8 {
constexpr int BM = 256, BK = 64, HALF = 128, HTB = HALF * BK * 2, STAGE_BYTES = 8 * HTB, NXCD = 8, WGM = 8;
__host__ __device__ __forceinline__ int lds_byte(int r, int c) { const int st = (r >> 4) * 2 + (c >> 5), rr = r & 15, cc = c & 31, ob = rr * 64 + cc * 2; return st * 1024 + (ob ^ (((ob >> 9) & 1) << 5)); }
__host__ __device__ __forceinline__ void stage_rc(int b, int& R, int& C) { const int st = b / 1024, sb = b % 1024, swz = sb ^ (((sb >> 9) & 1) << 5); R = (st >> 1) * 16 + swz / 64; C = (st & 1) * 32 + (swz % 64) / 2; }
struct Unit { int pm, pn; };
struct Gemm { const bf16_t* A; const bf16_t* Bt; int M, N, K; };
struct StaticOrder {
    int nM, nN, nwg, G, c;
    __host__ __device__ void init(int M, int N, int G_, int c_) { nM = M / BM; nN = N / BM; nwg = nM * nN; G = G_; c = c_; }
    __host__ __device__ bool next(int i, Unit& u) const {
        const long L = (long)i * G + c; if (L >= nwg) return false;
        int wgid = (int)L; { const int q = nwg / NXCD, r = nwg % NXCD, xcd = wgid % NXCD, off = wgid / NXCD; wgid = (xcd < r ? xcd * (q + 1) : r * (q + 1) + (xcd - r) * q) + off; }
        const int nig = WGM * nN, gid = wgid / nig, fm = gid * WGM, gsz = (nM - fm) < WGM ? (nM - fm) : WGM;
        u.pm = fm + ((wgid % nig) % gsz); u.pn = (wgid % nig) / gsz; return true;
    }
};

template <class Epi>
__device__ __forceinline__ void gemm_phase(PG8_LAS unsigned char* lds, const Gemm g, const StaticOrder& S, const Epi& E) {
    const int tid = opaque_tid(), wid = __builtin_amdgcn_readfirstlane(tid >> 6), lane = tid & 63, wr = wid >> 2, wc = wid & 3, fr = lane & 15, fq = lane >> 4;
    const int K = g.K, nt = K / BK;
    unsigned voffA[2], voffB[2];
#pragma unroll
    for (int i = 0; i < 2; ++i) { int R, C; stage_rc(tid * 16 + i * 8192, R, C); voffA[i] = (unsigned)(R * K + C) * 2u; voffB[i] = voffA[i]; }
    const size_t kstep = (size_t)(BK * 2);
    const size_t hstep = (size_t)HALF * K * 2;
    const size_t tstep = 2 * hstep;
    const unsigned ldsw = (unsigned)wid * 1024u;
    const int aoff = lds_byte(wr * 64 + fr, fq * 8), boff = lds_byte(wc * 32 + fr, fq * 8);
#define PG8_SA(b, h) (((b) * 2 + (h)) * HTB)
#define PG8_SB(b, h) ((4 + (b) * 2 + (h)) * HTB)
#define PG8_STAGE(bufoff, gbase, voff) do { _Pragma("unroll") for (int _i = 0; _i < 2; ++_i) \
        __builtin_amdgcn_global_load_lds((const unsigned*)((const char*)(gbase) + (voff)[_i]), (PG8_LAS unsigned*)(lds + (bufoff) + ldsw + _i * 8192), 16, 0, 0); } while (0)
#define PG8_LDA(dst, b, h) do { _Pragma("unroll") for (int m = 0; m < 4; ++m) _Pragma("unroll") for (int k = 0; k < 2; ++k) dst[m][k] = *(const PG8_LAS bf16x8*)(lds + PG8_SA(b, h) + aoff + m * 2048 + k * 1024); } while (0)
#define PG8_LDB(dst, b, h) do { _Pragma("unroll") for (int n = 0; n < 2; ++n) _Pragma("unroll") for (int k = 0; k < 2; ++k) dst[n][k] = *(const PG8_LAS bf16x8*)(lds + PG8_SB(b, h) + boff + n * 2048 + k * 1024); } while (0)
#define PG8_MMA(ai, bj, At, Bt) do { __builtin_amdgcn_s_setprio(1); _Pragma("unroll") for (int m = 0; m < 4; ++m) _Pragma("unroll") for (int n = 0; n < 2; ++n) _Pragma("unroll") for (int k = 0; k < 2; ++k) \
        acc[ai][bj][m][n] = __builtin_amdgcn_mfma_f32_16x16x32_bf16(Bt[n][k], At[m][k], acc[ai][bj][m][n], 0, 0, 0); __builtin_amdgcn_s_setprio(0); } while (0)
#define PG8_WAIT_V(n) asm volatile("s_waitcnt vmcnt(" #n ")" ::: "memory")
#define PG8_WAIT_L(n) asm volatile("s_waitcnt lgkmcnt(" #n ")" ::: "memory")
#define PG8_BAR __builtin_amdgcn_s_barrier()
#define PG8_SCHED __builtin_amdgcn_sched_barrier(0)
    Unit cur, nxt; int ui = 0;
    if (!S.next(0, cur)) return;
    f32x4 acc[2][2][4][2];
#pragma unroll
    for (int a = 0; a < 2; ++a)
#pragma unroll
        for (int b = 0; b < 2; ++b)
#pragma unroll
            for (int m = 0; m < 4; ++m)
#pragma unroll
                for (int n = 0; n < 2; ++n) acc[a][b][m][n] = (f32x4){0.f, 0.f, 0.f, 0.f};
    bf16x8 At[4][2], B0[2][2], B1[2][2];
    const char* cA = (const char*)g.A + (size_t)cur.pm * tstep; const char* cB = (const char*)g.Bt + (size_t)cur.pn * tstep;
    PG8_STAGE(PG8_SB(0, 0), cB, voffB); PG8_STAGE(PG8_SA(0, 0), cA, voffA); PG8_STAGE(PG8_SB(0, 1), cB + hstep, voffB); PG8_STAGE(PG8_SA(0, 1), cA + hstep, voffA);
    if (wr == 1) PG8_BAR;
    PG8_WAIT_V(4); PG8_BAR;
    PG8_STAGE(PG8_SB(1, 0), cB + kstep, voffB); PG8_STAGE(PG8_SA(1, 0), cA + kstep, voffA); PG8_STAGE(PG8_SB(1, 1), cB + hstep + kstep, voffB);
    PG8_WAIT_V(6); PG8_BAR;
    for (;;) {
        const bool has_next = S.next(ui + 1, nxt);
        const char* nA = has_next ? (const char*)g.A + (size_t)nxt.pm * tstep : cA; const char* nB = has_next ? (const char*)g.Bt + (size_t)nxt.pn * tstep : cB;
        for (int t = 0; t < nt; t += 2) {
            const bool last = (t == nt - 2);
            const char* a1 = cA + (size_t)(t + 1) * kstep;
            const char* a2 = last ? nA : cA + (size_t)(t + 2) * kstep; const char* b2 = last ? nB : cB + (size_t)(t + 2) * kstep;
            const char* a3 = a2 + kstep; const char* b3 = b2 + kstep;
            PG8_LDB(B0, 0, 0); PG8_SCHED; PG8_LDA(At, 0, 0); PG8_STAGE(PG8_SA(1, 1), a1 + hstep, voffA);
            PG8_WAIT_L(8); PG8_BAR; PG8_WAIT_L(0); PG8_MMA(0, 0, At, B0); PG8_BAR; PG8_SCHED;
            PG8_LDB(B1, 0, 1); PG8_STAGE(PG8_SB(0, 0), b2, voffB);
            PG8_BAR; PG8_WAIT_L(0); PG8_MMA(0, 1, At, B1); PG8_BAR;
            PG8_LDA(At, 0, 1); PG8_STAGE(PG8_SA(0, 0), a2, voffA);
            PG8_BAR; PG8_WAIT_L(0); PG8_MMA(1, 0, At, B0); PG8_BAR; PG8_SCHED;
            PG8_STAGE(PG8_SB(0, 1), b2 + hstep, voffB);
            PG8_WAIT_V(6); PG8_BAR; PG8_MMA(1, 1, At, B1); PG8_BAR;
            PG8_LDB(B0, 1, 0); PG8_SCHED; PG8_LDA(At, 1, 0); PG8_STAGE(PG8_SA(0, 1), a2 + hstep, voffA);
            PG8_WAIT_L(8); PG8_BAR; PG8_WAIT_L(0); PG8_MMA(0, 0, At, B0); PG8_BAR; PG8_SCHED;
            PG8_LDB(B1, 1, 1); PG8_STAGE(PG8_SB(1, 0), b3, voffB);
            PG8_BAR; PG8_WAIT_L(0); PG8_MMA(0, 1, At, B1); PG8_BAR;
            PG8_LDA(At, 1, 1); PG8_STAGE(PG8_SA(1, 0), a3, voffA);
            PG8_BAR; PG8_WAIT_L(0); PG8_MMA(1, 0, At, B0); PG8_BAR; PG8_SCHED;
            PG8_STAGE(PG8_SB(1, 1), b3 + hstep, voffB);
            PG8_WAIT_V(6); PG8_BAR; PG8_MMA(1, 1, At, B1); PG8_BAR;
        }
        asm volatile("s_nop 7\n\ts_nop 7\n\ts_nop 7" ::: "memory");
        E(acc, cur, wr, wc, fr, fq);
        if (!has_next) break;
#pragma unroll
        for (int a = 0; a < 2; ++a)
#pragma unroll
            for (int b = 0; b < 2; ++b)
#pragma unroll
                for (int m = 0; m < 4; ++m)
#pragma unroll
                    for (int n = 0; n < 2; ++n) acc[a][b][m][n] = (f32x4){0.f, 0.f, 0.f, 0.f};
        cur = nxt; cA = nA; cB = nB; ++ui;
    }
    PG8_WAIT_V(0);
    if (wr == 0) PG8_BAR;
    PG8_BAR;
#undef PG8_SA
#undef PG8_SB
#undef PG8_STAGE
#undef PG8_LDA
#undef PG8_LDB
#undef PG8_MMA
#undef PG8_WAIT_V
#undef PG8_WAIT_L
#undef PG8_BAR
#undef PG8_SCHED
}
}
using pg8::Unit;

struct EpiProj {
    u16* projA; u16* projB; float* shift_p; float* shift_s;
    __device__ __forceinline__ void operator()(const f32x4 (&acc)[2][2][4][2], const Unit& u, int wr, int wc, int fr, int fq) const {
        const int row0 = u.pm * 256 + wr * 64 + fr;
        const bool isA = u.pn < 7;
        u16* base = isA ? projA : projB;
        const int colt = (isA ? u.pn : u.pn - 7) * 256 + wc * 32 + 4 * fq;
#pragma unroll
        for (int ai = 0; ai < 2; ++ai)
#pragma unroll
            for (int m = 0; m < 4; ++m) {
                const int row = row0 + ai * 128 + m * 16;
                u16* rowp = base + (size_t)row * 1792 + colt;
#pragma unroll
                for (int bj = 0; bj < 2; ++bj)
#pragma unroll
                    for (int n = 0; n < 2; ++n) st_bf4_asm(rowp + bj * 128 + n * 16, acc[ai][bj][m][n]);
                if (isA) {
                    float* dst = nullptr;
                    if (row < MP) { if ((row & 2047) == 2047) dst = shift_p + (size_t)(row >> 11) * 1792; }
                    else { const int r = row - MP; if ((r & 3) == 3) dst = shift_s + (size_t)(r >> 2) * 1792; }
                    if (dst) {
#pragma unroll
                        for (int bj = 0; bj < 2; ++bj)
#pragma unroll
                            for (int n = 0; n < 2; ++n) *(f32x4*)(dst + colt + bj * 128 + n * 16) = acc[ai][bj][m][n];
                    }
                }
            }
    }
};
struct EpiResid {
    const float* base; float* out;
    __device__ __forceinline__ void operator()(const f32x4 (&acc)[2][2][4][2], const Unit& u, int wr, int wc, int fr, int fq) const {
        const int row0 = u.pm * 256 + wr * 64 + fr, col0 = u.pn * 256 + wc * 32 + 4 * fq;
#pragma unroll
        for (int ai = 0; ai < 2; ++ai)
#pragma unroll
            for (int m = 0; m < 4; ++m) {
                const size_t off = (size_t)(row0 + ai * 128 + m * 16) * 1024 + col0;
#pragma unroll
                for (int bj = 0; bj < 2; ++bj)
#pragma unroll
                    for (int n = 0; n < 2; ++n) { const f32x4 b = *(const f32x4*)(base + off + bj * 128 + n * 16); *(f32x4*)(out + off + bj * 128 + n * 16) = b * ALPHA + acc[ai][bj][m][n]; }
            }
    }
};
struct EpiResidB {
    const u16* base; float* out;
    __device__ __forceinline__ void operator()(const f32x4 (&acc)[2][2][4][2], const Unit& u, int wr, int wc, int fr, int fq) const {
        const int row0 = u.pm * 256 + wr * 64 + fr, col0 = u.pn * 256 + wc * 32 + 4 * fq;
#pragma unroll
        for (int ai = 0; ai < 2; ++ai)
#pragma unroll
            for (int m = 0; m < 4; ++m) {
                const size_t off = (size_t)(row0 + ai * 128 + m * 16) * 1024 + col0;
#pragma unroll
                for (int bj = 0; bj < 2; ++bj)
#pragma unroll
                    for (int n = 0; n < 2; ++n) { const f32x4 b = ld_bf4(base + off + bj * 128 + n * 16); *(f32x4*)(out + off + bj * 128 + n * 16) = b * ALPHA + acc[ai][bj][m][n]; }
            }
    }
};
struct EpiUp {
    u16* gate; u16* val; float* conv_p; float* conv_s;
    __device__ __forceinline__ void operator()(const f32x4 (&acc)[2][2][4][2], const Unit& u, int wr, int wc, int fr, int fq) const {
        const int row0 = u.pm * 256 + wr * 64 + fr;
        const bool isG = u.pn < 11;
        u16* base = isG ? gate : val;
        const int colt = (isG ? u.pn : u.pn - 11) * 256 + wc * 32 + 4 * fq;
#pragma unroll
        for (int ai = 0; ai < 2; ++ai)
#pragma unroll
            for (int m = 0; m < 4; ++m) {
                const int row = row0 + ai * 128 + m * 16;
                u16* rowp = base + (size_t)row * DFF + colt;
#pragma unroll
                for (int bj = 0; bj < 2; ++bj)
#pragma unroll
                    for (int n = 0; n < 2; ++n) st_bf4_asm(rowp + bj * 128 + n * 16, acc[ai][bj][m][n]);
                if (isG) {
                    float* dst = nullptr;
                    if (row < MP) { const int t = row & 2047; if (t >= 2046) dst = conv_p + (size_t)((row >> 11) * 2 + (t - 2046)) * DFF; }
                    else { const int r = row - MP, t = r & 3; if (t >= 2) dst = conv_s + (size_t)((r >> 2) * 2 + (t - 2)) * DFF; }
                    if (dst) {
#pragma unroll
                        for (int bj = 0; bj < 2; ++bj)
#pragma unroll
                            for (int n = 0; n < 2; ++n) *(f32x4*)(dst + colt + bj * 128 + n * 16) = acc[ai][bj][m][n];
                    }
                }
            }
    }
};

template <bool BASE_BF16>
__device__ void small_gemm_resid(const u16* __restrict__ A, const u16* __restrict__ Bt, int K, const void* __restrict__ base, float* __restrict__ out, PG8_LAS unsigned char* lds) {
    const int t = opaque_tid(), wid = t >> 6, lane = t & 63, fr = lane & 15, fq = lane >> 4;
    const int kw = K >> 3, nks = kw >> 5;
    for (int tile = opaque_bid(); tile < 256; tile += gridDim.x) {
        const int r0 = MP + (tile >> 4) * 32, c0 = (tile & 15) * 64;
        f32x4 acc[2][4];
#pragma unroll
        for (int mi = 0; mi < 2; ++mi)
#pragma unroll
            for (int ni = 0; ni < 4; ++ni) acc[mi][ni] = (f32x4){0.f, 0.f, 0.f, 0.f};
#pragma unroll 2
        for (int ks = 0; ks < nks; ++ks) {
            const int k = wid * kw + ks * 32 + fq * 8;
            bf16x8 a[2], b[4];
#pragma unroll
            for (int mi = 0; mi < 2; ++mi) a[mi] = *(const bf16x8*)(A + (size_t)(r0 + mi * 16 + fr) * K + k);
#pragma unroll
            for (int ni = 0; ni < 4; ++ni) b[ni] = *(const bf16x8*)(Bt + (size_t)(c0 + ni * 16 + fr) * K + k);
#pragma unroll
            for (int mi = 0; mi < 2; ++mi)
#pragma unroll
                for (int ni = 0; ni < 4; ++ni) acc[mi][ni] = __builtin_amdgcn_mfma_f32_16x16x32_bf16(b[ni], a[mi], acc[mi][ni], 0, 0, 0);
        }
        PG8_LAS f32x4* red = (PG8_LAS f32x4*)lds;
#pragma unroll
        for (int mi = 0; mi < 2; ++mi)
#pragma unroll
            for (int ni = 0; ni < 4; ++ni) red[(wid * 8 + mi * 4 + ni) * 64 + lane] = acc[mi][ni];
        __syncthreads();
        {
            f32x4 sum = (f32x4){0.f, 0.f, 0.f, 0.f};
#pragma unroll
            for (int w = 0; w < 8; ++w) sum += red[(w * 8 + wid) * 64 + lane];
            const int mi = wid >> 2, ni = wid & 3;
            const size_t off = (size_t)(r0 + mi * 16 + fr) * 1024 + c0 + ni * 16 + 4 * fq;
            const f32x4 bs = BASE_BF16 ? ld_bf4((const u16*)base + off) : *(const f32x4*)((const float*)base + off);
            *(f32x4*)(out + off) = bs * ALPHA + sum;
        }
        __syncthreads();
    }
}

__device__ __forceinline__ void transpose_tile(const float* __restrict__ src, u16* __restrict__ dst, int K, int N, int nT, int item, float* tile) {
    const int t = opaque_tid();
    const int kt = item / nT, ntile = item - kt * nT, k0 = kt * 64, n0 = ntile * 64;
    { const int row = t >> 3, c8 = (t & 7) * 8;
      f32x4 a = (f32x4){0.f, 0.f, 0.f, 0.f}, b = a;
      if (n0 + c8 < N) { const float* sp = src + (size_t)(k0 + row) * N + n0 + c8; a = *(const f32x4*)sp; b = *(const f32x4*)(sp + 4); }
      float* tp = tile + row * 65 + c8;
      tp[0] = a[0]; tp[1] = a[1]; tp[2] = a[2]; tp[3] = a[3]; tp[4] = b[0]; tp[5] = b[1]; tp[6] = b[2]; tp[7] = b[3]; }
    __syncthreads();
    { const int n = t >> 3, k8 = (t & 7) * 8;
      float v[8];
#pragma unroll
      for (int j = 0; j < 8; ++j) v[j] = tile[(k8 + j) * 65 + n];
      u32x4 w; w.x = cvt_pk_bf16(v[0], v[1]); w.y = cvt_pk_bf16(v[2], v[3]); w.z = cvt_pk_bf16(v[4], v[5]); w.w = cvt_pk_bf16(v[6], v[7]);
      *(u32x4*)(dst + (size_t)(n0 + n) * K + k0 + k8) = w; }
    __syncthreads();
}
__device__ __forceinline__ void small_transpose(const float* __restrict__ src, u16* __restrict__ dst, int K, int N, int Kpad, size_t gt, size_t nth) {
    for (size_t i = gt; i < (size_t)N * Kpad; i += nth) { const int n = (int)(i / Kpad), k = (int)(i - (size_t)n * Kpad); const float v = k < K ? src[(size_t)k * N + n] : 0.f; dst[i] = (u16)(cvt_pk_bf16(v, 0.f) & 0xffffu); }
}
__device__ void convert_phase(KP p, int l, float* tile) {
    unsigned char* ws = p->ws;
    const int bid = opaque_bid();
    const size_t gt = (size_t)bid * 512 + opaque_tid(), nth = (size_t)gridDim.x * 512;
    constexpr int n1 = 16 * 56, n2 = 16 * 16, n3 = 16 * 88, n4 = 44 * 16;
    for (int it = bid; it < n1 + n2 + n3 + n4; it += gridDim.x) {
        if (it < n1) transpose_tile(p->in[I_WIN] + (size_t)l * 1024 * 3344, (u16*)(ws + W_WIN), 1024, 3344, 56, it, tile);
        else if (it < n1 + n2) transpose_tile(p->in[I_WOUT] + (size_t)l * 1024 * 1024, (u16*)(ws + W_WOUT), 1024, 1024, 16, it - n1, tile);
        else if (it < n1 + n2 + n3) transpose_tile(p->in[I_WUP] + (size_t)l * 1024 * 5632, (u16*)(ws + W_WUP), 1024, 5632, 88, it - n1 - n2, tile);
        else transpose_tile(p->in[I_WDOWN] + (size_t)l * 2816 * 1024, (u16*)(ws + W_WDOWN), 2816, 1024, 16, it - n1 - n2 - n3, tile);
    }
    small_transpose(p->in[I_WLU] + (size_t)l * 64 * 512, (u16*)(ws + W_WLT), 64, 512, 64, gt, nth);
    small_transpose(p->in[I_ALU] + (size_t)l * 64 * 512, (u16*)(ws + W_ALT), 64, 512, 64, gt, nth);
    small_transpose(p->in[I_GLU] + (size_t)l * 128 * 512, (u16*)(ws + W_GLT), 128, 512, 128, gt, nth);
    if (l > 0) {
        small_transpose(p->in[I_VD] + (size_t)(l - 1) * 512 * 32, (u16*)(ws + W_V1T), 512, 32, 512, gt, nth);
        small_transpose(p->in[I_VU] + (size_t)(l - 1) * 32 * 512, (u16*)(ws + W_V2T), 32, 512, 32, gt, nth);
    }
    small_transpose(p->in[I_FUP] + (size_t)l * 16 * 256, (u16*)(ws + W_FT), 16, 256, 32, gt, nth);
    if (l == 0) {
        u16* xb = (u16*)(ws + W_XB);
        for (size_t i = gt; i < (size_t)MTOK * 256; i += nth) {
            const size_t e = i * 4;
            const f32x4 v = e < (size_t)MP * 1024 ? *(const f32x4*)(p->in[I_XP] + e) : *(const f32x4*)(p->in[I_XS] + (e - (size_t)MP * 1024));
            st_bf4(xb + e, v);
        }
    }
}

template <bool WRITE_F32>
__device__ void ln_phase(float* Y, u16* xb, const float* __restrict__ g, const float* __restrict__ b) {
    const int tt_ = opaque_tid();
    const int lane = tt_ & 63, gw = opaque_bid() * 8 + (tt_ >> 6), nw = gridDim.x * 8;
    f32x4 gv[4], bv[4];
#pragma unroll
    for (int i = 0; i < 4; ++i) { gv[i] = *(const f32x4*)(g + i * 256 + lane * 4); bv[i] = *(const f32x4*)(b + i * 256 + lane * 4); }
    for (int row = gw; row < MTOK; row += nw) {
        float* yp = Y + (size_t)row * 1024 + lane * 4;
        f32x4 v[4]; float s = 0.f;
#pragma unroll
        for (int i = 0; i < 4; ++i) { v[i] = *(const f32x4*)(yp + i * 256); s += (v[i][0] + v[i][1]) + (v[i][2] + v[i][3]); }
#pragma unroll
        for (int o = 32; o >= 1; o >>= 1) s += __shfl_xor(s, o);
        const float mu = s * (1.0f / 1024.0f); float q = 0.f;
#pragma unroll
        for (int i = 0; i < 4; ++i) { const f32x4 d = v[i] - mu; q += (d[0] * d[0] + d[1] * d[1]) + (d[2] * d[2] + d[3] * d[3]); }
#pragma unroll
        for (int o = 32; o >= 1; o >>= 1) q += __shfl_xor(q, o);
        const float rstd = rsqrtf(q * (1.0f / 1024.0f) + LN_EPS);
#pragma unroll
        for (int i = 0; i < 4; ++i) { const f32x4 o = (v[i] - mu) * rstd * gv[i] + bv[i]; if (WRITE_F32) *(f32x4*)(yp + i * 256) = o; st_bf4(xb + (size_t)row * 1024 + i * 256 + lane * 4, o); }
    }
}

__device__ __forceinline__ void unpack8(const u32x4 w, float* f) { f[0] = bflo(w.x); f[1] = bfhi(w.x); f[2] = bflo(w.y); f[3] = bfhi(w.y); f[4] = bflo(w.z); f[5] = bfhi(w.z); f[6] = bflo(w.w); f[7] = bfhi(w.w); }
__device__ __forceinline__ float gelu_as(float v) {
    const float av = fabsf(v), t = __builtin_amdgcn_rcpf(av * 0.2316418882f + 1.0f);
    float q = t * 0.5307027145f + (-0.7265760135f); q = q * t + 0.7107068705f; q = q * t + (-0.142248368f); q = q * t + 0.127414796f; q = q * t;
    const float e = __builtin_amdgcn_exp2f((v * v) * (-0.72134752044f));
    const float m = v * (q * e);
    return v < 0.f ? m : v - m;
}
__device__ void convglu_phase(const u16* __restrict__ gate, u16* val, const float* __restrict__ past  , const float* __restrict__ cw, const float* __restrict__ cb) {
    const size_t gt = (size_t)opaque_bid() * 512 + opaque_tid(), nth = (size_t)gridDim.x * 512;
    for (size_t idx = gt; idx < (size_t)(MTOK / 4) * 352; idx += nth) {
        const int rg = (int)(idx / 352), c = (int)(idx - (size_t)rg * 352) * 8, row0 = rg * 4;
        bool first; const float* pst = nullptr;
        if (row0 < MP) first = (row0 & 2047) == 0; else { first = true; pst = past + (size_t)((row0 - MP) >> 2) * 2 * DFF; }
        float w0[8], w1[8], w2[8], bb[8], gm2[8], gm1[8];
#pragma unroll
        for (int j = 0; j < 8; ++j) { w0[j] = cw[c + j]; w1[j] = cw[DFF + c + j]; w2[j] = cw[2 * DFF + c + j]; bb[j] = cb[c + j]; }
        if (!first) { unpack8(*(const u32x4*)(gate + (size_t)(row0 - 2) * DFF + c), gm2); unpack8(*(const u32x4*)(gate + (size_t)(row0 - 1) * DFF + c), gm1); }
        else {
#pragma unroll
            for (int j = 0; j < 8; ++j) { gm2[j] = pst ? pst[c + j] : 0.f; gm1[j] = pst ? pst[DFF + c + j] : 0.f; } }
#pragma unroll
        for (int r = 0; r < 4; ++r) {
            float g0[8], vv[8], h[8];
            unpack8(*(const u32x4*)(gate + (size_t)(row0 + r) * DFF + c), g0);
            unpack8(*(const u32x4*)(val + (size_t)(row0 + r) * DFF + c), vv);
#pragma unroll
            for (int j = 0; j < 8; ++j) { const float a = bb[j] + gm2[j] * w0[j] + gm1[j] * w1[j] + g0[j] * w2[j]; h[j] = gelu_as(a) * vv[j]; gm2[j] = gm1[j]; gm1[j] = g0[j]; }
            u32x4 w; w.x = cvt_pk_bf16(h[0], h[1]); w.y = cvt_pk_bf16(h[2], h[3]); w.z = cvt_pk_bf16(h[4], h[5]); w.w = cvt_pk_bf16(h[6], h[7]);
            *(u32x4*)(val + (size_t)(row0 + r) * DFF + c) = w;
        }
    }
}

struct PrepCtx {
    const u16* projA; const u16* projB; const float* mu; const float* sshift  ;
};
__device__ __forceinline__ f32x4 xs4(const PrepCtx& c, int i, int col) {
    const f32x4 cur = ld_bf4(c.projA + (size_t)i * 1792 + col);
    f32x4 prev;
    bool first; int b = 0;
    if (i < MP) first = (i & 2047) == 0; else { const int r = i - MP; first = (r & 3) == 0; b = r >> 2; }
    if (!first) prev = ld_bf4(c.projA + (size_t)(i - 1) * 1792 + col);
    else if (i < MP) prev = (f32x4){0.f, 0.f, 0.f, 0.f};
    else prev = *(const f32x4*)(c.sshift + (size_t)b * 1792 + col);
    const f32x4 m = *(const f32x4*)(c.mu + col);
    return cur + (prev - cur) * m;
}
__device__ __forceinline__ bf16x8 ldg_frag(const u16* p) { return *(const bf16x8*)p; }

__device__ void prep_phase(KP p, int l, PG8_LAS unsigned char* lds) {
    unsigned char* ws = p->ws;
    PrepCtx c; c.projA = (const u16*)(ws + W_PROJA); c.projB = (const u16*)(ws + W_PROJB); c.mu = p->in[I_MU] + (size_t)l * 1792; c.sshift = p->in[I_SSHIFT] + (size_t)l * 128 * 1792;
    const u16* wlT = (const u16*)(ws + W_WLT); const u16* alT = (const u16*)(ws + W_ALT); const u16* glT = (const u16*)(ws + W_GLT);
    const u16* v1T = (const u16*)(ws + W_V1T); const u16* v2T = (const u16*)(ws + W_V2T); const u16* fT = (const u16*)(ws + W_FT);
    u32x4* A16 = (u32x4*)(ws + W_BUFB); float* D8 = (float*)(ws + W_D8); u16* vbuf = (u16*)(ws + W_VBUF); u16* gbuf = (u16*)(ws + W_GBUF);
    float* decb = (float*)(ws + W_DEC); float* rkb = (float*)(ws + W_RK); u16* vfirst = (u16*)(ws + W_VFIRST);
    const float* w0 = p->in[I_W0] + l * 512; const float* a0 = p->in[I_A0] + l * 512; const float* k_k = p->in[I_KK] + l * 512; const float* k_a = p->in[I_KA] + l * 512;
    const float* r_k = p->in[I_RK] + l * 512; const float* vb = l > 0 ? p->in[I_VB] + (l - 1) * 512 : nullptr; const float* fbias = p->in[I_FB] + l * 256;
    constexpr int S_TW = 144, S_AL = 144, S_SG = 272, S_XV = 1040, S_FL = 80, S_PP = 80;
    constexpr int O_TW = 0, O_AL = O_TW + 16 * S_TW, O_SG = O_AL + 16 * S_AL, O_XV = O_SG + 16 * S_SG, O_FL = O_XV + 16 * S_XV, O_PP = O_FL + 16 * S_FL;
    const int t = opaque_tid(), wid = t >> 6, lane = t & 63, fr = lane & 15, fq = lane >> 4, h = wid;
    for (int blk = opaque_bid(); blk < MTOK / 16; blk += gridDim.x) {
        const int i0 = blk * 16;
#pragma unroll 1
        for (int q = 0; q < 6; ++q) {
            const int op = t + 512 * q, r = op / 192, g4 = op - r * 192, col = 1024 + 4 * g4;
            f32x4 x = xs4(c, i0 + r, col);
            int off;
            if (col < 1536) off = O_XV + r * S_XV + (col - 1024) * 2;
            else if (col < 1600) { off = O_TW + r * S_TW + (col - 1536) * 2; x = (f32x4){tanhf_(x[0]), tanhf_(x[1]), tanhf_(x[2]), tanhf_(x[3])}; }
            else if (col < 1664) off = O_AL + r * S_AL + (col - 1600) * 2;
            else { off = O_SG + r * S_SG + (col - 1664) * 2; x = (f32x4){sigmoidf_(x[0]), sigmoidf_(x[1]), sigmoidf_(x[2]), sigmoidf_(x[3])}; }
            u32x2 w; w.x = cvt_pk_bf16(x[0], x[1]); w.y = cvt_pk_bf16(x[2], x[3]);
            *(PG8_LAS u32x2*)(lds + off) = w;
        }
        if (t < 128) { const int r = t >> 3, c4 = (t & 7) * 4; u32x2 w = (u32x2){0u, 0u}; if (c4 < 16) w = *(const u32x2*)(c.projB + (size_t)(i0 + r) * 1792 + 1536 + c4); *(PG8_LAS u32x2*)(lds + O_FL + r * S_FL + c4 * 2) = w; }
        __syncthreads();
        bf16x8 pfrag = (bf16x8){0, 0, 0, 0, 0, 0, 0, 0};
        if (l > 0) {
            f32x4 accP0 = (f32x4){0.f, 0.f, 0.f, 0.f}, accP1 = accP0;
#pragma unroll 4
            for (int ks = 0; ks < 16; ++ks) {
                const bf16x8 af = *(const PG8_LAS bf16x8*)(lds + O_XV + fr * S_XV + (ks * 32 + fq * 8) * 2);
                accP0 = __builtin_amdgcn_mfma_f32_16x16x32_bf16(ldg_frag(v1T + (size_t)fr * 512 + ks * 32 + fq * 8), af, accP0, 0, 0, 0);
                accP1 = __builtin_amdgcn_mfma_f32_16x16x32_bf16(ldg_frag(v1T + (size_t)(16 + fr) * 512 + ks * 32 + fq * 8), af, accP1, 0, 0, 0);
            }
            const u32 w0_ = cvt_pk_bf16(accP0[0], accP0[1]), w1_ = cvt_pk_bf16(accP0[2], accP0[3]), w2_ = cvt_pk_bf16(accP1[0], accP1[1]), w3_ = cvt_pk_bf16(accP1[2], accP1[3]);
            const u32x4 pw = (u32x4){w0_, w1_, w2_, w3_};
            pfrag = __builtin_bit_cast(bf16x8, pw);
        }
        const int i = i0 + fr;
        float ss = 0.f;
#pragma unroll
        for (int n = 0; n < 4; ++n) { const int cb_ = h * 64 + 16 * n + 4 * fq; const f32x4 xk = xs4(c, i, 512 + cb_) * *(const f32x4*)(k_k + cb_); ss += (xk[0] * xk[0] + xk[1] * xk[1]) + (xk[2] * xk[2] + xk[3] * xk[3]); }
        ss += __shfl_xor(ss, 16); ss += __shfl_xor(ss, 32);
        const float inorm = rsqrtf(fmaxf(ss, 1e-24f));
        float rks = 0.f;
#pragma unroll 2
        for (int n = 0; n < 4; ++n) {
            const int cn = h * 64 + 16 * n, cb_ = cn + 4 * fq;
            f32x4 aW = (f32x4){0.f, 0.f, 0.f, 0.f}, aA = aW, aG = aW, aV = aW;
#pragma unroll
            for (int ks = 0; ks < 2; ++ks) {
                aW = __builtin_amdgcn_mfma_f32_16x16x32_bf16(ldg_frag(wlT + (size_t)(cn + fr) * 64 + ks * 32 + fq * 8), *(const PG8_LAS bf16x8*)(lds + O_TW + fr * S_TW + (ks * 32 + fq * 8) * 2), aW, 0, 0, 0);
                aA = __builtin_amdgcn_mfma_f32_16x16x32_bf16(ldg_frag(alT + (size_t)(cn + fr) * 64 + ks * 32 + fq * 8), *(const PG8_LAS bf16x8*)(lds + O_AL + fr * S_AL + (ks * 32 + fq * 8) * 2), aA, 0, 0, 0);
            }
#pragma unroll
            for (int ks = 0; ks < 4; ++ks)
                aG = __builtin_amdgcn_mfma_f32_16x16x32_bf16(ldg_frag(glT + (size_t)(cn + fr) * 128 + ks * 32 + fq * 8), *(const PG8_LAS bf16x8*)(lds + O_SG + fr * S_SG + (ks * 32 + fq * 8) * 2), aG, 0, 0, 0);
            if (l > 0) {
                const u32x2 va = *(const u32x2*)(v2T + (size_t)(cn + fr) * 32 + 4 * fq), vc = *(const u32x2*)(v2T + (size_t)(cn + fr) * 32 + 16 + 4 * fq);
                const u32x4 vw = (u32x4){va.x, va.y, vc.x, vc.y};
                aV = __builtin_amdgcn_mfma_f32_16x16x32_bf16(__builtin_bit_cast(bf16x8, vw), pfrag, aV, 0, 0, 0);
            }
            const f32x4 xr = xs4(c, i, cb_), xk = xs4(c, i, 512 + cb_), xv = xs4(c, i, 1024 + cb_);
            const f32x4 w0v = *(const f32x4*)(w0 + cb_), a0v = *(const f32x4*)(a0 + cb_), kkv = *(const f32x4*)(k_k + cb_), kav = *(const f32x4*)(k_a + cb_), rkv = *(const f32x4*)(r_k + cb_);
            f32x4 vp = xv;
            if (l == 0) st_bf4(vfirst + (size_t)i * 512 + cb_, xv);
            else { const f32x4 vf = ld_bf4(vfirst + (size_t)i * 512 + cb_); const f32x4 vbv = *(const f32x4*)(vb + cb_);
#pragma unroll
                for (int j = 0; j < 4; ++j) vp[j] = xv[j] + (vf[j] - xv[j]) * sigmoidf_(vbv[j] + aV[j]);
            }
            f32x4 dd, kt, kn, bb;
#pragma unroll
            for (int j = 0; j < 4; ++j) {
                const float wv = -softplusf_(-(w0v[j] + aW[j])) - 0.5f;
                dd[j] = __expf(-__expf(wv));
                const float a = sigmoidf_(a0v[j] + aA[j]);
                kn[j] = xk[j] * kkv[j] * inorm;
                kt[j] = xk[j] * (1.0f + (a - 1.0f) * kav[j]);
                bb[j] = kn[j] * a;
                rks += xr[j] * kt[j] * rkv[j];
            }
            const int p0 = 8 * n + 2 * fq;
            u32x4 rec0, rec1;
            rec0.x = cvt_pk_bf16(xr[0], xr[1]); rec0.y = cvt_pk_bf16(kt[0], kt[1]); rec0.z = cvt_pk_bf16(kn[0], kn[1]); rec0.w = cvt_pk_bf16(bb[0], bb[1]);
            rec1.x = cvt_pk_bf16(xr[2], xr[3]); rec1.y = cvt_pk_bf16(kt[2], kt[3]); rec1.z = cvt_pk_bf16(kn[2], kn[3]); rec1.w = cvt_pk_bf16(bb[2], bb[3]);
            u32x4* ap = A16 + ((size_t)i * 8 + h) * 32 + p0;
            ap[0] = rec0; ap[1] = rec1;
            *(f32x4*)(D8 + (size_t)i * 512 + cb_) = dd;
            st_bf4(vbuf + (size_t)i * 512 + cb_, vp);
            st_bf4(gbuf + (size_t)i * 512 + cb_, aG);
        }
        rks += __shfl_xor(rks, 16); rks += __shfl_xor(rks, 32);
        if (fq == 0) rkb[(size_t)i * 8 + h] = rks;
#pragma unroll
        for (int n2 = 0; n2 < 2; ++n2) {
            const int cn = 32 * h + 16 * n2;
            f32x4 aF = (f32x4){0.f, 0.f, 0.f, 0.f};
            aF = __builtin_amdgcn_mfma_f32_16x16x32_bf16(ldg_frag(fT + (size_t)(cn + fr) * 32 + fq * 8), *(const PG8_LAS bf16x8*)(lds + O_FL + fr * S_FL + (fq * 8) * 2), aF, 0, 0, 0);
            const f32x4 fb = *(const f32x4*)(fbias + cn + 4 * fq);
            f32x4 dc;
#pragma unroll
            for (int j = 0; j < 4; ++j) { const float z = aF[j] + fb[j]; dc[j] = __expf(-softplusf_(-z) * (1.0f / 16.0f)); }
            *(f32x4*)(decb + (size_t)i * 256 + cn + 4 * fq) = dc;
        }
        __syncthreads();
    }
}

struct ScanItem {
    int tok0, T, L;
    int h, q;
    int hg, cgp;
    const float* s0_rwkv; float* so_rwkv;
    const float* s0_gla; float* so_gla;
};
template <int LSEG>
__device__ __forceinline__ void scan_item(KP p, const ScanItem& it, PG8_LAS unsigned char* lds) {
    unsigned char* ws = p->ws;
    const u32x4* A16 = (const u32x4*)(ws + W_BUFB); const float* D8 = (const float*)(ws + W_D8); const u16* vbuf = (const u16*)(ws + W_VBUF);
    const u16* projB = (const u16*)(ws + W_PROJB); const float* decb = (const float*)(ws + W_DEC);
    u16* obufA = (u16*)(ws + W_OBUFA); u16* obufB = (u16*)(ws + W_OBUFB);
    const int t = opaque_tid(), wid = t >> 6, lane = t & 63, kq = lane & 15, rsel = lane >> 4;
    constexpr int BUF = 69632, OR = 0, OKT = 8192, OKN = 16384, OB = 24576, OD = 32768, OVR = 40960, OQ = 43008, OK = 51200, ODC = 59392, OVG = 67584;
    const int nchunk = it.T / TC;
    u32x4 sa0, sa1; f32x4 sd, sdec; u32x2 svr = (u32x2){0u, 0u}, sq, sk;
#define SC_GLOAD(ch_) do { const int tk_ = it.tok0 + (ch_) * TC; \
        { const int i0 = t, i1 = t + 512; sa0 = A16[((size_t)(tk_ + (i0 >> 5)) * 8 + it.h) * 32 + (i0 & 31)]; sa1 = A16[((size_t)(tk_ + (i1 >> 5)) * 8 + it.h) * 32 + (i1 & 31)]; } \
        { const int st = t >> 4, c4 = (t & 15) * 4; sd = *(const f32x4*)(D8 + (size_t)(tk_ + st) * 512 + it.h * 64 + c4); \
          sq = *(const u32x2*)(projB + (size_t)(tk_ + st) * 1792 + it.hg * 64 + c4); sk = *(const u32x2*)(projB + (size_t)(tk_ + st) * 1792 + 256 + it.hg * 64 + c4); \
          sdec = *(const f32x4*)(decb + (size_t)(tk_ + st) * 256 + it.hg * 64 + c4); } \
        if (t < 128) { const int st = t >> 2, c4 = (t & 3) * 4; svr = *(const u32x2*)(vbuf + (size_t)(tk_ + st) * 512 + it.h * 64 + it.q * 16 + c4); } \
        else if (t < 256) { const int tt = t - 128, st = tt >> 2, c4 = (tt & 3) * 4; svr = *(const u32x2*)(projB + (size_t)(tk_ + st) * 1792 + 512 + it.hg * 128 + it.cgp * 16 + c4); } } while (0)
#define SC_LSTORE(buf_) do { PG8_LAS unsigned char* b_ = lds + (buf_) * BUF; \
        { const int i0 = t, i1 = t + 512; \
          { const int st = i0 >> 5, pp = i0 & 31; const int o = (st * 64 + 2 * pp) * 4; \
            *(PG8_LAS f32x2*)(b_ + OR + o) = (f32x2){bflo(sa0.x), bfhi(sa0.x)}; *(PG8_LAS f32x2*)(b_ + OKT + o) = (f32x2){bflo(sa0.y), bfhi(sa0.y)}; \
            *(PG8_LAS f32x2*)(b_ + OKN + o) = (f32x2){bflo(sa0.z), bfhi(sa0.z)}; *(PG8_LAS f32x2*)(b_ + OB + o) = (f32x2){bflo(sa0.w), bfhi(sa0.w)}; } \
          { const int st = i1 >> 5, pp = i1 & 31; const int o = (st * 64 + 2 * pp) * 4; \
            *(PG8_LAS f32x2*)(b_ + OR + o) = (f32x2){bflo(sa1.x), bfhi(sa1.x)}; *(PG8_LAS f32x2*)(b_ + OKT + o) = (f32x2){bflo(sa1.y), bfhi(sa1.y)}; \
            *(PG8_LAS f32x2*)(b_ + OKN + o) = (f32x2){bflo(sa1.z), bfhi(sa1.z)}; *(PG8_LAS f32x2*)(b_ + OB + o) = (f32x2){bflo(sa1.w), bfhi(sa1.w)}; } } \
        { const int st = t >> 4, c4 = (t & 15) * 4; const int o = (st * 64 + c4) * 4; \
          *(PG8_LAS f32x4*)(b_ + OD + o) = sd; *(PG8_LAS f32x4*)(b_ + ODC + o) = sdec; \
          *(PG8_LAS f32x4*)(b_ + OQ + o) = (f32x4){bflo(sq.x), bfhi(sq.x), bflo(sq.y), bfhi(sq.y)} * 0.125f; \
          *(PG8_LAS f32x4*)(b_ + OK + o) = (f32x4){bflo(sk.x), bfhi(sk.x), bflo(sk.y), bfhi(sk.y)}; } \
        if (t < 128) { const int st = t >> 2, c4 = (t & 3) * 4; *(PG8_LAS f32x4*)(b_ + OVR + (st * 16 + c4) * 4) = (f32x4){bflo(svr.x), bfhi(svr.x), bflo(svr.y), bfhi(svr.y)}; } \
        else if (t < 256) { const int tt = t - 128, st = tt >> 2, c4 = (tt & 3) * 4; *(PG8_LAS f32x4*)(b_ + OVG + (st * 16 + c4) * 4) = (f32x4){bflo(svr.x), bfhi(svr.x), bflo(svr.y), bfhi(svr.y)}; } } while (0)
    const bool isR = wid < 4;
    const int w4 = wid & 3;
    const int row = it.q * 16 + 4 * w4 + rsel;
    const int col = it.cgp * 16 + 4 * w4 + rsel;
    f32x4 S = (f32x4){0.f, 0.f, 0.f, 0.f}, Sn = S;
#define SC_LOAD_STATE(dst_, seg_) do { const int sg_ = (seg_); \
        if (isR) { if (!it.s0_rwkv) dst_ = (f32x4){0.f, 0.f, 0.f, 0.f}; else dst_ = *(const f32x4*)(it.s0_rwkv + (size_t)sg_ * 8 * 4096 + row * 64 + 4 * kq); } \
        else if (!it.s0_gla) dst_ = (f32x4){0.f, 0.f, 0.f, 0.f}; \
        else { const float* sp_ = it.s0_gla + (size_t)sg_ * 4 * 8192 + (size_t)(4 * kq) * 128 + col; dst_ = (f32x4){sp_[0], sp_[128], sp_[256], sp_[384]}; } } while (0)
#define SC_STORE_STATE(seg_, s_) do { const int sg_ = (seg_); \
        if (isR) { *(f32x4*)(it.so_rwkv + (size_t)sg_ * 8 * 4096 + row * 64 + 4 * kq) = s_; } \
        else { float* sp_ = it.so_gla + (size_t)sg_ * 4 * 8192 + (size_t)(4 * kq) * 128 + col; sp_[0] = s_[0]; sp_[128] = s_[1]; sp_[256] = s_[2]; sp_[384] = s_[3]; } } while (0)
    SC_GLOAD(0);
    SC_LOAD_STATE(Sn, 0);
    SC_LSTORE(0);
    __syncthreads();
    u16* oAp = obufA + (size_t)it.tok0 * 512 + it.h * 64 + row;
    u16* oBp = obufB + (size_t)it.tok0 * 512 + it.hg * 128 + col;
    const int vsl = (4 * w4 + rsel) * 4;
#define SC_STEP_R(s_, ov_) do { const int o = ((s_) * 64 + 4 * kq) * 4; \
        const f32x4 r4 = *(const PG8_LAS f32x4*)(b + OR + o), k4 = *(const PG8_LAS f32x4*)(b + OKT + o), n4 = *(const PG8_LAS f32x4*)(b + OKN + o), b4 = *(const PG8_LAS f32x4*)(b + OB + o), d4 = *(const PG8_LAS f32x4*)(b + OD + o); \
        const float v = *(const PG8_LAS float*)(b + OVR + (s_) * 64 + vsl); \
        float dot = dot4pk(S, n4); \
        dot = red16(dot); \
        S = S * d4 - b4 * dot + k4 * v; \
        float o_ = dot4pk(S, r4); \
        (ov_) = red16(o_); } while (0)
#define SC_STEP_G(s_, ov_) do { const int o = ((s_) * 64 + 4 * kq) * 4; \
        const f32x4 q4 = *(const PG8_LAS f32x4*)(b + OQ + o), k4 = *(const PG8_LAS f32x4*)(b + OK + o), d4 = *(const PG8_LAS f32x4*)(b + ODC + o); \
        const float v = *(const PG8_LAS float*)(b + OVG + (s_) * 64 + vsl); \
        S = S * d4 + k4 * v; \
        float o_ = dot4pk(S, q4); \
        (ov_) = red16(o_); } while (0)
#define SC_BLOCK(STEP_, s0_, NB_, optr_) do { float ov[NB_]; \
        _Pragma("unroll") for (int j_ = 0; j_ < (NB_); ++j_) STEP_((s0_) + j_, ov[j_]); \
        float outv = ov[0]; \
        _Pragma("unroll") for (int j_ = 1; j_ < (NB_); ++j_) outv = (kq == j_) ? ov[j_] : outv; \
        if (kq < (NB_)) (optr_)[(size_t)((s0_) + kq) * 512] = (u16)(cvt_pk_bf16(outv, 0.f) & 0xffffu); } while (0)
    for (int ch = 0; ch < nchunk; ++ch) {
        const bool more = ch + 1 < nchunk;
        if (more) SC_GLOAD(ch + 1);
        PG8_LAS unsigned char* b = lds + (ch & 1) * BUF;
        if (LSEG >= TC) {
            if (ch == 0) S = Sn;
            if (isR) {
                {
                    struct InR { f32x4 r4, k4, n4, b4, d4; float v; };
                    InR in_[TC]; float ov[8]; float op = 0.f;
#define LD_R(s_) do { const int o = ((s_) * 64 + 4 * kq) * 4; in_[s_].r4 = *(const PG8_LAS f32x4*)(b + OR + o); in_[s_].k4 = *(const PG8_LAS f32x4*)(b + OKT + o); in_[s_].n4 = *(const PG8_LAS f32x4*)(b + OKN + o); \
                        in_[s_].b4 = *(const PG8_LAS f32x4*)(b + OB + o); in_[s_].d4 = *(const PG8_LAS f32x4*)(b + OD + o); in_[s_].v = *(const PG8_LAS float*)(b + OVR + (s_) * 64 + vsl); } while (0)
#pragma unroll
                    for (int j = 0; j < SC_PD; ++j) LD_R(j);
#pragma unroll
                    for (int s = 0; s < TC; ++s) {
                        float dot = dot4pk(S, in_[s].n4);
                        dot += dppf<0xB1>(dot); op += dppf<0xB1>(op);
                        dot += dppf<0x4E>(dot); op += dppf<0x4E>(op);
                        dot += dppf<0x141>(dot); op += dppf<0x141>(op);
                        dot += dppf<0x140>(dot); op += dppf<0x140>(op);
                        if (s > 0) ov[(s - 1) & 7] = op;
                        if (s > 0 && (s & 7) == 0) { float outv = ov[0];
#pragma unroll
                            for (int j = 1; j < 8; ++j) outv = (kq == j) ? ov[j] : outv;
                            if (kq < 8) oAp[(size_t)(s - 8 + kq) * 512] = (u16)(cvt_pk_bf16(outv, 0.f) & 0xffffu); }
                        S = S * in_[s].d4 - in_[s].b4 * dot + in_[s].k4 * in_[s].v;
                        op = dot4pk(S, in_[s].r4);
                        if (s + SC_PD < TC) LD_R(s + SC_PD);
                        __builtin_amdgcn_sched_barrier(0);
                    }
                    ov[7] = red16(op);
                    { float outv = ov[0];
#pragma unroll
                      for (int j = 1; j < 8; ++j) outv = (kq == j) ? ov[j] : outv;
                      if (kq < 8) oAp[(size_t)(TC - 8 + kq) * 512] = (u16)(cvt_pk_bf16(outv, 0.f) & 0xffffu); }
#undef LD_R
                }
            } else {
                {
                    struct InG { f32x4 q4, k4, d4; float v; };
                    InG in_[TC]; float ov[8];
#define LD_G(s_) do { const int o = ((s_) * 64 + 4 * kq) * 4; in_[s_].q4 = *(const PG8_LAS f32x4*)(b + OQ + o); in_[s_].k4 = *(const PG8_LAS f32x4*)(b + OK + o); in_[s_].d4 = *(const PG8_LAS f32x4*)(b + ODC + o); \
                        in_[s_].v = *(const PG8_LAS float*)(b + OVG + (s_) * 64 + vsl); } while (0)
#pragma unroll
                    for (int j = 0; j < SC_PD; ++j) LD_G(j);
#pragma unroll
                    for (int s = 0; s < TC; ++s) {
                        S = S * in_[s].d4 + in_[s].k4 * in_[s].v;
                        float o_ = dot4pk(S, in_[s].q4);
                        ov[s & 7] = red16(o_);
                        if (s + SC_PD < TC) LD_G(s + SC_PD);
                        __builtin_amdgcn_sched_barrier(0);
                        if ((s & 7) == 7) { float outv = ov[0];
#pragma unroll
                            for (int j = 1; j < 8; ++j) outv = (kq == j) ? ov[j] : outv;
                            if (kq < 8) oBp[(size_t)((s & ~7) + kq) * 512] = (u16)(cvt_pk_bf16(outv, 0.f) & 0xffffu); }
                    }
#undef LD_G
                }
            }
            if (!more) SC_STORE_STATE(0, S);
        } else {
#pragma unroll 1
            for (int sgi = 0; sgi < TC / LSEG; ++sgi) {
                const int seg = ch * (TC / LSEG) + sgi;
                S = Sn;
                if ((seg + 1) * LSEG < it.T) SC_LOAD_STATE(Sn, seg + 1);
                if (isR) {
                    SC_BLOCK(SC_STEP_R, sgi * LSEG, (LSEG < TC ? LSEG : 1), oAp);
                } else {
                    SC_BLOCK(SC_STEP_G, sgi * LSEG, (LSEG < TC ? LSEG : 1), oBp);
                }
                SC_STORE_STATE(seg, S);
            }
        }
        oAp += (size_t)TC * 512; oBp += (size_t)TC * 512;
        if (more) SC_LSTORE((ch + 1) & 1);
        __syncthreads();
    }
#undef SC_BLOCK
#undef SC_STEP_R
#undef SC_STEP_G
}
__device__ void scan_phase(KP p, int l, PG8_LAS unsigned char* lds) {
    float* out = p->out;
    const int bid = opaque_bid();
    for (int i = bid; i < 256; i += gridDim.x) {
        ScanItem it; const int s = i >> 5;
        it.tok0 = s * 2048; it.T = 2048; it.L = 2048; it.h = (i >> 2) & 7; it.q = i & 3; it.hg = (i >> 3) & 3; it.cgp = i & 7;
        it.s0_rwkv = nullptr; it.so_rwkv = out + O_RWKV_P + ((size_t)(l * 8 + s) * 8 + it.h) * 4096;
        it.s0_gla = nullptr; it.so_gla = out + O_GLA_P + ((size_t)(l * 8 + s) * 4 + it.hg) * 8192;
        scan_item<2048>(p, it, lds);
    }
    for (int i = bid; i < 256; i += gridDim.x) {
        ScanItem it; const int bg = i >> 5, b0 = bg * 16;
        it.tok0 = MP + bg * 64; it.T = 64; it.L = 4; it.h = (i >> 2) & 7; it.q = i & 3; it.hg = (i >> 3) & 3; it.cgp = i & 7;
        it.s0_rwkv = p->in[I_SRWKV] + ((size_t)(l * 128 + b0) * 8 + it.h) * 4096; it.so_rwkv = out + O_RWKV_S + ((size_t)(l * 128 + b0) * 8 + it.h) * 4096;
        it.s0_gla = p->in[I_SGLA] + ((size_t)(l * 128 + b0) * 4 + it.hg) * 8192; it.so_gla = out + O_GLA_S + ((size_t)(l * 128 + b0) * 4 + it.hg) * 8192;
        scan_item<4>(p, it, lds);
    }
}

__device__ void post_phase(KP p, int l) {
    unsigned char* ws = p->ws;
    const u16* obufA = (const u16*)(ws + W_OBUFA); const u16* obufB = (const u16*)(ws + W_OBUFB); const u16* vbuf = (const u16*)(ws + W_VBUF); const u16* gbuf = (const u16*)(ws + W_GBUF);
    const float* rkb = (const float*)(ws + W_RK); const u16* projB = (const u16*)(ws + W_PROJB); u16* oab = (u16*)(ws + W_XB);
    const float* lg = p->in[I_LNXG] + l * 512; const float* lb = p->in[I_LNXB] + l * 512; const float* ng = p->in[I_NG] + l * 128;
    const int tt_ = opaque_tid();
    const int lane = tt_ & 63, gw = opaque_bid() * 8 + (tt_ >> 6), nw = gridDim.x * 8;
    const int c = lane * 8;
    float lgv[8], lbv[8], ngv[8];
#pragma unroll
    for (int j = 0; j < 8; ++j) { lgv[j] = lg[c + j]; lbv[j] = lb[c + j]; ngv[j] = ng[(c & 127) + j]; }
    for (int i = gw; i < MTOK; i += nw) {
        {
            const f32x4 o0 = ld_bf4(obufA + (size_t)i * 512 + c), o1 = ld_bf4(obufA + (size_t)i * 512 + c + 4);
            const f32x4 v0 = ld_bf4(vbuf + (size_t)i * 512 + c), v1 = ld_bf4(vbuf + (size_t)i * 512 + c + 4);
            const f32x4 g0 = ld_bf4(gbuf + (size_t)i * 512 + c), g1 = ld_bf4(gbuf + (size_t)i * 512 + c + 4);
            const float rk = rkb[(size_t)i * 8 + (lane >> 3)];
            float s = (o0[0] + o0[1]) + (o0[2] + o0[3]) + (o1[0] + o1[1]) + (o1[2] + o1[3]);
            s += __shfl_xor(s, 1); s += __shfl_xor(s, 2); s += __shfl_xor(s, 4);
            const float m = s * (1.0f / 64.0f);
            const f32x4 d0 = o0 - m, d1 = o1 - m;
            float q = (d0[0] * d0[0] + d0[1] * d0[1]) + (d0[2] * d0[2] + d0[3] * d0[3]) + (d1[0] * d1[0] + d1[1] * d1[1]) + (d1[2] * d1[2] + d1[3] * d1[3]);
            q += __shfl_xor(q, 1); q += __shfl_xor(q, 2); q += __shfl_xor(q, 4);
            const float rs = rsqrtf(q * (1.0f / 64.0f) + GN_EPS_A);
            f32x4 y0, y1;
#pragma unroll
            for (int j = 0; j < 4; ++j) { y0[j] = (d0[j] * rs * lgv[j] + lbv[j] + rk * v0[j]) * g0[j]; y1[j] = (d1[j] * rs * lgv[4 + j] + lbv[4 + j] + rk * v1[j]) * g1[j]; }
            u32x4 w; w.x = cvt_pk_bf16(y0[0], y0[1]); w.y = cvt_pk_bf16(y0[2], y0[3]); w.z = cvt_pk_bf16(y1[0], y1[1]); w.w = cvt_pk_bf16(y1[2], y1[3]);
            *(u32x4*)(oab + (size_t)i * 1024 + c) = w;
        }
        {
            const f32x4 o0 = ld_bf4(obufB + (size_t)i * 512 + c), o1 = ld_bf4(obufB + (size_t)i * 512 + c + 4);
            const f32x4 g0 = ld_bf4(projB + (size_t)i * 1792 + 1024 + c), g1 = ld_bf4(projB + (size_t)i * 1792 + 1024 + c + 4);
            float q = (o0[0] * o0[0] + o0[1] * o0[1]) + (o0[2] * o0[2] + o0[3] * o0[3]) + (o1[0] * o1[0] + o1[1] * o1[1]) + (o1[2] * o1[2] + o1[3] * o1[3]);
            q += __shfl_xor(q, 1); q += __shfl_xor(q, 2); q += __shfl_xor(q, 4); q += __shfl_xor(q, 8);
            const float rs = rsqrtf(q * (1.0f / 128.0f) + RMS_EPS);
            f32x4 y0, y1;
#pragma unroll
            for (int j = 0; j < 4; ++j) { y0[j] = o0[j] * rs * ngv[j] * (g0[j] * sigmoidf_(g0[j])); y1[j] = o1[j] * rs * ngv[4 + j] * (g1[j] * sigmoidf_(g1[j])); }
            u32x4 w; w.x = cvt_pk_bf16(y0[0], y0[1]); w.y = cvt_pk_bf16(y0[2], y0[3]); w.z = cvt_pk_bf16(y1[0], y1[1]); w.w = cvt_pk_bf16(y1[2], y1[3]);
            *(u32x4*)(oab + (size_t)i * 1024 + 512 + c) = w;
        }
    }
}

#define XB_TMO      128
#define XB_XCNT(j)  (256  + 64 * (j))
#define XB_XSUB(j)  (1280 + 64 * (j))
#define XB_XGEN(j)  (2304 + 64 * (j))
#define XB_TOP      3328
#define XB_TOPGEN   3392
#define XCD_BAR_WORDS 3456
#define XB_SPIN_CAP (1u << 18)
__device__ __forceinline__ unsigned xb_ld(unsigned* p)              { return __hip_atomic_load(p, __ATOMIC_RELAXED, __HIP_MEMORY_SCOPE_AGENT); }
__device__ __forceinline__ unsigned xb_add(unsigned* p, unsigned v) { return __hip_atomic_fetch_add(p, v, __ATOMIC_RELAXED, __HIP_MEMORY_SCOPE_AGENT); }
__device__ __forceinline__ unsigned xb_xcc_id() { return (unsigned)__builtin_amdgcn_s_getreg((3 << 11) | 20) & 0xFu; }
#define XB_SPIN(cond, bar) do { unsigned _sp = 0; while (cond) { __builtin_amdgcn_s_sleep(1); \
    if ((++_sp & 255u) == 0u) { if (xb_ld(&(bar)[XB_TMO])) break; if (_sp > XB_SPIN_CAP) { atomicAdd(&(bar)[XB_TMO], 1u); break; } } } } while (0)
__device__ __forceinline__ void xcd_barrier_complete(unsigned* bar, unsigned x, unsigned& nloc, unsigned& nx) {
    const unsigned G = gridDim.x * gridDim.y * gridDim.z;
    unsigned sum, cnt, mine, sp = 0u;
    for (;;) {
        sum = 0u; cnt = 0u; mine = 0u;
#pragma unroll
        for (unsigned j = 0; j < 16; ++j) { const unsigned c = xb_ld(&bar[XB_XCNT(j)]); sum += c; cnt += (c > 0u) ? 1u : 0u; mine = (j == x) ? c : mine; }
        if (sum == G) break;
        __builtin_amdgcn_s_sleep(1);
        if ((++sp & 255u) == 0u) { if (xb_ld(&bar[XB_TMO])) break; if (sp > XB_SPIN_CAP) { atomicAdd(&bar[XB_TMO], 1u); break; } }
    }
    nloc = mine > 0u ? mine : 1u; nx = cnt > 0u ? cnt : 1u;
}
__device__ __forceinline__ void xcd_barrier(unsigned* bar, volatile PG8_LAS unsigned* st) {
    asm volatile("s_waitcnt vmcnt(0)" ::: "memory");
    __syncthreads();
    if (threadIdx.x == 0) {
        const unsigned x = xb_xcc_id();
        __builtin_amdgcn_s_waitcnt(0);
        unsigned nloc = st[0], nx = st[1];
        if (nloc == 0u) { xcd_barrier_complete(bar, x, nloc, nx); st[0] = nloc; st[1] = nx; }
        const unsigned old = xb_add(&bar[XB_XSUB(x)], 1u);
        const unsigned gen = old / nloc;
        if (old + 1u == (gen + 1u) * nloc) {
            __builtin_amdgcn_fence(__ATOMIC_RELEASE, "agent");
            asm volatile("s_waitcnt vmcnt(0)" ::: "memory");
            const unsigned og = xb_add(&bar[XB_TOP], 1u);
            const unsigned tg = og / nx;
            if (og + 1u == (tg + 1u) * nx) xb_add(&bar[XB_TOPGEN], 1u);
            else XB_SPIN(xb_ld(&bar[XB_TOPGEN]) == tg, bar);
            __builtin_amdgcn_fence(__ATOMIC_ACQUIRE, "agent");
            xb_add(&bar[XB_XGEN(x)], 1u);
            asm volatile("s_waitcnt vmcnt(0)" ::: "memory");
        } else {
            XB_SPIN(xb_ld(&bar[XB_XGEN(x)]) == gen, bar);
            __builtin_amdgcn_fence(__ATOMIC_ACQUIRE, "agent");
            asm volatile("s_waitcnt vmcnt(0)" ::: "memory");
        }
    }
    __syncthreads();
}
__device__ __forceinline__ void gsync(cg::grid_group& grid) {
    asm volatile("s_waitcnt vmcnt(0)" ::: "memory");
    grid.sync();
    if (threadIdx.x < 64) { __builtin_amdgcn_fence(__ATOMIC_ACQUIRE, "agent"); asm volatile("s_waitcnt vmcnt(0)" ::: "memory"); }
    __syncthreads();
}

__global__ void __launch_bounds__(512, 2) mega(Params p_unused) {
    KP p = kparams();
    extern __shared__ __attribute__((aligned(16))) unsigned char smem[];
    PG8_LAS unsigned char* lds = (PG8_LAS unsigned char*)smem;
    cg::grid_group grid = cg::this_grid();
    unsigned char* ws = p->ws;
    float* bufA = p->out + O_Y; float* bufB = (float*)(ws + W_BUFB); u16* xb = (u16*)(ws + W_XB);
    pg8::StaticOrder S;
    volatile PG8_LAS unsigned* xst = (volatile PG8_LAS unsigned*)(lds + 139264);
    if (threadIdx.x == 0) { xst[0] = 0u; xst[1] = 0u; }
    gsync(grid);
    unsigned* xbar = (unsigned*)(kparams()->ws + W_BAR);
    if (threadIdx.x == 0) (void)xb_add(&xbar[XB_XCNT(xb_xcc_id())], 1u);
#define PHASE_END() xcd_barrier((unsigned*)(kparams()->ws + W_BAR), xst)
    convert_phase(kparams(), 0, (float*)smem);
    PHASE_END();
    for (int l = 0; l < NL; ++l) {
        {
            pg8::Gemm g; g.A = xb; g.Bt = (const u16*)(ws + W_WIN); g.M = MTOK; g.N = INP; g.K = 1024;
            EpiProj E; E.projA = (u16*)(ws + W_PROJA); E.projB = (u16*)(ws + W_PROJB); E.shift_p = p->out + O_SHIFT_P + (size_t)l * 8 * 1792; E.shift_s = p->out + O_SHIFT_S + (size_t)l * 128 * 1792;
            S.init(MTOK, INP, gridDim.x, opaque_bid()); pg8::gemm_phase(lds, g, S, E);
        }
        PHASE_END();
        prep_phase(kparams(), l, lds);
        PHASE_END();
        scan_phase(kparams(), l, lds);
        PHASE_END();
        post_phase(kparams(), l);
        PHASE_END();
        {
            pg8::Gemm g; g.A = xb; g.Bt = (const u16*)(ws + W_WOUT); g.M = MTOK; g.N = 1024; g.K = 1024;
            EpiResid E; E.base = (l == 0) ? p->in[I_XP] : bufA; E.out = bufB;
            g.M = MP; S.init(MP, 1024, gridDim.x, opaque_bid()); pg8::gemm_phase(lds, g, S, E);
            small_gemm_resid<false>(g.A, g.Bt, 1024, (l == 0) ? (const void*)(p->in[I_XS] - (size_t)MP * 1024) : (const void*)bufA, E.out, lds);
        }
        PHASE_END();
        ln_phase<false>(bufB, xb, p->in[I_LN1G] + l * 1024, p->in[I_LN1B] + l * 1024);
        PHASE_END();
        {
            pg8::Gemm g; g.A = xb; g.Bt = (const u16*)(ws + W_WUP); g.M = MTOK; g.N = 5632; g.K = 1024;
            EpiUp E; E.gate = (u16*)(ws + W_GATE); E.val = (u16*)(ws + W_VAL); E.conv_p = p->out + O_CONV_P + (size_t)l * 8 * 2 * DFF; E.conv_s = p->out + O_CONV_S + (size_t)l * 128 * 2 * DFF;
            S.init(MTOK, 5632, gridDim.x, opaque_bid()); pg8::gemm_phase(lds, g, S, E);
        }
        PHASE_END();
        convglu_phase((const u16*)(ws + W_GATE), (u16*)(ws + W_VAL), p->in[I_SCONV] + (size_t)l * 128 * 2 * DFF, p->in[I_CW] + (size_t)l * 3 * DFF, p->in[I_CB] + (size_t)l * DFF);
        PHASE_END();
        {
            pg8::Gemm g; g.A = (const u16*)(ws + W_VAL); g.Bt = (const u16*)(ws + W_WDOWN); g.M = MTOK; g.N = 1024; g.K = DFF;
            EpiResidB E; E.base = xb; E.out = bufA;
            g.M = MP; S.init(MP, 1024, gridDim.x, opaque_bid()); pg8::gemm_phase(lds, g, S, E);
            small_gemm_resid<true>(g.A, g.Bt, DFF, E.base, E.out, lds);
        }
        PHASE_END();
        ln_phase<true>(bufA, xb, p->in[I_LN2G] + l * 1024, p->in[I_LN2B] + l * 1024);
        if (l + 1 < NL) convert_phase(kparams(), l + 1, (float*)smem);
        PHASE_END();
    }
}

extern "C" void kernel_launch(void* const* d_in, const int* in_sizes, int n_in, void* d_out, int out_size, void* d_ws, size_t ws_size, hipStream_t stream) {
    static int grid_blocks = 0;
    if (!grid_blocks) {
        int dev = 0, cus = 0, per_cu = 0;
        (void)hipGetDevice(&dev);
        (void)hipDeviceGetAttribute(&cus, hipDeviceAttributeMultiprocessorCount, dev);
        (void)hipFuncSetAttribute((const void*)mega, hipFuncAttributeMaxDynamicSharedMemorySize, LDS_BYTES);
        (void)hipOccupancyMaxActiveBlocksPerMultiprocessor(&per_cu, (const void*)mega, 512, LDS_BYTES);
        grid_blocks = cus;
        if (n_in != 33 || (size_t)out_size != O_END || ws_size < W_TOTAL) { fprintf(stderr, "kernel_launch: unexpected sizes n_in %d out %d ws %zu (need %zu)\n", n_in, out_size, ws_size, (size_t)W_TOTAL); grid_blocks = -1; }
    }
    if (grid_blocks < 0) return;
    (void)hipMemsetAsync((unsigned char*)d_ws + W_BAR, 0, XCD_BAR_WORDS * sizeof(unsigned), stream);
    Params p{};
    for (int i = 0; i < 33; ++i) p.in[i] = (const float*)d_in[i];
    p.out = (float*)d_out; p.ws = (unsigned char*)d_ws;
    void* args[] = {&p};
    hipError_t e = hipLaunchCooperativeKernel((const void*)mega, dim3(grid_blocks), dim3(512), args, LDS_BYTES, stream);
    if (e != hipSuccess) fprintf(stderr, "cooperative launch failed: %s (grid %d)\n", hipGetErrorString(e), grid_blocks);
}
```

```cpp
#include <hip/hip_runtime.h>
#include <hip/hip_cooperative_groups.h>
#include <cstdio>
namespace cg = cooperative_groups;

#define PG8_LAS __attribute__((address_space(3)))
typedef unsigned short u16;
typedef unsigned int u32;
typedef unsigned short bf16_t;
typedef short bf16x8 __attribute__((ext_vector_type(8)));
typedef float f32x4 __attribute__((ext_vector_type(4)));
typedef float f32x2 __attribute__((ext_vector_type(2)));
typedef unsigned u32x4 __attribute__((ext_vector_type(4)));
typedef unsigned u32x2 __attribute__((ext_vector_type(2)));

constexpr int MTOK = 16896, MP = 16384, DM = 1024, NL = 4;
constexpr int SHIFT_W = 1792, INP = 3584, DFF = 2816;
constexpr float ALPHA = 1.6817928305074290f;
constexpr float GN_EPS_A = 64e-5f, RMS_EPS = 1e-5f, LN_EPS = 1e-5f;
constexpr int LDS_BYTES = 139264 + 16;
constexpr int TC = 32;
#define SC_PD 3

enum { I_XP = 0, I_XS, I_SRWKV, I_SSHIFT, I_SGLA, I_SCONV, I_WIN, I_MU, I_W0, I_WLU, I_A0, I_ALU, I_GLU, I_KK, I_KA, I_RK, I_LNXG, I_LNXB,
       I_VB, I_VD, I_VU, I_FUP, I_FB, I_NG, I_WOUT, I_LN1G, I_LN1B, I_WUP, I_CW, I_CB, I_WDOWN, I_LN2G, I_LN2B };

constexpr size_t O_Y = 0;
constexpr size_t O_RWKV_P = (size_t)MTOK * DM;
constexpr size_t O_RWKV_S = O_RWKV_P + (size_t)4 * 8 * 8 * 4096;
constexpr size_t O_SHIFT_P = O_RWKV_S + (size_t)4 * 128 * 8 * 4096;
constexpr size_t O_SHIFT_S = O_SHIFT_P + (size_t)4 * 8 * 1792;
constexpr size_t O_GLA_P = O_SHIFT_S + (size_t)4 * 128 * 1792;
constexpr size_t O_GLA_S = O_GLA_P + (size_t)4 * 8 * 4 * 8192;
constexpr size_t O_CONV_P = O_GLA_S + (size_t)4 * 128 * 4 * 8192;
constexpr size_t O_CONV_S = O_CONV_P + (size_t)4 * 8 * 2 * 2816;
constexpr size_t O_END = O_CONV_S + (size_t)4 * 128 * 2 * 2816;

constexpr size_t W_WIN = 0;
constexpr size_t W_WOUT = W_WIN + (size_t)INP * 1024 * 2;
constexpr size_t W_WUP = W_WOUT + (size_t)1024 * 1024 * 2;
constexpr size_t W_WDOWN = W_WUP + (size_t)5632 * 1024 * 2;
constexpr size_t W_WLT = W_WDOWN + (size_t)1024 * 2816 * 2;
constexpr size_t W_ALT = W_WLT + 512 * 64 * 2;
constexpr size_t W_GLT = W_ALT + 512 * 64 * 2;
constexpr size_t W_V1T = W_GLT + 512 * 128 * 2;
constexpr size_t W_V2T = W_V1T + 32 * 512 * 2;
constexpr size_t W_FT = W_V2T + 512 * 32 * 2;
constexpr size_t W_XB = W_FT + 256 * 32 * 2;
constexpr size_t W_VFIRST = W_XB + (size_t)MTOK * 1024 * 2;
constexpr size_t W_BUFB = W_VFIRST + (size_t)MTOK * 512 * 2;
constexpr size_t W_R = W_BUFB + (size_t)MTOK * 1024 * 4;
constexpr size_t W_PROJA = W_R;
constexpr size_t W_PROJB = W_PROJA + (size_t)MTOK * 1792 * 2;
constexpr size_t W_D8 = W_PROJB + (size_t)MTOK * 1792 * 2;
constexpr size_t W_VBUF = W_D8 + (size_t)MTOK * 512 * 4;
constexpr size_t W_GBUF = W_VBUF + (size_t)MTOK * 512 * 2;
constexpr size_t W_DEC = W_GBUF + (size_t)MTOK * 512 * 2;
constexpr size_t W_RK = W_DEC + (size_t)MTOK * 256 * 4;
constexpr size_t W_END1 = W_RK + (size_t)MTOK * 8 * 4;
constexpr size_t W_GATE = W_R;
constexpr size_t W_VAL = W_GATE + (size_t)MTOK * 2816 * 2;
constexpr size_t W_END2 = W_VAL + (size_t)MTOK * 2816 * 2;
constexpr size_t W_END = W_END1 > W_END2 ? W_END1 : W_END2;
constexpr size_t W_BAR = (W_END + 255) / 256 * 256;
constexpr size_t W_TOTAL = W_BAR + 16384;
constexpr size_t W_OBUFA = W_PROJA;
constexpr size_t W_OBUFB = W_PROJA + (size_t)MTOK * 512 * 2;

struct Params { const float* in[33]; float* out; unsigned char* ws; };
typedef const Params __attribute__((address_space(4)))* KP;
__device__ __forceinline__ KP kparams() { unsigned long long k = (unsigned long long)__builtin_amdgcn_kernarg_segment_ptr(); asm volatile("" : "+s"(k)); return (KP)k; }

typedef __bf16 bf16v2 __attribute__((ext_vector_type(2)));
__device__ __forceinline__ unsigned cvt_pk_bf16(float lo, float hi) { const f32x2 v = (f32x2){lo, hi}; const bf16v2 b = __builtin_convertvector(v, bf16v2); return __builtin_bit_cast(unsigned, b); }
__device__ __forceinline__ float bflo(u32 w) { return __uint_as_float(w << 16); }
__device__ __forceinline__ float bfhi(u32 w) { return __uint_as_float(w & 0xffff0000u); }
__device__ __forceinline__ f32x4 ld_bf4(const u16* p) { const u32x2 w = *(const u32x2*)p; return (f32x4){bflo(w.x), bfhi(w.x), bflo(w.y), bfhi(w.y)}; }
__device__ __forceinline__ unsigned cvt_pk_bf16_asm(float lo, float hi) { unsigned r; asm volatile("v_cvt_pk_bf16_f32 %0, %1, %2" : "=v"(r) : "v"(lo), "v"(hi)); return r; }
__device__ __forceinline__ void st_bf4_asm(u16* p, f32x4 v) { u32x2 w; w.x = cvt_pk_bf16_asm(v[0], v[1]); w.y = cvt_pk_bf16_asm(v[2], v[3]); *(u32x2*)p = w; }
__device__ __forceinline__ void st_bf4(u16* p, f32x4 v) { u32x2 w; w.x = cvt_pk_bf16(v[0], v[1]); w.y = cvt_pk_bf16(v[2], v[3]); *(u32x2*)p = w; }
__device__ __forceinline__ float sigmoidf_(float x) { return __builtin_amdgcn_rcpf(1.0f + __expf(-x)); }
__device__ __forceinline__ float tanhf_(float x) { return 1.0f - 2.0f * __builtin_amdgcn_rcpf(1.0f + __expf(2.0f * x)); }
__device__ __forceinline__ float softplusf_(float x) { return fmaxf(x, 0.f) + __logf(1.0f + __expf(-fabsf(x))); }
template <int CTRL> __device__ __forceinline__ float dppf(float x) { return __builtin_bit_cast(float, __builtin_amdgcn_update_dpp(0, __builtin_bit_cast(int, x), CTRL, 0xF, 0xF, true)); }
__device__ __forceinline__ float dot4pk(f32x4 a, f32x4 b) { f32x2 p = (f32x2){a[0], a[1]} * (f32x2){b[0], b[1]}; p = (f32x2){a[2], a[3]} * (f32x2){b[2], b[3]} + p; return p.x + p.y; }
__device__ __forceinline__ float red16(float x) { x += dppf<0xB1>(x); x += dppf<0x4E>(x); x += dppf<0x141>(x); x += dppf<0x140>(x); return x; }

__device__ __forceinline__ int opaque_tid() { int t = threadIdx.x; asm volatile("" : "+v"(t)); return t; }
__device__ __forceinline__ int opaque_bid() { int b = blockIdx.x; asm volatile("" : "+s"(b)); return b; }

namespace pg8 {
constexpr int BM = 256, BK = 64, HALF = 128, HTB = HALF * BK * 2, STAGE_BYTES = 8 * HTB, NXCD = 8, WGM = 8;
__host__ __device__ __forceinline__ int lds_byte(int r, int c) { const int st = (r >> 4) * 2 + (c >> 5), rr = r & 15, cc = c & 31, ob = rr * 64 + cc * 2; return st * 1024 + (ob ^ (((ob >> 9) & 1) << 5)); }
__host__ __device__ __forceinline__ void stage_rc(int b, int& R, int& C) { const int st = b / 1024, sb = b % 1024, swz = sb ^ (((sb >> 9) & 1) << 5); R = (st >> 1) * 16 + swz / 64; C = (st & 1) * 32 + (swz % 64) / 2; }
struct Unit { int pm, pn; };
struct Gemm { const bf16_t* A; const bf16_t* Bt; int M, N, K; };
struct StaticOrder {
    int nM, nN, nwg, G, c;
    __host__ __device__ void init(int M, int N, int G_, int c_) { nM = M / BM; nN = N / BM; nwg = nM * nN; G = G_; c = c_; }
    __host__ __device__ bool next(int i, Unit& u) const {
        const long L = (long)i * G + c; if (L >= nwg) return false;
        int wgid = (int)L; { const int q = nwg / NXCD, r = nwg % NXCD, xcd = wgid % NXCD, off = wgid / NXCD; wgid = (xcd < r ? xcd * (q + 1) : r * (q + 1) + (xcd - r) * q) + off; }
        const int nig = WGM * nN, gid = wgid / nig, fm = gid * WGM, gsz = (nM - fm) < WGM ? (nM - fm) : WGM;
        u.pm = fm + ((wgid % nig) % gsz); u.pn = (wgid % nig) / gsz; return true;
    }
};

template <class Epi>
__device__ __forceinline__ void gemm_phase(PG8_LAS unsigned char* lds, const Gemm g, const StaticOrder& S, const Epi& E) {
    const int tid = opaque_tid(), wid = __builtin_amdgcn_readfirstlane(tid >> 6), lane = tid & 63, wr = wid >> 2, wc = wid & 3, fr = lane & 15, fq = lane >> 4;
    const int K = g.K, nt = K / BK;
    unsigned voffA[2], voffB[2];
#pragma unroll
    for (int i = 0; i < 2; ++i) { int R, C; stage_rc(tid * 16 + i * 8192, R, C); voffA[i] = (unsigned)(R * K + C) * 2u; voffB[i] = voffA[i]; }
    const size_t kstep = (size_t)(BK * 2);
    const size_t hstep = (size_t)HALF * K * 2;
    const size_t tstep = 2 * hstep;
    const unsigned ldsw = (unsigned)wid * 1024u;
    const int aoff = lds_byte(wr * 64 + fr, fq * 8), boff = lds_byte(wc * 32 + fr, fq * 8);
#define PG8_SA(b, h) (((b) * 2 + (h)) * HTB)
#define PG8_SB(b, h) ((4 + (b) * 2 + (h)) * HTB)
#define PG8_STAGE(bufoff, gbase, voff) do { _Pragma("unroll") for (int _i = 0; _i < 2; ++_i) \
        __builtin_amdgcn_global_load_lds((const unsigned*)((const char*)(gbase) + (voff)[_i]), (PG8_LAS unsigned*)(lds + (bufoff) + ldsw + _i * 8192), 16, 0, 0); } while (0)
#define PG8_LDA(dst, b, h) do { _Pragma("unroll") for (int m = 0; m < 4; ++m) _Pragma("unroll") for (int k = 0; k < 2; ++k) dst[m][k] = *(const PG8_LAS bf16x8*)(lds + PG8_SA(b, h) + aoff + m * 2048 + k * 1024); } while (0)
#define PG8_LDB(dst, b, h) do { _Pragma("unroll") for (int n = 0; n < 2; ++n) _Pragma("unroll") for (int k = 0; k < 2; ++k) dst[n][k] = *(const PG8_LAS bf16x8*)(lds + PG8_SB(b, h) + boff + n * 2048 + k * 1024); } while (0)
#define PG8_MMA(ai, bj, At, Bt) do { __builtin_amdgcn_s_setprio(1); _Pragma("unroll") for (int m = 0; m < 4; ++m) _Pragma("unroll") for (int n = 0; n < 2; ++n) _Pragma("unroll") for (int k = 0; k < 2; ++k) \
        acc[ai][bj][m][n] = __builtin_amdgcn_mfma_f32_16x16x32_bf16(Bt[n][k], At[m][k], acc[ai][bj][m][n], 0, 0, 0); __builtin_amdgcn_s_setprio(0); } while (0)
#define PG8_WAIT_V(n) asm volatile("s_waitcnt vmcnt(" #n ")" ::: "memory")
#define PG8_WAIT_L(n) asm volatile("s_waitcnt lgkmcnt(" #n ")" ::: "memory")
#define PG8_BAR __builtin_amdgcn_s_barrier()
#define PG8_SCHED __builtin_amdgcn_sched_barrier(0)
    Unit cur, nxt; int ui = 0;
    if (!S.next(0, cur)) return;
    f32x4 acc[2][2][4][2];
#pragma unroll
    for (int a = 0; a < 2; ++a)
#pragma unroll
        for (int b = 0; b < 2; ++b)
#pragma unroll
            for (int m = 0; m < 4; ++m)
#pragma unroll
                for (int n = 0; n < 2; ++n) acc[a][b][m][n] = (f32x4){0.f, 0.f, 0.f, 0.f};
    bf16x8 At[4][2], B0[2][2], B1[2][2];
    const char* cA = (const char*)g.A + (size_t)cur.pm * tstep; const char* cB = (const char*)g.Bt + (size_t)cur.pn * tstep;
    PG8_STAGE(PG8_SB(0, 0), cB, voffB); PG8_STAGE(PG8_SA(0, 0), cA, voffA); PG8_STAGE(PG8_SB(0, 1), cB + hstep, voffB); PG8_STAGE(PG8_SA(0, 1), cA + hstep, voffA);
    if (wr == 1) PG8_BAR;
    PG8_WAIT_V(4); PG8_BAR;
    PG8_STAGE(PG8_SB(1, 0), cB + kstep, voffB); PG8_STAGE(PG8_SA(1, 0), cA + kstep, voffA); PG8_STAGE(PG8_SB(1, 1), cB + hstep + kstep, voffB);
    PG8_WAIT_V(6); PG8_BAR;
    for (;;) {
        const bool has_next = S.next(ui + 1, nxt);
        const char* nA = has_next ? (const char*)g.A + (size_t)nxt.pm * tstep : cA; const char* nB = has_next ? (const char*)g.Bt + (size_t)nxt.pn * tstep : cB;
        for (int t = 0; t < nt; t += 2) {
            const bool last = (t == nt - 2);
            const char* a1 = cA + (size_t)(t + 1) * kstep;
            const char* a2 = last ? nA : cA + (size_t)(t + 2) * kstep; const char* b2 = last ? nB : cB + (size_t)(t + 2) * kstep;
            const char* a3 = a2 + kstep; const char* b3 = b2 + kstep;
            PG8_LDB(B0, 0, 0); PG8_SCHED; PG8_LDA(At, 0, 0); PG8_STAGE(PG8_SA(1, 1), a1 + hstep, voffA);
            PG8_WAIT_L(8); PG8_BAR; PG8_WAIT_L(0); PG8_MMA(0, 0, At, B0); PG8_BAR; PG8_SCHED;
            PG8_LDB(B1, 0, 1); PG8_STAGE(PG8_SB(0, 0), b2, voffB);
            PG8_BAR; PG8_WAIT_L(0); PG8_MMA(0, 1, At, B1); PG8_BAR;
            PG8_LDA(At, 0, 1); PG8_STAGE(PG8_SA(0, 0), a2, voffA);
            PG8_BAR; PG8_WAIT_L(0); PG8_MMA(1, 0, At, B0); PG8_BAR; PG8_SCHED;
            PG8_STAGE(PG8_SB(0, 1), b2 + hstep, voffB);
            PG8_WAIT_V(6); PG8_BAR; PG8_MMA(1, 1, At, B1); PG8_BAR;
            PG8_LDB(B0, 1, 0); PG8_SCHED; PG8_LDA(At, 1, 0); PG8_STAGE(PG8_SA(0, 1), a2 + hstep, voffA);
            PG8_WAIT_L(8); PG8_BAR; PG8_WAIT_L(0); PG8_MMA(0, 0, At, B0); PG8_BAR; PG8_SCHED;
            PG8_LDB(B1, 1, 1); PG8_STAGE(PG8_SB(1, 0), b3, voffB);
            PG8_BAR; PG8_WAIT_L(0); PG8_MMA(0, 1, At, B1); PG8_BAR;
            PG8_LDA(At, 1, 1); PG8_STAGE(PG8_SA(1, 0), a3, voffA);
            PG8_BAR; PG8_WAIT_L(0); PG8_MMA(1, 0, At, B0); PG8_BAR; PG8_SCHED;
            PG8_STAGE(PG8_SB(1, 1), b3 + hstep, voffB);
            PG8_WAIT_V(6); PG8_BAR; PG8_MMA(1, 1, At, B1); PG8_BAR;
        }
        asm volatile("s_nop 7\n\ts_nop 7\n\ts_nop 7" ::: "memory");
        E(acc, cur, wr, wc, fr, fq);
        if (!has_next) break;
#pragma unroll
        for (int a = 0; a < 2; ++a)
#pragma unroll
            for (int b = 0; b < 2; ++b)
#pragma unroll
                for (int m = 0; m < 4; ++m)
#pragma unroll
                    for (int n = 0; n < 2; ++n) acc[a][b][m][n] = (f32x4){0.f, 0.f, 0.f, 0.f};
        cur = nxt; cA = nA; cB = nB; ++ui;
    }
    PG8_WAIT_V(0);
    if (wr == 0) PG8_BAR;
    PG8_BAR;
#undef PG8_SA
#undef PG8_SB
#undef PG8_STAGE
#undef PG8_LDA
#undef PG8_LDB
#undef PG8_MMA
#undef PG8_WAIT_V
#undef PG8_WAIT_L
#undef PG8_BAR
#undef PG8_SCHED
}
}
using pg8::Unit;

struct EpiProj {
    u16* projA; u16* projB; float* shift_p; float* shift_s;
    __device__ __forceinline__ void operator()(const f32x4 (&acc)[2][2][4][2], const Unit& u, int wr, int wc, int fr, int fq) const {
        const int row0 = u.pm * 256 + wr * 64 + fr;
        const bool isA = u.pn < 7;
        u16* base = isA ? projA : projB;
        const int colt = (isA ? u.pn : u.pn - 7) * 256 + wc * 32 + 4 * fq;
#pragma unroll
        for (int ai = 0; ai < 2; ++ai)
#pragma unroll
            for (int m = 0; m < 4; ++m) {
                const int row = row0 + ai * 128 + m * 16;
                u16* rowp = base + (size_t)row * 1792 + colt;
#pragma unroll
                for (int bj = 0; bj < 2; ++bj)
#pragma unroll
                    for (int n = 0; n < 2; ++n) st_bf4_asm(rowp + bj * 128 + n * 16, acc[ai][bj][m][n]);
                if (isA) {
                    float* dst = nullptr;
                    if (row < MP) { if ((row & 2047) == 2047) dst = shift_p + (size_t)(row >> 11) * 1792; }
                    else { const int r = row - MP; if ((r & 3) == 3) dst = shift_s + (size_t)(r >> 2) * 1792; }
                    if (dst) {
#pragma unroll
                        for (int bj = 0; bj < 2; ++bj)
#pragma unroll
                            for (int n = 0; n < 2; ++n) *(f32x4*)(dst + colt + bj * 128 + n * 16) = acc[ai][bj][m][n];
                    }
                }
            }
    }
};
struct EpiResid {
    const float* base; float* out;
    __device__ __forceinline__ void operator()(const f32x4 (&acc)[2][2][4][2], const Unit& u, int wr, int wc, int fr, int fq) const {
        const int row0 = u.pm * 256 + wr * 64 + fr, col0 = u.pn * 256 + wc * 32 + 4 * fq;
#pragma unroll
        for (int ai = 0; ai < 2; ++ai)
#pragma unroll
            for (int m = 0; m < 4; ++m) {
                const size_t off = (size_t)(row0 + ai * 128 + m * 16) * 1024 + col0;
#pragma unroll
                for (int bj = 0; bj < 2; ++bj)
#pragma unroll
                    for (int n = 0; n < 2; ++n) { const f32x4 b = *(const f32x4*)(base + off + bj * 128 + n * 16); *(f32x4*)(out + off + bj * 128 + n * 16) = b * ALPHA + acc[ai][bj][m][n]; }
            }
    }
};
struct EpiResidB {
    const u16* base; float* out;
    __device__ __forceinline__ void operator()(const f32x4 (&acc)[2][2][4][2], const Unit& u, int wr, int wc, int fr, int fq) const {
        const int row0 = u.pm * 256 + wr * 64 + fr, col0 = u.pn * 256 + wc * 32 + 4 * fq;
#pragma unroll
        for (int ai = 0; ai < 2; ++ai)
#pragma unroll
            for (int m = 0; m < 4; ++m) {
                const size_t off = (size_t)(row0 + ai * 128 + m * 16) * 1024 + col0;
#pragma unroll
                for (int bj = 0; bj < 2; ++bj)
#pragma unroll
                    for (int n = 0; n < 2; ++n) { const f32x4 b = ld_bf4(base + off + bj * 128 + n * 16); *(f32x4*)(out + off + bj * 128 + n * 16) = b * ALPHA + acc[ai][bj][m][n]; }
            }
    }
};
struct EpiUp {
    u16* gate; u16* val; float* conv_p; float* conv_s;
    __device__ __forceinline__ void operator()(const f32x4 (&acc)[2][2][4][2], const Unit& u, int wr, int wc, int fr, int fq) const {
        const int row0 = u.pm * 256 + wr * 64 + fr;
        const bool isG = u.pn < 11;
        u16* base = isG ? gate : val;
        const int colt = (isG ? u.pn : u.pn - 11) * 256 + wc * 32 + 4 * fq;
#pragma unroll
        for (int ai = 0; ai < 2; ++ai)
#pragma unroll
            for (int m = 0; m < 4; ++m) {
                const int row = row0 + ai * 128 + m * 16;
                u16* rowp = base + (size_t)row * DFF + colt;
#pragma unroll
                for (int bj = 0; bj < 2; ++bj)
#pragma unroll
                    for (int n = 0; n < 2; ++n) st_bf4_asm(rowp + bj * 128 + n * 16, acc[ai][bj][m][n]);
                if (isG) {
                    float* dst = nullptr;
                    if (row < MP) { const int t = row & 2047; if (t >= 2046) dst = conv_p + (size_t)((row >> 11) * 2 + (t - 2046)) * DFF; }
                    else { const int r = row - MP, t = r & 3; if (t >= 2) dst = conv_s + (size_t)((r >> 2) * 2 + (t - 2)) * DFF; }
                    if (dst) {
#pragma unroll
                        for (int bj = 0; bj < 2; ++bj)
#pragma unroll
                            for (int n = 0; n < 2; ++n) *(f32x4*)(dst + colt + bj * 128 + n * 16) = acc[ai][bj][m][n];
                    }
                }
            }
    }
};

template <bool BASE_BF16>
__device__ void small_gemm_resid(const u16* __restrict__ A, const u16* __restrict__ Bt, int K, const void* __restrict__ base, float* __restrict__ out, PG8_LAS unsigned char* lds) {
    const int t = opaque_tid(), wid = t >> 6, lane = t & 63, fr = lane & 15, fq = lane >> 4;
    const int kw = K >> 3, nks = kw >> 5;
    for (int tile = opaque_bid(); tile < 256; tile += gridDim.x) {
        const int r0 = MP + (tile >> 4) * 32, c0 = (tile & 15) * 64;
        f32x4 acc[2][4];
#pragma unroll
        for (int mi = 0; mi < 2; ++mi)
#pragma unroll
            for (int ni = 0; ni < 4; ++ni) acc[mi][ni] = (f32x4){0.f, 0.f, 0.f, 0.f};
#pragma unroll 2
        for (int ks = 0; ks < nks; ++ks) {
            const int k = wid * kw + ks * 32 + fq * 8;
            bf16x8 a[2], b[4];
#pragma unroll
            for (int mi = 0; mi < 2; ++mi) a[mi] = *(const bf16x8*)(A + (size_t)(r0 + mi * 16 + fr) * K + k);
#pragma unroll
            for (int ni = 0; ni < 4; ++ni) b[ni] = *(const bf16x8*)(Bt + (size_t)(c0 + ni * 16 + fr) * K + k);
#pragma unroll
            for (int mi = 0; mi < 2; ++mi)
#pragma unroll
                for (int ni = 0; ni < 4; ++ni) acc[mi][ni] = __builtin_amdgcn_mfma_f32_16x16x32_bf16(b[ni], a[mi], acc[mi][ni], 0, 0, 0);
        }
        PG8_LAS f32x4* red = (PG8_LAS f32x4*)lds;
#pragma unroll
        for (int mi = 0; mi < 2; ++mi)
#pragma unroll
            for (int ni = 0; ni < 4; ++ni) red[(wid * 8 + mi * 4 + ni) * 64 + lane] = acc[mi][ni];
        __syncthreads();
        {
            f32x4 sum = (f32x4){0.f, 0.f, 0.f, 0.f};
#pragma unroll
            for (int w = 0; w < 8; ++w) sum += red[(w * 8 + wid) * 64 + lane];
            const int mi = wid >> 2, ni = wid & 3;
            const size_t off = (size_t)(r0 + mi * 16 + fr) * 1024 + c0 + ni * 16 + 4 * fq;
            const f32x4 bs = BASE_BF16 ? ld_bf4((const u16*)base + off) : *(const f32x4*)((const float*)base + off);
            *(f32x4*)(out + off) = bs * ALPHA + sum;
        }
        __syncthreads();
    }
}

__device__ __forceinline__ void transpose_tile(const float* __restrict__ src, u16* __restrict__ dst, int K, int N, int nT, int item, float* tile) {
    const int t = opaque_tid();
    const int kt = item / nT, ntile = item - kt * nT, k0 = kt * 64, n0 = ntile * 64;
    { const int row = t >> 3, c8 = (t & 7) * 8;
      f32x4 a = (f32x4){0.f, 0.f, 0.f, 0.f}, b = a;
      if (n0 + c8 < N) { const float* sp = src + (size_t)(k0 + row) * N + n0 + c8; a = *(const f32x4*)sp; b = *(const f32x4*)(sp + 4); }
      float* tp = tile + row * 65 + c8;
      tp[0] = a[0]; tp[1] = a[1]; tp[2] = a[2]; tp[3] = a[3]; tp[4] = b[0]; tp[5] = b[1]; tp[6] = b[2]; tp[7] = b[3]; }
    __syncthreads();
    { const int n = t >> 3, k8 = (t & 7) * 8;
      float v[8];
#pragma unroll
      for (int j = 0; j < 8; ++j) v[j] = tile[(k8 + j) * 65 + n];
      u32x4 w; w.x = cvt_pk_bf16(v[0], v[1]); w.y = cvt_pk_bf16(v[2], v[3]); w.z = cvt_pk_bf16(v[4], v[5]); w.w = cvt_pk_bf16(v[6], v[7]);
      *(u32x4*)(dst + (size_t)(n0 + n) * K + k0 + k8) = w; }
    __syncthreads();
}
__device__ __forceinline__ void small_transpose(const float* __restrict__ src, u16* __restrict__ dst, int K, int N, int Kpad, size_t gt, size_t nth) {
    for (size_t i = gt; i < (size_t)N * Kpad; i += nth) { const int n = (int)(i / Kpad), k = (int)(i - (size_t)n * Kpad); const float v = k < K ? src[(size_t)k * N + n] : 0.f; dst[i] = (u16)(cvt_pk_bf16(v, 0.f) & 0xffffu); }
}
__device__ void convert_phase(KP p, int l, float* tile) {
    unsigned char* ws = p->ws;
    const int bid = opaque_bid();
    const size_t gt = (size_t)bid * 512 + opaque_tid(), nth = (size_t)gridDim.x * 512;
    constexpr int n1 = 16 * 56, n2 = 16 * 16, n3 = 16 * 88, n4 = 44 * 16;
    for (int it = bid; it < n1 + n2 + n3 + n4; it += gridDim.x) {
        if (it < n1) transpose_tile(p->in[I_WIN] + (size_t)l * 1024 * 3344, (u16*)(ws + W_WIN), 1024, 3344, 56, it, tile);
        else if (it < n1 + n2) transpose_tile(p->in[I_WOUT] + (size_t)l * 1024 * 1024, (u16*)(ws + W_WOUT), 1024, 1024, 16, it - n1, tile);
        else if (it < n1 + n2 + n3) transpose_tile(p->in[I_WUP] + (size_t)l * 1024 * 5632, (u16*)(ws + W_WUP), 1024, 5632, 88, it - n1 - n2, tile);
        else transpose_tile(p->in[I_WDOWN] + (size_t)l * 2816 * 1024, (u16*)(ws + W_WDOWN), 2816, 1024, 16, it - n1 - n2 - n3, tile);
    }
    small_transpose(p->in[I_WLU] + (size_t)l * 64 * 512, (u16*)(ws + W_WLT), 64, 512, 64, gt, nth);
    small_transpose(p->in[I_ALU] + (size_t)l * 64 * 512, (u16*)(ws + W_ALT), 64, 512, 64, gt, nth);
    small_transpose(p->in[I_GLU] + (size_t)l * 128 * 512, (u16*)(ws + W_GLT), 128, 512, 128, gt, nth);
    if (l > 0) {
        small_transpose(p->in[I_VD] + (size_t)(l - 1) * 512 * 32, (u16*)(ws + W_V1T), 512, 32, 512, gt, nth);
        small_transpose(p->in[I_VU] + (size_t)(l - 1) * 32 * 512, (u16*)(ws + W_V2T), 32, 512, 32, gt, nth);
    }
    small_transpose(p->in[I_FUP] + (size_t)l * 16 * 256, (u16*)(ws + W_FT), 16, 256, 32, gt, nth);
    if (l == 0) {
        u16* xb = (u16*)(ws + W_XB);
        for (size_t i = gt; i < (size_t)MTOK * 256; i += nth) {
            const size_t e = i * 4;
            const f32x4 v = e < (size_t)MP * 1024 ? *(const f32x4*)(p->in[I_XP] + e) : *(const f32x4*)(p->in[I_XS] + (e - (size_t)MP * 1024));
            st_bf4(xb + e, v);
        }
    }
}

template <bool WRITE_F32>
__device__ void ln_phase(float* Y, u16* xb, const float* __restrict__ g, const float* __restrict__ b) {
    const int tt_ = opaque_tid();
    const int lane = tt_ & 63, gw = opaque_bid() * 8 + (tt_ >> 6), nw = gridDim.x * 8;
    f32x4 gv[4], bv[4];
#pragma unroll
    for (int i = 0; i < 4; ++i) { gv[i] = *(const f32x4*)(g + i * 256 + lane * 4); bv[i] = *(const f32x4*)(b + i * 256 + lane * 4); }
    for (int row = gw; row < MTOK; row += nw) {
        float* yp = Y + (size_t)row * 1024 + lane * 4;
        f32x4 v[4]; float s = 0.f;
#pragma unroll
        for (int i = 0; i < 4; ++i) { v[i] = __builtin_nontemporal_load((const f32x4*)(yp + i * 256)); s += (v[i][0] + v[i][1]) + (v[i][2] + v[i][3]); }
#pragma unroll
        for (int o = 32; o >= 1; o >>= 1) s += __shfl_xor(s, o);
        const float mu = s * (1.0f / 1024.0f); float q = 0.f;
#pragma unroll
        for (int i = 0; i < 4; ++i) { const f32x4 d = v[i] - mu; q += (d[0] * d[0] + d[1] * d[1]) + (d[2] * d[2] + d[3] * d[3]); }
#pragma unroll
        for (int o = 32; o >= 1; o >>= 1) q += __shfl_xor(q, o);
        const float rstd = rsqrtf(q * (1.0f / 1024.0f) + LN_EPS);
#pragma unroll
        for (int i = 0; i < 4; ++i) { const f32x4 o = (v[i] - mu) * rstd * gv[i] + bv[i]; if (WRITE_F32) __builtin_nontemporal_store(o, (f32x4*)(yp + i * 256)); st_bf4(xb + (size_t)row * 1024 + i * 256 + lane * 4, o); }
    }
}

__device__ __forceinline__ void unpack8(const u32x4 w, float* f) { f[0] = bflo(w.x); f[1] = bfhi(w.x); f[2] = bflo(w.y); f[3] = bfhi(w.y); f[4] = bflo(w.z); f[5] = bfhi(w.z); f[6] = bflo(w.w); f[7] = bfhi(w.w); }
__device__ __forceinline__ float gelu_as(float v) {
    const float av = fabsf(v), t = __builtin_amdgcn_rcpf(av * 0.2316418882f + 1.0f);
    float q = t * 0.5307027145f + (-0.7265760135f); q = q * t + 0.7107068705f; q = q * t + (-0.142248368f); q = q * t + 0.127414796f; q = q * t;
    const float e = __builtin_amdgcn_exp2f((v * v) * (-0.72134752044f));
    const float m = v * (q * e);
    return v < 0.f ? m : v - m;
}
__device__ void convglu_phase(const u16* __restrict__ gate, u16* val, const float* __restrict__ past  , const float* __restrict__ cw, const float* __restrict__ cb) {
    const size_t gt = (size_t)opaque_bid() * 512 + opaque_tid(), nth = (size_t)gridDim.x * 512;
    for (size_t idx = gt; idx < (size_t)(MTOK / 4) * 352; idx += nth) {
        const int rg = (int)(idx / 352), c = (int)(idx - (size_t)rg * 352) * 8, row0 = rg * 4;
        bool first; const float* pst = nullptr;
        if (row0 < MP) first = (row0 & 2047) == 0; else { first = true; pst = past + (size_t)((row0 - MP) >> 2) * 2 * DFF; }
        float w0[8], w1[8], w2[8], bb[8], gm2[8], gm1[8];
#pragma unroll
        for (int j = 0; j < 8; ++j) { w0[j] = cw[c + j]; w1[j] = cw[DFF + c + j]; w2[j] = cw[2 * DFF + c + j]; bb[j] = cb[c + j]; }
        if (!first) { unpack8(*(const u32x4*)(gate + (size_t)(row0 - 2) * DFF + c), gm2); unpack8(*(const u32x4*)(gate + (size_t)(row0 - 1) * DFF + c), gm1); }
        else {
#pragma unroll
            for (int j = 0; j < 8; ++j) { gm2[j] = pst ? pst[c + j] : 0.f; gm1[j] = pst ? pst[DFF + c + j] : 0.f; } }
#pragma unroll
        for (int r = 0; r < 4; ++r) {
            float g0[8], vv[8], h[8];
            unpack8(*(const u32x4*)(gate + (size_t)(row0 + r) * DFF + c), g0);
            unpack8(__builtin_nontemporal_load((const u32x4*)(val + (size_t)(row0 + r) * DFF + c)), vv);
#pragma unroll
            for (int j = 0; j < 8; ++j) { const float a = bb[j] + gm2[j] * w0[j] + gm1[j] * w1[j] + g0[j] * w2[j]; h[j] = gelu_as(a) * vv[j]; gm2[j] = gm1[j]; gm1[j] = g0[j]; }
            u32x4 w; w.x = cvt_pk_bf16(h[0], h[1]); w.y = cvt_pk_bf16(h[2], h[3]); w.z = cvt_pk_bf16(h[4], h[5]); w.w = cvt_pk_bf16(h[6], h[7]);
            *(u32x4*)(val + (size_t)(row0 + r) * DFF + c) = w;
        }
    }
}

struct PrepCtx {
    const u16* projA; const u16* projB; const float* mu; const float* sshift  ;
};
__device__ __forceinline__ f32x4 xs4(const PrepCtx& c, int i, int col) {
    const f32x4 cur = ld_bf4(c.projA + (size_t)i * 1792 + col);
    f32x4 prev;
    bool first; int b = 0;
    if (i < MP) first = (i & 2047) == 0; else { const int r = i - MP; first = (r & 3) == 0; b = r >> 2; }
    if (!first) prev = ld_bf4(c.projA + (size_t)(i - 1) * 1792 + col);
    else if (i < MP) prev = (f32x4){0.f, 0.f, 0.f, 0.f};
    else prev = *(const f32x4*)(c.sshift + (size_t)b * 1792 + col);
    const f32x4 m = *(const f32x4*)(c.mu + col);
    return cur + (prev - cur) * m;
}
__device__ __forceinline__ bf16x8 ldg_frag(const u16* p) { return *(const bf16x8*)p; }

__device__ void prep_phase(KP p, int l, PG8_LAS unsigned char* lds) {
    unsigned char* ws = p->ws;
    PrepCtx c; c.projA = (const u16*)(ws + W_PROJA); c.projB = (const u16*)(ws + W_PROJB); c.mu = p->in[I_MU] + (size_t)l * 1792; c.sshift = p->in[I_SSHIFT] + (size_t)l * 128 * 1792;
    const u16* wlT = (const u16*)(ws + W_WLT); const u16* alT = (const u16*)(ws + W_ALT); const u16* glT = (const u16*)(ws + W_GLT);
    const u16* v1T = (const u16*)(ws + W_V1T); const u16* v2T = (const u16*)(ws + W_V2T); const u16* fT = (const u16*)(ws + W_FT);
    u32x4* A16 = (u32x4*)(ws + W_BUFB); float* D8 = (float*)(ws + W_D8); u16* vbuf = (u16*)(ws + W_VBUF); u16* gbuf = (u16*)(ws + W_GBUF);
    float* decb = (float*)(ws + W_DEC); float* rkb = (float*)(ws + W_RK); u16* vfirst = (u16*)(ws + W_VFIRST);
    const float* w0 = p->in[I_W0] + l * 512; const float* a0 = p->in[I_A0] + l * 512; const float* k_k = p->in[I_KK] + l * 512; const float* k_a = p->in[I_KA] + l * 512;
    const float* r_k = p->in[I_RK] + l * 512; const float* vb = l > 0 ? p->in[I_VB] + (l - 1) * 512 : nullptr; const float* fbias = p->in[I_FB] + l * 256;
    constexpr int S_TW = 144, S_AL = 144, S_SG = 272, S_XV = 1040, S_FL = 80, S_PP = 80;
    constexpr int O_TW = 0, O_AL = O_TW + 16 * S_TW, O_SG = O_AL + 16 * S_AL, O_XV = O_SG + 16 * S_SG, O_FL = O_XV + 16 * S_XV, O_PP = O_FL + 16 * S_FL;
    const int t = opaque_tid(), wid = t >> 6, lane = t & 63, fr = lane & 15, fq = lane >> 4, h = wid;
    for (int blk = opaque_bid(); blk < MTOK / 16; blk += gridDim.x) {
        const int i0 = blk * 16;
#pragma unroll 1
        for (int q = 0; q < 6; ++q) {
            const int op = t + 512 * q, r = op / 192, g4 = op - r * 192, col = 1024 + 4 * g4;
            f32x4 x = xs4(c, i0 + r, col);
            int off;
            if (col < 1536) off = O_XV + r * S_XV + (col - 1024) * 2;
            else if (col < 1600) { off = O_TW + r * S_TW + (col - 1536) * 2; x = (f32x4){tanhf_(x[0]), tanhf_(x[1]), tanhf_(x[2]), tanhf_(x[3])}; }
            else if (col < 1664) off = O_AL + r * S_AL + (col - 1600) * 2;
            else { off = O_SG + r * S_SG + (col - 1664) * 2; x = (f32x4){sigmoidf_(x[0]), sigmoidf_(x[1]), sigmoidf_(x[2]), sigmoidf_(x[3])}; }
            u32x2 w; w.x = cvt_pk_bf16(x[0], x[1]); w.y = cvt_pk_bf16(x[2], x[3]);
            *(PG8_LAS u32x2*)(lds + off) = w;
        }
        if (t < 128) { const int r = t >> 3, c4 = (t & 7) * 4; u32x2 w = (u32x2){0u, 0u}; if (c4 < 16) w = *(const u32x2*)(c.projB + (size_t)(i0 + r) * 1792 + 1536 + c4); *(PG8_LAS u32x2*)(lds + O_FL + r * S_FL + c4 * 2) = w; }
        __syncthreads();
        bf16x8 pfrag = (bf16x8){0, 0, 0, 0, 0, 0, 0, 0};
        if (l > 0) {
            f32x4 accP0 = (f32x4){0.f, 0.f, 0.f, 0.f}, accP1 = accP0;
#pragma unroll 4
            for (int ks = 0; ks < 16; ++ks) {
                const bf16x8 af = *(const PG8_LAS bf16x8*)(lds + O_XV + fr * S_XV + (ks * 32 + fq * 8) * 2);
                accP0 = __builtin_amdgcn_mfma_f32_16x16x32_bf16(ldg_frag(v1T + (size_t)fr * 512 + ks * 32 + fq * 8), af, accP0, 0, 0, 0);
                accP1 = __builtin_amdgcn_mfma_f32_16x16x32_bf16(ldg_frag(v1T + (size_t)(16 + fr) * 512 + ks * 32 + fq * 8), af, accP1, 0, 0, 0);
            }
            const u32 w0_ = cvt_pk_bf16(accP0[0], accP0[1]), w1_ = cvt_pk_bf16(accP0[2], accP0[3]), w2_ = cvt_pk_bf16(accP1[0], accP1[1]), w3_ = cvt_pk_bf16(accP1[2], accP1[3]);
            const u32x4 pw = (u32x4){w0_, w1_, w2_, w3_};
            pfrag = __builtin_bit_cast(bf16x8, pw);
        }
        const int i = i0 + fr;
        float ss = 0.f;
#pragma unroll
        for (int n = 0; n < 4; ++n) { const int cb_ = h * 64 + 16 * n + 4 * fq; const f32x4 xk = xs4(c, i, 512 + cb_) * *(const f32x4*)(k_k + cb_); ss += (xk[0] * xk[0] + xk[1] * xk[1]) + (xk[2] * xk[2] + xk[3] * xk[3]); }
        ss += __shfl_xor(ss, 16); ss += __shfl_xor(ss, 32);
        const float inorm = rsqrtf(fmaxf(ss, 1e-24f));
        float rks = 0.f;
#pragma unroll 2
        for (int n = 0; n < 4; ++n) {
            const int cn = h * 64 + 16 * n, cb_ = cn + 4 * fq;
            f32x4 aW = (f32x4){0.f, 0.f, 0.f, 0.f}, aA = aW, aG = aW, aV = aW;
#pragma unroll
            for (int ks = 0; ks < 2; ++ks) {
                aW = __builtin_amdgcn_mfma_f32_16x16x32_bf16(ldg_frag(wlT + (size_t)(cn + fr) * 64 + ks * 32 + fq * 8), *(const PG8_LAS bf16x8*)(lds + O_TW + fr * S_TW + (ks * 32 + fq * 8) * 2), aW, 0, 0, 0);
                aA = __builtin_amdgcn_mfma_f32_16x16x32_bf16(ldg_frag(alT + (size_t)(cn + fr) * 64 + ks * 32 + fq * 8), *(const PG8_LAS bf16x8*)(lds + O_AL + fr * S_AL + (ks * 32 + fq * 8) * 2), aA, 0, 0, 0);
            }
#pragma unroll
            for (int ks = 0; ks < 4; ++ks)
                aG = __builtin_amdgcn_mfma_f32_16x16x32_bf16(ldg_frag(glT + (size_t)(cn + fr) * 128 + ks * 32 + fq * 8), *(const PG8_LAS bf16x8*)(lds + O_SG + fr * S_SG + (ks * 32 + fq * 8) * 2), aG, 0, 0, 0);
            if (l > 0) {
                const u32x2 va = *(const u32x2*)(v2T + (size_t)(cn + fr) * 32 + 4 * fq), vc = *(const u32x2*)(v2T + (size_t)(cn + fr) * 32 + 16 + 4 * fq);
                const u32x4 vw = (u32x4){va.x, va.y, vc.x, vc.y};
                aV = __builtin_amdgcn_mfma_f32_16x16x32_bf16(__builtin_bit_cast(bf16x8, vw), pfrag, aV, 0, 0, 0);
            }
            const f32x4 xr = xs4(c, i, cb_), xk = xs4(c, i, 512 + cb_), xv = xs4(c, i, 1024 + cb_);
            const f32x4 w0v = *(const f32x4*)(w0 + cb_), a0v = *(const f32x4*)(a0 + cb_), kkv = *(const f32x4*)(k_k + cb_), kav = *(const f32x4*)(k_a + cb_), rkv = *(const f32x4*)(r_k + cb_);
            f32x4 vp = xv;
            if (l == 0) st_bf4(vfirst + (size_t)i * 512 + cb_, xv);
            else { const f32x4 vf = ld_bf4(vfirst + (size_t)i * 512 + cb_); const f32x4 vbv = *(const f32x4*)(vb + cb_);
#pragma unroll
                for (int j = 0; j < 4; ++j) vp[j] = xv[j] + (vf[j] - xv[j]) * sigmoidf_(vbv[j] + aV[j]);
            }
            f32x4 dd, kt, kn, bb;
#pragma unroll
            for (int j = 0; j < 4; ++j) {
                const float wv = -softplusf_(-(w0v[j] + aW[j])) - 0.5f;
                dd[j] = __expf(-__expf(wv));
                const float a = sigmoidf_(a0v[j] + aA[j]);
                kn[j] = xk[j] * kkv[j] * inorm;
                kt[j] = xk[j] * (1.0f + (a - 1.0f) * kav[j]);
                bb[j] = kn[j] * a;
                rks += xr[j] * kt[j] * rkv[j];
            }
            const int p0 = 8 * n + 2 * fq;
            u32x4 rec0, rec1;
            rec0.x = cvt_pk_bf16(xr[0], xr[1]); rec0.y = cvt_pk_bf16(kt[0], kt[1]); rec0.z = cvt_pk_bf16(kn[0], kn[1]); rec0.w = cvt_pk_bf16(bb[0], bb[1]);
            rec1.x = cvt_pk_bf16(xr[2], xr[3]); rec1.y = cvt_pk_bf16(kt[2], kt[3]); rec1.z = cvt_pk_bf16(kn[2], kn[3]); rec1.w = cvt_pk_bf16(bb[2], bb[3]);
            u32x4* ap = A16 + ((size_t)i * 8 + h) * 32 + p0;
            ap[0] = rec0; ap[1] = rec1;
            *(f32x4*)(D8 + (size_t)i * 512 + cb_) = dd;
            st_bf4(vbuf + (size_t)i * 512 + cb_, vp);
            st_bf4(gbuf + (size_t)i * 512 + cb_, aG);
        }
        rks += __shfl_xor(rks, 16); rks += __shfl_xor(rks, 32);
        if (fq == 0) rkb[(size_t)i * 8 + h] = rks;
#pragma unroll
        for (int n2 = 0; n2 < 2; ++n2) {
            const int cn = 32 * h + 16 * n2;
            f32x4 aF = (f32x4){0.f, 0.f, 0.f, 0.f};
            aF = __builtin_amdgcn_mfma_f32_16x16x32_bf16(ldg_frag(fT + (size_t)(cn + fr) * 32 + fq * 8), *(const PG8_LAS bf16x8*)(lds + O_FL + fr * S_FL + (fq * 8) * 2), aF, 0, 0, 0);
            const f32x4 fb = *(const f32x4*)(fbias + cn + 4 * fq);
            f32x4 dc;
#pragma unroll
            for (int j = 0; j < 4; ++j) { const float z = aF[j] + fb[j]; dc[j] = __expf(-softplusf_(-z) * (1.0f / 16.0f)); }
            *(f32x4*)(decb + (size_t)i * 256 + cn + 4 * fq) = dc;
        }
        __syncthreads();
    }
}

struct ScanItem {
    int tok0, T, L;
    int h, q;
    int hg, cgp;
    const float* s0_rwkv; float* so_rwkv;
    const float* s0_gla; float* so_gla;
};
template <int LSEG>
__device__ __forceinline__ void scan_item(KP p, const ScanItem& it, PG8_LAS unsigned char* lds) {
    unsigned char* ws = p->ws;
    const u32x4* A16 = (const u32x4*)(ws + W_BUFB); const float* D8 = (const float*)(ws + W_D8); const u16* vbuf = (const u16*)(ws + W_VBUF);
    const u16* projB = (const u16*)(ws + W_PROJB); const float* decb = (const float*)(ws + W_DEC);
    u16* obufA = (u16*)(ws + W_OBUFA); u16* obufB = (u16*)(ws + W_OBUFB);
    const int t = opaque_tid(), wid = t >> 6, lane = t & 63, kq = lane & 15, rsel = lane >> 4;
    constexpr int BUF = 69632, OR = 0, OKT = 8192, OKN = 16384, OB = 24576, OD = 32768, OVR = 40960, OQ = 43008, OK = 51200, ODC = 59392, OVG = 67584;
    const int nchunk = it.T / TC;
    u32x4 sa0, sa1; f32x4 sd, sdec; u32x2 svr = (u32x2){0u, 0u}, sq, sk;
#define SC_GLOAD(ch_) do { const int tk_ = it.tok0 + (ch_) * TC; \
        { const int i0 = t, i1 = t + 512; sa0 = A16[((size_t)(tk_ + (i0 >> 5)) * 8 + it.h) * 32 + (i0 & 31)]; sa1 = A16[((size_t)(tk_ + (i1 >> 5)) * 8 + it.h) * 32 + (i1 & 31)]; } \
        { const int st = t >> 4, c4 = (t & 15) * 4; sd = *(const f32x4*)(D8 + (size_t)(tk_ + st) * 512 + it.h * 64 + c4); \
          sq = *(const u32x2*)(projB + (size_t)(tk_ + st) * 1792 + it.hg * 64 + c4); sk = *(const u32x2*)(projB + (size_t)(tk_ + st) * 1792 + 256 + it.hg * 64 + c4); \
          sdec = *(const f32x4*)(decb + (size_t)(tk_ + st) * 256 + it.hg * 64 + c4); } \
        if (t < 128) { const int st = t >> 2, c4 = (t & 3) * 4; svr = *(const u32x2*)(vbuf + (size_t)(tk_ + st) * 512 + it.h * 64 + it.q * 16 + c4); } \
        else if (t < 256) { const int tt = t - 128, st = tt >> 2, c4 = (tt & 3) * 4; svr = *(const u32x2*)(projB + (size_t)(tk_ + st) * 1792 + 512 + it.hg * 128 + it.cgp * 16 + c4); } } while (0)
#define SC_LSTORE(buf_) do { PG8_LAS unsigned char* b_ = lds + (buf_) * BUF; \
        { const int i0 = t, i1 = t + 512; \
          { const int st = i0 >> 5, pp = i0 & 31; const int o = (st * 64 + 2 * pp) * 4; \
            *(PG8_LAS f32x2*)(b_ + OR + o) = (f32x2){bflo(sa0.x), bfhi(sa0.x)}; *(PG8_LAS f32x2*)(b_ + OKT + o) = (f32x2){bflo(sa0.y), bfhi(sa0.y)}; \
            *(PG8_LAS f32x2*)(b_ + OKN + o) = (f32x2){bflo(sa0.z), bfhi(sa0.z)}; *(PG8_LAS f32x2*)(b_ + OB + o) = (f32x2){bflo(sa0.w), bfhi(sa0.w)}; } \
          { const int st = i1 >> 5, pp = i1 & 31; const int o = (st * 64 + 2 * pp) * 4; \
            *(PG8_LAS f32x2*)(b_ + OR + o) = (f32x2){bflo(sa1.x), bfhi(sa1.x)}; *(PG8_LAS f32x2*)(b_ + OKT + o) = (f32x2){bflo(sa1.y), bfhi(sa1.y)}; \
            *(PG8_LAS f32x2*)(b_ + OKN + o) = (f32x2){bflo(sa1.z), bfhi(sa1.z)}; *(PG8_LAS f32x2*)(b_ + OB + o) = (f32x2){bflo(sa1.w), bfhi(sa1.w)}; } } \
        { const int st = t >> 4, c4 = (t & 15) * 4; const int o = (st * 64 + c4) * 4; \
          *(PG8_LAS f32x4*)(b_ + OD + o) = sd; *(PG8_LAS f32x4*)(b_ + ODC + o) = sdec; \
          *(PG8_LAS f32x4*)(b_ + OQ + o) = (f32x4){bflo(sq.x), bfhi(sq.x), bflo(sq.y), bfhi(sq.y)} * 0.125f; \
          *(PG8_LAS f32x4*)(b_ + OK + o) = (f32x4){bflo(sk.x), bfhi(sk.x), bflo(sk.y), bfhi(sk.y)}; } \
        if (t < 128) { const int st = t >> 2, c4 = (t & 3) * 4; *(PG8_LAS f32x4*)(b_ + OVR + (st * 16 + c4) * 4) = (f32x4){bflo(svr.x), bfhi(svr.x), bflo(svr.y), bfhi(svr.y)}; } \
        else if (t < 256) { const int tt = t - 128, st = tt >> 2, c4 = (tt & 3) * 4; *(PG8_LAS f32x4*)(b_ + OVG + (st * 16 + c4) * 4) = (f32x4){bflo(svr.x), bfhi(svr.x), bflo(svr.y), bfhi(svr.y)}; } } while (0)
    const bool isR = wid < 4;
    const int w4 = wid & 3;
    const int row = it.q * 16 + 4 * w4 + rsel;
    const int col = it.cgp * 16 + 4 * w4 + rsel;
    f32x4 S = (f32x4){0.f, 0.f, 0.f, 0.f}, Sn = S;
#define SC_LOAD_STATE(dst_, seg_) do { const int sg_ = (seg_); \
        if (isR) { if (!it.s0_rwkv) dst_ = (f32x4){0.f, 0.f, 0.f, 0.f}; else dst_ = *(const f32x4*)(it.s0_rwkv + (size_t)sg_ * 8 * 4096 + row * 64 + 4 * kq); } \
        else if (!it.s0_gla) dst_ = (f32x4){0.f, 0.f, 0.f, 0.f}; \
        else { const float* sp_ = it.s0_gla + (size_t)sg_ * 4 * 8192 + (size_t)(4 * kq) * 128 + col; dst_ = (f32x4){sp_[0], sp_[128], sp_[256], sp_[384]}; } } while (0)
#define SC_STORE_STATE(seg_, s_) do { const int sg_ = (seg_); \
        if (isR) { *(f32x4*)(it.so_rwkv + (size_t)sg_ * 8 * 4096 + row * 64 + 4 * kq) = s_; } \
        else { float* sp_ = it.so_gla + (size_t)sg_ * 4 * 8192 + (size_t)(4 * kq) * 128 + col; sp_[0] = s_[0]; sp_[128] = s_[1]; sp_[256] = s_[2]; sp_[384] = s_[3]; } } while (0)
    SC_GLOAD(0);
    SC_LOAD_STATE(Sn, 0);
    SC_LSTORE(0);
    __syncthreads();
    u16* oAp = obufA + (size_t)it.tok0 * 512 + it.h * 64 + row;
    u16* oBp = obufB + (size_t)it.tok0 * 512 + it.hg * 128 + col;
    const int vsl = (4 * w4 + rsel) * 4;
#define SC_STEP_R(s_, ov_) do { const int o = ((s_) * 64 + 4 * kq) * 4; \
        const f32x4 r4 = *(const PG8_LAS f32x4*)(b + OR + o), k4 = *(const PG8_LAS f32x4*)(b + OKT + o), n4 = *(const PG8_LAS f32x4*)(b + OKN + o), b4 = *(const PG8_LAS f32x4*)(b + OB + o), d4 = *(const PG8_LAS f32x4*)(b + OD + o); \
        const float v = *(const PG8_LAS float*)(b + OVR + (s_) * 64 + vsl); \
        float dot = dot4pk(S, n4); \
        dot = red16(dot); \
        S = S * d4 - b4 * dot + k4 * v; \
        float o_ = dot4pk(S, r4); \
        (ov_) = red16(o_); } while (0)
#define SC_STEP_G(s_, ov_) do { const int o = ((s_) * 64 + 4 * kq) * 4; \
        const f32x4 q4 = *(const PG8_LAS f32x4*)(b + OQ + o), k4 = *(const PG8_LAS f32x4*)(b + OK + o), d4 = *(const PG8_LAS f32x4*)(b + ODC + o); \
        const float v = *(const PG8_LAS float*)(b + OVG + (s_) * 64 + vsl); \
        S = S * d4 + k4 * v; \
        float o_ = dot4pk(S, q4); \
        (ov_) = red16(o_); } while (0)
#define SC_BLOCK(STEP_, s0_, NB_, optr_) do { float ov[NB_]; \
        _Pragma("unroll") for (int j_ = 0; j_ < (NB_); ++j_) STEP_((s0_) + j_, ov[j_]); \
        float outv = ov[0]; \
        _Pragma("unroll") for (int j_ = 1; j_ < (NB_); ++j_) outv = (kq == j_) ? ov[j_] : outv; \
        if (kq < (NB_)) (optr_)[(size_t)((s0_) + kq) * 512] = (u16)(cvt_pk_bf16(outv, 0.f) & 0xffffu); } while (0)
    for (int ch = 0; ch < nchunk; ++ch) {
        const bool more = ch + 1 < nchunk;
        if (more) SC_GLOAD(ch + 1);
        PG8_LAS unsigned char* b = lds + (ch & 1) * BUF;
        if (LSEG >= TC) {
            if (ch == 0) S = Sn;
            if (isR) {
                {
                    struct InR { f32x4 r4, k4, n4, b4, d4; float v; };
                    InR in_[TC]; float ov[8]; float op = 0.f;
#define LD_R(s_) do { const int o = ((s_) * 64 + 4 * kq) * 4; in_[s_].r4 = *(const PG8_LAS f32x4*)(b + OR + o); in_[s_].k4 = *(const PG8_LAS f32x4*)(b + OKT + o); in_[s_].n4 = *(const PG8_LAS f32x4*)(b + OKN + o); \
                        in_[s_].b4 = *(const PG8_LAS f32x4*)(b + OB + o); in_[s_].d4 = *(const PG8_LAS f32x4*)(b + OD + o); in_[s_].v = *(const PG8_LAS float*)(b + OVR + (s_) * 64 + vsl); } while (0)
#pragma unroll
                    for (int j = 0; j < SC_PD; ++j) LD_R(j);
#pragma unroll
                    for (int s = 0; s < TC; ++s) {
                        float dot = dot4pk(S, in_[s].n4);
                        dot += dppf<0xB1>(dot); op += dppf<0xB1>(op);
                        dot += dppf<0x4E>(dot); op += dppf<0x4E>(op);
                        dot += dppf<0x141>(dot); op += dppf<0x141>(op);
                        dot += dppf<0x140>(dot); op += dppf<0x140>(op);
                        if (s > 0) ov[(s - 1) & 7] = op;
                        if (s > 0 && (s & 7) == 0) { float outv = ov[0];
#pragma unroll
                            for (int j = 1; j < 8; ++j) outv = (kq == j) ? ov[j] : outv;
                            if (kq < 8) oAp[(size_t)(s - 8 + kq) * 512] = (u16)(cvt_pk_bf16(outv, 0.f) & 0xffffu); }
                        S = S * in_[s].d4 - in_[s].b4 * dot + in_[s].k4 * in_[s].v;
                        op = dot4pk(S, in_[s].r4);
                        if (s + SC_PD < TC) LD_R(s + SC_PD);
                        __builtin_amdgcn_sched_barrier(0);
                    }
                    ov[7] = red16(op);
                    { float outv = ov[0];
#pragma unroll
                      for (int j = 1; j < 8; ++j) outv = (kq == j) ? ov[j] : outv;
                      if (kq < 8) oAp[(size_t)(TC - 8 + kq) * 512] = (u16)(cvt_pk_bf16(outv, 0.f) & 0xffffu); }
#undef LD_R
                }
            } else {
                {
                    struct InG { f32x4 q4, k4, d4; float v; };
                    InG in_[TC]; float ov[8];
#define LD_G(s_) do { const int o = ((s_) * 64 + 4 * kq) * 4; in_[s_].q4 = *(const PG8_LAS f32x4*)(b + OQ + o); in_[s_].k4 = *(const PG8_LAS f32x4*)(b + OK + o); in_[s_].d4 = *(const PG8_LAS f32x4*)(b + ODC + o); \
                        in_[s_].v = *(const PG8_LAS float*)(b + OVG + (s_) * 64 + vsl); } while (0)
#pragma unroll
                    for (int j = 0; j < SC_PD; ++j) LD_G(j);
#pragma unroll
                    for (int s = 0; s < TC; ++s) {
                        S = S * in_[s].d4 + in_[s].k4 * in_[s].v;
                        float o_ = dot4pk(S, in_[s].q4);
                        ov[s & 7] = red16(o_);
                        if (s + SC_PD < TC) LD_G(s + SC_PD);
                        __builtin_amdgcn_sched_barrier(0);
                        if ((s & 7) == 7) { float outv = ov[0];
#pragma unroll
                            for (int j = 1; j < 8; ++j) outv = (kq == j) ? ov[j] : outv;
                            if (kq < 8) oBp[(size_t)((s & ~7) + kq) * 512] = (u16)(cvt_pk_bf16(outv, 0.f) & 0xffffu); }
                    }
#undef LD_G
                }
            }
            if (!more) SC_STORE_STATE(0, S);
        } else {
#pragma unroll 1
            for (int sgi = 0; sgi < TC / LSEG; ++sgi) {
                const int seg = ch * (TC / LSEG) + sgi;
                S = Sn;
                if ((seg + 1) * LSEG < it.T) SC_LOAD_STATE(Sn, seg + 1);
                if (isR) {
                    SC_BLOCK(SC_STEP_R, sgi * LSEG, (LSEG < TC ? LSEG : 1), oAp);
                } else {
                    SC_BLOCK(SC_STEP_G, sgi * LSEG, (LSEG < TC ? LSEG : 1), oBp);
                }
                SC_STORE_STATE(seg, S);
            }
        }
        oAp += (size_t)TC * 512; oBp += (size_t)TC * 512;
        if (more) SC_LSTORE((ch + 1) & 1);
        __syncthreads();
    }
#undef SC_BLOCK
#undef SC_STEP_R
#undef SC_STEP_G
}
__device__ void scan_phase(KP p, int l, PG8_LAS unsigned char* lds) {
    float* out = p->out;
    const int bid = opaque_bid();
    for (int i = bid; i < 256; i += gridDim.x) {
        ScanItem it; const int s = i >> 5;
        it.tok0 = s * 2048; it.T = 2048; it.L = 2048; it.h = (i >> 2) & 7; it.q = i & 3; it.hg = (i >> 3) & 3; it.cgp = i & 7;
        it.s0_rwkv = nullptr; it.so_rwkv = out + O_RWKV_P + ((size_t)(l * 8 + s) * 8 + it.h) * 4096;
        it.s0_gla = nullptr; it.so_gla = out + O_GLA_P + ((size_t)(l * 8 + s) * 4 + it.hg) * 8192;
        scan_item<2048>(p, it, lds);
    }
    for (int i = bid; i < 256; i += gridDim.x) {
        ScanItem it; const int bg = i >> 5, b0 = bg * 16;
        it.tok0 = MP + bg * 64; it.T = 64; it.L = 4; it.h = (i >> 2) & 7; it.q = i & 3; it.hg = (i >> 3) & 3; it.cgp = i & 7;
        it.s0_rwkv = p->in[I_SRWKV] + ((size_t)(l * 128 + b0) * 8 + it.h) * 4096; it.so_rwkv = out + O_RWKV_S + ((size_t)(l * 128 + b0) * 8 + it.h) * 4096;
        it.s0_gla = p->in[I_SGLA] + ((size_t)(l * 128 + b0) * 4 + it.hg) * 8192; it.so_gla = out + O_GLA_S + ((size_t)(l * 128 + b0) * 4 + it.hg) * 8192;
        scan_item<4>(p, it, lds);
    }
}

__device__ void post_phase(KP p, int l) {
    unsigned char* ws = p->ws;
    const u16* obufA = (const u16*)(ws + W_OBUFA); const u16* obufB = (const u16*)(ws + W_OBUFB); const u16* vbuf = (const u16*)(ws + W_VBUF); const u16* gbuf = (const u16*)(ws + W_GBUF);
    const float* rkb = (const float*)(ws + W_RK); const u16* projB = (const u16*)(ws + W_PROJB); u16* oab = (u16*)(ws + W_XB);
    const float* lg = p->in[I_LNXG] + l * 512; const float* lb = p->in[I_LNXB] + l * 512; const float* ng = p->in[I_NG] + l * 128;
    const int tt_ = opaque_tid();
    const int lane = tt_ & 63, gw = opaque_bid() * 8 + (tt_ >> 6), nw = gridDim.x * 8;
    const int c = lane * 8;
    float lgv[8], lbv[8], ngv[8];
#pragma unroll
    for (int j = 0; j < 8; ++j) { lgv[j] = lg[c + j]; lbv[j] = lb[c + j]; ngv[j] = ng[(c & 127) + j]; }
    for (int i = gw; i < MTOK; i += nw) {
        {
            const f32x4 o0 = ld_bf4(obufA + (size_t)i * 512 + c), o1 = ld_bf4(obufA + (size_t)i * 512 + c + 4);
            const f32x4 v0 = ld_bf4(vbuf + (size_t)i * 512 + c), v1 = ld_bf4(vbuf + (size_t)i * 512 + c + 4);
            const f32x4 g0 = ld_bf4(gbuf + (size_t)i * 512 + c), g1 = ld_bf4(gbuf + (size_t)i * 512 + c + 4);
            const float rk = rkb[(size_t)i * 8 + (lane >> 3)];
            float s = (o0[0] + o0[1]) + (o0[2] + o0[3]) + (o1[0] + o1[1]) + (o1[2] + o1[3]);
            s += __shfl_xor(s, 1); s += __shfl_xor(s, 2); s += __shfl_xor(s, 4);
            const float m = s * (1.0f / 64.0f);
            const f32x4 d0 = o0 - m, d1 = o1 - m;
            float q = (d0[0] * d0[0] + d0[1] * d0[1]) + (d0[2] * d0[2] + d0[3] * d0[3]) + (d1[0] * d1[0] + d1[1] * d1[1]) + (d1[2] * d1[2] + d1[3] * d1[3]);
            q += __shfl_xor(q, 1); q += __shfl_xor(q, 2); q += __shfl_xor(q, 4);
            const float rs = rsqrtf(q * (1.0f / 64.0f) + GN_EPS_A);
            f32x4 y0, y1;
#pragma unroll
            for (int j = 0; j < 4; ++j) { y0[j] = (d0[j] * rs * lgv[j] + lbv[j] + rk * v0[j]) * g0[j]; y1[j] = (d1[j] * rs * lgv[4 + j] + lbv[4 + j] + rk * v1[j]) * g1[j]; }
            u32x4 w; w.x = cvt_pk_bf16(y0[0], y0[1]); w.y = cvt_pk_bf16(y0[2], y0[3]); w.z = cvt_pk_bf16(y1[0], y1[1]); w.w = cvt_pk_bf16(y1[2], y1[3]);
            *(u32x4*)(oab + (size_t)i * 1024 + c) = w;
        }
        {
            const f32x4 o0 = ld_bf4(obufB + (size_t)i * 512 + c), o1 = ld_bf4(obufB + (size_t)i * 512 + c + 4);
            const f32x4 g0 = ld_bf4(projB + (size_t)i * 1792 + 1024 + c), g1 = ld_bf4(projB + (size_t)i * 1792 + 1024 + c + 4);
            float q = (o0[0] * o0[0] + o0[1] * o0[1]) + (o0[2] * o0[2] + o0[3] * o0[3]) + (o1[0] * o1[0] + o1[1] * o1[1]) + (o1[2] * o1[2] + o1[3] * o1[3]);
            q += __shfl_xor(q, 1); q += __shfl_xor(q, 2); q += __shfl_xor(q, 4); q += __shfl_xor(q, 8);
            const float rs = rsqrtf(q * (1.0f / 128.0f) + RMS_EPS);
            f32x4 y0, y1;
#pragma unroll
            for (int j = 0; j < 4; ++j) { y0[j] = o0[j] * rs * ngv[j] * (g0[j] * sigmoidf_(g0[j])); y1[j] = o1[j] * rs * ngv[4 + j] * (g1[j] * sigmoidf_(g1[j])); }
            u32x4 w; w.x = cvt_pk_bf16(y0[0], y0[1]); w.y = cvt_pk_bf16(y0[2], y0[3]); w.z = cvt_pk_bf16(y1[0], y1[1]); w.w = cvt_pk_bf16(y1[2], y1[3]);
            *(u32x4*)(oab + (size_t)i * 1024 + 512 + c) = w;
        }
    }
}

#define XB_TMO      128
#define XB_XCNT(j)  (256  + 64 * (j))
#define XB_XSUB(j)  (1280 + 64 * (j))
#define XB_XGEN(j)  (2304 + 64 * (j))
#define XB_TOP      3328
#define XB_TOPGEN   3392
#define XCD_BAR_WORDS 3456
#define XB_SPIN_CAP (1u << 18)
__device__ __forceinline__ unsigned xb_ld(unsigned* p)              { return __hip_atomic_load(p, __ATOMIC_RELAXED, __HIP_MEMORY_SCOPE_AGENT); }
__device__ __forceinline__ unsigned xb_add(unsigned* p, unsigned v) { return __hip_atomic_fetch_add(p, v, __ATOMIC_RELAXED, __HIP_MEMORY_SCOPE_AGENT); }
__device__ __forceinline__ unsigned xb_xcc_id() { return (unsigned)__builtin_amdgcn_s_getreg((3 << 11) | 20) & 0xFu; }
#define XB_SPIN(cond, bar) do { unsigned _sp = 0; while (cond) { __builtin_amdgcn_s_sleep(1); \
    if ((++_sp & 255u) == 0u) { if (xb_ld(&(bar)[XB_TMO])) break; if (_sp > XB_SPIN_CAP) { atomicAdd(&(bar)[XB_TMO], 1u); break; } } } } while (0)
__device__ __forceinline__ void xcd_barrier_complete(unsigned* bar, unsigned x, unsigned& nloc, unsigned& nx) {
    const unsigned G = gridDim.x * gridDim.y * gridDim.z;
    unsigned sum, cnt, mine, sp = 0u;
    for (;;) {
        sum = 0u; cnt = 0u; mine = 0u;
#pragma unroll
        for (unsigned j = 0; j < 16; ++j) { const unsigned c = xb_ld(&bar[XB_XCNT(j)]); sum += c; cnt += (c > 0u) ? 1u : 0u; mine = (j == x) ? c : mine; }
        if (sum == G) break;
        __builtin_amdgcn_s_sleep(1);
        if ((++sp & 255u) == 0u) { if (xb_ld(&bar[XB_TMO])) break; if (sp > XB_SPIN_CAP) { atomicAdd(&bar[XB_TMO], 1u); break; } }
    }
    nloc = mine > 0u ? mine : 1u; nx = cnt > 0u ? cnt : 1u;
}
__device__ __forceinline__ void xcd_barrier(unsigned* bar, volatile PG8_LAS unsigned* st) {
    asm volatile("s_waitcnt vmcnt(0)" ::: "memory");
    __syncthreads();
    if (threadIdx.x == 0) {
        const unsigned x = xb_xcc_id();
        __builtin_amdgcn_s_waitcnt(0);
        unsigned nloc = st[0], nx = st[1];
        if (nloc == 0u) { xcd_barrier_complete(bar, x, nloc, nx); st[0] = nloc; st[1] = nx; }
        const unsigned old = xb_add(&bar[XB_XSUB(x)], 1u);
        const unsigned gen = old / nloc;
        if (old + 1u == (gen + 1u) * nloc) {
            __builtin_amdgcn_fence(__ATOMIC_RELEASE, "agent");
            asm volatile("s_waitcnt vmcnt(0)" ::: "memory");
            const unsigned og = xb_add(&bar[XB_TOP], 1u);
            const unsigned tg = og / nx;
            if (og + 1u == (tg + 1u) * nx) xb_add(&bar[XB_TOPGEN], 1u);
            else XB_SPIN(xb_ld(&bar[XB_TOPGEN]) == tg, bar);
            __builtin_amdgcn_fence(__ATOMIC_ACQUIRE, "agent");
            xb_add(&bar[XB_XGEN(x)], 1u);
            asm volatile("s_waitcnt vmcnt(0)" ::: "memory");
        } else {
            XB_SPIN(xb_ld(&bar[XB_XGEN(x)]) == gen, bar);
            __builtin_amdgcn_fence(__ATOMIC_ACQUIRE, "agent");
            asm volatile("s_waitcnt vmcnt(0)" ::: "memory");
        }
    }
    __syncthreads();
}
__device__ __forceinline__ void gsync(cg::grid_group& grid) {
    asm volatile("s_waitcnt vmcnt(0)" ::: "memory");
    grid.sync();
    if (threadIdx.x < 64) { __builtin_amdgcn_fence(__ATOMIC_ACQUIRE, "agent"); asm volatile("s_waitcnt vmcnt(0)" ::: "memory"); }
    __syncthreads();
}

__global__ void __launch_bounds__(512, 2) mega(Params p_unused) {
    KP p = kparams();
    extern __shared__ __attribute__((aligned(16))) unsigned char smem[];
    PG8_LAS unsigned char* lds = (PG8_LAS unsigned char*)smem;
    cg::grid_group grid = cg::this_grid();
    unsigned char* ws = p->ws;
    float* bufA = p->out + O_Y; float* bufB = (float*)(ws + W_BUFB); u16* xb = (u16*)(ws + W_XB);
    pg8::StaticOrder S;
    volatile PG8_LAS unsigned* xst = (volatile PG8_LAS unsigned*)(lds + 139264);
    if (threadIdx.x == 0) { xst[0] = 0u; xst[1] = 0u; }
    gsync(grid);
    unsigned* xbar = (unsigned*)(kparams()->ws + W_BAR);
    if (threadIdx.x == 0) (void)xb_add(&xbar[XB_XCNT(xb_xcc_id())], 1u);
#define PHASE_END() xcd_barrier((unsigned*)(kparams()->ws + W_BAR), xst)
    convert_phase(kparams(), 0, (float*)smem);
    PHASE_END();
    for (int l = 0; l < NL; ++l) {
        {
            pg8::Gemm g; g.A = xb; g.Bt = (const u16*)(ws + W_WIN); g.M = MTOK; g.N = INP; g.K = 1024;
            EpiProj E; E.projA = (u16*)(ws + W_PROJA); E.projB = (u16*)(ws + W_PROJB); E.shift_p = p->out + O_SHIFT_P + (size_t)l * 8 * 1792; E.shift_s = p->out + O_SHIFT_S + (size_t)l * 128 * 1792;
            S.init(MTOK, INP, gridDim.x, opaque_bid()); pg8::gemm_phase(lds, g, S, E);
        }
        PHASE_END();
        prep_phase(kparams(), l, lds);
        PHASE_END();
        scan_phase(kparams(), l, lds);
        PHASE_END();
        post_phase(kparams(), l);
        PHASE_END();
        {
            pg8::Gemm g; g.A = xb; g.Bt = (const u16*)(ws + W_WOUT); g.M = MTOK; g.N = 1024; g.K = 1024;
            EpiResid E; E.base = (l == 0) ? p->in[I_XP] : bufA; E.out = bufB;
            g.M = MP; S.init(MP, 1024, gridDim.x, opaque_bid()); pg8::gemm_phase(lds, g, S, E);
            small_gemm_resid<false>(g.A, g.Bt, 1024, (l == 0) ? (const void*)(p->in[I_XS] - (size_t)MP * 1024) : (const void*)bufA, E.out, lds);
        }
        PHASE_END();
        ln_phase<false>(bufB, xb, p->in[I_LN1G] + l * 1024, p->in[I_LN1B] + l * 1024);
        PHASE_END();
        {
            pg8::Gemm g; g.A = xb; g.Bt = (const u16*)(ws + W_WUP); g.M = MTOK; g.N = 5632; g.K = 1024;
            EpiUp E; E.gate = (u16*)(ws + W_GATE); E.val = (u16*)(ws + W_VAL); E.conv_p = p->out + O_CONV_P + (size_t)l * 8 * 2 * DFF; E.conv_s = p->out + O_CONV_S + (size_t)l * 128 * 2 * DFF;
            S.init(MTOK, 5632, gridDim.x, opaque_bid()); pg8::gemm_phase(lds, g, S, E);
        }
        PHASE_END();
        convglu_phase((const u16*)(ws + W_GATE), (u16*)(ws + W_VAL), p->in[I_SCONV] + (size_t)l * 128 * 2 * DFF, p->in[I_CW] + (size_t)l * 3 * DFF, p->in[I_CB] + (size_t)l * DFF);
        PHASE_END();
        {
            pg8::Gemm g; g.A = (const u16*)(ws + W_VAL); g.Bt = (const u16*)(ws + W_WDOWN); g.M = MTOK; g.N = 1024; g.K = DFF;
            EpiResidB E; E.base = xb; E.out = bufA;
            g.M = MP; S.init(MP, 1024, gridDim.x, opaque_bid()); pg8::gemm_phase(lds, g, S, E);
            small_gemm_resid<true>(g.A, g.Bt, DFF, E.base, E.out, lds);
        }
        PHASE_END();
        ln_phase<true>(bufA, xb, p->in[I_LN2G] + l * 1024, p->in[I_LN2B] + l * 1024);
        if (l + 1 < NL) convert_phase(kparams(), l + 1, (float*)smem);
        PHASE_END();
    }
}

extern "C" void kernel_launch(void* const* d_in, const int* in_sizes, int n_in, void* d_out, int out_size, void* d_ws, size_t ws_size, hipStream_t stream) {
    static int grid_blocks = 0;
    if (!grid_blocks) {
        int dev = 0, cus = 0, per_cu = 0;
        (void)hipGetDevice(&dev);
        (void)hipDeviceGetAttribute(&cus, hipDeviceAttributeMultiprocessorCount, dev);
        (void)hipFuncSetAttribute((const void*)mega, hipFuncAttributeMaxDynamicSharedMemorySize, LDS_BYTES);
        (void)hipOccupancyMaxActiveBlocksPerMultiprocessor(&per_cu, (const void*)mega, 512, LDS_BYTES);
        grid_blocks = cus;
        if (n_in != 33 || (size_t)out_size != O_END || ws_size < W_TOTAL) { fprintf(stderr, "kernel_launch: unexpected sizes n_in %d out %d ws %zu (need %zu)\n", n_in, out_size, ws_size, (size_t)W_TOTAL); grid_blocks = -1; }
    }
    if (grid_blocks < 0) return;
    (void)hipMemsetAsync((unsigned char*)d_ws + W_BAR, 0, XCD_BAR_WORDS * sizeof(unsigned), stream);
    Params p{};
    for (int i = 0; i < 33; ++i) p.in[i] = (const float*)d_in[i];
    p.out = (float*)d_out; p.ws = (unsigned char*)d_ws;
    void* args[] = {&p};
    hipError_t e = hipLaunchCooperativeKernel((const void*)mega, dim3(grid_blocks), dim3(512), args, LDS_BYTES, stream);
    if (e != hipSuccess) fprintf(stderr, "cooperative launch failed: %s (grid %d)\n", hipGetErrorString(e), grid_blocks);
}
```

```cpp
#include <hip/hip_runtime.h>
#include <hip/hip_cooperative_groups.h>
#include <cstdio>
namespace cg = cooperative_groups;

#define PG8_LAS __attribute__((address_space(3)))
typedef unsigned short u16;
typedef unsigned int u32;
typedef unsigned short bf16_t;
typedef short bf16x8 __attribute__((ext_vector_type(8)));
typedef float f32x4 __attribute__((ext_vector_type(4)));
typedef float f32x2 __attribute__((ext_vector_type(2)));
typedef unsigned u32x4 __attribute__((ext_vector_type(4)));
typedef unsigned u32x2 __attribute__((ext_vector_type(2)));

constexpr int MTOK = 16896, MP = 16384, DM = 1024, NL = 4;
constexpr int SHIFT_W = 1792, INP = 3584, DFF = 2816;
constexpr float ALPHA = 1.6817928305074290f;
constexpr float GN_EPS_A = 64e-5f, RMS_EPS = 1e-5f, LN_EPS = 1e-5f;
constexpr int LDS_BYTES = 139264 + 16;
constexpr int TC = 32;
#define SC_PD 3

enum { I_XP = 0, I_XS, I_SRWKV, I_SSHIFT, I_SGLA, I_SCONV, I_WIN, I_MU, I_W0, I_WLU, I_A0, I_ALU, I_GLU, I_KK, I_KA, I_RK, I_LNXG, I_LNXB,
       I_VB, I_VD, I_VU, I_FUP, I_FB, I_NG, I_WOUT, I_LN1G, I_LN1B, I_WUP, I_CW, I_CB, I_WDOWN, I_LN2G, I_LN2B };

constexpr size_t O_Y = 0;
constexpr size_t O_RWKV_P = (size_t)MTOK * DM;
constexpr size_t O_RWKV_S = O_RWKV_P + (size_t)4 * 8 * 8 * 4096;
constexpr size_t O_SHIFT_P = O_RWKV_S + (size_t)4 * 128 * 8 * 4096;
constexpr size_t O_SHIFT_S = O_SHIFT_P + (size_t)4 * 8 * 1792;
constexpr size_t O_GLA_P = O_SHIFT_S + (size_t)4 * 128 * 1792;
constexpr size_t O_GLA_S = O_GLA_P + (size_t)4 * 8 * 4 * 8192;
constexpr size_t O_CONV_P = O_GLA_S + (size_t)4 * 128 * 4 * 8192;
constexpr size_t O_CONV_S = O_CONV_P + (size_t)4 * 8 * 2 * 2816;
constexpr size_t O_END = O_CONV_S + (size_t)4 * 128 * 2 * 2816;

constexpr size_t W_WIN = 0;
constexpr size_t W_WOUT = W_WIN + (size_t)INP * 1024 * 2;
constexpr size_t W_WUP = W_WOUT + (size_t)1024 * 1024 * 2;
constexpr size_t W_WDOWN = W_WUP + (size_t)5632 * 1024 * 2;
constexpr size_t W_WLT = W_WDOWN + (size_t)1024 * 2816 * 2;
constexpr size_t W_ALT = W_WLT + 512 * 64 * 2;
constexpr size_t W_GLT = W_ALT + 512 * 64 * 2;
constexpr size_t W_V1T = W_GLT + 512 * 128 * 2;
constexpr size_t W_V2T = W_V1T + 32 * 512 * 2;
constexpr size_t W_FT = W_V2T + 512 * 32 * 2;
constexpr size_t W_XB = W_FT + 256 * 32 * 2;
constexpr size_t W_VFIRST = W_XB + (size_t)MTOK * 1024 * 2;
constexpr size_t W_BUFB = W_VFIRST + (size_t)MTOK * 512 * 2;
constexpr size_t W_R = W_BUFB + (size_t)MTOK * 1024 * 4;
constexpr size_t W_PROJA = W_R;
constexpr size_t W_PROJB = W_PROJA + (size_t)MTOK * 1792 * 2;
constexpr size_t W_D8 = W_PROJB + (size_t)MTOK * 1792 * 2;
constexpr size_t W_VBUF = W_D8 + (size_t)MTOK * 512 * 4;
constexpr size_t W_GBUF = W_VBUF + (size_t)MTOK * 512 * 2;
constexpr size_t W_DEC = W_GBUF + (size_t)MTOK * 512 * 2;
constexpr size_t W_RK = W_DEC + (size_t)MTOK * 256 * 4;
constexpr size_t W_END1 = W_RK + (size_t)MTOK * 8 * 4;
constexpr size_t W_GATE = W_R;
constexpr size_t W_VAL = W_GATE + (size_t)MTOK * 2816 * 2;
constexpr size_t W_END2 = W_VAL + (size_t)MTOK * 2816 * 2;
constexpr size_t W_END = W_END1 > W_END2 ? W_END1 : W_END2;
constexpr size_t W_BAR = (W_END + 255) / 256 * 256;
constexpr size_t W_TOTAL = W_BAR + 16384;
constexpr size_t W_OBUFA = W_PROJA;
constexpr size_t W_OBUFB = W_PROJA + (size_t)MTOK * 512 * 2;

struct Params { const float* in[33]; float* out; unsigned char* ws; };
typedef const Params __attribute__((address_space(4)))* KP;
__device__ __forceinline__ KP kparams() { unsigned long long k = (unsigned long long)__builtin_amdgcn_kernarg_segment_ptr(); asm volatile("" : "+s"(k)); return (KP)k; }

typedef __bf16 bf16v2 __attribute__((ext_vector_type(2)));
__device__ __forceinline__ unsigned cvt_pk_bf16(float lo, float hi) { const f32x2 v = (f32x2){lo, hi}; const bf16v2 b = __builtin_convertvector(v, bf16v2); return __builtin_bit_cast(unsigned, b); }
__device__ __forceinline__ float bflo(u32 w) { return __uint_as_float(w << 16); }
__device__ __forceinline__ float bfhi(u32 w) { return __uint_as_float(w & 0xffff0000u); }
__device__ __forceinline__ f32x4 ld_bf4(const u16* p) { const u32x2 w = *(const u32x2*)p; return (f32x4){bflo(w.x), bfhi(w.x), bflo(w.y), bfhi(w.y)}; }
__device__ __forceinline__ unsigned cvt_pk_bf16_asm(float lo, float hi) { unsigned r; asm volatile("v_cvt_pk_bf16_f32 %0, %1, %2" : "=v"(r) : "v"(lo), "v"(hi)); return r; }
__device__ __forceinline__ void st_bf4_asm(u16* p, f32x4 v) { u32x2 w; w.x = cvt_pk_bf16_asm(v[0], v[1]); w.y = cvt_pk_bf16_asm(v[2], v[3]); *(u32x2*)p = w; }
__device__ __forceinline__ void st_bf4(u16* p, f32x4 v) { u32x2 w; w.x = cvt_pk_bf16(v[0], v[1]); w.y = cvt_pk_bf16(v[2], v[3]); *(u32x2*)p = w; }
__device__ __forceinline__ float sigmoidf_(float x) { return __builtin_amdgcn_rcpf(1.0f + __expf(-x)); }
__device__ __forceinline__ float tanhf_(float x) { return 1.0f - 2.0f * __builtin_amdgcn_rcpf(1.0f + __expf(2.0f * x)); }
__device__ __forceinline__ float softplusf_(float x) { return fmaxf(x, 0.f) + __logf(1.0f + __expf(-fabsf(x))); }
template <int CTRL> __device__ __forceinline__ float dppf(float x) { return __builtin_bit_cast(float, __builtin_amdgcn_update_dpp(0, __builtin_bit_cast(int, x), CTRL, 0xF, 0xF, true)); }
__device__ __forceinline__ float dot4pk(f32x4 a, f32x4 b) { f32x2 p = (f32x2){a[0], a[1]} * (f32x2){b[0], b[1]}; p = (f32x2){a[2], a[3]} * (f32x2){b[2], b[3]} + p; return p.x + p.y; }
__device__ __forceinline__ float red16(float x) { x += dppf<0xB1>(x); x += dppf<0x4E>(x); x += dppf<0x141>(x); x += dppf<0x140>(x); return x; }

__device__ __forceinline__ int opaque_tid() { int t = threadIdx.x; asm volatile("" : "+v"(t)); return t; }
__device__ __forceinline__ int opaque_bid() { int b = blockIdx.x; asm volatile("" : "+s"(b)); return b; }

namespace pg8 {
constexpr int BM = 256, BK = 64, HALF = 128, HTB = HALF * BK * 2, STAGE_BYTES = 8 * HTB, NXCD = 8, WGM = 8;
__host__ __device__ __forceinline__ int lds_byte(int r, int c) { const int st = (r >> 4) * 2 + (c >> 5), rr = r & 15, cc = c & 31, ob = rr * 64 + cc * 2; return st * 1024 + (ob ^ (((ob >> 9) & 1) << 5)); }
__host__ __device__ __forceinline__ void stage_rc(int b, int& R, int& C) { const int st = b / 1024, sb = b % 1024, swz = sb ^ (((sb >> 9) & 1) << 5); R = (st >> 1) * 16 + swz / 64; C = (st & 1) * 32 + (swz % 64) / 2; }
struct Unit { int pm, pn; };
struct Gemm { const bf16_t* A; const bf16_t* Bt; int M, N, K; };
struct StaticOrder {
    int nM, nN, nwg, G, c;
    __host__ __device__ void init(int M, int N, int G_, int c_) { nM = M / BM; nN = N / BM; nwg = nM * nN; G = G_; c = c_; }
    __host__ __device__ bool next(int i, Unit& u) const {
        const long L = (long)i * G + c; if (L >= nwg) return false;
        int wgid = (int)L; { const int q = nwg / NXCD, r = nwg % NXCD, xcd = wgid % NXCD, off = wgid / NXCD; wgid = (xcd < r ? xcd * (q + 1) : r * (q + 1) + (xcd - r) * q) + off; }
        const int nig = WGM * nN, gid = wgid / nig, fm = gid * WGM, gsz = (nM - fm) < WGM ? (nM - fm) : WGM;
        u.pm = fm + ((wgid % nig) % gsz); u.pn = (wgid % nig) / gsz; return true;
    }
};

template <class Epi>
__device__ __forceinline__ void gemm_phase(PG8_LAS unsigned char* lds, const Gemm g, const StaticOrder& S, const Epi& E) {
    const int tid = opaque_tid(), wid = __builtin_amdgcn_readfirstlane(tid >> 6), lane = tid & 63, wr = wid >> 2, wc = wid & 3, fr = lane & 15, fq = lane >> 4;
    const int K = g.K, nt = K / BK;
    unsigned voffA[2], voffB[2];
#pragma unroll
    for (int i = 0; i < 2; ++i) { int R, C; stage_rc(tid * 16 + i * 8192, R, C); voffA[i] = (unsigned)(R * K + C) * 2u; voffB[i] = voffA[i]; }
    const size_t kstep = (size_t)(BK * 2);
    const size_t hstep = (size_t)HALF * K * 2;
    const size_t tstep = 2 * hstep;
    const unsigned ldsw = (unsigned)wid * 1024u;
    const int aoff = lds_byte(wr * 64 + fr, fq * 8), boff = lds_byte(wc * 32 + fr, fq * 8);
#define PG8_SA(b, h) (((b) * 2 + (h)) * HTB)
#define PG8_SB(b, h) ((4 + (b) * 2 + (h)) * HTB)
#define PG8_STAGE(bufoff, gbase, voff) do { _Pragma("unroll") for (int _i = 0; _i < 2; ++_i) \
        __builtin_amdgcn_global_load_lds((const unsigned*)((const char*)(gbase) + (voff)[_i]), (PG8_LAS unsigned*)(lds + (bufoff) + ldsw + _i * 8192), 16, 0, 0); } while (0)
#define PG8_LDA(dst, b, h) do { _Pragma("unroll") for (int m = 0; m < 4; ++m) _Pragma("unroll") for (int k = 0; k < 2; ++k) dst[m][k] = *(const PG8_LAS bf16x8*)(lds + PG8_SA(b, h) + aoff + m * 2048 + k * 1024); } while (0)
#define PG8_LDB(dst, b, h) do { _Pragma("unroll") for (int n = 0; n < 2; ++n) _Pragma("unroll") for (int k = 0; k < 2; ++k) dst[n][k] = *(const PG8_LAS bf16x8*)(lds + PG8_SB(b, h) + boff + n * 2048 + k * 1024); } while (0)
#define PG8_MMA(ai, bj, At, Bt) do { __builtin_amdgcn_s_setprio(1); _Pragma("unroll") for (int m = 0; m < 4; ++m) _Pragma("unroll") for (int n = 0; n < 2; ++n) _Pragma("unroll") for (int k = 0; k < 2; ++k) \
        acc[ai][bj][m][n] = __builtin_amdgcn_mfma_f32_16x16x32_bf16(Bt[n][k], At[m][k], acc[ai][bj][m][n], 0, 0, 0); __builtin_amdgcn_s_setprio(0); } while (0)
#define PG8_WAIT_V(n) asm volatile("s_waitcnt vmcnt(" #n ")" ::: "memory")
#define PG8_WAIT_L(n) asm volatile("s_waitcnt lgkmcnt(" #n ")" ::: "memory")
#define PG8_BAR __builtin_amdgcn_s_barrier()
#define PG8_SCHED __builtin_amdgcn_sched_barrier(0)
    Unit cur, nxt; int ui = 0;
    if (!S.next(0, cur)) return;
    f32x4 acc[2][2][4][2];
#pragma unroll
    for (int a = 0; a < 2; ++a)
#pragma unroll
        for (int b = 0; b < 2; ++b)
#pragma unroll
            for (int m = 0; m < 4; ++m)
#pragma unroll
                for (int n = 0; n < 2; ++n) acc[a][b][m][n] = (f32x4){0.f, 0.f, 0.f, 0.f};
    bf16x8 At[4][2], B0[2][2], B1[2][2];
    const char* cA = (const char*)g.A + (size_t)cur.pm * tstep; const char* cB = (const char*)g.Bt + (size_t)cur.pn * tstep;
    PG8_STAGE(PG8_SB(0, 0), cB, voffB); PG8_STAGE(PG8_SA(0, 0), cA, voffA); PG8_STAGE(PG8_SB(0, 1), cB + hstep, voffB); PG8_STAGE(PG8_SA(0, 1), cA + hstep, voffA);
    if (wr == 1) PG8_BAR;
    PG8_WAIT_V(4); PG8_BAR;
    PG8_STAGE(PG8_SB(1, 0), cB + kstep, voffB); PG8_STAGE(PG8_SA(1, 0), cA + kstep, voffA); PG8_STAGE(PG8_SB(1, 1), cB + hstep + kstep, voffB);
    PG8_WAIT_V(6); PG8_BAR;
    for (;;) {
        const bool has_next = S.next(ui + 1, nxt);
        const char* nA = has_next ? (const char*)g.A + (size_t)nxt.pm * tstep : cA; const char* nB = has_next ? (const char*)g.Bt + (size_t)nxt.pn * tstep : cB;
        for (int t = 0; t < nt; t += 2) {
            const bool last = (t == nt - 2);
            const char* a1 = cA + (size_t)(t + 1) * kstep;
            const char* a2 = last ? nA : cA + (size_t)(t + 2) * kstep; const char* b2 = last ? nB : cB + (size_t)(t + 2) * kstep;
            const char* a3 = a2 + kstep; const char* b3 = b2 + kstep;
            PG8_LDB(B0, 0, 0); PG8_SCHED; PG8_LDA(At, 0, 0); PG8_STAGE(PG8_SA(1, 1), a1 + hstep, voffA);
            PG8_WAIT_L(8); PG8_BAR; PG8_WAIT_L(0); PG8_MMA(0, 0, At, B0); PG8_BAR; PG8_SCHED;
            PG8_LDB(B1, 0, 1); PG8_STAGE(PG8_SB(0, 0), b2, voffB);
            PG8_BAR; PG8_WAIT_L(0); PG8_MMA(0, 1, At, B1); PG8_BAR;
            PG8_LDA(At, 0, 1); PG8_STAGE(PG8_SA(0, 0), a2, voffA);
            PG8_BAR; PG8_WAIT_L(0); PG8_MMA(1, 0, At, B0); PG8_BAR; PG8_SCHED;
            PG8_STAGE(PG8_SB(0, 1), b2 + hstep, voffB);
            PG8_WAIT_V(6); PG8_BAR; PG8_MMA(1, 1, At, B1); PG8_BAR;
            PG8_LDB(B0, 1, 0); PG8_SCHED; PG8_LDA(At, 1, 0); PG8_STAGE(PG8_SA(0, 1), a2 + hstep, voffA);
            PG8_WAIT_L(8); PG8_BAR; PG8_WAIT_L(0); PG8_MMA(0, 0, At, B0); PG8_BAR; PG8_SCHED;
            PG8_LDB(B1, 1, 1); PG8_STAGE(PG8_SB(1, 0), b3, voffB);
            PG8_BAR; PG8_WAIT_L(0); PG8_MMA(0, 1, At, B1); PG8_BAR;
            PG8_LDA(At, 1, 1); PG8_STAGE(PG8_SA(1, 0), a3, voffA);
            PG8_BAR; PG8_WAIT_L(0); PG8_MMA(1, 0, At, B0); PG8_BAR; PG8_SCHED;
            PG8_STAGE(PG8_SB(1, 1), b3 + hstep, voffB);
            PG8_WAIT_V(6); PG8_BAR; PG8_MMA(1, 1, At, B1); PG8_BAR;
        }
        asm volatile("s_nop 7\n\ts_nop 7\n\ts_nop 7" ::: "memory");
        E(acc, cur, wr, wc, fr, fq);
        if (!has_next) break;
#pragma unroll
        for (int a = 0; a < 2; ++a)
#pragma unroll
            for (int b = 0; b < 2; ++b)
#pragma unroll
                for (int m = 0; m < 4; ++m)
#pragma unroll
                    for (int n = 0; n < 2; ++n) acc[a][b][m][n] = (f32x4){0.f, 0.f, 0.f, 0.f};
        cur = nxt; cA = nA; cB = nB; ++ui;
    }
    PG8_WAIT_V(0);
    if (wr == 0) PG8_BAR;
    PG8_BAR;
#undef PG8_SA
#undef PG8_SB
#undef PG8_STAGE
#undef PG8_LDA
#undef PG8_LDB
#undef PG8_MMA
#undef PG8_WAIT_V
#undef PG8_WAIT_L
#undef PG8_BAR
#undef PG8_SCHED
}
}
using pg8::Unit;

struct EpiProj {
    u16* projA; u16* projB; float* shift_p; float* shift_s;
    __device__ __forceinline__ void operator()(const f32x4 (&acc)[2][2][4][2], const Unit& u, int wr, int wc, int fr, int fq) const {
        const int row0 = u.pm * 256 + wr * 64 + fr;
        const bool isA = u.pn < 7;
        u16* base = isA ? projA : projB;
        const int colt = (isA ? u.pn : u.pn - 7) * 256 + wc * 32 + 4 * fq;
#pragma unroll
        for (int ai = 0; ai < 2; ++ai)
#pragma unroll
            for (int m = 0; m < 4; ++m) {
                const int row = row0 + ai * 128 + m * 16;
                u16* rowp = base + (size_t)row * 1792 + colt;
#pragma unroll
                for (int bj = 0; bj < 2; ++bj)
#pragma unroll
                    for (int n = 0; n < 2; ++n) st_bf4_asm(rowp + bj * 128 + n * 16, acc[ai][bj][m][n]);
                if (isA) {
                    float* dst = nullptr;
                    if (row < MP) { if ((row & 2047) == 2047) dst = shift_p + (size_t)(row >> 11) * 1792; }
                    else { const int r = row - MP; if ((r & 3) == 3) dst = shift_s + (size_t)(r >> 2) * 1792; }
                    if (dst) {
#pragma unroll
                        for (int bj = 0; bj < 2; ++bj)
#pragma unroll
                            for (int n = 0; n < 2; ++n) *(f32x4*)(dst + colt + bj * 128 + n * 16) = acc[ai][bj][m][n];
                    }
                }
            }
    }
};
struct EpiResid {
    const float* base; float* out;
    __device__ __forceinline__ void operator()(const f32x4 (&acc)[2][2][4][2], const Unit& u, int wr, int wc, int fr, int fq) const {
        const int row0 = u.pm * 256 + wr * 64 + fr, col0 = u.pn * 256 + wc * 32 + 4 * fq;
#pragma unroll
        for (int ai = 0; ai < 2; ++ai)
#pragma unroll
            for (int m = 0; m < 4; ++m) {
                const size_t off = (size_t)(row0 + ai * 128 + m * 16) * 1024 + col0;
#pragma unroll
                for (int bj = 0; bj < 2; ++bj)
#pragma unroll
                    for (int n = 0; n < 2; ++n) { const f32x4 b = *(const f32x4*)(base + off + bj * 128 + n * 16); *(f32x4*)(out + off + bj * 128 + n * 16) = b * ALPHA + acc[ai][bj][m][n]; }
            }
    }
};
struct EpiResidB {
    const u16* base; float* out;
    __device__ __forceinline__ void operator()(const f32x4 (&acc)[2][2][4][2], const Unit& u, int wr, int wc, int fr, int fq) const {
        const int row0 = u.pm * 256 + wr * 64 + fr, col0 = u.pn * 256 + wc * 32 + 4 * fq;
#pragma unroll
        for (int ai = 0; ai < 2; ++ai)
#pragma unroll
            for (int m = 0; m < 4; ++m) {
                const size_t off = (size_t)(row0 + ai * 128 + m * 16) * 1024 + col0;
#pragma unroll
                for (int bj = 0; bj < 2; ++bj)
#pragma unroll
                    for (int n = 0; n < 2; ++n) { const f32x4 b = ld_bf4(base + off + bj * 128 + n * 16); *(f32x4*)(out + off + bj * 128 + n * 16) = b * ALPHA + acc[ai][bj][m][n]; }
            }
    }
};
struct EpiUp {
    u16* gate; u16* val; float* conv_p; float* conv_s;
    __device__ __forceinline__ void operator()(const f32x4 (&acc)[2][2][4][2], const Unit& u, int wr, int wc, int fr, int fq) const {
        const int row0 = u.pm * 256 + wr * 64 + fr;
        const bool isG = u.pn < 11;
        u16* base = isG ? gate : val;
        const int colt = (isG ? u.pn : u.pn - 11) * 256 + wc * 32 + 4 * fq;
#pragma unroll
        for (int ai = 0; ai < 2; ++ai)
#pragma unroll
            for (int m = 0; m < 4; ++m) {
                const int row = row0 + ai * 128 + m * 16;
                u16* rowp = base + (size_t)row * DFF + colt;
#pragma unroll
                for (int bj = 0; bj < 2; ++bj)
#pragma unroll
                    for (int n = 0; n < 2; ++n) st_bf4_asm(rowp + bj * 128 + n * 16, acc[ai][bj][m][n]);
                if (isG) {
                    float* dst = nullptr;
                    if (row < MP) { const int t = row & 2047; if (t >= 2046) dst = conv_p + (size_t)((row >> 11) * 2 + (t - 2046)) * DFF; }
                    else { const int r = row - MP, t = r & 3; if (t >= 2) dst = conv_s + (size_t)((r >> 2) * 2 + (t - 2)) * DFF; }
                    if (dst) {
#pragma unroll
                        for (int bj = 0; bj < 2; ++bj)
#pragma unroll
                            for (int n = 0; n < 2; ++n) *(f32x4*)(dst + colt + bj * 128 + n * 16) = acc[ai][bj][m][n];
                    }
                }
            }
    }
};

template <bool BASE_BF16>
__device__ void small_gemm_resid(const u16* __restrict__ A, const u16* __restrict__ Bt, int K, const void* __restrict__ base, float* __restrict__ out, PG8_LAS unsigned char* lds) {
    const int t = opaque_tid(), wid = t >> 6, lane = t & 63, fr = lane & 15, fq = lane >> 4;
    const int kw = K >> 3, nks = kw >> 5;
    for (int tile = opaque_bid(); tile < 256; tile += gridDim.x) {
        const int r0 = MP + (tile >> 4) * 32, c0 = (tile & 15) * 64;
        f32x4 acc[2][4];
#pragma unroll
        for (int mi = 0; mi < 2; ++mi)
#pragma unroll
            for (int ni = 0; ni < 4; ++ni) acc[mi][ni] = (f32x4){0.f, 0.f, 0.f, 0.f};
#pragma unroll 2
        for (int ks = 0; ks < nks; ++ks) {
            const int k = wid * kw + ks * 32 + fq * 8;
            bf16x8 a[2], b[4];
#pragma unroll
            for (int mi = 0; mi < 2; ++mi) a[mi] = *(const bf16x8*)(A + (size_t)(r0 + mi * 16 + fr) * K + k);
#pragma unroll
            for (int ni = 0; ni < 4; ++ni) b[ni] = *(const bf16x8*)(Bt + (size_t)(c0 + ni * 16 + fr) * K + k);
#pragma unroll
            for (int mi = 0; mi < 2; ++mi)
#pragma unroll
                for (int ni = 0; ni < 4; ++ni) acc[mi][ni] = __builtin_amdgcn_mfma_f32_16x16x32_bf16(b[ni], a[mi], acc[mi][ni], 0, 0, 0);
        }
        PG8_LAS f32x4* red = (PG8_LAS f32x4*)lds;
#pragma unroll
        for (int mi = 0; mi < 2; ++mi)
#pragma unroll
            for (int ni = 0; ni < 4; ++ni) red[(wid * 8 + mi * 4 + ni) * 64 + lane] = acc[mi][ni];
        __syncthreads();
        {
            f32x4 sum = (f32x4){0.f, 0.f, 0.f, 0.f};
#pragma unroll
            for (int w = 0; w < 8; ++w) sum += red[(w * 8 + wid) * 64 + lane];
            const int mi = wid >> 2, ni = wid & 3;
            const size_t off = (size_t)(r0 + mi * 16 + fr) * 1024 + c0 + ni * 16 + 4 * fq;
            const f32x4 bs = BASE_BF16 ? ld_bf4((const u16*)base + off) : *(const f32x4*)((const float*)base + off);
            *(f32x4*)(out + off) = bs * ALPHA + sum;
        }
        __syncthreads();
    }
}

__device__ __forceinline__ void transpose_tile(const float* __restrict__ src, u16* __restrict__ dst, int K, int N, int nT, int item, float* tile) {
    const int t = opaque_tid();
    const int kt = item / nT, ntile = item - kt * nT, k0 = kt * 64, n0 = ntile * 64;
    { const int row = t >> 3, c8 = (t & 7) * 8;
      f32x4 a = (f32x4){0.f, 0.f, 0.f, 0.f}, b = a;
      if (n0 + c8 < N) { const float* sp = src + (size_t)(k0 + row) * N + n0 + c8; a = *(const f32x4*)sp; b = *(const f32x4*)(sp + 4); }
      float* tp = tile + row * 65 + c8;
      tp[0] = a[0]; tp[1] = a[1]; tp[2] = a[2]; tp[3] = a[3]; tp[4] = b[0]; tp[5] = b[1]; tp[6] = b[2]; tp[7] = b[3]; }
    __syncthreads();
    { const int n = t >> 3, k8 = (t & 7) * 8;
      float v[8];
#pragma unroll
      for (int j = 0; j < 8; ++j) v[j] = tile[(k8 + j) * 65 + n];
      u32x4 w; w.x = cvt_pk_bf16(v[0], v[1]); w.y = cvt_pk_bf16(v[2], v[3]); w.z = cvt_pk_bf16(v[4], v[5]); w.w = cvt_pk_bf16(v[6], v[7]);
      *(u32x4*)(dst + (size_t)(n0 + n) * K + k0 + k8) = w; }
    __syncthreads();
}
__device__ __forceinline__ void small_transpose(const float* __restrict__ src, u16* __restrict__ dst, int K, int N, int Kpad, size_t gt, size_t nth) {
    for (size_t i = gt; i < (size_t)N * Kpad; i += nth) { const int n = (int)(i / Kpad), k = (int)(i - (size_t)n * Kpad); const float v = k < K ? src[(size_t)k * N + n] : 0.f; dst[i] = (u16)(cvt_pk_bf16(v, 0.f) & 0xffffu); }
}
__device__ void convert_phase(KP p, int l, float* tile) {
    unsigned char* ws = p->ws;
    const int bid = opaque_bid();
    const size_t gt = (size_t)bid * 512 + opaque_tid(), nth = (size_t)gridDim.x * 512;
    constexpr int n1 = 16 * 56, n2 = 16 * 16, n3 = 16 * 88, n4 = 44 * 16;
    for (int it = bid; it < n1 + n2 + n3 + n4; it += gridDim.x) {
        if (it < n1) transpose_tile(p->in[I_WIN] + (size_t)l * 1024 * 3344, (u16*)(ws + W_WIN), 1024, 3344, 56, it, tile);
        else if (it < n1 + n2) transpose_tile(p->in[I_WOUT] + (size_t)l * 1024 * 1024, (u16*)(ws + W_WOUT), 1024, 1024, 16, it - n1, tile);
        else if (it < n1 + n2 + n3) transpose_tile(p->in[I_WUP] + (size_t)l * 1024 * 5632, (u16*)(ws + W_WUP), 1024, 5632, 88, it - n1 - n2, tile);
        else transpose_tile(p->in[I_WDOWN] + (size_t)l * 2816 * 1024, (u16*)(ws + W_WDOWN), 2816, 1024, 16, it - n1 - n2 - n3, tile);
    }
    small_transpose(p->in[I_WLU] + (size_t)l * 64 * 512, (u16*)(ws + W_WLT), 64, 512, 64, gt, nth);
    small_transpose(p->in[I_ALU] + (size_t)l * 64 * 512, (u16*)(ws + W_ALT), 64, 512, 64, gt, nth);
    small_transpose(p->in[I_GLU] + (size_t)l * 128 * 512, (u16*)(ws + W_GLT), 128, 512, 128, gt, nth);
    if (l > 0) {
        small_transpose(p->in[I_VD] + (size_t)(l - 1) * 512 * 32, (u16*)(ws + W_V1T), 512, 32, 512, gt, nth);
        small_transpose(p->in[I_VU] + (size_t)(l - 1) * 32 * 512, (u16*)(ws + W_V2T), 32, 512, 32, gt, nth);
    }
    small_transpose(p->in[I_FUP] + (size_t)l * 16 * 256, (u16*)(ws + W_FT), 16, 256, 32, gt, nth);
    if (l == 0) {
        u16* xb = (u16*)(ws + W_XB);
        for (size_t i = gt; i < (size_t)MTOK * 256; i += nth) {
            const size_t e = i * 4;
            const f32x4 v = e < (size_t)MP * 1024 ? *(const f32x4*)(p->in[I_XP] + e) : *(const f32x4*)(p->in[I_XS] + (e - (size_t)MP * 1024));
            st_bf4(xb + e, v);
        }
    }
}

template <bool WRITE_F32>
__device__ void ln_phase(float* Y, u16* xb, const float* __restrict__ g, const float* __restrict__ b) {
    const int tt_ = opaque_tid();
    const int lane = tt_ & 63, gw = opaque_bid() * 8 + (tt_ >> 6), nw = gridDim.x * 8;
    f32x4 gv[4], bv[4];
#pragma unroll
    for (int i = 0; i < 4; ++i) { gv[i] = *(const f32x4*)(g + i * 256 + lane * 4); bv[i] = *(const f32x4*)(b + i * 256 + lane * 4); }
    for (int row = gw; row < MTOK; row += nw) {
        float* yp = Y + (size_t)row * 1024 + lane * 4;
        f32x4 v[4]; float s = 0.f;
#pragma unroll
        for (int i = 0; i < 4; ++i) { v[i] = __builtin_nontemporal_load((const f32x4*)(yp + i * 256)); s += (v[i][0] + v[i][1]) + (v[i][2] + v[i][3]); }
#pragma unroll
        for (int o = 32; o >= 1; o >>= 1) s += __shfl_xor(s, o);
        const float mu = s * (1.0f / 1024.0f); float q = 0.f;
#pragma unroll
        for (int i = 0; i < 4; ++i) { const f32x4 d = v[i] - mu; q += (d[0] * d[0] + d[1] * d[1]) + (d[2] * d[2] + d[3] * d[3]); }
#pragma unroll
        for (int o = 32; o >= 1; o >>= 1) q += __shfl_xor(q, o);
        const float rstd = rsqrtf(q * (1.0f / 1024.0f) + LN_EPS);
#pragma unroll
        for (int i = 0; i < 4; ++i) { const f32x4 o = (v[i] - mu) * rstd * gv[i] + bv[i]; if (WRITE_F32) __builtin_nontemporal_store(o, (f32x4*)(yp + i * 256)); st_bf4(xb + (size_t)row * 1024 + i * 256 + lane * 4, o); }
    }
}

__device__ __forceinline__ void unpack8(const u32x4 w, float* f) { f[0] = bflo(w.x); f[1] = bfhi(w.x); f[2] = bflo(w.y); f[3] = bfhi(w.y); f[4] = bflo(w.z); f[5] = bfhi(w.z); f[6] = bflo(w.w); f[7] = bfhi(w.w); }
__device__ __forceinline__ float gelu_as(float v) {
    const float av = fabsf(v), t = __builtin_amdgcn_rcpf(av * 0.2316418882f + 1.0f);
    float q = t * 0.5307027145f + (-0.7265760135f); q = q * t + 0.7107068705f; q = q * t + (-0.142248368f); q = q * t + 0.127414796f; q = q * t;
    const float e = __builtin_amdgcn_exp2f((v * v) * (-0.72134752044f));
    const float m = v * (q * e);
    return v < 0.f ? m : v - m;
}
__device__ void convglu_phase(const u16* __restrict__ gate, u16* val, const float* __restrict__ past  , const float* __restrict__ cw, const float* __restrict__ cb) {
    const int b0_ = opaque_bid(), bx_ = (gridDim.x == 256) ? (((b0_ & 7) << 5) | (b0_ >> 3)) : b0_;
    const size_t gt = (size_t)bx_ * 512 + opaque_tid(), nth = (size_t)gridDim.x * 512;
    for (size_t idx = gt; idx < (size_t)(MTOK / 4) * 352; idx += nth) {
        const int rg = (int)(idx / 352), c = (int)(idx - (size_t)rg * 352) * 8, row0 = rg * 4;
        bool first; const float* pst = nullptr;
        if (row0 < MP) first = (row0 & 2047) == 0; else { first = true; pst = past + (size_t)((row0 - MP) >> 2) * 2 * DFF; }
        float w0[8], w1[8], w2[8], bb[8], gm2[8], gm1[8];
#pragma unroll
        for (int j = 0; j < 8; ++j) { w0[j] = cw[c + j]; w1[j] = cw[DFF + c + j]; w2[j] = cw[2 * DFF + c + j]; bb[j] = cb[c + j]; }
        if (!first) { unpack8(*(const u32x4*)(gate + (size_t)(row0 - 2) * DFF + c), gm2); unpack8(*(const u32x4*)(gate + (size_t)(row0 - 1) * DFF + c), gm1); }
        else {
#pragma unroll
            for (int j = 0; j < 8; ++j) { gm2[j] = pst ? pst[c + j] : 0.f; gm1[j] = pst ? pst[DFF + c + j] : 0.f; } }
#pragma unroll
        for (int r = 0; r < 4; ++r) {
            float g0[8], vv[8], h[8];
            unpack8(*(const u32x4*)(gate + (size_t)(row0 + r) * DFF + c), g0);
            unpack8(__builtin_nontemporal_load((const u32x4*)(val + (size_t)(row0 + r) * DFF + c)), vv);
#pragma unroll
            for (int j = 0; j < 8; ++j) { const float a = bb[j] + gm2[j] * w0[j] + gm1[j] * w1[j] + g0[j] * w2[j]; h[j] = gelu_as(a) * vv[j]; gm2[j] = gm1[j]; gm1[j] = g0[j]; }
            u32x4 w; w.x = cvt_pk_bf16(h[0], h[1]); w.y = cvt_pk_bf16(h[2], h[3]); w.z = cvt_pk_bf16(h[4], h[5]); w.w = cvt_pk_bf16(h[6], h[7]);
            *(u32x4*)(val + (size_t)(row0 + r) * DFF + c) = w;
        }
    }
}

struct PrepCtx {
    const u16* projA; const u16* projB; const float* mu; const float* sshift  ;
};
__device__ __forceinline__ f32x4 xs4(const PrepCtx& c, int i, int col) {
    const f32x4 cur = ld_bf4(c.projA + (size_t)i * 1792 + col);
    f32x4 prev;
    bool first; int b = 0;
    if (i < MP) first = (i & 2047) == 0; else { const int r = i - MP; first = (r & 3) == 0; b = r >> 2; }
    if (!first) prev = ld_bf4(c.projA + (size_t)(i - 1) * 1792 + col);
    else if (i < MP) prev = (f32x4){0.f, 0.f, 0.f, 0.f};
    else prev = *(const f32x4*)(c.sshift + (size_t)b * 1792 + col);
    const f32x4 m = *(const f32x4*)(c.mu + col);
    return cur + (prev - cur) * m;
}
__device__ __forceinline__ bf16x8 ldg_frag(const u16* p) { return *(const bf16x8*)p; }

__device__ void prep_phase(KP p, int l, PG8_LAS unsigned char* lds) {
    unsigned char* ws = p->ws;
    PrepCtx c; c.projA = (const u16*)(ws + W_PROJA); c.projB = (const u16*)(ws + W_PROJB); c.mu = p->in[I_MU] + (size_t)l * 1792; c.sshift = p->in[I_SSHIFT] + (size_t)l * 128 * 1792;
    const u16* wlT = (const u16*)(ws + W_WLT); const u16* alT = (const u16*)(ws + W_ALT); const u16* glT = (const u16*)(ws + W_GLT);
    const u16* v1T = (const u16*)(ws + W_V1T); const u16* v2T = (const u16*)(ws + W_V2T); const u16* fT = (const u16*)(ws + W_FT);
    u32x4* A16 = (u32x4*)(ws + W_BUFB); float* D8 = (float*)(ws + W_D8); u16* vbuf = (u16*)(ws + W_VBUF); u16* gbuf = (u16*)(ws + W_GBUF);
    float* decb = (float*)(ws + W_DEC); float* rkb = (float*)(ws + W_RK); u16* vfirst = (u16*)(ws + W_VFIRST);
    const float* w0 = p->in[I_W0] + l * 512; const float* a0 = p->in[I_A0] + l * 512; const float* k_k = p->in[I_KK] + l * 512; const float* k_a = p->in[I_KA] + l * 512;
    const float* r_k = p->in[I_RK] + l * 512; const float* vb = l > 0 ? p->in[I_VB] + (l - 1) * 512 : nullptr; const float* fbias = p->in[I_FB] + l * 256;
    constexpr int S_TW = 144, S_AL = 144, S_SG = 272, S_XV = 1040, S_FL = 80, S_PP = 80;
    constexpr int O_TW = 0, O_AL = O_TW + 16 * S_TW, O_SG = O_AL + 16 * S_AL, O_XV = O_SG + 16 * S_SG, O_FL = O_XV + 16 * S_XV, O_PP = O_FL + 16 * S_FL;
    const int t = opaque_tid(), wid = t >> 6, lane = t & 63, fr = lane & 15, fq = lane >> 4, h = wid;
    for (int blk = opaque_bid(); blk < MTOK / 16; blk += gridDim.x) {
        const int i0 = blk * 16;
#pragma unroll 1
        for (int q = 0; q < 6; ++q) {
            const int op = t + 512 * q, r = op / 192, g4 = op - r * 192, col = 1024 + 4 * g4;
            f32x4 x = xs4(c, i0 + r, col);
            int off;
            if (col < 1536) off = O_XV + r * S_XV + (col - 1024) * 2;
            else if (col < 1600) { off = O_TW + r * S_TW + (col - 1536) * 2; x = (f32x4){tanhf_(x[0]), tanhf_(x[1]), tanhf_(x[2]), tanhf_(x[3])}; }
            else if (col < 1664) off = O_AL + r * S_AL + (col - 1600) * 2;
            else { off = O_SG + r * S_SG + (col - 1664) * 2; x = (f32x4){sigmoidf_(x[0]), sigmoidf_(x[1]), sigmoidf_(x[2]), sigmoidf_(x[3])}; }
            u32x2 w; w.x = cvt_pk_bf16(x[0], x[1]); w.y = cvt_pk_bf16(x[2], x[3]);
            *(PG8_LAS u32x2*)(lds + off) = w;
        }
        if (t < 128) { const int r = t >> 3, c4 = (t & 7) * 4; u32x2 w = (u32x2){0u, 0u}; if (c4 < 16) w = *(const u32x2*)(c.projB + (size_t)(i0 + r) * 1792 + 1536 + c4); *(PG8_LAS u32x2*)(lds + O_FL + r * S_FL + c4 * 2) = w; }
        __syncthreads();
        bf16x8 pfrag = (bf16x8){0, 0, 0, 0, 0, 0, 0, 0};
        if (l > 0) {
            f32x4 accP0 = (f32x4){0.f, 0.f, 0.f, 0.f}, accP1 = accP0;
#pragma unroll 4
            for (int ks = 0; ks < 16; ++ks) {
                const bf16x8 af = *(const PG8_LAS bf16x8*)(lds + O_XV + fr * S_XV + (ks * 32 + fq * 8) * 2);
                accP0 = __builtin_amdgcn_mfma_f32_16x16x32_bf16(ldg_frag(v1T + (size_t)fr * 512 + ks * 32 + fq * 8), af, accP0, 0, 0, 0);
                accP1 = __builtin_amdgcn_mfma_f32_16x16x32_bf16(ldg_frag(v1T + (size_t)(16 + fr) * 512 + ks * 32 + fq * 8), af, accP1, 0, 0, 0);
            }
            const u32 w0_ = cvt_pk_bf16(accP0[0], accP0[1]), w1_ = cvt_pk_bf16(accP0[2], accP0[3]), w2_ = cvt_pk_bf16(accP1[0], accP1[1]), w3_ = cvt_pk_bf16(accP1[2], accP1[3]);
            const u32x4 pw = (u32x4){w0_, w1_, w2_, w3_};
            pfrag = __builtin_bit_cast(bf16x8, pw);
        }
        const int i = i0 + fr;
        float ss = 0.f;
#pragma unroll
        for (int n = 0; n < 4; ++n) { const int cb_ = h * 64 + 16 * n + 4 * fq; const f32x4 xk = xs4(c, i, 512 + cb_) * *(const f32x4*)(k_k + cb_); ss += (xk[0] * xk[0] + xk[1] * xk[1]) + (xk[2] * xk[2] + xk[3] * xk[3]); }
        ss += __shfl_xor(ss, 16); ss += __shfl_xor(ss, 32);
        const float inorm = rsqrtf(fmaxf(ss, 1e-24f));
        float rks = 0.f;
#pragma unroll 2
        for (int n = 0; n < 4; ++n) {
            const int cn = h * 64 + 16 * n, cb_ = cn + 4 * fq;
            f32x4 aW = (f32x4){0.f, 0.f, 0.f, 0.f}, aA = aW, aG = aW, aV = aW;
#pragma unroll
            for (int ks = 0; ks < 2; ++ks) {
                aW = __builtin_amdgcn_mfma_f32_16x16x32_bf16(ldg_frag(wlT + (size_t)(cn + fr) * 64 + ks * 32 + fq * 8), *(const PG8_LAS bf16x8*)(lds + O_TW + fr * S_TW + (ks * 32 + fq * 8) * 2), aW, 0, 0, 0);
                aA = __builtin_amdgcn_mfma_f32_16x16x32_bf16(ldg_frag(alT + (size_t)(cn + fr) * 64 + ks * 32 + fq * 8), *(const PG8_LAS bf16x8*)(lds + O_AL + fr * S_AL + (ks * 32 + fq * 8) * 2), aA, 0, 0, 0);
            }
#pragma unroll
            for (int ks = 0; ks < 4; ++ks)
                aG = __builtin_amdgcn_mfma_f32_16x16x32_bf16(ldg_frag(glT + (size_t)(cn + fr) * 128 + ks * 32 + fq * 8), *(const PG8_LAS bf16x8*)(lds + O_SG + fr * S_SG + (ks * 32 + fq * 8) * 2), aG, 0, 0, 0);
            if (l > 0) {
                const u32x2 va = *(const u32x2*)(v2T + (size_t)(cn + fr) * 32 + 4 * fq), vc = *(const u32x2*)(v2T + (size_t)(cn + fr) * 32 + 16 + 4 * fq);
                const u32x4 vw = (u32x4){va.x, va.y, vc.x, vc.y};
                aV = __builtin_amdgcn_mfma_f32_16x16x32_bf16(__builtin_bit_cast(bf16x8, vw), pfrag, aV, 0, 0, 0);
            }
            const f32x4 xr = xs4(c, i, cb_), xk = xs4(c, i, 512 + cb_), xv = xs4(c, i, 1024 + cb_);
            const f32x4 w0v = *(const f32x4*)(w0 + cb_), a0v = *(const f32x4*)(a0 + cb_), kkv = *(const f32x4*)(k_k + cb_), kav = *(const f32x4*)(k_a + cb_), rkv = *(const f32x4*)(r_k + cb_);
            f32x4 vp = xv;
            if (l == 0) st_bf4(vfirst + (size_t)i * 512 + cb_, xv);
            else { const f32x4 vf = ld_bf4(vfirst + (size_t)i * 512 + cb_); const f32x4 vbv = *(const f32x4*)(vb + cb_);
#pragma unroll
                for (int j = 0; j < 4; ++j) vp[j] = xv[j] + (vf[j] - xv[j]) * sigmoidf_(vbv[j] + aV[j]);
            }
            f32x4 dd, kt, kn, bb;
#pragma unroll
            for (int j = 0; j < 4; ++j) {
                const float wv = -softplusf_(-(w0v[j] + aW[j])) - 0.5f;
                dd[j] = __expf(-__expf(wv));
                const float a = sigmoidf_(a0v[j] + aA[j]);
                kn[j] = xk[j] * kkv[j] * inorm;
                kt[j] = xk[j] * (1.0f + (a - 1.0f) * kav[j]);
                bb[j] = kn[j] * a;
                rks += xr[j] * kt[j] * rkv[j];
            }
            const int p0 = 8 * n + 2 * fq;
            u32x4 rec0, rec1;
            rec0.x = cvt_pk_bf16(xr[0], xr[1]); rec0.y = cvt_pk_bf16(kt[0], kt[1]); rec0.z = cvt_pk_bf16(kn[0], kn[1]); rec0.w = cvt_pk_bf16(bb[0], bb[1]);
            rec1.x = cvt_pk_bf16(xr[2], xr[3]); rec1.y = cvt_pk_bf16(kt[2], kt[3]); rec1.z = cvt_pk_bf16(kn[2], kn[3]); rec1.w = cvt_pk_bf16(bb[2], bb[3]);
            u32x4* ap = A16 + ((size_t)i * 8 + h) * 32 + p0;
            ap[0] = rec0; ap[1] = rec1;
            *(f32x4*)(D8 + (size_t)i * 512 + cb_) = dd;
            st_bf4(vbuf + (size_t)i * 512 + cb_, vp);
            st_bf4(gbuf + (size_t)i * 512 + cb_, aG);
        }
        rks += __shfl_xor(rks, 16); rks += __shfl_xor(rks, 32);
        if (fq == 0) rkb[(size_t)i * 8 + h] = rks;
#pragma unroll
        for (int n2 = 0; n2 < 2; ++n2) {
            const int cn = 32 * h + 16 * n2;
            f32x4 aF = (f32x4){0.f, 0.f, 0.f, 0.f};
            aF = __builtin_amdgcn_mfma_f32_16x16x32_bf16(ldg_frag(fT + (size_t)(cn + fr) * 32 + fq * 8), *(const PG8_LAS bf16x8*)(lds + O_FL + fr * S_FL + (fq * 8) * 2), aF, 0, 0, 0);
            const f32x4 fb = *(const f32x4*)(fbias + cn + 4 * fq);
            f32x4 dc;
#pragma unroll
            for (int j = 0; j < 4; ++j) { const float z = aF[j] + fb[j]; dc[j] = __expf(-softplusf_(-z) * (1.0f / 16.0f)); }
            *(f32x4*)(decb + (size_t)i * 256 + cn + 4 * fq) = dc;
        }
        __syncthreads();
    }
}

struct ScanItem {
    int tok0, T, L;
    int h, q;
    int hg, cgp;
    const float* s0_rwkv; float* so_rwkv;
    const float* s0_gla; float* so_gla;
};
template <int LSEG>
__device__ __forceinline__ void scan_item(KP p, const ScanItem& it, PG8_LAS unsigned char* lds) {
    unsigned char* ws = p->ws;
    const u32x4* A16 = (const u32x4*)(ws + W_BUFB); const float* D8 = (const float*)(ws + W_D8); const u16* vbuf = (const u16*)(ws + W_VBUF);
    const u16* projB = (const u16*)(ws + W_PROJB); const float* decb = (const float*)(ws + W_DEC);
    u16* obufA = (u16*)(ws + W_OBUFA); u16* obufB = (u16*)(ws + W_OBUFB);
    const int t = opaque_tid(), wid = t >> 6, lane = t & 63, kq = lane & 15, rsel = lane >> 4;
    constexpr int BUF = 69632, OR = 0, OKT = 8192, OKN = 16384, OB = 24576, OD = 32768, OVR = 40960, OQ = 43008, OK = 51200, ODC = 59392, OVG = 67584;
    const int nchunk = it.T / TC;
    u32x4 sa0, sa1; f32x4 sd, sdec; u32x2 svr = (u32x2){0u, 0u}, sq, sk;
#define SC_GLOAD(ch_) do { const int tk_ = it.tok0 + (ch_) * TC; \
        { const int i0 = t, i1 = t + 512; sa0 = A16[((size_t)(tk_ + (i0 >> 5)) * 8 + it.h) * 32 + (i0 & 31)]; sa1 = A16[((size_t)(tk_ + (i1 >> 5)) * 8 + it.h) * 32 + (i1 & 31)]; } \
        { const int st = t >> 4, c4 = (t & 15) * 4; sd = *(const f32x4*)(D8 + (size_t)(tk_ + st) * 512 + it.h * 64 + c4); \
          sq = *(const u32x2*)(projB + (size_t)(tk_ + st) * 1792 + it.hg * 64 + c4); sk = *(const u32x2*)(projB + (size_t)(tk_ + st) * 1792 + 256 + it.hg * 64 + c4); \
          sdec = *(const f32x4*)(decb + (size_t)(tk_ + st) * 256 + it.hg * 64 + c4); } \
        if (t < 128) { const int st = t >> 2, c4 = (t & 3) * 4; svr = *(const u32x2*)(vbuf + (size_t)(tk_ + st) * 512 + it.h * 64 + it.q * 16 + c4); } \
        else if (t < 256) { const int tt = t - 128, st = tt >> 2, c4 = (tt & 3) * 4; svr = *(const u32x2*)(projB + (size_t)(tk_ + st) * 1792 + 512 + it.hg * 128 + it.cgp * 16 + c4); } } while (0)
#define SC_LSTORE(buf_) do { PG8_LAS unsigned char* b_ = lds + (buf_) * BUF; \
        { const int i0 = t, i1 = t + 512; \
          { const int st = i0 >> 5, pp = i0 & 31; const int o = (st * 64 + 2 * pp) * 4; \
            *(PG8_LAS f32x2*)(b_ + OR + o) = (f32x2){bflo(sa0.x), bfhi(sa0.x)}; *(PG8_LAS f32x2*)(b_ + OKT + o) = (f32x2){bflo(sa0.y), bfhi(sa0.y)}; \
            *(PG8_LAS f32x2*)(b_ + OKN + o) = (f32x2){bflo(sa0.z), bfhi(sa0.z)}; *(PG8_LAS f32x2*)(b_ + OB + o) = (f32x2){bflo(sa0.w), bfhi(sa0.w)}; } \
          { const int st = i1 >> 5, pp = i1 & 31; const int o = (st * 64 + 2 * pp) * 4; \
            *(PG8_LAS f32x2*)(b_ + OR + o) = (f32x2){bflo(sa1.x), bfhi(sa1.x)}; *(PG8_LAS f32x2*)(b_ + OKT + o) = (f32x2){bflo(sa1.y), bfhi(sa1.y)}; \
            *(PG8_LAS f32x2*)(b_ + OKN + o) = (f32x2){bflo(sa1.z), bfhi(sa1.z)}; *(PG8_LAS f32x2*)(b_ + OB + o) = (f32x2){bflo(sa1.w), bfhi(sa1.w)}; } } \
        { const int st = t >> 4, c4 = (t & 15) * 4; const int o = (st * 64 + c4) * 4; \
          *(PG8_LAS f32x4*)(b_ + OD + o) = sd; *(PG8_LAS f32x4*)(b_ + ODC + o) = sdec; \
          *(PG8_LAS f32x4*)(b_ + OQ + o) = (f32x4){bflo(sq.x), bfhi(sq.x), bflo(sq.y), bfhi(sq.y)} * 0.125f; \
          *(PG8_LAS f32x4*)(b_ + OK + o) = (f32x4){bflo(sk.x), bfhi(sk.x), bflo(sk.y), bfhi(sk.y)}; } \
        if (t < 128) { const int st = t >> 2, c4 = (t & 3) * 4; *(PG8_LAS f32x4*)(b_ + OVR + (st * 16 + c4) * 4) = (f32x4){bflo(svr.x), bfhi(svr.x), bflo(svr.y), bfhi(svr.y)}; } \
        else if (t < 256) { const int tt = t - 128, st = tt >> 2, c4 = (tt & 3) * 4; *(PG8_LAS f32x4*)(b_ + OVG + (st * 16 + c4) * 4) = (f32x4){bflo(svr.x), bfhi(svr.x), bflo(svr.y), bfhi(svr.y)}; } } while (0)
    const bool isR = wid < 4;
    const int w4 = wid & 3;
    const int row = it.q * 16 + 4 * w4 + rsel;
    const int col = it.cgp * 16 + 4 * w4 + rsel;
    f32x4 S = (f32x4){0.f, 0.f, 0.f, 0.f}, Sn = S;
#define SC_LOAD_STATE(dst_, seg_) do { const int sg_ = (seg_); \
        if (isR) { if (!it.s0_rwkv) dst_ = (f32x4){0.f, 0.f, 0.f, 0.f}; else dst_ = *(const f32x4*)(it.s0_rwkv + (size_t)sg_ * 8 * 4096 + row * 64 + 4 * kq); } \
        else if (!it.s0_gla) dst_ = (f32x4){0.f, 0.f, 0.f, 0.f}; \
        else { const float* sp_ = it.s0_gla + (size_t)sg_ * 4 * 8192 + (size_t)(4 * kq) * 128 + col; dst_ = (f32x4){sp_[0], sp_[128], sp_[256], sp_[384]}; } } while (0)
#define SC_STORE_STATE(seg_, s_) do { const int sg_ = (seg_); \
        if (isR) { *(f32x4*)(it.so_rwkv + (size_t)sg_ * 8 * 4096 + row * 64 + 4 * kq) = s_; } \
        else { float* sp_ = it.so_gla + (size_t)sg_ * 4 * 8192 + (size_t)(4 * kq) * 128 + col; sp_[0] = s_[0]; sp_[128] = s_[1]; sp_[256] = s_[2]; sp_[384] = s_[3]; } } while (0)
    SC_GLOAD(0);
    SC_LOAD_STATE(Sn, 0);
    SC_LSTORE(0);
    __syncthreads();
    u16* oAp = obufA + (size_t)it.tok0 * 512 + it.h * 64 + row;
    u16* oBp = obufB + (size_t)it.tok0 * 512 + it.hg * 128 + col;
    const int vsl = (4 * w4 + rsel) * 4;
#define SC_STEP_R(s_, ov_) do { const int o = ((s_) * 64 + 4 * kq) * 4; \
        const f32x4 r4 = *(const PG8_LAS f32x4*)(b + OR + o), k4 = *(const PG8_LAS f32x4*)(b + OKT + o), n4 = *(const PG8_LAS f32x4*)(b + OKN + o), b4 = *(const PG8_LAS f32x4*)(b + OB + o), d4 = *(const PG8_LAS f32x4*)(b + OD + o); \
        const float v = *(const PG8_LAS float*)(b + OVR + (s_) * 64 + vsl); \
        float dot = dot4pk(S, n4); \
        dot = red16(dot); \
        S = S * d4 - b4 * dot + k4 * v; \
        float o_ = dot4pk(S, r4); \
        (ov_) = red16(o_); } while (0)
#define SC_STEP_G(s_, ov_) do { const int o = ((s_) * 64 + 4 * kq) * 4; \
        const f32x4 q4 = *(const PG8_LAS f32x4*)(b + OQ + o), k4 = *(const PG8_LAS f32x4*)(b + OK + o), d4 = *(const PG8_LAS f32x4*)(b + ODC + o); \
        const float v = *(const PG8_LAS float*)(b + OVG + (s_) * 64 + vsl); \
        S = S * d4 + k4 * v; \
        float o_ = dot4pk(S, q4); \
        (ov_) = red16(o_); } while (0)
#define SC_BLOCK(STEP_, s0_, NB_, optr_) do { float ov[NB_]; \
        _Pragma("unroll") for (int j_ = 0; j_ < (NB_); ++j_) STEP_((s0_) + j_, ov[j_]); \
        float outv = ov[0]; \
        _Pragma("unroll") for (int j_ = 1; j_ < (NB_); ++j_) outv = (kq == j_) ? ov[j_] : outv; \
        if (kq < (NB_)) (optr_)[(size_t)((s0_) + kq) * 512] = (u16)(cvt_pk_bf16(outv, 0.f) & 0xffffu); } while (0)
    for (int ch = 0; ch < nchunk; ++ch) {
        const bool more = ch + 1 < nchunk;
        if (more) SC_GLOAD(ch + 1);
        PG8_LAS unsigned char* b = lds + (ch & 1) * BUF;
        if (LSEG >= TC) {
            if (ch == 0) S = Sn;
            if (isR) {
                {
                    struct InR { f32x4 r4, k4, n4, b4, d4; float v; };
                    InR in_[TC]; float ov[8]; float op = 0.f;
#define LD_R(s_) do { const int o = ((s_) * 64 + 4 * kq) * 4; in_[s_].r4 = *(const PG8_LAS f32x4*)(b + OR + o); in_[s_].k4 = *(const PG8_LAS f32x4*)(b + OKT + o); in_[s_].n4 = *(const PG8_LAS f32x4*)(b + OKN + o); \
                        in_[s_].b4 = *(const PG8_LAS f32x4*)(b + OB + o); in_[s_].d4 = *(const PG8_LAS f32x4*)(b + OD + o); in_[s_].v = *(const PG8_LAS float*)(b + OVR + (s_) * 64 + vsl); } while (0)
#pragma unroll
                    for (int j = 0; j < SC_PD; ++j) LD_R(j);
#pragma unroll
                    for (int s = 0; s < TC; ++s) {
                        float dot = dot4pk(S, in_[s].n4);
                        dot += dppf<0xB1>(dot); op += dppf<0xB1>(op);
                        dot += dppf<0x4E>(dot); op += dppf<0x4E>(op);
                        dot += dppf<0x141>(dot); op += dppf<0x141>(op);
                        dot += dppf<0x140>(dot); op += dppf<0x140>(op);
                        if (s > 0) ov[(s - 1) & 7] = op;
                        if (s > 0 && (s & 7) == 0) { float outv = ov[0];
#pragma unroll
                            for (int j = 1; j < 8; ++j) outv = (kq == j) ? ov[j] : outv;
                            if (kq < 8) oAp[(size_t)(s - 8 + kq) * 512] = (u16)(cvt_pk_bf16(outv, 0.f) & 0xffffu); }
                        S = S * in_[s].d4 - in_[s].b4 * dot + in_[s].k4 * in_[s].v;
                        op = dot4pk(S, in_[s].r4);
                        if (s + SC_PD < TC) LD_R(s + SC_PD);
                        __builtin_amdgcn_sched_barrier(0);
                    }
                    ov[7] = red16(op);
                    { float outv = ov[0];
#pragma unroll
                      for (int j = 1; j < 8; ++j) outv = (kq == j) ? ov[j] : outv;
                      if (kq < 8) oAp[(size_t)(TC - 8 + kq) * 512] = (u16)(cvt_pk_bf16(outv, 0.f) & 0xffffu); }
#undef LD_R
                }
            } else {
                {
                    struct InG { f32x4 q4, k4, d4; float v; };
                    InG in_[TC]; float ov[8];
#define LD_G(s_) do { const int o = ((s_) * 64 + 4 * kq) * 4; in_[s_].q4 = *(const PG8_LAS f32x4*)(b + OQ + o); in_[s_].k4 = *(const PG8_LAS f32x4*)(b + OK + o); in_[s_].d4 = *(const PG8_LAS f32x4*)(b + ODC + o); \
                        in_[s_].v = *(const PG8_LAS float*)(b + OVG + (s_) * 64 + vsl); } while (0)
#pragma unroll
                    for (int j = 0; j < SC_PD; ++j) LD_G(j);
#pragma unroll
                    for (int s = 0; s < TC; ++s) {
                        S = S * in_[s].d4 + in_[s].k4 * in_[s].v;
                        float o_ = dot4pk(S, in_[s].q4);
                        ov[s & 7] = red16(o_);
                        if (s + SC_PD < TC) LD_G(s + SC_PD);
                        __builtin_amdgcn_sched_barrier(0);
                        if ((s & 7) == 7) { float outv = ov[0];
#pragma unroll
                            for (int j = 1; j < 8; ++j) outv = (kq == j) ? ov[j] : outv;
                            if (kq < 8) oBp[(size_t)((s & ~7) + kq) * 512] = (u16)(cvt_pk_bf16(outv, 0.f) & 0xffffu); }
                    }
#undef LD_G
                }
            }
            if (!more) SC_STORE_STATE(0, S);
        } else {
#pragma unroll 1
            for (int sgi = 0; sgi < TC / LSEG; ++sgi) {
                const int seg = ch * (TC / LSEG) + sgi;
                S = Sn;
                if ((seg + 1) * LSEG < it.T) SC_LOAD_STATE(Sn, seg + 1);
                if (isR) {
                    SC_BLOCK(SC_STEP_R, sgi * LSEG, (LSEG < TC ? LSEG : 1), oAp);
                } else {
                    SC_BLOCK(SC_STEP_G, sgi * LSEG, (LSEG < TC ? LSEG : 1), oBp);
                }
                SC_STORE_STATE(seg, S);
            }
        }
        oAp += (size_t)TC * 512; oBp += (size_t)TC * 512;
        if (more) SC_LSTORE((ch + 1) & 1);
        __syncthreads();
    }
#undef SC_BLOCK
#undef SC_STEP_R
#undef SC_STEP_G
}
__device__ void scan_phase(KP p, int l, PG8_LAS unsigned char* lds) {
    float* out = p->out;
    const int bid = opaque_bid();
    for (int i0_ = bid; i0_ < 256; i0_ += gridDim.x) {
        const int i = (gridDim.x == 256) ? (((i0_ & 7) << 5) | (i0_ >> 3)) : i0_;
        ScanItem it; const int s = i >> 5;
        it.tok0 = s * 2048; it.T = 2048; it.L = 2048; it.h = (i >> 2) & 7; it.q = i & 3; it.hg = (i >> 3) & 3; it.cgp = i & 7;
        it.s0_rwkv = nullptr; it.so_rwkv = out + O_RWKV_P + ((size_t)(l * 8 + s) * 8 + it.h) * 4096;
        it.s0_gla = nullptr; it.so_gla = out + O_GLA_P + ((size_t)(l * 8 + s) * 4 + it.hg) * 8192;
        scan_item<2048>(p, it, lds);
    }
    for (int i0_ = bid; i0_ < 256; i0_ += gridDim.x) {
        const int i = (gridDim.x == 256) ? (((i0_ & 7) << 5) | (i0_ >> 3)) : i0_;
        ScanItem it; const int bg = i >> 5, b0 = bg * 16;
        it.tok0 = MP + bg * 64; it.T = 64; it.L = 4; it.h = (i >> 2) & 7; it.q = i & 3; it.hg = (i >> 3) & 3; it.cgp = i & 7;
        it.s0_rwkv = p->in[I_SRWKV] + ((size_t)(l * 128 + b0) * 8 + it.h) * 4096; it.so_rwkv = out + O_RWKV_S + ((size_t)(l * 128 + b0) * 8 + it.h) * 4096;
        it.s0_gla = p->in[I_SGLA] + ((size_t)(l * 128 + b0) * 4 + it.hg) * 8192; it.so_gla = out + O_GLA_S + ((size_t)(l * 128 + b0) * 4 + it.hg) * 8192;
        scan_item<4>(p, it, lds);
    }
}

__device__ void post_phase(KP p, int l) {
    unsigned char* ws = p->ws;
    const u16* obufA = (const u16*)(ws + W_OBUFA); const u16* obufB = (const u16*)(ws + W_OBUFB); const u16* vbuf = (const u16*)(ws + W_VBUF); const u16* gbuf = (const u16*)(ws + W_GBUF);
    const float* rkb = (const float*)(ws + W_RK); const u16* projB = (const u16*)(ws + W_PROJB); u16* oab = (u16*)(ws + W_XB);
    const float* lg = p->in[I_LNXG] + l * 512; const float* lb = p->in[I_LNXB] + l * 512; const float* ng = p->in[I_NG] + l * 128;
    const int tt_ = opaque_tid();
    const int lane = tt_ & 63, gw = opaque_bid() * 8 + (tt_ >> 6), nw = gridDim.x * 8;
    const int c = lane * 8;
    float lgv[8], lbv[8], ngv[8];
#pragma unroll
    for (int j = 0; j < 8; ++j) { lgv[j] = lg[c + j]; lbv[j] = lb[c + j]; ngv[j] = ng[(c & 127) + j]; }
    for (int i = gw; i < MTOK; i += nw) {
        {
            const f32x4 o0 = ld_bf4(obufA + (size_t)i * 512 + c), o1 = ld_bf4(obufA + (size_t)i * 512 + c + 4);
            const f32x4 v0 = ld_bf4(vbuf + (size_t)i * 512 + c), v1 = ld_bf4(vbuf + (size_t)i * 512 + c + 4);
            const f32x4 g0 = ld_bf4(gbuf + (size_t)i * 512 + c), g1 = ld_bf4(gbuf + (size_t)i * 512 + c + 4);
            const float rk = rkb[(size_t)i * 8 + (lane >> 3)];
            float s = (o0[0] + o0[1]) + (o0[2] + o0[3]) + (o1[0] + o1[1]) + (o1[2] + o1[3]);
            s += __shfl_xor(s, 1); s += __shfl_xor(s, 2); s += __shfl_xor(s, 4);
            const float m = s * (1.0f / 64.0f);
            const f32x4 d0 = o0 - m, d1 = o1 - m;
            float q = (d0[0] * d0[0] + d0[1] * d0[1]) + (d0[2] * d0[2] + d0[3] * d0[3]) + (d1[0] * d1[0] + d1[1] * d1[1]) + (d1[2] * d1[2] + d1[3] * d1[3]);
            q += __shfl_xor(q, 1); q += __shfl_xor(q, 2); q += __shfl_xor(q, 4);
            const float rs = rsqrtf(q * (1.0f / 64.0f) + GN_EPS_A);
            f32x4 y0, y1;
#pragma unroll
            for (int j = 0; j < 4; ++j) { y0[j] = (d0[j] * rs * lgv[j] + lbv[j] + rk * v0[j]) * g0[j]; y1[j] = (d1[j] * rs * lgv[4 + j] + lbv[4 + j] + rk * v1[j]) * g1[j]; }
            u32x4 w; w.x = cvt_pk_bf16(y0[0], y0[1]); w.y = cvt_pk_bf16(y0[2], y0[3]); w.z = cvt_pk_bf16(y1[0], y1[1]); w.w = cvt_pk_bf16(y1[2], y1[3]);
            *(u32x4*)(oab + (size_t)i * 1024 + c) = w;
        }
        {
            const f32x4 o0 = ld_bf4(obufB + (size_t)i * 512 + c), o1 = ld_bf4(obufB + (size_t)i * 512 + c + 4);
            const f32x4 g0 = ld_bf4(projB + (size_t)i * 1792 + 1024 + c), g1 = ld_bf4(projB + (size_t)i * 1792 + 1024 + c + 4);
            float q = (o0[0] * o0[0] + o0[1] * o0[1]) + (o0[2] * o0[2] + o0[3] * o0[3]) + (o1[0] * o1[0] + o1[1] * o1[1]) + (o1[2] * o1[2] + o1[3] * o1[3]);
            q += __shfl_xor(q, 1); q += __shfl_xor(q, 2); q += __shfl_xor(q, 4); q += __shfl_xor(q, 8);
            const float rs = rsqrtf(q * (1.0f / 128.0f) + RMS_EPS);
            f32x4 y0, y1;
#pragma unroll
            for (int j = 0; j < 4; ++j) { y0[j] = o0[j] * rs * ngv[j] * (g0[j] * sigmoidf_(g0[j])); y1[j] = o1[j] * rs * ngv[4 + j] * (g1[j] * sigmoidf_(g1[j])); }
            u32x4 w; w.x = cvt_pk_bf16(y0[0], y0[1]); w.y = cvt_pk_bf16(y0[2], y0[3]); w.z = cvt_pk_bf16(y1[0], y1[1]); w.w = cvt_pk_bf16(y1[2], y1[3]);
            *(u32x4*)(oab + (size_t)i * 1024 + 512 + c) = w;
        }
    }
}

#define XB_TMO      128
#define XB_XCNT(j)  (256  + 64 * (j))
#define XB_XSUB(j)  (1280 + 64 * (j))
#define XB_XGEN(j)  (2304 + 64 * (j))
#define XB_TOP      3328
#define XB_TOPGEN   3392
#define XCD_BAR_WORDS 3456
#define XB_SPIN_CAP (1u << 18)
__device__ __forceinline__ unsigned xb_ld(unsigned* p)              { return __hip_atomic_load(p, __ATOMIC_RELAXED, __HIP_MEMORY_SCOPE_AGENT); }
__device__ __forceinline__ unsigned xb_add(unsigned* p, unsigned v) { return __hip_atomic_fetch_add(p, v, __ATOMIC_RELAXED, __HIP_MEMORY_SCOPE_AGENT); }
__device__ __forceinline__ unsigned xb_xcc_id() { return (unsigned)__builtin_amdgcn_s_getreg((3 << 11) | 20) & 0xFu; }
#define XB_SPIN(cond, bar) do { unsigned _sp = 0; while (cond) { __builtin_amdgcn_s_sleep(1); \
    if ((++_sp & 255u) == 0u) { if (xb_ld(&(bar)[XB_TMO])) break; if (_sp > XB_SPIN_CAP) { atomicAdd(&(bar)[XB_TMO], 1u); break; } } } } while (0)
__device__ __forceinline__ void xcd_barrier_complete(unsigned* bar, unsigned x, unsigned& nloc, unsigned& nx) {
    const unsigned G = gridDim.x * gridDim.y * gridDim.z;
    unsigned sum, cnt, mine, sp = 0u;
    for (;;) {
        sum = 0u; cnt = 0u; mine = 0u;
#pragma unroll
        for (unsigned j = 0; j < 16; ++j) { const unsigned c = xb_ld(&bar[XB_XCNT(j)]); sum += c; cnt += (c > 0u) ? 1u : 0u; mine = (j == x) ? c : mine; }
        if (sum == G) break;
        __builtin_amdgcn_s_sleep(1);
        if ((++sp & 255u) == 0u) { if (xb_ld(&bar[XB_TMO])) break; if (sp > XB_SPIN_CAP) { atomicAdd(&bar[XB_TMO], 1u); break; } }
    }
    nloc = mine > 0u ? mine : 1u; nx = cnt > 0u ? cnt : 1u;
}
__device__ __forceinline__ void xcd_barrier(unsigned* bar, volatile PG8_LAS unsigned* st) {
    asm volatile("s_waitcnt vmcnt(0)" ::: "memory");
    __syncthreads();
    if (threadIdx.x == 0) {
        const unsigned x = xb_xcc_id();
        __builtin_amdgcn_s_waitcnt(0);
        unsigned nloc = st[0], nx = st[1];
        if (nloc == 0u) { xcd_barrier_complete(bar, x, nloc, nx); st[0] = nloc; st[1] = nx; }
        const unsigned old = xb_add(&bar[XB_XSUB(x)], 1u);
        const unsigned gen = old / nloc;
        if (old + 1u == (gen + 1u) * nloc) {
            __builtin_amdgcn_fence(__ATOMIC_RELEASE, "agent");
            asm volatile("s_waitcnt vmcnt(0)" ::: "memory");
            const unsigned og = xb_add(&bar[XB_TOP], 1u);
            const unsigned tg = og / nx;
            if (og + 1u == (tg + 1u) * nx) xb_add(&bar[XB_TOPGEN], 1u);
            else XB_SPIN(xb_ld(&bar[XB_TOPGEN]) == tg, bar);
            __builtin_amdgcn_fence(__ATOMIC_ACQUIRE, "agent");
            xb_add(&bar[XB_XGEN(x)], 1u);
            asm volatile("s_waitcnt vmcnt(0)" ::: "memory");
        } else {
            XB_SPIN(xb_ld(&bar[XB_XGEN(x)]) == gen, bar);
            __builtin_amdgcn_fence(__ATOMIC_ACQUIRE, "agent");
            asm volatile("s_waitcnt vmcnt(0)" ::: "memory");
        }
    }
    __syncthreads();
}
__device__ __forceinline__ void gsync(cg::grid_group& grid) {
    asm volatile("s_waitcnt vmcnt(0)" ::: "memory");
    grid.sync();
    if (threadIdx.x < 64) { __builtin_amdgcn_fence(__ATOMIC_ACQUIRE, "agent"); asm volatile("s_waitcnt vmcnt(0)" ::: "memory"); }
    __syncthreads();
}

__global__ void __launch_bounds__(512, 2) mega(Params p_unused) {
    KP p = kparams();
    extern __shared__ __attribute__((aligned(16))) unsigned char smem[];
    PG8_LAS unsigned char* lds = (PG8_LAS unsigned char*)smem;
    cg::grid_group grid = cg::this_grid();
    unsigned char* ws = p->ws;
    float* bufA = p->out + O_Y; float* bufB = (float*)(ws + W_BUFB); u16* xb = (u16*)(ws + W_XB);
    pg8::StaticOrder S;
    volatile PG8_LAS unsigned* xst = (volatile PG8_LAS unsigned*)(lds + 139264);
    if (threadIdx.x == 0) { xst[0] = 0u; xst[1] = 0u; }
    gsync(grid);
    unsigned* xbar = (unsigned*)(kparams()->ws + W_BAR);
    if (threadIdx.x == 0) (void)xb_add(&xbar[XB_XCNT(xb_xcc_id())], 1u);
#define PHASE_END() xcd_barrier((unsigned*)(kparams()->ws + W_BAR), xst)
    convert_phase(kparams(), 0, (float*)smem);
    PHASE_END();
    for (int l = 0; l < NL; ++l) {
        {
            pg8::Gemm g; g.A = xb; g.Bt = (const u16*)(ws + W_WIN); g.M = MTOK; g.N = INP; g.K = 1024;
            EpiProj E; E.projA = (u16*)(ws + W_PROJA); E.projB = (u16*)(ws + W_PROJB); E.shift_p = p->out + O_SHIFT_P + (size_t)l * 8 * 1792; E.shift_s = p->out + O_SHIFT_S + (size_t)l * 128 * 1792;
            S.init(MTOK, INP, gridDim.x, opaque_bid()); pg8::gemm_phase(lds, g, S, E);
        }
        PHASE_END();
        prep_phase(kparams(), l, lds);
        PHASE_END();
        scan_phase(kparams(), l, lds);
        PHASE_END();
        post_phase(kparams(), l);
        PHASE_END();
        {
            pg8::Gemm g; g.A = xb; g.Bt = (const u16*)(ws + W_WOUT); g.M = MTOK; g.N = 1024; g.K = 1024;
            EpiResid E; E.base = (l == 0) ? p->in[I_XP] : bufA; E.out = bufB;
            g.M = MP; S.init(MP, 1024, gridDim.x, opaque_bid()); pg8::gemm_phase(lds, g, S, E);
            small_gemm_resid<false>(g.A, g.Bt, 1024, (l == 0) ? (const void*)(p->in[I_XS] - (size_t)MP * 1024) : (const void*)bufA, E.out, lds);
        }
        PHASE_END();
        ln_phase<false>(bufB, xb, p->in[I_LN1G] + l * 1024, p->in[I_LN1B] + l * 1024);
        PHASE_END();
        {
            pg8::Gemm g; g.A = xb; g.Bt = (const u16*)(ws + W_WUP); g.M = MTOK; g.N = 5632; g.K = 1024;
            EpiUp E; E.gate = (u16*)(ws + W_GATE); E.val = (u16*)(ws + W_VAL); E.conv_p = p->out + O_CONV_P + (size_t)l * 8 * 2 * DFF; E.conv_s = p->out + O_CONV_S + (size_t)l * 128 * 2 * DFF;
            S.init(MTOK, 5632, gridDim.x, opaque_bid()); pg8::gemm_phase(lds, g, S, E);
        }
        PHASE_END();
        convglu_phase((const u16*)(ws + W_GATE), (u16*)(ws + W_VAL), p->in[I_SCONV] + (size_t)l * 128 * 2 * DFF, p->in[I_CW] + (size_t)l * 3 * DFF, p->in[I_CB] + (size_t)l * DFF);
        PHASE_END();
        {
            pg8::Gemm g; g.A = (const u16*)(ws + W_VAL); g.Bt = (const u16*)(ws + W_WDOWN); g.M = MTOK; g.N = 1024; g.K = DFF;
            EpiResidB E; E.base = xb; E.out = bufA;
            g.M = MP; S.init(MP, 1024, gridDim.x, opaque_bid()); pg8::gemm_phase(lds, g, S, E);
            small_gemm_resid<true>(g.A, g.Bt, DFF, E.base, E.out, lds);
        }
        PHASE_END();
        ln_phase<true>(bufA, xb, p->in[I_LN2G] + l * 1024, p->in[I_LN2B] + l * 1024);
        if (l + 1 < NL) convert_phase(kparams(), l + 1, (float*)smem);
        PHASE_END();
    }
}

extern "C" void kernel_launch(void* const* d_in, const int* in_sizes, int n_in, void* d_out, int out_size, void* d_ws, size_t ws_size, hipStream_t stream) {
    static int grid_blocks = 0;
    if (!grid_blocks) {
        int dev = 0, cus = 0, per_cu = 0;
        (void)hipGetDevice(&dev);
        (void)hipDeviceGetAttribute(&cus, hipDeviceAttributeMultiprocessorCount, dev);
        (void)hipFuncSetAttribute((const void*)mega, hipFuncAttributeMaxDynamicSharedMemorySize, LDS_BYTES);
        (void)hipOccupancyMaxActiveBlocksPerMultiprocessor(&per_cu, (const void*)mega, 512, LDS_BYTES);
        grid_blocks = cus;
        if (n_in != 33 || (size_t)out_size != O_END || ws_size < W_TOTAL) { fprintf(stderr, "kernel_launch: unexpected sizes n_in %d out %d ws %zu (need %zu)\n", n_in, out_size, ws_size, (size_t)W_TOTAL); grid_blocks = -1; }
    }
    if (grid_blocks < 0) return;
    (void)hipMemsetAsync((unsigned char*)d_ws + W_BAR, 0, XCD_BAR_WORDS * sizeof(unsigned), stream);
    Params p{};
    for (int i = 0; i < 33; ++i) p.in[i] = (const float*)d_in[i];
    p.out = (float*)d_out; p.ws = (unsigned char*)d_ws;
    void* args[] = {&p};
    hipError_t e = hipLaunchCooperativeKernel((const void*)mega, dim3(grid_blocks), dim3(512), args, LDS_BYTES, stream);
    if (e != hipSuccess) fprintf(stderr, "cooperative launch failed: %s (grid %d)\n", hipGetErrorString(e), grid_blocks);
}
```

```cpp
#include <hip/hip_runtime.h>
#include <hip/hip_cooperative_groups.h>
#include <cstdio>
namespace cg = cooperative_groups;

#define PG8_LAS __attribute__((address_space(3)))
typedef unsigned short u16;
typedef unsigned int u32;
typedef unsigned short bf16_t;
typedef short bf16x8 __attribute__((ext_vector_type(8)));
typedef float f32x4 __attribute__((ext_vector_type(4)));
typedef float f32x2 __attribute__((ext_vector_type(2)));
typedef unsigned u32x4 __attribute__((ext_vector_type(4)));
typedef unsigned u32x2 __attribute__((ext_vector_type(2)));

constexpr int MTOK = 16896, MP = 16384, DM = 1024, NL = 4;
constexpr int SHIFT_W = 1792, INP = 3584, DFF = 2816;
constexpr float ALPHA = 1.6817928305074290f;
constexpr float GN_EPS_A = 64e-5f, RMS_EPS = 1e-5f, LN_EPS = 1e-5f;
constexpr int LDS_BYTES = 139264 + 16;
constexpr int TC = 32;
#define SC_PD 3

enum { I_XP = 0, I_XS, I_SRWKV, I_SSHIFT, I_SGLA, I_SCONV, I_WIN, I_MU, I_W0, I_WLU, I_A0, I_ALU, I_GLU, I_KK, I_KA, I_RK, I_LNXG, I_LNXB,
       I_VB, I_VD, I_VU, I_FUP, I_FB, I_NG, I_WOUT, I_LN1G, I_LN1B, I_WUP, I_CW, I_CB, I_WDOWN, I_LN2G, I_LN2B };

constexpr size_t O_Y = 0;
constexpr size_t O_RWKV_P = (size_t)MTOK * DM;
constexpr size_t O_RWKV_S = O_RWKV_P + (size_t)4 * 8 * 8 * 4096;
constexpr size_t O_SHIFT_P = O_RWKV_S + (size_t)4 * 128 * 8 * 4096;
constexpr size_t O_SHIFT_S = O_SHIFT_P + (size_t)4 * 8 * 1792;
constexpr size_t O_GLA_P = O_SHIFT_S + (size_t)4 * 128 * 1792;
constexpr size_t O_GLA_S = O_GLA_P + (size_t)4 * 8 * 4 * 8192;
constexpr size_t O_CONV_P = O_GLA_S + (size_t)4 * 128 * 4 * 8192;
constexpr size_t O_CONV_S = O_CONV_P + (size_t)4 * 8 * 2 * 2816;
constexpr size_t O_END = O_CONV_S + (size_t)4 * 128 * 2 * 2816;

constexpr size_t W_WIN = 0;
constexpr size_t W_WOUT = W_WIN + (size_t)INP * 1024 * 2;
constexpr size_t W_WUP = W_WOUT + (size_t)1024 * 1024 * 2;
constexpr size_t W_WDOWN = W_WUP + (size_t)5632 * 1024 * 2;
constexpr size_t W_WLT = W_WDOWN + (size_t)1024 * 2816 * 2;
constexpr size_t W_ALT = W_WLT + 512 * 64 * 2;
constexpr size_t W_GLT = W_ALT + 512 * 64 * 2;
constexpr size_t W_V1T = W_GLT + 512 * 128 * 2;
constexpr size_t W_V2T = W_V1T + 32 * 512 * 2;
constexpr size_t W_FT = W_V2T + 512 * 32 * 2;
constexpr size_t W_XB = W_FT + 256 * 32 * 2;
constexpr size_t W_VFIRST = W_XB + (size_t)MTOK * 1024 * 2;
constexpr size_t W_BUFB = W_VFIRST + (size_t)MTOK * 512 * 2;
constexpr size_t W_R = W_BUFB + (size_t)MTOK * 1024 * 4;
constexpr size_t W_PROJA = W_R;
constexpr size_t W_PROJB = W_PROJA + (size_t)MTOK * 1792 * 2;
constexpr size_t W_D8 = W_PROJB + (size_t)MTOK * 1792 * 2;
constexpr size_t W_VBUF = W_D8 + (size_t)MTOK * 512 * 4;
constexpr size_t W_GBUF = W_VBUF + (size_t)MTOK * 512 * 2;
constexpr size_t W_DEC = W_GBUF + (size_t)MTOK * 512 * 2;
constexpr size_t W_RK = W_DEC + (size_t)MTOK * 256 * 4;
constexpr size_t W_END1 = W_RK + (size_t)MTOK * 8 * 4;
constexpr size_t W_GATE = W_R;
constexpr size_t W_VAL = W_GATE + (size_t)MTOK * 2816 * 2;
constexpr size_t W_END2 = W_VAL + (size_t)MTOK * 2816 * 2;
constexpr size_t W_END = W_END1 > W_END2 ? W_END1 : W_END2;
constexpr size_t W_BAR = (W_END + 255) / 256 * 256;
constexpr size_t W_TOTAL = W_BAR + 16384;
constexpr size_t W_OBUFA = W_PROJA;
constexpr size_t W_OBUFB = W_PROJA + (size_t)MTOK * 512 * 2;

struct Params { const float* in[33]; float* out; unsigned char* ws; };
typedef const Params __attribute__((address_space(4)))* KP;
__device__ __forceinline__ KP kparams() { unsigned long long k = (unsigned long long)__builtin_amdgcn_kernarg_segment_ptr(); asm volatile("" : "+s"(k)); return (KP)k; }

typedef __bf16 bf16v2 __attribute__((ext_vector_type(2)));
__device__ __forceinline__ unsigned cvt_pk_bf16(float lo, float hi) { const f32x2 v = (f32x2){lo, hi}; const bf16v2 b = __builtin_convertvector(v, bf16v2); return __builtin_bit_cast(unsigned, b); }
__device__ __forceinline__ float bflo(u32 w) { return __uint_as_float(w << 16); }
__device__ __forceinline__ float bfhi(u32 w) { return __uint_as_float(w & 0xffff0000u); }
__device__ __forceinline__ f32x4 ld_bf4(const u16* p) { const u32x2 w = *(const u32x2*)p; return (f32x4){bflo(w.x), bfhi(w.x), bflo(w.y), bfhi(w.y)}; }
__device__ __forceinline__ unsigned cvt_pk_bf16_asm(float lo, float hi) { unsigned r; asm volatile("v_cvt_pk_bf16_f32 %0, %1, %2" : "=v"(r) : "v"(lo), "v"(hi)); return r; }
__device__ __forceinline__ void st_bf4_asm(u16* p, f32x4 v) { u32x2 w; w.x = cvt_pk_bf16_asm(v[0], v[1]); w.y = cvt_pk_bf16_asm(v[2], v[3]); *(u32x2*)p = w; }
__device__ __forceinline__ void st_bf4(u16* p, f32x4 v) { u32x2 w; w.x = cvt_pk_bf16(v[0], v[1]); w.y = cvt_pk_bf16(v[2], v[3]); *(u32x2*)p = w; }
__device__ __forceinline__ float sigmoidf_(float x) { return __builtin_amdgcn_rcpf(1.0f + __expf(-x)); }
__device__ __forceinline__ float tanhf_(float x) { return 1.0f - 2.0f * __builtin_amdgcn_rcpf(1.0f + __expf(2.0f * x)); }
__device__ __forceinline__ float softplusf_(float x) { return fmaxf(x, 0.f) + __logf(1.0f + __expf(-fabsf(x))); }
template <int CTRL> __device__ __forceinline__ float dppf(float x) { return __builtin_bit_cast(float, __builtin_amdgcn_update_dpp(0, __builtin_bit_cast(int, x), CTRL, 0xF, 0xF, true)); }
__device__ __forceinline__ float dot4pk(f32x4 a, f32x4 b) { f32x2 p = (f32x2){a[0], a[1]} * (f32x2){b[0], b[1]}; p = (f32x2){a[2], a[3]} * (f32x2){b[2], b[3]} + p; return p.x + p.y; }
__device__ __forceinline__ float red16(float x) { x += dppf<0xB1>(x); x += dppf<0x4E>(x); x += dppf<0x141>(x); x += dppf<0x140>(x); return x; }

__device__ __forceinline__ int opaque_tid() { int t = threadIdx.x; asm volatile("" : "+v"(t)); return t; }
__device__ __forceinline__ int opaque_bid() { int b = blockIdx.x; asm volatile("" : "+s"(b)); return b; }

namespace pg8 {
constexpr int BM = 256, BK = 64, HALF = 128, HTB = HALF * BK * 2, STAGE_BYTES = 8 * HTB, NXCD = 8, WGM = 4;
__host__ __device__ __forceinline__ int lds_byte(int r, int c) { const int st = (r >> 4) * 2 + (c >> 5), rr = r & 15, cc = c & 31, ob = rr * 64 + cc * 2; return st * 1024 + (ob ^ (((ob >> 9) & 1) << 5)); }
__host__ __device__ __forceinline__ void stage_rc(int b, int& R, int& C) { const int st = b / 1024, sb = b % 1024, swz = sb ^ (((sb >> 9) & 1) << 5); R = (st >> 1) * 16 + swz / 64; C = (st & 1) * 32 + (swz % 64) / 2; }
struct Unit { int pm, pn; };
struct Gemm { const bf16_t* A; const bf16_t* Bt; int M, N, K; };
struct StaticOrder {
    int nM, nN, nwg, G, c;
    __host__ __device__ void init(int M, int N, int G_, int c_) { nM = M / BM; nN = N / BM; nwg = nM * nN; G = G_; c = c_; }
    __host__ __device__ bool next(int i, Unit& u) const {
        const long L = (long)i * G + c; if (L >= nwg) return false;
        int wgid = (int)L; { const int q = nwg / NXCD, r = nwg % NXCD, xcd = wgid % NXCD, off = wgid / NXCD; wgid = (xcd < r ? xcd * (q + 1) : r * (q + 1) + (xcd - r) * q) + off; }
        const int nig = WGM * nN, gid = wgid / nig, fm = gid * WGM, gsz = (nM - fm) < WGM ? (nM - fm) : WGM;
        u.pm = fm + ((wgid % nig) % gsz); u.pn = (wgid % nig) / gsz; return true;
    }
};

template <class Epi>
__device__ __forceinline__ void gemm_phase(PG8_LAS unsigned char* lds, const Gemm g, const StaticOrder& S, const Epi& E) {
    const int tid = opaque_tid(), wid = __builtin_amdgcn_readfirstlane(tid >> 6), lane = tid & 63, wr = wid >> 2, wc = wid & 3, fr = lane & 15, fq = lane >> 4;
    const int K = g.K, nt = K / BK;
    unsigned voffA[2], voffB[2];
#pragma unroll
    for (int i = 0; i < 2; ++i) { int R, C; stage_rc(tid * 16 + i * 8192, R, C); voffA[i] = (unsigned)(R * K + C) * 2u; voffB[i] = voffA[i]; }
    const size_t kstep = (size_t)(BK * 2);
    const size_t hstep = (size_t)HALF * K * 2;
    const size_t tstep = 2 * hstep;
    const unsigned ldsw = (unsigned)wid * 1024u;
    const int aoff = lds_byte(wr * 64 + fr, fq * 8), boff = lds_byte(wc * 32 + fr, fq * 8);
#define PG8_SA(b, h) (((b) * 2 + (h)) * HTB)
#define PG8_SB(b, h) ((4 + (b) * 2 + (h)) * HTB)
#define PG8_STAGE(bufoff, gbase, voff) do { _Pragma("unroll") for (int _i = 0; _i < 2; ++_i) \
        __builtin_amdgcn_global_load_lds((const unsigned*)((const char*)(gbase) + (voff)[_i]), (PG8_LAS unsigned*)(lds + (bufoff) + ldsw + _i * 8192), 16, 0, 0); } while (0)
#define PG8_LDA(dst, b, h) do { _Pragma("unroll") for (int m = 0; m < 4; ++m) _Pragma("unroll") for (int k = 0; k < 2; ++k) dst[m][k] = *(const PG8_LAS bf16x8*)(lds + PG8_SA(b, h) + aoff + m * 2048 + k * 1024); } while (0)
#define PG8_LDB(dst, b, h) do { _Pragma("unroll") for (int n = 0; n < 2; ++n) _Pragma("unroll") for (int k = 0; k < 2; ++k) dst[n][k] = *(const PG8_LAS bf16x8*)(lds + PG8_SB(b, h) + boff + n * 2048 + k * 1024); } while (0)
#define PG8_MMA(ai, bj, At, Bt) do { __builtin_amdgcn_s_setprio(1); _Pragma("unroll") for (int m = 0; m < 4; ++m) _Pragma("unroll") for (int n = 0; n < 2; ++n) _Pragma("unroll") for (int k = 0; k < 2; ++k) \
        acc[ai][bj][m][n] = __builtin_amdgcn_mfma_f32_16x16x32_bf16(Bt[n][k], At[m][k], acc[ai][bj][m][n], 0, 0, 0); __builtin_amdgcn_s_setprio(0); } while (0)
#define PG8_WAIT_V(n) asm volatile("s_waitcnt vmcnt(" #n ")" ::: "memory")
#define PG8_WAIT_L(n) asm volatile("s_waitcnt lgkmcnt(" #n ")" ::: "memory")
#define PG8_BAR __builtin_amdgcn_s_barrier()
#define PG8_SCHED __builtin_amdgcn_sched_barrier(0)
    Unit cur, nxt; int ui = 0;
    if (!S.next(0, cur)) return;
    f32x4 acc[2][2][4][2];
#pragma unroll
    for (int a = 0; a < 2; ++a)
#pragma unroll
        for (int b = 0; b < 2; ++b)
#pragma unroll
            for (int m = 0; m < 4; ++m)
#pragma unroll
                for (int n = 0; n < 2; ++n) acc[a][b][m][n] = (f32x4){0.f, 0.f, 0.f, 0.f};
    bf16x8 At[4][2], B0[2][2], B1[2][2];
    const char* cA = (const char*)g.A + (size_t)cur.pm * tstep; const char* cB = (const char*)g.Bt + (size_t)cur.pn * tstep;
    PG8_STAGE(PG8_SB(0, 0), cB, voffB); PG8_STAGE(PG8_SA(0, 0), cA, voffA); PG8_STAGE(PG8_SB(0, 1), cB + hstep, voffB); PG8_STAGE(PG8_SA(0, 1), cA + hstep, voffA);
    if (wr == 1) PG8_BAR;
    PG8_WAIT_V(4); PG8_BAR;
    PG8_STAGE(PG8_SB(1, 0), cB + kstep, voffB); PG8_STAGE(PG8_SA(1, 0), cA + kstep, voffA); PG8_STAGE(PG8_SB(1, 1), cB + hstep + kstep, voffB);
    PG8_WAIT_V(6); PG8_BAR;
    for (;;) {
        const bool has_next = S.next(ui + 1, nxt);
        const char* nA = has_next ? (const char*)g.A + (size_t)nxt.pm * tstep : cA; const char* nB = has_next ? (const char*)g.Bt + (size_t)nxt.pn * tstep : cB;
        for (int t = 0; t < nt; t += 2) {
            const bool last = (t == nt - 2);
            const char* a1 = cA + (size_t)(t + 1) * kstep;
            const char* a2 = last ? nA : cA + (size_t)(t + 2) * kstep; const char* b2 = last ? nB : cB + (size_t)(t + 2) * kstep;
            const char* a3 = a2 + kstep; const char* b3 = b2 + kstep;
            PG8_LDB(B0, 0, 0); PG8_SCHED; PG8_LDA(At, 0, 0); PG8_STAGE(PG8_SA(1, 1), a1 + hstep, voffA);
            PG8_WAIT_L(8); PG8_BAR; PG8_WAIT_L(0); PG8_MMA(0, 0, At, B0); PG8_BAR; PG8_SCHED;
            PG8_LDB(B1, 0, 1); PG8_STAGE(PG8_SB(0, 0), b2, voffB);
            PG8_BAR; PG8_WAIT_L(0); PG8_MMA(0, 1, At, B1); PG8_BAR;
            PG8_LDA(At, 0, 1); PG8_STAGE(PG8_SA(0, 0), a2, voffA);
            PG8_BAR; PG8_WAIT_L(0); PG8_MMA(1, 0, At, B0); PG8_BAR; PG8_SCHED;
            PG8_STAGE(PG8_SB(0, 1), b2 + hstep, voffB);
            PG8_WAIT_V(6); PG8_BAR; PG8_MMA(1, 1, At, B1); PG8_BAR;
            PG8_LDB(B0, 1, 0); PG8_SCHED; PG8_LDA(At, 1, 0); PG8_STAGE(PG8_SA(0, 1), a2 + hstep, voffA);
            PG8_WAIT_L(8); PG8_BAR; PG8_WAIT_L(0); PG8_MMA(0, 0, At, B0); PG8_BAR; PG8_SCHED;
            PG8_LDB(B1, 1, 1); PG8_STAGE(PG8_SB(1, 0), b3, voffB);
            PG8_BAR; PG8_WAIT_L(0); PG8_MMA(0, 1, At, B1); PG8_BAR;
            PG8_LDA(At, 1, 1); PG8_STAGE(PG8_SA(1, 0), a3, voffA);
            PG8_BAR; PG8_WAIT_L(0); PG8_MMA(1, 0, At, B0); PG8_BAR; PG8_SCHED;
            PG8_STAGE(PG8_SB(1, 1), b3 + hstep, voffB);
            PG8_WAIT_V(6); PG8_BAR; PG8_MMA(1, 1, At, B1); PG8_BAR;
        }
        asm volatile("s_nop 7\n\ts_nop 7\n\ts_nop 7" ::: "memory");
        E(acc, cur, wr, wc, fr, fq);
        if (!has_next) break;
#pragma unroll
        for (int a = 0; a < 2; ++a)
#pragma unroll
            for (int b = 0; b < 2; ++b)
#pragma unroll
                for (int m = 0; m < 4; ++m)
#pragma unroll
                    for (int n = 0; n < 2; ++n) acc[a][b][m][n] = (f32x4){0.f, 0.f, 0.f, 0.f};
        cur = nxt; cA = nA; cB = nB; ++ui;
    }
    PG8_WAIT_V(0);
    if (wr == 0) PG8_BAR;
    PG8_BAR;
#undef PG8_SA
#undef PG8_SB
#undef PG8_STAGE
#undef PG8_LDA
#undef PG8_LDB
#undef PG8_MMA
#undef PG8_WAIT_V
#undef PG8_WAIT_L
#undef PG8_BAR
#undef PG8_SCHED
}
}
using pg8::Unit;

struct EpiProj {
    u16* projA; u16* projB; float* shift_p; float* shift_s;
    __device__ __forceinline__ void operator()(const f32x4 (&acc)[2][2][4][2], const Unit& u, int wr, int wc, int fr, int fq) const {
        const int row0 = u.pm * 256 + wr * 64 + fr;
        const bool isA = u.pn < 7;
        u16* base = isA ? projA : projB;
        const int colt = (isA ? u.pn : u.pn - 7) * 256 + wc * 32 + 4 * fq;
#pragma unroll
        for (int ai = 0; ai < 2; ++ai)
#pragma unroll
            for (int m = 0; m < 4; ++m) {
                const int row = row0 + ai * 128 + m * 16;
                u16* rowp = base + (size_t)row * 1792 + colt;
#pragma unroll
                for (int bj = 0; bj < 2; ++bj)
#pragma unroll
                    for (int n = 0; n < 2; ++n) st_bf4_asm(rowp + bj * 128 + n * 16, acc[ai][bj][m][n]);
                if (isA) {
                    float* dst = nullptr;
                    if (row < MP) { if ((row & 2047) == 2047) dst = shift_p + (size_t)(row >> 11) * 1792; }
                    else { const int r = row - MP; if ((r & 3) == 3) dst = shift_s + (size_t)(r >> 2) * 1792; }
                    if (dst) {
#pragma unroll
                        for (int bj = 0; bj < 2; ++bj)
#pragma unroll
                            for (int n = 0; n < 2; ++n) *(f32x4*)(dst + colt + bj * 128 + n * 16) = acc[ai][bj][m][n];
                    }
                }
            }
    }
};
struct EpiResid {
    const float* base; float* out;
    __device__ __forceinline__ void operator()(const f32x4 (&acc)[2][2][4][2], const Unit& u, int wr, int wc, int fr, int fq) const {
        const int row0 = u.pm * 256 + wr * 64 + fr, col0 = u.pn * 256 + wc * 32 + 4 * fq;
#pragma unroll
        for (int ai = 0; ai < 2; ++ai)
#pragma unroll
            for (int m = 0; m < 4; ++m) {
                const size_t off = (size_t)(row0 + ai * 128 + m * 16) * 1024 + col0;
#pragma unroll
                for (int bj = 0; bj < 2; ++bj)
#pragma unroll
                    for (int n = 0; n < 2; ++n) { const f32x4 b = *(const f32x4*)(base + off + bj * 128 + n * 16); *(f32x4*)(out + off + bj * 128 + n * 16) = b * ALPHA + acc[ai][bj][m][n]; }
            }
    }
};
struct EpiResidB {
    const u16* base; float* out;
    __device__ __forceinline__ void operator()(const f32x4 (&acc)[2][2][4][2], const Unit& u, int wr, int wc, int fr, int fq) const {
        const int row0 = u.pm * 256 + wr * 64 + fr, col0 = u.pn * 256 + wc * 32 + 4 * fq;
#pragma unroll
        for (int ai = 0; ai < 2; ++ai)
#pragma unroll
            for (int m = 0; m < 4; ++m) {
                const size_t off = (size_t)(row0 + ai * 128 + m * 16) * 1024 + col0;
#pragma unroll
                for (int bj = 0; bj < 2; ++bj)
#pragma unroll
                    for (int n = 0; n < 2; ++n) { const f32x4 b = ld_bf4(base + off + bj * 128 + n * 16); *(f32x4*)(out + off + bj * 128 + n * 16) = b * ALPHA + acc[ai][bj][m][n]; }
            }
    }
};
struct EpiUp {
    u16* gate; u16* val; float* conv_p; float* conv_s;
    __device__ __forceinline__ void operator()(const f32x4 (&acc)[2][2][4][2], const Unit& u, int wr, int wc, int fr, int fq) const {
        const int row0 = u.pm * 256 + wr * 64 + fr;
        const bool isG = u.pn < 11;
        u16* base = isG ? gate : val;
        const int colt = (isG ? u.pn : u.pn - 11) * 256 + wc * 32 + 4 * fq;
#pragma unroll
        for (int ai = 0; ai < 2; ++ai)
#pragma unroll
            for (int m = 0; m < 4; ++m) {
                const int row = row0 + ai * 128 + m * 16;
                u16* rowp = base + (size_t)row * DFF + colt;
#pragma unroll
                for (int bj = 0; bj < 2; ++bj)
#pragma unroll
                    for (int n = 0; n < 2; ++n) st_bf4_asm(rowp + bj * 128 + n * 16, acc[ai][bj][m][n]);
                if (isG) {
                    float* dst = nullptr;
                    if (row < MP) { const int t = row & 2047; if (t >= 2046) dst = conv_p + (size_t)((row >> 11) * 2 + (t - 2046)) * DFF; }
                    else { const int r = row - MP, t = r & 3; if (t >= 2) dst = conv_s + (size_t)((r >> 2) * 2 + (t - 2)) * DFF; }
                    if (dst) {
#pragma unroll
                        for (int bj = 0; bj < 2; ++bj)
#pragma unroll
                            for (int n = 0; n < 2; ++n) *(f32x4*)(dst + colt + bj * 128 + n * 16) = acc[ai][bj][m][n];
                    }
                }
            }
    }
};

template <bool BASE_BF16>
__device__ void small_gemm_resid(const u16* __restrict__ A, const u16* __restrict__ Bt, int K, const void* __restrict__ base, float* __restrict__ out, PG8_LAS unsigned char* lds) {
    const int t = opaque_tid(), wid = t >> 6, lane = t & 63, fr = lane & 15, fq = lane >> 4;
    const int kw = K >> 3, nks = kw >> 5;
    for (int tile = opaque_bid(); tile < 256; tile += gridDim.x) {
        const int r0 = MP + (tile >> 4) * 32, c0 = (tile & 15) * 64;
        f32x4 acc[2][4];
#pragma unroll
        for (int mi = 0; mi < 2; ++mi)
#pragma unroll
            for (int ni = 0; ni < 4; ++ni) acc[mi][ni] = (f32x4){0.f, 0.f, 0.f, 0.f};
#pragma unroll 2
        for (int ks = 0; ks < nks; ++ks) {
            const int k = wid * kw + ks * 32 + fq * 8;
            bf16x8 a[2], b[4];
#pragma unroll
            for (int mi = 0; mi < 2; ++mi) a[mi] = *(const bf16x8*)(A + (size_t)(r0 + mi * 16 + fr) * K + k);
#pragma unroll
            for (int ni = 0; ni < 4; ++ni) b[ni] = *(const bf16x8*)(Bt + (size_t)(c0 + ni * 16 + fr) * K + k);
#pragma unroll
            for (int mi = 0; mi < 2; ++mi)
#pragma unroll
                for (int ni = 0; ni < 4; ++ni) acc[mi][ni] = __builtin_amdgcn_mfma_f32_16x16x32_bf16(b[ni], a[mi], acc[mi][ni], 0, 0, 0);
        }
        PG8_LAS f32x4* red = (PG8_LAS f32x4*)lds;
#pragma unroll
        for (int mi = 0; mi < 2; ++mi)
#pragma unroll
            for (int ni = 0; ni < 4; ++ni) red[(wid * 8 + mi * 4 + ni) * 64 + lane] = acc[mi][ni];
        __syncthreads();
        {
            f32x4 sum = (f32x4){0.f, 0.f, 0.f, 0.f};
#pragma unroll
            for (int w = 0; w < 8; ++w) sum += red[(w * 8 + wid) * 64 + lane];
            const int mi = wid >> 2, ni = wid & 3;
            const size_t off = (size_t)(r0 + mi * 16 + fr) * 1024 + c0 + ni * 16 + 4 * fq;
            const f32x4 bs = BASE_BF16 ? ld_bf4((const u16*)base + off) : *(const f32x4*)((const float*)base + off);
            *(f32x4*)(out + off) = bs * ALPHA + sum;
        }
        __syncthreads();
    }
}

__device__ __forceinline__ void transpose_tile(const float* __restrict__ src, u16* __restrict__ dst, int K, int N, int nT, int item, float* tile) {
    const int t = opaque_tid();
    const int kt = item / nT, ntile = item - kt * nT, k0 = kt * 64, n0 = ntile * 64;
    { const int row = t >> 3, c8 = (t & 7) * 8;
      f32x4 a = (f32x4){0.f, 0.f, 0.f, 0.f}, b = a;
      if (n0 + c8 < N) { const float* sp = src + (size_t)(k0 + row) * N + n0 + c8; a = *(const f32x4*)sp; b = *(const f32x4*)(sp + 4); }
      float* tp = tile + row * 65 + c8;
      tp[0] = a[0]; tp[1] = a[1]; tp[2] = a[2]; tp[3] = a[3]; tp[4] = b[0]; tp[5] = b[1]; tp[6] = b[2]; tp[7] = b[3]; }
    __syncthreads();
    { const int n = t >> 3, k8 = (t & 7) * 8;
      float v[8];
#pragma unroll
      for (int j = 0; j < 8; ++j) v[j] = tile[(k8 + j) * 65 + n];
      u32x4 w; w.x = cvt_pk_bf16(v[0], v[1]); w.y = cvt_pk_bf16(v[2], v[3]); w.z = cvt_pk_bf16(v[4], v[5]); w.w = cvt_pk_bf16(v[6], v[7]);
      *(u32x4*)(dst + (size_t)(n0 + n) * K + k0 + k8) = w; }
    __syncthreads();
}
__device__ __forceinline__ void small_transpose(const float* __restrict__ src, u16* __restrict__ dst, int K, int N, int Kpad, size_t gt, size_t nth) {
    for (size_t i = gt; i < (size_t)N * Kpad; i += nth) { const int n = (int)(i / Kpad), k = (int)(i - (size_t)n * Kpad); const float v = k < K ? src[(size_t)k * N + n] : 0.f; dst[i] = (u16)(cvt_pk_bf16(v, 0.f) & 0xffffu); }
}
__device__ void convert_phase(KP p, int l, float* tile) {
    unsigned char* ws = p->ws;
    const int bid = opaque_bid();
    const size_t gt = (size_t)bid * 512 + opaque_tid(), nth = (size_t)gridDim.x * 512;
    constexpr int n1 = 16 * 56, n2 = 16 * 16, n3 = 16 * 88, n4 = 44 * 16;
    for (int it = bid; it < n1 + n2 + n3 + n4; it += gridDim.x) {
        if (it < n1) transpose_tile(p->in[I_WIN] + (size_t)l * 1024 * 3344, (u16*)(ws + W_WIN), 1024, 3344, 56, it, tile);
        else if (it < n1 + n2) transpose_tile(p->in[I_WOUT] + (size_t)l * 1024 * 1024, (u16*)(ws + W_WOUT), 1024, 1024, 16, it - n1, tile);
        else if (it < n1 + n2 + n3) transpose_tile(p->in[I_WUP] + (size_t)l * 1024 * 5632, (u16*)(ws + W_WUP), 1024, 5632, 88, it - n1 - n2, tile);
        else transpose_tile(p->in[I_WDOWN] + (size_t)l * 2816 * 1024, (u16*)(ws + W_WDOWN), 2816, 1024, 16, it - n1 - n2 - n3, tile);
    }
    small_transpose(p->in[I_WLU] + (size_t)l * 64 * 512, (u16*)(ws + W_WLT), 64, 512, 64, gt, nth);
    small_transpose(p->in[I_ALU] + (size_t)l * 64 * 512, (u16*)(ws + W_ALT), 64, 512, 64, gt, nth);
    small_transpose(p->in[I_GLU] + (size_t)l * 128 * 512, (u16*)(ws + W_GLT), 128, 512, 128, gt, nth);
    if (l > 0) {
        small_transpose(p->in[I_VD] + (size_t)(l - 1) * 512 * 32, (u16*)(ws + W_V1T), 512, 32, 512, gt, nth);
        small_transpose(p->in[I_VU] + (size_t)(l - 1) * 32 * 512, (u16*)(ws + W_V2T), 32, 512, 32, gt, nth);
    }
    small_transpose(p->in[I_FUP] + (size_t)l * 16 * 256, (u16*)(ws + W_FT), 16, 256, 32, gt, nth);
    if (l == 0) {
        u16* xb = (u16*)(ws + W_XB);
        for (size_t i = gt; i < (size_t)MTOK * 256; i += nth) {
            const size_t e = i * 4;
            const f32x4 v = e < (size_t)MP * 1024 ? *(const f32x4*)(p->in[I_XP] + e) : *(const f32x4*)(p->in[I_XS] + (e - (size_t)MP * 1024));
            st_bf4(xb + e, v);
        }
    }
}

template <bool WRITE_F32>
__device__ void ln_phase(float* Y, u16* xb, const float* __restrict__ g, const float* __restrict__ b) {
    const int tt_ = opaque_tid();
    const int lane = tt_ & 63, gw = opaque_bid() * 8 + (tt_ >> 6), nw = gridDim.x * 8;
    f32x4 gv[4], bv[4];
#pragma unroll
    for (int i = 0; i < 4; ++i) { gv[i] = *(const f32x4*)(g + i * 256 + lane * 4); bv[i] = *(const f32x4*)(b + i * 256 + lane * 4); }
    for (int row = gw; row < MTOK; row += nw) {
        float* yp = Y + (size_t)row * 1024 + lane * 4;
        f32x4 v[4]; float s = 0.f;
#pragma unroll
        for (int i = 0; i < 4; ++i) { v[i] = __builtin_nontemporal_load((const f32x4*)(yp + i * 256)); s += (v[i][0] + v[i][1]) + (v[i][2] + v[i][3]); }
#pragma unroll
        for (int o = 32; o >= 1; o >>= 1) s += __shfl_xor(s, o);
        const float mu = s * (1.0f / 1024.0f); float q = 0.f;
#pragma unroll
        for (int i = 0; i < 4; ++i) { const f32x4 d = v[i] - mu; q += (d[0] * d[0] + d[1] * d[1]) + (d[2] * d[2] + d[3] * d[3]); }
#pragma unroll
        for (int o = 32; o >= 1; o >>= 1) q += __shfl_xor(q, o);
        const float rstd = rsqrtf(q * (1.0f / 1024.0f) + LN_EPS);
#pragma unroll
        for (int i = 0; i < 4; ++i) { const f32x4 o = (v[i] - mu) * rstd * gv[i] + bv[i]; if (WRITE_F32) __builtin_nontemporal_store(o, (f32x4*)(yp + i * 256)); st_bf4(xb + (size_t)row * 1024 + i * 256 + lane * 4, o); }
    }
}

__device__ __forceinline__ void unpack8(const u32x4 w, float* f) { f[0] = bflo(w.x); f[1] = bfhi(w.x); f[2] = bflo(w.y); f[3] = bfhi(w.y); f[4] = bflo(w.z); f[5] = bfhi(w.z); f[6] = bflo(w.w); f[7] = bfhi(w.w); }
__device__ __forceinline__ float gelu_as(float v) {
    const float av = fabsf(v), t = __builtin_amdgcn_rcpf(av * 0.2316418882f + 1.0f);
    float q = t * 0.5307027145f + (-0.7265760135f); q = q * t + 0.7107068705f; q = q * t + (-0.142248368f); q = q * t + 0.127414796f; q = q * t;
    const float e = __builtin_amdgcn_exp2f((v * v) * (-0.72134752044f));
    const float m = v * (q * e);
    return v < 0.f ? m : v - m;
}
__device__ void convglu_phase(const u16* __restrict__ gate, u16* val, const float* __restrict__ past  , const float* __restrict__ cw, const float* __restrict__ cb) {
    const int b0_ = opaque_bid(), bx_ = (gridDim.x == 256) ? (((b0_ & 7) << 5) | (b0_ >> 3)) : b0_;
    const size_t gt = (size_t)bx_ * 512 + opaque_tid(), nth = (size_t)gridDim.x * 512;
    for (size_t idx = gt; idx < (size_t)(MTOK / 4) * 352; idx += nth) {
        const int rg = (int)(idx / 352), c = (int)(idx - (size_t)rg * 352) * 8, row0 = rg * 4;
        bool first; const float* pst = nullptr;
        if (row0 < MP) first = (row0 & 2047) == 0; else { first = true; pst = past + (size_t)((row0 - MP) >> 2) * 2 * DFF; }
        float w0[8], w1[8], w2[8], bb[8], gm2[8], gm1[8];
#pragma unroll
        for (int j = 0; j < 8; ++j) { w0[j] = cw[c + j]; w1[j] = cw[DFF + c + j]; w2[j] = cw[2 * DFF + c + j]; bb[j] = cb[c + j]; }
        if (!first) { unpack8(*(const u32x4*)(gate + (size_t)(row0 - 2) * DFF + c), gm2); unpack8(*(const u32x4*)(gate + (size_t)(row0 - 1) * DFF + c), gm1); }
        else {
#pragma unroll
            for (int j = 0; j < 8; ++j) { gm2[j] = pst ? pst[c + j] : 0.f; gm1[j] = pst ? pst[DFF + c + j] : 0.f; } }
#pragma unroll
        for (int r = 0; r < 4; ++r) {
            float g0[8], vv[8], h[8];
            unpack8(*(const u32x4*)(gate + (size_t)(row0 + r) * DFF + c), g0);
            unpack8(__builtin_nontemporal_load((const u32x4*)(val + (size_t)(row0 + r) * DFF + c)), vv);
#pragma unroll
            for (int j = 0; j < 8; ++j) { const float a = bb[j] + gm2[j] * w0[j] + gm1[j] * w1[j] + g0[j] * w2[j]; h[j] = gelu_as(a) * vv[j]; gm2[j] = gm1[j]; gm1[j] = g0[j]; }
            u32x4 w; w.x = cvt_pk_bf16(h[0], h[1]); w.y = cvt_pk_bf16(h[2], h[3]); w.z = cvt_pk_bf16(h[4], h[5]); w.w = cvt_pk_bf16(h[6], h[7]);
            *(u32x4*)(val + (size_t)(row0 + r) * DFF + c) = w;
        }
    }
}

struct PrepCtx {
    const u16* projA; const u16* projB; const float* mu; const float* sshift  ;
};
__device__ __forceinline__ f32x4 xs4(const PrepCtx& c, int i, int col) {
    const f32x4 cur = ld_bf4(c.projA + (size_t)i * 1792 + col);
    f32x4 prev;
    bool first; int b = 0;
    if (i < MP) first = (i & 2047) == 0; else { const int r = i - MP; first = (r & 3) == 0; b = r >> 2; }
    if (!first) prev = ld_bf4(c.projA + (size_t)(i - 1) * 1792 + col);
    else if (i < MP) prev = (f32x4){0.f, 0.f, 0.f, 0.f};
    else prev = *(const f32x4*)(c.sshift + (size_t)b * 1792 + col);
    const f32x4 m = *(const f32x4*)(c.mu + col);
    return cur + (prev - cur) * m;
}
__device__ __forceinline__ bf16x8 ldg_frag(const u16* p) { return *(const bf16x8*)p; }

__device__ void prep_phase(KP p, int l, PG8_LAS unsigned char* lds) {
    unsigned char* ws = p->ws;
    PrepCtx c; c.projA = (const u16*)(ws + W_PROJA); c.projB = (const u16*)(ws + W_PROJB); c.mu = p->in[I_MU] + (size_t)l * 1792; c.sshift = p->in[I_SSHIFT] + (size_t)l * 128 * 1792;
    const u16* wlT = (const u16*)(ws + W_WLT); const u16* alT = (const u16*)(ws + W_ALT); const u16* glT = (const u16*)(ws + W_GLT);
    const u16* v1T = (const u16*)(ws + W_V1T); const u16* v2T = (const u16*)(ws + W_V2T); const u16* fT = (const u16*)(ws + W_FT);
    u32x4* A16 = (u32x4*)(ws + W_BUFB); float* D8 = (float*)(ws + W_D8); u16* vbuf = (u16*)(ws + W_VBUF); u16* gbuf = (u16*)(ws + W_GBUF);
    float* decb = (float*)(ws + W_DEC); float* rkb = (float*)(ws + W_RK); u16* vfirst = (u16*)(ws + W_VFIRST);
    const float* w0 = p->in[I_W0] + l * 512; const float* a0 = p->in[I_A0] + l * 512; const float* k_k = p->in[I_KK] + l * 512; const float* k_a = p->in[I_KA] + l * 512;
    const float* r_k = p->in[I_RK] + l * 512; const float* vb = l > 0 ? p->in[I_VB] + (l - 1) * 512 : nullptr; const float* fbias = p->in[I_FB] + l * 256;
    constexpr int S_TW = 144, S_AL = 144, S_SG = 272, S_XV = 1040, S_FL = 80, S_PP = 80;
    constexpr int O_TW = 0, O_AL = O_TW + 16 * S_TW, O_SG = O_AL + 16 * S_AL, O_XV = O_SG + 16 * S_SG, O_FL = O_XV + 16 * S_XV, O_PP = O_FL + 16 * S_FL;
    const int t = opaque_tid(), wid = t >> 6, lane = t & 63, fr = lane & 15, fq = lane >> 4, h = wid;
    for (int blk = opaque_bid(); blk < MTOK / 16; blk += gridDim.x) {
        const int i0 = blk * 16;
#pragma unroll 1
        for (int q = 0; q < 6; ++q) {
            const int op = t + 512 * q, r = op / 192, g4 = op - r * 192, col = 1024 + 4 * g4;
            f32x4 x = xs4(c, i0 + r, col);
            int off;
            if (col < 1536) off = O_XV + r * S_XV + (col - 1024) * 2;
            else if (col < 1600) { off = O_TW + r * S_TW + (col - 1536) * 2; x = (f32x4){tanhf_(x[0]), tanhf_(x[1]), tanhf_(x[2]), tanhf_(x[3])}; }
            else if (col < 1664) off = O_AL + r * S_AL + (col - 1600) * 2;
            else { off = O_SG + r * S_SG + (col - 1664) * 2; x = (f32x4){sigmoidf_(x[0]), sigmoidf_(x[1]), sigmoidf_(x[2]), sigmoidf_(x[3])}; }
            u32x2 w; w.x = cvt_pk_bf16(x[0], x[1]); w.y = cvt_pk_bf16(x[2], x[3]);
            *(PG8_LAS u32x2*)(lds + off) = w;
        }
        if (t < 128) { const int r = t >> 3, c4 = (t & 7) * 4; u32x2 w = (u32x2){0u, 0u}; if (c4 < 16) w = *(const u32x2*)(c.projB + (size_t)(i0 + r) * 1792 + 1536 + c4); *(PG8_LAS u32x2*)(lds + O_FL + r * S_FL + c4 * 2) = w; }
        __syncthreads();
        bf16x8 pfrag = (bf16x8){0, 0, 0, 0, 0, 0, 0, 0};
        if (l > 0) {
            f32x4 accP0 = (f32x4){0.f, 0.f, 0.f, 0.f}, accP1 = accP0;
#pragma unroll 4
            for (int ks = 0; ks < 16; ++ks) {
                const bf16x8 af = *(const PG8_LAS bf16x8*)(lds + O_XV + fr * S_XV + (ks * 32 + fq * 8) * 2);
                accP0 = __builtin_amdgcn_mfma_f32_16x16x32_bf16(ldg_frag(v1T + (size_t)fr * 512 + ks * 32 + fq * 8), af, accP0, 0, 0, 0);
                accP1 = __builtin_amdgcn_mfma_f32_16x16x32_bf16(ldg_frag(v1T + (size_t)(16 + fr) * 512 + ks * 32 + fq * 8), af, accP1, 0, 0, 0);
            }
            const u32 w0_ = cvt_pk_bf16(accP0[0], accP0[1]), w1_ = cvt_pk_bf16(accP0[2], accP0[3]), w2_ = cvt_pk_bf16(accP1[0], accP1[1]), w3_ = cvt_pk_bf16(accP1[2], accP1[3]);
            const u32x4 pw = (u32x4){w0_, w1_, w2_, w3_};
            pfrag = __builtin_bit_cast(bf16x8, pw);
        }
        const int i = i0 + fr;
        float ss = 0.f;
#pragma unroll
        for (int n = 0; n < 4; ++n) { const int cb_ = h * 64 + 16 * n + 4 * fq; const f32x4 xk = xs4(c, i, 512 + cb_) * *(const f32x4*)(k_k + cb_); ss += (xk[0] * xk[0] + xk[1] * xk[1]) + (xk[2] * xk[2] + xk[3] * xk[3]); }
        ss += __shfl_xor(ss, 16); ss += __shfl_xor(ss, 32);
        const float inorm = rsqrtf(fmaxf(ss, 1e-24f));
        float rks = 0.f;
#pragma unroll 2
        for (int n = 0; n < 4; ++n) {
            const int cn = h * 64 + 16 * n, cb_ = cn + 4 * fq;
            f32x4 aW = (f32x4){0.f, 0.f, 0.f, 0.f}, aA = aW, aG = aW, aV = aW;
#pragma unroll
            for (int ks = 0; ks < 2; ++ks) {
                aW = __builtin_amdgcn_mfma_f32_16x16x32_bf16(ldg_frag(wlT + (size_t)(cn + fr) * 64 + ks * 32 + fq * 8), *(const PG8_LAS bf16x8*)(lds + O_TW + fr * S_TW + (ks * 32 + fq * 8) * 2), aW, 0, 0, 0);
                aA = __builtin_amdgcn_mfma_f32_16x16x32_bf16(ldg_frag(alT + (size_t)(cn + fr) * 64 + ks * 32 + fq * 8), *(const PG8_LAS bf16x8*)(lds + O_AL + fr * S_AL + (ks * 32 + fq * 8) * 2), aA, 0, 0, 0);
            }
#pragma unroll
            for (int ks = 0; ks < 4; ++ks)
                aG = __builtin_amdgcn_mfma_f32_16x16x32_bf16(ldg_frag(glT + (size_t)(cn + fr) * 128 + ks * 32 + fq * 8), *(const PG8_LAS bf16x8*)(lds + O_SG + fr * S_SG + (ks * 32 + fq * 8) * 2), aG, 0, 0, 0);
            if (l > 0) {
                const u32x2 va = *(const u32x2*)(v2T + (size_t)(cn + fr) * 32 + 4 * fq), vc = *(const u32x2*)(v2T + (size_t)(cn + fr) * 32 + 16 + 4 * fq);
                const u32x4 vw = (u32x4){va.x, va.y, vc.x, vc.y};
                aV = __builtin_amdgcn_mfma_f32_16x16x32_bf16(__builtin_bit_cast(bf16x8, vw), pfrag, aV, 0, 0, 0);
            }
            const f32x4 xr = xs4(c, i, cb_), xk = xs4(c, i, 512 + cb_), xv = xs4(c, i, 1024 + cb_);
            const f32x4 w0v = *(const f32x4*)(w0 + cb_), a0v = *(const f32x4*)(a0 + cb_), kkv = *(const f32x4*)(k_k + cb_), kav = *(const f32x4*)(k_a + cb_), rkv = *(const f32x4*)(r_k + cb_);
            f32x4 vp = xv;
            if (l == 0) st_bf4(vfirst + (size_t)i * 512 + cb_, xv);
            else { const f32x4 vf = ld_bf4(vfirst + (size_t)i * 512 + cb_); const f32x4 vbv = *(const f32x4*)(vb + cb_);
#pragma unroll
                for (int j = 0; j < 4; ++j) vp[j] = xv[j] + (vf[j] - xv[j]) * sigmoidf_(vbv[j] + aV[j]);
            }
            f32x4 dd, kt, kn, bb;
#pragma unroll
            for (int j = 0; j < 4; ++j) {
                const float wv = -softplusf_(-(w0v[j] + aW[j])) - 0.5f;
                dd[j] = __expf(-__expf(wv));
                const float a = sigmoidf_(a0v[j] + aA[j]);
                kn[j] = xk[j] * kkv[j] * inorm;
                kt[j] = xk[j] * (1.0f + (a - 1.0f) * kav[j]);
                bb[j] = kn[j] * a;
                rks += xr[j] * kt[j] * rkv[j];
            }
            const int p0 = 8 * n + 2 * fq;
            u32x4 rec0, rec1;
            rec0.x = cvt_pk_bf16(xr[0], xr[1]); rec0.y = cvt_pk_bf16(kt[0], kt[1]); rec0.z = cvt_pk_bf16(kn[0], kn[1]); rec0.w = cvt_pk_bf16(bb[0], bb[1]);
            rec1.x = cvt_pk_bf16(xr[2], xr[3]); rec1.y = cvt_pk_bf16(kt[2], kt[3]); rec1.z = cvt_pk_bf16(kn[2], kn[3]); rec1.w = cvt_pk_bf16(bb[2], bb[3]);
            u32x4* ap = A16 + ((size_t)i * 8 + h) * 32 + p0;
            ap[0] = rec0; ap[1] = rec1;
            *(f32x4*)(D8 + (size_t)i * 512 + cb_) = dd;
            st_bf4(vbuf + (size_t)i * 512 + cb_, vp);
            st_bf4(gbuf + (size_t)i * 512 + cb_, aG);
        }
        rks += __shfl_xor(rks, 16); rks += __shfl_xor(rks, 32);
        if (fq == 0) rkb[(size_t)i * 8 + h] = rks;
#pragma unroll
        for (int n2 = 0; n2 < 2; ++n2) {
            const int cn = 32 * h + 16 * n2;
            f32x4 aF = (f32x4){0.f, 0.f, 0.f, 0.f};
            aF = __builtin_amdgcn_mfma_f32_16x16x32_bf16(ldg_frag(fT + (size_t)(cn + fr) * 32 + fq * 8), *(const PG8_LAS bf16x8*)(lds + O_FL + fr * S_FL + (fq * 8) * 2), aF, 0, 0, 0);
            const f32x4 fb = *(const f32x4*)(fbias + cn + 4 * fq);
            f32x4 dc;
#pragma unroll
            for (int j = 0; j < 4; ++j) { const float z = aF[j] + fb[j]; dc[j] = __expf(-softplusf_(-z) * (1.0f / 16.0f)); }
            *(f32x4*)(decb + (size_t)i * 256 + cn + 4 * fq) = dc;
        }
        __syncthreads();
    }
}

struct ScanItem {
    int tok0, T, L;
    int h, q;
    int hg, cgp;
    const float* s0_rwkv; float* so_rwkv;
    const float* s0_gla; float* so_gla;
};
template <int LSEG>
__device__ __forceinline__ void scan_item(KP p, const ScanItem& it, PG8_LAS unsigned char* lds) {
    unsigned char* ws = p->ws;
    const u32x4* A16 = (const u32x4*)(ws + W_BUFB); const float* D8 = (const float*)(ws + W_D8); const u16* vbuf = (const u16*)(ws + W_VBUF);
    const u16* projB = (const u16*)(ws + W_PROJB); const float* decb = (const float*)(ws + W_DEC);
    u16* obufA = (u16*)(ws + W_OBUFA); u16* obufB = (u16*)(ws + W_OBUFB);
    const int t = opaque_tid(), wid = t >> 6, lane = t & 63, kq = lane & 15, rsel = lane >> 4;
    constexpr int BUF = 69632, OR = 0, OKT = 8192, OKN = 16384, OB = 24576, OD = 32768, OVR = 40960, OQ = 43008, OK = 51200, ODC = 59392, OVG = 67584;
    const int nchunk = it.T / TC;
    u32x4 sa0, sa1; f32x4 sd, sdec; u32x2 svr = (u32x2){0u, 0u}, sq, sk;
#define SC_GLOAD(ch_) do { const int tk_ = it.tok0 + (ch_) * TC; \
        { const int i0 = t, i1 = t + 512; sa0 = A16[((size_t)(tk_ + (i0 >> 5)) * 8 + it.h) * 32 + (i0 & 31)]; sa1 = A16[((size_t)(tk_ + (i1 >> 5)) * 8 + it.h) * 32 + (i1 & 31)]; } \
        { const int st = t >> 4, c4 = (t & 15) * 4; sd = *(const f32x4*)(D8 + (size_t)(tk_ + st) * 512 + it.h * 64 + c4); \
          sq = *(const u32x2*)(projB + (size_t)(tk_ + st) * 1792 + it.hg * 64 + c4); sk = *(const u32x2*)(projB + (size_t)(tk_ + st) * 1792 + 256 + it.hg * 64 + c4); \
          sdec = *(const f32x4*)(decb + (size_t)(tk_ + st) * 256 + it.hg * 64 + c4); } \
        if (t < 128) { const int st = t >> 2, c4 = (t & 3) * 4; svr = *(const u32x2*)(vbuf + (size_t)(tk_ + st) * 512 + it.h * 64 + it.q * 16 + c4); } \
        else if (t < 256) { const int tt = t - 128, st = tt >> 2, c4 = (tt & 3) * 4; svr = *(const u32x2*)(projB + (size_t)(tk_ + st) * 1792 + 512 + it.hg * 128 + it.cgp * 16 + c4); } } while (0)
#define SC_LSTORE(buf_) do { PG8_LAS unsigned char* b_ = lds + (buf_) * BUF; \
        { const int i0 = t, i1 = t + 512; \
          { const int st = i0 >> 5, pp = i0 & 31; const int o = (st * 64 + 2 * pp) * 4; \
            *(PG8_LAS f32x2*)(b_ + OR + o) = (f32x2){bflo(sa0.x), bfhi(sa0.x)}; *(PG8_LAS f32x2*)(b_ + OKT + o) = (f32x2){bflo(sa0.y), bfhi(sa0.y)}; \
            *(PG8_LAS f32x2*)(b_ + OKN + o) = (f32x2){bflo(sa0.z), bfhi(sa0.z)}; *(PG8_LAS f32x2*)(b_ + OB + o) = (f32x2){bflo(sa0.w), bfhi(sa0.w)}; } \
          { const int st = i1 >> 5, pp = i1 & 31; const int o = (st * 64 + 2 * pp) * 4; \
            *(PG8_LAS f32x2*)(b_ + OR + o) = (f32x2){bflo(sa1.x), bfhi(sa1.x)}; *(PG8_LAS f32x2*)(b_ + OKT + o) = (f32x2){bflo(sa1.y), bfhi(sa1.y)}; \
            *(PG8_LAS f32x2*)(b_ + OKN + o) = (f32x2){bflo(sa1.z), bfhi(sa1.z)}; *(PG8_LAS f32x2*)(b_ + OB + o) = (f32x2){bflo(sa1.w), bfhi(sa1.w)}; } } \
        { const int st = t >> 4, c4 = (t & 15) * 4; const int o = (st * 64 + c4) * 4; \
          *(PG8_LAS f32x4*)(b_ + OD + o) = sd; *(PG8_LAS f32x4*)(b_ + ODC + o) = sdec; \
          *(PG8_LAS f32x4*)(b_ + OQ + o) = (f32x4){bflo(sq.x), bfhi(sq.x), bflo(sq.y), bfhi(sq.y)} * 0.125f; \
          *(PG8_LAS f32x4*)(b_ + OK + o) = (f32x4){bflo(sk.x), bfhi(sk.x), bflo(sk.y), bfhi(sk.y)}; } \
        if (t < 128) { const int st = t >> 2, c4 = (t & 3) * 4; *(PG8_LAS f32x4*)(b_ + OVR + (st * 16 + c4) * 4) = (f32x4){bflo(svr.x), bfhi(svr.x), bflo(svr.y), bfhi(svr.y)}; } \
        else if (t < 256) { const int tt = t - 128, st = tt >> 2, c4 = (tt & 3) * 4; *(PG8_LAS f32x4*)(b_ + OVG + (st * 16 + c4) * 4) = (f32x4){bflo(svr.x), bfhi(svr.x), bflo(svr.y), bfhi(svr.y)}; } } while (0)
    const bool isR = wid < 4;
    const int w4 = wid & 3;
    const int row = it.q * 16 + 4 * w4 + rsel;
    const int col = it.cgp * 16 + 4 * w4 + rsel;
    f32x4 S = (f32x4){0.f, 0.f, 0.f, 0.f}, Sn = S;
#define SC_LOAD_STATE(dst_, seg_) do { const int sg_ = (seg_); \
        if (isR) { if (!it.s0_rwkv) dst_ = (f32x4){0.f, 0.f, 0.f, 0.f}; else dst_ = *(const f32x4*)(it.s0_rwkv + (size_t)sg_ * 8 * 4096 + row * 64 + 4 * kq); } \
        else if (!it.s0_gla) dst_ = (f32x4){0.f, 0.f, 0.f, 0.f}; \
        else { const float* sp_ = it.s0_gla + (size_t)sg_ * 4 * 8192 + (size_t)(4 * kq) * 128 + col; dst_ = (f32x4){sp_[0], sp_[128], sp_[256], sp_[384]}; } } while (0)
#define SC_STORE_STATE(seg_, s_) do { const int sg_ = (seg_); \
        if (isR) { *(f32x4*)(it.so_rwkv + (size_t)sg_ * 8 * 4096 + row * 64 + 4 * kq) = s_; } \
        else { float* sp_ = it.so_gla + (size_t)sg_ * 4 * 8192 + (size_t)(4 * kq) * 128 + col; sp_[0] = s_[0]; sp_[128] = s_[1]; sp_[256] = s_[2]; sp_[384] = s_[3]; } } while (0)
    SC_GLOAD(0);
    SC_LOAD_STATE(Sn, 0);
    SC_LSTORE(0);
    __syncthreads();
    u16* oAp = obufA + (size_t)it.tok0 * 512 + it.h * 64 + row;
    u16* oBp = obufB + (size_t)it.tok0 * 512 + it.hg * 128 + col;
    const int vsl = (4 * w4 + rsel) * 4;
#define SC_STEP_R(s_, ov_) do { const int o = ((s_) * 64 + 4 * kq) * 4; \
        const f32x4 r4 = *(const PG8_LAS f32x4*)(b + OR + o), k4 = *(const PG8_LAS f32x4*)(b + OKT + o), n4 = *(const PG8_LAS f32x4*)(b + OKN + o), b4 = *(const PG8_LAS f32x4*)(b + OB + o), d4 = *(const PG8_LAS f32x4*)(b + OD + o); \
        const float v = *(const PG8_LAS float*)(b + OVR + (s_) * 64 + vsl); \
        float dot = dot4pk(S, n4); \
        dot = red16(dot); \
        S = S * d4 - b4 * dot + k4 * v; \
        float o_ = dot4pk(S, r4); \
        (ov_) = red16(o_); } while (0)
#define SC_STEP_G(s_, ov_) do { const int o = ((s_) * 64 + 4 * kq) * 4; \
        const f32x4 q4 = *(const PG8_LAS f32x4*)(b + OQ + o), k4 = *(const PG8_LAS f32x4*)(b + OK + o), d4 = *(const PG8_LAS f32x4*)(b + ODC + o); \
        const float v = *(const PG8_LAS float*)(b + OVG + (s_) * 64 + vsl); \
        S = S * d4 + k4 * v; \
        float o_ = dot4pk(S, q4); \
        (ov_) = red16(o_); } while (0)
#define SC_BLOCK(STEP_, s0_, NB_, optr_) do { float ov[NB_]; \
        _Pragma("unroll") for (int j_ = 0; j_ < (NB_); ++j_) STEP_((s0_) + j_, ov[j_]); \
        float outv = ov[0]; \
        _Pragma("unroll") for (int j_ = 1; j_ < (NB_); ++j_) outv = (kq == j_) ? ov[j_] : outv; \
        if (kq < (NB_)) (optr_)[(size_t)((s0_) + kq) * 512] = (u16)(cvt_pk_bf16(outv, 0.f) & 0xffffu); } while (0)
    for (int ch = 0; ch < nchunk; ++ch) {
        const bool more = ch + 1 < nchunk;
        if (more) SC_GLOAD(ch + 1);
        PG8_LAS unsigned char* b = lds + (ch & 1) * BUF;
        if (LSEG >= TC) {
            if (ch == 0) S = Sn;
            if (isR) {
                {
                    struct InR { f32x4 r4, k4, n4, b4, d4; float v; };
                    InR in_[TC]; float ov[8]; float op = 0.f;
#define LD_R(s_) do { const int o = ((s_) * 64 + 4 * kq) * 4; in_[s_].r4 = *(const PG8_LAS f32x4*)(b + OR + o); in_[s_].k4 = *(const PG8_LAS f32x4*)(b + OKT + o); in_[s_].n4 = *(const PG8_LAS f32x4*)(b + OKN + o); \
                        in_[s_].b4 = *(const PG8_LAS f32x4*)(b + OB + o); in_[s_].d4 = *(const PG8_LAS f32x4*)(b + OD + o); in_[s_].v = *(const PG8_LAS float*)(b + OVR + (s_) * 64 + vsl); } while (0)
#pragma unroll
                    for (int j = 0; j < SC_PD; ++j) LD_R(j);
#pragma unroll
                    for (int s = 0; s < TC; ++s) {
                        float dot = dot4pk(S, in_[s].n4);
                        dot += dppf<0xB1>(dot); op += dppf<0xB1>(op);
                        dot += dppf<0x4E>(dot); op += dppf<0x4E>(op);
                        dot += dppf<0x141>(dot); op += dppf<0x141>(op);
                        dot += dppf<0x140>(dot); op += dppf<0x140>(op);
                        if (s > 0) ov[(s - 1) & 7] = op;
                        if (s > 0 && (s & 7) == 0) { float outv = ov[0];
#pragma unroll
                            for (int j = 1; j < 8; ++j) outv = (kq == j) ? ov[j] : outv;
                            if (kq < 8) oAp[(size_t)(s - 8 + kq) * 512] = (u16)(cvt_pk_bf16(outv, 0.f) & 0xffffu); }
                        S = S * in_[s].d4 - in_[s].b4 * dot + in_[s].k4 * in_[s].v;
                        op = dot4pk(S, in_[s].r4);
                        if (s + SC_PD < TC) LD_R(s + SC_PD);
                        __builtin_amdgcn_sched_barrier(0);
                    }
                    ov[7] = red16(op);
                    { float outv = ov[0];
#pragma unroll
                      for (int j = 1; j < 8; ++j) outv = (kq == j) ? ov[j] : outv;
                      if (kq < 8) oAp[(size_t)(TC - 8 + kq) * 512] = (u16)(cvt_pk_bf16(outv, 0.f) & 0xffffu); }
#undef LD_R
                }
            } else {
                {
                    struct InG { f32x4 q4, k4, d4; float v; };
                    InG in_[TC]; float ov[8];
#define LD_G(s_) do { const int o = ((s_) * 64 + 4 * kq) * 4; in_[s_].q4 = *(const PG8_LAS f32x4*)(b + OQ + o); in_[s_].k4 = *(const PG8_LAS f32x4*)(b + OK + o); in_[s_].d4 = *(const PG8_LAS f32x4*)(b + ODC + o); \
                        in_[s_].v = *(const PG8_LAS float*)(b + OVG + (s_) * 64 + vsl); } while (0)
#pragma unroll
                    for (int j = 0; j < SC_PD; ++j) LD_G(j);
#pragma unroll
                    for (int s = 0; s < TC; ++s) {
                        S = S * in_[s].d4 + in_[s].k4 * in_[s].v;
                        float o_ = dot4pk(S, in_[s].q4);
                        ov[s & 7] = red16(o_);
                        if (s + SC_PD < TC) LD_G(s + SC_PD);
                        __builtin_amdgcn_sched_barrier(0);
                        if ((s & 7) == 7) { float outv = ov[0];
#pragma unroll
                            for (int j = 1; j < 8; ++j) outv = (kq == j) ? ov[j] : outv;
                            if (kq < 8) oBp[(size_t)((s & ~7) + kq) * 512] = (u16)(cvt_pk_bf16(outv, 0.f) & 0xffffu); }
                    }
#undef LD_G
                }
            }
            if (!more) SC_STORE_STATE(0, S);
        } else {
#pragma unroll 1
            for (int sgi = 0; sgi < TC / LSEG; ++sgi) {
                const int seg = ch * (TC / LSEG) + sgi;
                S = Sn;
                if ((seg + 1) * LSEG < it.T) SC_LOAD_STATE(Sn, seg + 1);
                if (isR) {
                    SC_BLOCK(SC_STEP_R, sgi * LSEG, (LSEG < TC ? LSEG : 1), oAp);
                } else {
                    SC_BLOCK(SC_STEP_G, sgi * LSEG, (LSEG < TC ? LSEG : 1), oBp);
                }
                SC_STORE_STATE(seg, S);
            }
        }
        oAp += (size_t)TC * 512; oBp += (size_t)TC * 512;
        if (more) SC_LSTORE((ch + 1) & 1);
        __syncthreads();
    }
#undef SC_BLOCK
#undef SC_STEP_R
#undef SC_STEP_G
}
__device__ void scan_phase(KP p, int l, PG8_LAS unsigned char* lds) {
    float* out = p->out;
    const int bid = opaque_bid();
    for (int i0_ = bid; i0_ < 256; i0_ += gridDim.x) {
        const int i = (gridDim.x == 256) ? (((i0_ & 7) << 5) | (i0_ >> 3)) : i0_;
        ScanItem it; const int s = i >> 5;
        it.tok0 = s * 2048; it.T = 2048; it.L = 2048; it.h = (i >> 2) & 7; it.q = i & 3; it.hg = (i >> 3) & 3; it.cgp = i & 7;
        it.s0_rwkv = nullptr; it.so_rwkv = out + O_RWKV_P + ((size_t)(l * 8 + s) * 8 + it.h) * 4096;
        it.s0_gla = nullptr; it.so_gla = out + O_GLA_P + ((size_t)(l * 8 + s) * 4 + it.hg) * 8192;
        scan_item<2048>(p, it, lds);
    }
    for (int i0_ = bid; i0_ < 256; i0_ += gridDim.x) {
        const int i = (gridDim.x == 256) ? (((i0_ & 7) << 5) | (i0_ >> 3)) : i0_;
        ScanItem it; const int bg = i >> 5, b0 = bg * 16;
        it.tok0 = MP + bg * 64; it.T = 64; it.L = 4; it.h = (i >> 2) & 7; it.q = i & 3; it.hg = (i >> 3) & 3; it.cgp = i & 7;
        it.s0_rwkv = p->in[I_SRWKV] + ((size_t)(l * 128 + b0) * 8 + it.h) * 4096; it.so_rwkv = out + O_RWKV_S + ((size_t)(l * 128 + b0) * 8 + it.h) * 4096;
        it.s0_gla = p->in[I_SGLA] + ((size_t)(l * 128 + b0) * 4 + it.hg) * 8192; it.so_gla = out + O_GLA_S + ((size_t)(l * 128 + b0) * 4 + it.hg) * 8192;
        scan_item<4>(p, it, lds);
    }
}

__device__ void post_phase(KP p, int l) {
    unsigned char* ws = p->ws;
    const u16* obufA = (const u16*)(ws + W_OBUFA); const u16* obufB = (const u16*)(ws + W_OBUFB); const u16* vbuf = (const u16*)(ws + W_VBUF); const u16* gbuf = (const u16*)(ws + W_GBUF);
    const float* rkb = (const float*)(ws + W_RK); const u16* projB = (const u16*)(ws + W_PROJB); u16* oab = (u16*)(ws + W_XB);
    const float* lg = p->in[I_LNXG] + l * 512; const float* lb = p->in[I_LNXB] + l * 512; const float* ng = p->in[I_NG] + l * 128;
    const int tt_ = opaque_tid();
    const int lane = tt_ & 63, gw = opaque_bid() * 8 + (tt_ >> 6), nw = gridDim.x * 8;
    const int c = lane * 8;
    float lgv[8], lbv[8], ngv[8];
#pragma unroll
    for (int j = 0; j < 8; ++j) { lgv[j] = lg[c + j]; lbv[j] = lb[c + j]; ngv[j] = ng[(c & 127) + j]; }
    for (int i = gw; i < MTOK; i += nw) {
        {
            const f32x4 o0 = ld_bf4(obufA + (size_t)i * 512 + c), o1 = ld_bf4(obufA + (size_t)i * 512 + c + 4);
            const f32x4 v0 = ld_bf4(vbuf + (size_t)i * 512 + c), v1 = ld_bf4(vbuf + (size_t)i * 512 + c + 4);
            const f32x4 g0 = ld_bf4(gbuf + (size_t)i * 512 + c), g1 = ld_bf4(gbuf + (size_t)i * 512 + c + 4);
            const float rk = rkb[(size_t)i * 8 + (lane >> 3)];
            float s = (o0[0] + o0[1]) + (o0[2] + o0[3]) + (o1[0] + o1[1]) + (o1[2] + o1[3]);
            s += __shfl_xor(s, 1); s += __shfl_xor(s, 2); s += __shfl_xor(s, 4);
            const float m = s * (1.0f / 64.0f);
            const f32x4 d0 = o0 - m, d1 = o1 - m;
            float q = (d0[0] * d0[0] + d0[1] * d0[1]) + (d0[2] * d0[2] + d0[3] * d0[3]) + (d1[0] * d1[0] + d1[1] * d1[1]) + (d1[2] * d1[2] + d1[3] * d1[3]);
            q += __shfl_xor(q, 1); q += __shfl_xor(q, 2); q += __shfl_xor(q, 4);
            const float rs = rsqrtf(q * (1.0f / 64.0f) + GN_EPS_A);
            f32x4 y0, y1;
#pragma unroll
            for (int j = 0; j < 4; ++j) { y0[j] = (d0[j] * rs * lgv[j] + lbv[j] + rk * v0[j]) * g0[j]; y1[j] = (d1[j] * rs * lgv[4 + j] + lbv[4 + j] + rk * v1[j]) * g1[j]; }
            u32x4 w; w.x = cvt_pk_bf16(y0[0], y0[1]); w.y = cvt_pk_bf16(y0[2], y0[3]); w.z = cvt_pk_bf16(y1[0], y1[1]); w.w = cvt_pk_bf16(y1[2], y1[3]);
            *(u32x4*)(oab + (size_t)i * 1024 + c) = w;
        }
        {
            const f32x4 o0 = ld_bf4(obufB + (size_t)i * 512 + c), o1 = ld_bf4(obufB + (size_t)i * 512 + c + 4);
            const f32x4 g0 = ld_bf4(projB + (size_t)i * 1792 + 1024 + c), g1 = ld_bf4(projB + (size_t)i * 1792 + 1024 + c + 4);
            float q = (o0[0] * o0[0] + o0[1] * o0[1]) + (o0[2] * o0[2] + o0[3] * o0[3]) + (o1[0] * o1[0] + o1[1] * o1[1]) + (o1[2] * o1[2] + o1[3] * o1[3]);
            q += __shfl_xor(q, 1); q += __shfl_xor(q, 2); q += __shfl_xor(q, 4); q += __shfl_xor(q, 8);
            const float rs = rsqrtf(q * (1.0f / 128.0f) + RMS_EPS);
            f32x4 y0, y1;
#pragma unroll
            for (int j = 0; j < 4; ++j) { y0[j] = o0[j] * rs * ngv[j] * (g0[j] * sigmoidf_(g0[j])); y1[j] = o1[j] * rs * ngv[4 + j] * (g1[j] * sigmoidf_(g1[j])); }
            u32x4 w; w.x = cvt_pk_bf16(y0[0], y0[1]); w.y = cvt_pk_bf16(y0[2], y0[3]); w.z = cvt_pk_bf16(y1[0], y1[1]); w.w = cvt_pk_bf16(y1[2], y1[3]);
            *(u32x4*)(oab + (size_t)i * 1024 + 512 + c) = w;
        }
    }
}

#define XB_TMO      128
#define XB_XCNT(j)  (256  + 64 * (j))
#define XB_XSUB(j)  (1280 + 64 * (j))
#define XB_XGEN(j)  (2304 + 64 * (j))
#define XB_TOP      3328
#define XB_TOPGEN   3392
#define XCD_BAR_WORDS 3456
#define XB_SPIN_CAP (1u << 18)
__device__ __forceinline__ unsigned xb_ld(unsigned* p)              { return __hip_atomic_load(p, __ATOMIC_RELAXED, __HIP_MEMORY_SCOPE_AGENT); }
__device__ __forceinline__ unsigned xb_add(unsigned* p, unsigned v) { return __hip_atomic_fetch_add(p, v, __ATOMIC_RELAXED, __HIP_MEMORY_SCOPE_AGENT); }
__device__ __forceinline__ unsigned xb_xcc_id() { return (unsigned)__builtin_amdgcn_s_getreg((3 << 11) | 20) & 0xFu; }
#define XB_SPIN(cond, bar) do { unsigned _sp = 0; while (cond) { __builtin_amdgcn_s_sleep(1); \
    if ((++_sp & 255u) == 0u) { if (xb_ld(&(bar)[XB_TMO])) break; if (_sp > XB_SPIN_CAP) { atomicAdd(&(bar)[XB_TMO], 1u); break; } } } } while (0)
__device__ __forceinline__ void xcd_barrier_complete(unsigned* bar, unsigned x, unsigned& nloc, unsigned& nx) {
    const unsigned G = gridDim.x * gridDim.y * gridDim.z;
    unsigned sum, cnt, mine, sp = 0u;
    for (;;) {
        sum = 0u; cnt = 0u; mine = 0u;
#pragma unroll
        for (unsigned j = 0; j < 16; ++j) { const unsigned c = xb_ld(&bar[XB_XCNT(j)]); sum += c; cnt += (c > 0u) ? 1u : 0u; mine = (j == x) ? c : mine; }
        if (sum == G) break;
        __builtin_amdgcn_s_sleep(1);
        if ((++sp & 255u) == 0u) { if (xb_ld(&bar[XB_TMO])) break; if (sp > XB_SPIN_CAP) { atomicAdd(&bar[XB_TMO], 1u); break; } }
    }
    nloc = mine > 0u ? mine : 1u; nx = cnt > 0u ? cnt : 1u;
}
__device__ __forceinline__ void xcd_barrier(unsigned* bar, volatile PG8_LAS unsigned* st) {
    asm volatile("s_waitcnt vmcnt(0)" ::: "memory");
    __syncthreads();
    if (threadIdx.x == 0) {
        const unsigned x = xb_xcc_id();
        __builtin_amdgcn_s_waitcnt(0);
        unsigned nloc = st[0], nx = st[1];
        if (nloc == 0u) { xcd_barrier_complete(bar, x, nloc, nx); st[0] = nloc; st[1] = nx; }
        const unsigned old = xb_add(&bar[XB_XSUB(x)], 1u);
        const unsigned gen = old / nloc;
        if (old + 1u == (gen + 1u) * nloc) {
            __builtin_amdgcn_fence(__ATOMIC_RELEASE, "agent");
            asm volatile("s_waitcnt vmcnt(0)" ::: "memory");
            const unsigned og = xb_add(&bar[XB_TOP], 1u);
            const unsigned tg = og / nx;
            if (og + 1u == (tg + 1u) * nx) xb_add(&bar[XB_TOPGEN], 1u);
            else XB_SPIN(xb_ld(&bar[XB_TOPGEN]) == tg, bar);
            __builtin_amdgcn_fence(__ATOMIC_ACQUIRE, "agent");
            xb_add(&bar[XB_XGEN(x)], 1u);
            asm volatile("s_waitcnt vmcnt(0)" ::: "memory");
        } else {
            XB_SPIN(xb_ld(&bar[XB_XGEN(x)]) == gen, bar);
            __builtin_amdgcn_fence(__ATOMIC_ACQUIRE, "agent");
            asm volatile("s_waitcnt vmcnt(0)" ::: "memory");
        }
    }
    __syncthreads();
}
__device__ __forceinline__ void gsync(cg::grid_group& grid) {
    asm volatile("s_waitcnt vmcnt(0)" ::: "memory");
    grid.sync();
    if (threadIdx.x < 64) { __builtin_amdgcn_fence(__ATOMIC_ACQUIRE, "agent"); asm volatile("s_waitcnt vmcnt(0)" ::: "memory"); }
    __syncthreads();
}

__global__ void __launch_bounds__(512, 2) mega(Params p_unused) {
    KP p = kparams();
    extern __shared__ __attribute__((aligned(16))) unsigned char smem[];
    PG8_LAS unsigned char* lds = (PG8_LAS unsigned char*)smem;
    cg::grid_group grid = cg::this_grid();
    unsigned char* ws = p->ws;
    float* bufA = p->out + O_Y; float* bufB = (float*)(ws + W_BUFB); u16* xb = (u16*)(ws + W_XB);
    pg8::StaticOrder S;
    volatile PG8_LAS unsigned* xst = (volatile PG8_LAS unsigned*)(lds + 139264);
    if (threadIdx.x == 0) { xst[0] = 0u; xst[1] = 0u; }
    gsync(grid);
    unsigned* xbar = (unsigned*)(kparams()->ws + W_BAR);
    if (threadIdx.x == 0) (void)xb_add(&xbar[XB_XCNT(xb_xcc_id())], 1u);
#define PHASE_END() xcd_barrier((unsigned*)(kparams()->ws + W_BAR), xst)
    convert_phase(kparams(), 0, (float*)smem);
    PHASE_END();
    for (int l = 0; l < NL; ++l) {
        {
            pg8::Gemm g; g.A = xb; g.Bt = (const u16*)(ws + W_WIN); g.M = MTOK; g.N = INP; g.K = 1024;
            EpiProj E; E.projA = (u16*)(ws + W_PROJA); E.projB = (u16*)(ws + W_PROJB); E.shift_p = p->out + O_SHIFT_P + (size_t)l * 8 * 1792; E.shift_s = p->out + O_SHIFT_S + (size_t)l * 128 * 1792;
            S.init(MTOK, INP, gridDim.x, opaque_bid()); pg8::gemm_phase(lds, g, S, E);
        }
        PHASE_END();
        prep_phase(kparams(), l, lds);
        PHASE_END();
        scan_phase(kparams(), l, lds);
        PHASE_END();
        post_phase(kparams(), l);
        PHASE_END();
        {
            pg8::Gemm g; g.A = xb; g.Bt = (const u16*)(ws + W_WOUT); g.M = MTOK; g.N = 1024; g.K = 1024;
            EpiResid E; E.base = (l == 0) ? p->in[I_XP] : bufA; E.out = bufB;
            g.M = MP; S.init(MP, 1024, gridDim.x, opaque_bid()); pg8::gemm_phase(lds, g, S, E);
            small_gemm_resid<false>(g.A, g.Bt, 1024, (l == 0) ? (const void*)(p->in[I_XS] - (size_t)MP * 1024) : (const void*)bufA, E.out, lds);
        }
        PHASE_END();
        ln_phase<false>(bufB, xb, p->in[I_LN1G] + l * 1024, p->in[I_LN1B] + l * 1024);
        PHASE_END();
        {
            pg8::Gemm g; g.A = xb; g.Bt = (const u16*)(ws + W_WUP); g.M = MTOK; g.N = 5632; g.K = 1024;
            EpiUp E; E.gate = (u16*)(ws + W_GATE); E.val = (u16*)(ws + W_VAL); E.conv_p = p->out + O_CONV_P + (size_t)l * 8 * 2 * DFF; E.conv_s = p->out + O_CONV_S + (size_t)l * 128 * 2 * DFF;
            S.init(MTOK, 5632, gridDim.x, opaque_bid()); pg8::gemm_phase(lds, g, S, E);
        }
        PHASE_END();
        convglu_phase((const u16*)(ws + W_GATE), (u16*)(ws + W_VAL), p->in[I_SCONV] + (size_t)l * 128 * 2 * DFF, p->in[I_CW] + (size_t)l * 3 * DFF, p->in[I_CB] + (size_t)l * DFF);
        PHASE_END();
        {
            pg8::Gemm g; g.A = (const u16*)(ws + W_VAL); g.Bt = (const u16*)(ws + W_WDOWN); g.M = MTOK; g.N = 1024; g.K = DFF;
            EpiResidB E; E.base = xb; E.out = bufA;
            g.M = MP; S.init(MP, 1024, gridDim.x, opaque_bid()); pg8::gemm_phase(lds, g, S, E);
            small_gemm_resid<true>(g.A, g.Bt, DFF, E.base, E.out, lds);
        }
        PHASE_END();
        ln_phase<true>(bufA, xb, p->in[I_LN2G] + l * 1024, p->in[I_LN2B] + l * 1024);
        if (l + 1 < NL) convert_phase(kparams(), l + 1, (float*)smem);
        PHASE_END();
    }
}

extern "C" void kernel_launch(void* const* d_in, const int* in_sizes, int n_in, void* d_out, int out_size, void* d_ws, size_t ws_size, hipStream_t stream) {
    static int grid_blocks = 0;
    if (!grid_blocks) {
        int dev = 0, cus = 0, per_cu = 0;
        (void)hipGetDevice(&dev);
        (void)hipDeviceGetAttribute(&cus, hipDeviceAttributeMultiprocessorCount, dev);
        (void)hipFuncSetAttribute((const void*)mega, hipFuncAttributeMaxDynamicSharedMemorySize, LDS_BYTES);
        (void)hipOccupancyMaxActiveBlocksPerMultiprocessor(&per_cu, (const void*)mega, 512, LDS_BYTES);
        grid_blocks = cus;
        if (n_in != 33 || (size_t)out_size != O_END || ws_size < W_TOTAL) { fprintf(stderr, "kernel_launch: unexpected sizes n_in %d out %d ws %zu (need %zu)\n", n_in, out_size, ws_size, (size_t)W_TOTAL); grid_blocks = -1; }
    }
    if (grid_blocks < 0) return;
    (void)hipMemsetAsync((unsigned char*)d_ws + W_BAR, 0, XCD_BAR_WORDS * sizeof(unsigned), stream);
    Params p{};
    for (int i = 0; i < 33; ++i) p.in[i] = (const float*)d_in[i];
    p.out = (float*)d_out; p.ws = (unsigned char*)d_ws;
    void* args[] = {&p};
    hipError_t e = hipLaunchCooperativeKernel((const void*)mega, dim3(grid_blocks), dim3(512), args, LDS_BYTES, stream);
    if (e != hipSuccess) fprintf(stderr, "cooperative launch failed: %s (grid %d)\n", hipGetErrorString(e), grid_blocks);
}
```
